# Optimizing an MI355X kernel written in HIP

```python
import math
import jax, jax.numpy as jnp
from jax import lax
import numpy as np

D_MODEL = 2048
BATCH = 4
SEQ = 4096
DEPTH = 2

GRID_W = 64
CTX_LEN = 256
EPS = 1e-6
CONV_DIM = 1024
CONV_GROUPS = 16
FOURIER_DIM = 1024
FOURIER_GROUPS = 4
FOURIER_GROUP_DIM = FOURIER_DIM // FOURIER_GROUPS
CONV_WIDTH = 3
EVEN_IN_DIM = 3 * CONV_DIM + FOURIER_DIM
EVEN_OUT_DIM = CONV_DIM + FOURIER_DIM
DIFF_HEADS = 8
DIFF_HEAD_DIM = 128
DIFF_V_DIM = 2 * DIFF_HEAD_DIM
QK_DIM = DIFF_HEADS * 2 * DIFF_HEAD_DIM
V_DIM = DIFF_HEADS * DIFF_V_DIM
ROPE_THETA = 10000.0
ROPE_FREQS = DIFF_HEAD_DIM // 4
Q_BLOCK = 128
LAMBDA_STD = 0.1
N_GROUPS = 4
EXPERTS_PER_GROUP = 4
N_EXPERTS = N_GROUPS * EXPERTS_PER_GROUP
TOP_K = 2
EXPERT_FF = 512
MOE_BLOCK = 128
MOD_SCALE = 0.5

kernel_name = "hybrid_conv_fourier_diffattn_hmoe_dit"


def rmsnorm(x, w):
    xf = x.astype(jnp.float32)
    y = xf * lax.rsqrt(jnp.mean(xf * xf, axis=-1, keepdims=True) + EPS)
    return (y * w.astype(jnp.float32)).astype(x.dtype)


def modulation(cond, w_mod, b_mod):
    m = jax.nn.silu(cond) @ w_mod + b_mod
    return jnp.split(m[..., None, :], 6, axis=-1)


def short_conv3(u, w):
    up = jnp.pad(u, ((0, 0), (1, 1), (0, 0)))
    return up[:, :-2] * w[0] + up[:, 1:-1] * w[1] + up[:, 2:] * w[2]


def conv_fourier_mixer(u, w_in, conv_w, w_out):
    b, n, _ = u.shape
    p = u @ w_in
    b_gate, c_gate, v_in, f_in = jnp.split(p, [CONV_DIM, 2 * CONV_DIM, 3 * CONV_DIM], axis=-1)
    y_conv = b_gate * short_conv3(c_gate * v_in, conv_w)
    fg = f_in.reshape(b, n, FOURIER_GROUPS, FOURIER_GROUP_DIM).astype(jnp.float32)
    y_fourier = jnp.fft.fft2(fg, axes=(1, 3), norm="ortho").real
    y_fourier = y_fourier.reshape(b, n, FOURIER_DIM).astype(u.dtype)
    return jnp.concatenate([y_conv, y_fourier], axis=-1) @ w_out


def axial_rope_tables(n_tok):
    rows = n_tok // GRID_W
    row = jnp.repeat(jnp.arange(rows, dtype=jnp.float32), GRID_W)
    col = jnp.tile(jnp.arange(GRID_W, dtype=jnp.float32), rows)
    inv_freq = ROPE_THETA ** (-jnp.arange(ROPE_FREQS, dtype=jnp.float32) / ROPE_FREQS)
    ang = jnp.stack([row, col], axis=-1)[:, :, None] * inv_freq
    return jnp.cos(ang), jnp.sin(ang)


def apply_axial_rope(x, cos, sin):
    sh = x.shape
    xr = x.reshape(sh[:-1] + (2, 2, ROPE_FREQS)).astype(jnp.float32)
    x1, x2 = xr[..., 0, :], xr[..., 1, :]
    cc = cos[None, :, None, None]
    ss = sin[None, :, None, None]
    out = jnp.stack([x1 * cc - x2 * ss, x2 * cc + x1 * ss], axis=-2)
    return out.reshape(sh).astype(x.dtype)


def diff_attend(q, k, v, lam):
    s = jnp.einsum('bqhcd,bkhcd->bhcqk', q, k).astype(jnp.float32) * (DIFF_HEAD_DIM ** -0.5)
    p = jax.nn.softmax(s, axis=-1)
    a = p[:, :, 0] - lam * p[:, :, 1]
    return jnp.einsum('bhqk,bkhe->bqhe', a.astype(v.dtype), v)


def blockwise_diff_attend(q, k, v, lam):
    b, nq = q.shape[:2]
    nb = nq // Q_BLOCK
    qb = jnp.moveaxis(q.reshape((b, nb, Q_BLOCK) + q.shape[2:]), 1, 0)
    ob = lax.map(lambda qq: diff_attend(qq, k, v, lam), qb)
    return jnp.moveaxis(ob, 0, 1).reshape((b, nq) + ob.shape[3:])


def diff_attention_mixer(u_lat, u_ctx, layer_idx, cos, sin, w_qkv, q_norm, k_norm,
                         lam_q1, lam_k1, lam_q2, lam_k2, subln_w, w_out, need_ctx):
    f32 = jnp.float32
    lam_init = 0.8 - 0.6 * math.exp(-0.3 * layer_idx)
    lam = (jnp.exp(jnp.sum(lam_q1.astype(f32) * lam_k1.astype(f32)))
           - jnp.exp(jnp.sum(lam_q2.astype(f32) * lam_k2.astype(f32))) + lam_init)
    w_q, w_kv = w_qkv[:, :QK_DIM], w_qkv[:, QK_DIM:]

    def split_qk(t, gain):
        b, n, _ = t.shape
        return rmsnorm(t.reshape(b, n, DIFF_HEADS, 2, DIFF_HEAD_DIM), gain)

    def keys_values(u):
        b, n, _ = u.shape
        kv = u @ w_kv
        return split_qk(kv[..., :QK_DIM], k_norm), kv[..., QK_DIM:].reshape(b, n, DIFF_HEADS, DIFF_V_DIM)

    def merge(o):
        b, n = o.shape[:2]
        o = rmsnorm(o, subln_w) * (1.0 - lam_init)
        return o.reshape(b, n, V_DIM) @ w_out

    k_ctx, v_ctx = keys_values(u_ctx)
    k_lat, v_lat = keys_values(u_lat)
    k_lat = apply_axial_rope(k_lat, cos, sin)
    q_lat = apply_axial_rope(split_qk(u_lat @ w_q, q_norm), cos, sin)
    k_all = jnp.concatenate([k_ctx, k_lat], axis=1)
    v_all = jnp.concatenate([v_ctx, v_lat], axis=1)
    out_lat = merge(blockwise_diff_attend(q_lat, k_all, v_all, lam))
    if need_ctx:
        q_ctx = split_qk(u_ctx @ w_q, q_norm)
        out_ctx = merge(diff_attend(q_ctx, k_ctx, v_ctx, lam))
    else:
        out_ctx = None
    return out_lat, out_ctx


def hier_moe(h, w_rg, b_rg, w_re, b_re, w_gate, w_up, w_down):
    f32 = jnp.float32
    n, d = h.shape
    g_logits = (h @ w_rg).astype(f32) + b_rg.astype(f32)
    g_idx = jnp.argmax(g_logits, axis=-1)
    g_w = jnp.max(jax.nn.softmax(g_logits, axis=-1), axis=-1)
    e_logits = ((h @ w_re).astype(f32) + b_re.astype(f32)).reshape(n, N_GROUPS, EXPERTS_PER_GROUP)
    e_sel = e_logits[jnp.arange(n), g_idx]
    top_v, top_i = lax.top_k(e_sel, TOP_K)
    top_w = jax.nn.softmax(top_v, axis=-1) * g_w[:, None]
    expert = (g_idx[:, None] * EXPERTS_PER_GROUP + top_i).reshape(-1).astype(jnp.int32)
    token = jnp.repeat(jnp.arange(n, dtype=jnp.int32), TOP_K)
    weight = top_w.reshape(-1)
    n_assign = n * TOP_K
    n_blocks = -(-n_assign // MOE_BLOCK) + N_EXPERTS
    n_rows = n_blocks * MOE_BLOCK
    counts = jnp.zeros((N_EXPERTS,), jnp.int32).at[expert].add(1)
    blocks_per = (counts + MOE_BLOCK - 1) // MOE_BLOCK
    block_end = jnp.cumsum(blocks_per)
    row_start = (block_end - blocks_per) * MOE_BLOCK
    assign_start = jnp.cumsum(counts) - counts
    order = jnp.argsort(expert)
    e_sorted = expert[order]
    dest = row_start[e_sorted] + (jnp.arange(n_assign, dtype=jnp.int32) - assign_start[e_sorted])
    row_token = jnp.zeros((n_rows,), jnp.int32).at[dest].set(token[order])
    row_weight = jnp.zeros((n_rows,), f32).at[dest].set(weight[order])
    block_expert = jnp.minimum(jnp.searchsorted(block_end, jnp.arange(n_blocks, dtype=jnp.int32), side='right'),
                               N_EXPERTS - 1)

    def run_block(args):
        tok_b, w_b, e_b = args
        xb = h[tok_b]
        yb = (jax.nn.silu(xb @ w_gate[e_b]) * (xb @ w_up[e_b])) @ w_down[e_b]
        return yb * w_b[:, None].astype(yb.dtype)

    y_rows = lax.map(run_block, (row_token.reshape(n_blocks, MOE_BLOCK),
                                 row_weight.reshape(n_blocks, MOE_BLOCK), block_expert))
    return jnp.zeros_like(h).at[row_token].add(y_rows.reshape(n_rows, d))


def setup_inputs(seed: int = 0) -> dict:
    key = jax.random.key(seed)
    ks = jax.random.split(key, 32)
    D = D_MODEL
    n_even = (DEPTH + 1) // 2
    n_odd = DEPTH // 2
    f32 = jnp.float32

    def nrm(k, shape, std):
        return jax.random.normal(k, shape, f32) * std

    return {
        "x": nrm(ks[0], (BATCH, SEQ, D), 1.0),
        "c": nrm(ks[1], (BATCH, D), 1.0),
        "ctx": nrm(ks[2], (BATCH, CTX_LEN, D), 1.0),
        "c_ctx": nrm(ks[3], (D,), 1.0),
        "norm1_w": 1.0 + nrm(ks[4], (DEPTH, D), 0.02),
        "norm2_w": 1.0 + nrm(ks[5], (DEPTH, D), 0.02),
        "w_mod": nrm(ks[6], (DEPTH, D, 6 * D), MOD_SCALE * D ** -0.5),
        "b_mod": nrm(ks[7], (DEPTH, 6 * D), 0.02),
        "even_w_in": nrm(ks[8], (n_even, D, EVEN_IN_DIM), D ** -0.5),
        "even_conv_w": nrm(ks[9], (n_even, CONV_WIDTH, CONV_DIM), CONV_WIDTH ** -0.5),
        "even_w_out": nrm(ks[10], (n_even, EVEN_OUT_DIM, D), EVEN_OUT_DIM ** -0.5),
        "odd_w_qkv": nrm(ks[11], (n_odd, D, 2 * QK_DIM + V_DIM), D ** -0.5),
        "odd_q_norm": 1.0 + nrm(ks[12], (n_odd, DIFF_HEAD_DIM), 0.02),
        "odd_k_norm": 1.0 + nrm(ks[13], (n_odd, DIFF_HEAD_DIM), 0.02),
        "odd_lambda_q1": nrm(ks[14], (n_odd, DIFF_HEAD_DIM), LAMBDA_STD),
        "odd_lambda_k1": nrm(ks[15], (n_odd, DIFF_HEAD_DIM), LAMBDA_STD),
        "odd_lambda_q2": nrm(ks[16], (n_odd, DIFF_HEAD_DIM), LAMBDA_STD),
        "odd_lambda_k2": nrm(ks[17], (n_odd, DIFF_HEAD_DIM), LAMBDA_STD),
        "odd_subln_w": 1.0 + nrm(ks[18], (n_odd, DIFF_V_DIM), 0.02),
        "odd_w_out": nrm(ks[19], (n_odd, V_DIM, D), V_DIM ** -0.5),
        "moe_w_group": nrm(ks[20], (DEPTH, D, N_GROUPS), D ** -0.5),
        "moe_b_group": nrm(ks[21], (DEPTH, N_GROUPS), 0.01),
        "moe_w_expert": nrm(ks[22], (DEPTH, D, N_EXPERTS), D ** -0.5),
        "moe_b_expert": nrm(ks[23], (DEPTH, N_EXPERTS), 0.01),
        "moe_w_gate": nrm(ks[24], (DEPTH, N_EXPERTS, D, EXPERT_FF), D ** -0.5),
        "moe_w_up": nrm(ks[25], (DEPTH, N_EXPERTS, D, EXPERT_FF), D ** -0.5),
        "moe_w_down": nrm(ks[26], (DEPTH, N_EXPERTS, EXPERT_FF, D), EXPERT_FF ** -0.5),
    }


def reference(x, c, ctx, c_ctx, norm1_w, norm2_w, w_mod, b_mod,
              even_w_in, even_conv_w, even_w_out,
              odd_w_qkv, odd_q_norm, odd_k_norm, odd_lambda_q1, odd_lambda_k1,
              odd_lambda_q2, odd_lambda_k2, odd_subln_w, odd_w_out,
              moe_w_group, moe_b_group, moe_w_expert, moe_b_expert,
              moe_w_gate, moe_w_up, moe_w_down):
    bsz, n_lat, d = x.shape
    n_ctx = ctx.shape[1]
    cos, sin = axial_rope_tables(n_lat)
    h_lat, h_ctx = x, ctx
    for l in range(DEPTH):
        last = l == DEPTH - 1
        i = l // 2
        sh1, sc1, g1, sh2, sc2, g2 = modulation(c, w_mod[l], b_mod[l])
        csh1, csc1, cg1, csh2, csc2, cg2 = modulation(c_ctx, w_mod[l], b_mod[l])
        u_lat = rmsnorm(h_lat, norm1_w[l]) * (1.0 + sc1) + sh1
        u_ctx = rmsnorm(h_ctx, norm1_w[l]) * (1.0 + csc1) + csh1
        if l % 2 == 0:
            m_lat = conv_fourier_mixer(u_lat, even_w_in[i], even_conv_w[i], even_w_out[i])
            m_ctx = None if last else conv_fourier_mixer(u_ctx, even_w_in[i], even_conv_w[i], even_w_out[i])
        else:
            m_lat, m_ctx = diff_attention_mixer(
                u_lat, u_ctx, l, cos, sin, odd_w_qkv[i], odd_q_norm[i], odd_k_norm[i],
                odd_lambda_q1[i], odd_lambda_k1[i], odd_lambda_q2[i], odd_lambda_k2[i],
                odd_subln_w[i], odd_w_out[i], not last)
        h_lat = h_lat + g1 * m_lat
        v_lat = rmsnorm(h_lat, norm2_w[l]) * (1.0 + sc2) + sh2
        moe_args = (moe_w_group[l], moe_b_group[l], moe_w_expert[l], moe_b_expert[l],
                    moe_w_gate[l], moe_w_up[l], moe_w_down[l])
        if last:
            y_lat = hier_moe(v_lat.reshape(-1, d), *moe_args)
            h_lat = h_lat + g2 * y_lat.reshape(bsz, n_lat, d)
        else:
            h_ctx = h_ctx + cg1 * m_ctx
            v_ctx = rmsnorm(h_ctx, norm2_w[l]) * (1.0 + csc2) + csh2
            tokens = jnp.concatenate([v_lat.reshape(-1, d), v_ctx.reshape(-1, d)], axis=0)
            y = hier_moe(tokens, *moe_args)
            y_lat = y[:bsz * n_lat].reshape(bsz, n_lat, d)
            y_ctx = y[bsz * n_lat:].reshape(bsz, n_ctx, d)
            h_lat = h_lat + g2 * y_lat
            h_ctx = h_ctx + cg2 * y_ctx
    return h_lat
```

```cpp
#include <hip/hip_runtime.h>
#include <hip/hip_cooperative_groups.h>
#include <cstdio>
#include <cstdint>
namespace cg = cooperative_groups;

#define LAS __attribute__((address_space(3)))
typedef unsigned short bf16_t;
typedef short bf16x8 __attribute__((ext_vector_type(8)));
typedef short s16x4 __attribute__((ext_vector_type(4)));
typedef float f32x2 __attribute__((ext_vector_type(2)));
typedef float f32x4 __attribute__((ext_vector_type(4)));
typedef float f32x8 __attribute__((ext_vector_type(8)));
typedef float f32x16 __attribute__((ext_vector_type(16)));
typedef unsigned u32x2 __attribute__((ext_vector_type(2)));
typedef unsigned u32x4 __attribute__((ext_vector_type(4)));

constexpr int DM = 2048, NB = 4, SEQ = 4096, CTX = 256, TPB = SEQ + CTX  ;
constexpr int NTOK = NB * TPB  , NLAT = NB * SEQ  ;
constexpr int NEXP = 16, EFF = 512, LCAP = 2 * NTOK  ;
constexpr float EPS = 1e-6f;
constexpr int NWAVES = 8, NTHREADS = 512;
constexpr int LDS_BYTES = 155648;
constexpr int RING_BYTES = 131072;

constexpr size_t MiB = 1u << 20;
constexpr size_t WS_CTL = 0, WS_MOD = 1 * MiB, WS_TOKW = 2 * MiB, WS_LIST = 3 * MiB;
constexpr size_t WS_WIN = 6 * MiB, WS_WOUT0 = 26 * MiB, WS_WQKV = 34 * MiB, WS_WOUT1 = 58 * MiB, WS_WGU = 66 * MiB, WS_WD = 130 * MiB;
constexpr size_t WS_CMAT = 162 * MiB, WS_CMATC = 226 * MiB, WS_HID = 162 * MiB  ;
constexpr size_t WS_H = 227 * MiB, WS_U = 363 * MiB;
constexpr size_t WS_P = 431 * MiB, WS_ZTL = 533 * MiB, WS_ZTC = 597 * MiB, WS_YCAT = 601 * MiB;
constexpr size_t WS_Q = 431 * MiB, WS_K = 499 * MiB, WS_V = 567 * MiB, WS_A = 431 * MiB;
static_assert(WS_V - WS_K == WS_K - WS_Q, "QKV spacing");
constexpr size_t WS_Y = 669 * MiB, WS_O = 669 * MiB, WS_END = 805 * MiB;
constexpr int MODSZ = 6 * DM;

__device__ __forceinline__ unsigned f2bf(float f) { unsigned u = __builtin_bit_cast(unsigned, f); return (u + 0x7fffu + ((u >> 16) & 1u)) >> 16; }
__device__ __forceinline__ unsigned pk2(float lo, float hi) { return f2bf(lo) | (f2bf(hi) << 16); }
__device__ __forceinline__ float bflo(unsigned w) { return __uint_as_float(w << 16); }
__device__ __forceinline__ float bfhi(unsigned w) { return __uint_as_float(w & 0xffff0000u); }
__device__ __forceinline__ unsigned cvt_pk_bf16(float lo, float hi) { unsigned r; asm volatile("v_cvt_pk_bf16_f32 %0, %1, %2" : "=v"(r) : "v"(lo), "v"(hi)); return r; }
__device__ __forceinline__ float wave_sum(float v) {
#pragma unroll
    for (int o = 1; o < 64; o <<= 1) v += __shfl_xor(v, o);
    return v;
}
__device__ __forceinline__ float silu_f(float x) { return x * __builtin_amdgcn_rcpf(1.0f + __expf(-x)); }

namespace pg8 {
constexpr int BM = 256, BK = 64, HALF = 128, HTB = HALF * BK * 2, STAGE_BYTES = 8 * HTB, NXCD = 8, WGM = 8;
__host__ __device__ __forceinline__ int lds_byte(int r, int c) { const int st = (r >> 4) * 2 + (c >> 5), rr = r & 15, cc = c & 31, ob = rr * 64 + cc * 2; return st * 1024 + (ob ^ (((ob >> 9) & 1) << 5)); }
__host__ __device__ __forceinline__ void stage_rc(int b, int& R, int& C) { const int st = b / 1024, sb = b % 1024, swz = sb ^ (((sb >> 9) & 1) << 5); R = (st >> 1) * 16 + swz / 64; C = (st & 1) * 32 + (swz % 64) / 2; }
__host__ __device__ __forceinline__ int perm32(int rho) { const int n = rho >> 4, i = rho & 15; return 8 * (i >> 2) + 4 * n + (i & 3); }

struct GUnit {
    const char* A; const char* B; unsigned lda, ldb; int nt;
    char* O; int ldc; float scale;
    const char* src; const float* gate;
    const int* glist; int gcount;
    int aux;
};
__device__ __forceinline__ void tile_of(int L, int nM, int nN, int& pm, int& pn) {
    const int nwg = nM * nN; int wgid = L;
    { const int q = nwg / NXCD, r = nwg % NXCD, xcd = wgid % NXCD, off = wgid / NXCD; wgid = (xcd < r ? xcd * (q + 1) : r * (q + 1) + (xcd - r) * q) + off; }
    const int nig = WGM * nN, gid = wgid / nig, fm = gid * WGM, gsz = (nM - fm) < WGM ? (nM - fm) : WGM;
    pm = fm + ((wgid % nig) % gsz); pn = (wgid % nig) / gsz;
}
__device__ __forceinline__ int xcd_remap(int L, int nwg) {
    const int q = nwg / NXCD, r = nwg % NXCD, xcd = L % NXCD, off = L / NXCD; return (xcd < r ? xcd * (q + 1) : r * (q + 1) + (xcd - r) * q) + off;
}

struct EpiStore {
    __device__ __forceinline__ void operator()(const f32x4 (&acc)[2][2][4][2], const GUnit& u, int wr, int wc, int fr, int fq) const {
        const float sc = u.scale;
#pragma unroll
        for (int ai = 0; ai < 2; ++ai)
#pragma unroll
            for (int m = 0; m < 4; ++m) { bf16_t* rowp = (bf16_t*)u.O + (size_t)(ai * HALF + wr * 64 + m * 16 + fr) * u.ldc + wc * 32 + 8 * fq;
#pragma unroll
                for (int bj = 0; bj < 2; ++bj) { const f32x4 v0 = acc[ai][bj][m][0] * sc, v1 = acc[ai][bj][m][1] * sc;
                    u32x4 w; w.x = cvt_pk_bf16(v0[0], v0[1]); w.y = cvt_pk_bf16(v0[2], v0[3]); w.z = cvt_pk_bf16(v1[0], v1[1]); w.w = cvt_pk_bf16(v1[2], v1[3]);
                    *(u32x4*)(rowp + bj * HALF) = w; } }
    }
};
struct EpiSwiGLU {
    __device__ __forceinline__ void operator()(const f32x4 (&acc)[2][2][4][2], const GUnit& u, int wr, int wc, int fr, int fq) const {
#pragma unroll
        for (int ai = 0; ai < 2; ++ai)
#pragma unroll
            for (int m = 0; m < 4; ++m) { bf16_t* rowp = (bf16_t*)u.O + (size_t)(ai * HALF + wr * 64 + m * 16 + fr) * u.ldc + wc * 32 + 8 * fq;
                float h[8];
#pragma unroll
                for (int n = 0; n < 2; ++n)
#pragma unroll
                    for (int i = 0; i < 4; ++i) h[4 * n + i] = silu_f(acc[ai][0][m][n][i]) * acc[ai][1][m][n][i];
                u32x4 w; w.x = cvt_pk_bf16(h[0], h[1]); w.y = cvt_pk_bf16(h[2], h[3]); w.z = cvt_pk_bf16(h[4], h[5]); w.w = cvt_pk_bf16(h[6], h[7]);
                *(u32x4*)rowp = w; }
    }
};
struct EpiScatter {
    bf16_t* Y; const float* tokw;
    __device__ __forceinline__ void operator()(const f32x4 (&acc)[2][2][4][2], const GUnit& u, int wr, int wc, int fr, int fq) const {
#pragma unroll
        for (int ai = 0; ai < 2; ++ai)
#pragma unroll
            for (int m = 0; m < 4; ++m) { const int r = ai * HALF + wr * 64 + m * 16 + fr;
                if (r < u.gcount) { const int a = u.glist[r]; const float sc = tokw[a];
                    bf16_t* rowp = Y + (size_t)a * DM + u.aux * 256 + wc * 32 + 8 * fq;
#pragma unroll
                    for (int bj = 0; bj < 2; ++bj) { const f32x4 v0 = acc[ai][bj][m][0] * sc, v1 = acc[ai][bj][m][1] * sc;
                        u32x4 w; w.x = cvt_pk_bf16(v0[0], v0[1]); w.y = cvt_pk_bf16(v0[2], v0[3]); w.z = cvt_pk_bf16(v1[0], v1[1]); w.w = cvt_pk_bf16(v1[2], v1[3]);
                        *(u32x4*)(rowp + bj * HALF) = w; } } }
    }
};
struct EpiResid {
    __device__ __forceinline__ void operator()(const f32x4 (&acc)[2][2][4][2], const GUnit& u, int wr, int wc, int fr, int fq) const {
        f32x4 g[2][2];
#pragma unroll
        for (int bj = 0; bj < 2; ++bj)
#pragma unroll
            for (int n = 0; n < 2; ++n) g[bj][n] = *(const f32x4*)(u.gate + bj * HALF + wc * 32 + 8 * fq + 4 * n);
#pragma unroll
        for (int ai = 0; ai < 2; ++ai)
#pragma unroll
            for (int m = 0; m < 4; ++m) { const size_t off = (size_t)(ai * HALF + wr * 64 + m * 16 + fr) * DM + wc * 32 + 8 * fq;
#pragma unroll
                for (int bj = 0; bj < 2; ++bj)
#pragma unroll
                    for (int n = 0; n < 2; ++n) { const f32x4 s = *(const f32x4*)((const float*)u.src + off + bj * HALF + 4 * n);
                        *(f32x4*)((float*)u.O + off + bj * HALF + 4 * n) = s + g[bj][n] * acc[ai][bj][m][n]; } }
    }
};

template <bool GATHER>
__device__ __forceinline__ void mkvoff(const GUnit& u, unsigned (&vA)[2][2], unsigned (&vB)[2][2]) {
    int tid = threadIdx.x; asm volatile("" : "+v"(tid));
    int R0, C0, R1, C1; stage_rc(tid * 16, R0, C0); stage_rc(tid * 16 + 8192, R1, C1);
    const int Rb0 = (R0 & ~31) + perm32(R0 & 31), Rb1 = (R1 & ~31) + perm32(R1 & 31);
#pragma unroll
    for (int h = 0; h < 2; ++h) {
        if constexpr (GATHER) {
            const int r0 = h * HALF + R0, r1 = h * HALF + R1;
            const int t0 = (r0 < u.gcount) ? (u.glist[r0] >> 1) : 0, t1 = (r1 < u.gcount) ? (u.glist[r1] >> 1) : 0;
            vA[h][0] = (unsigned)t0 * u.lda + (unsigned)C0 * 2u; vA[h][1] = (unsigned)t1 * u.lda + (unsigned)C1 * 2u;
        } else {
            vA[h][0] = (unsigned)(h * HALF + R0) * u.lda + (unsigned)C0 * 2u; vA[h][1] = (unsigned)(h * HALF + R1) * u.lda + (unsigned)C1 * 2u;
        }
        vB[h][0] = (unsigned)(h * HALF + Rb0) * u.ldb + (unsigned)C0 * 2u; vB[h][1] = (unsigned)(h * HALF + Rb1) * u.ldb + (unsigned)C1 * 2u;
    }
}

template <class Sched, class Epi, bool GATHER>
__device__ __forceinline__ void gemm_phase(LAS unsigned char* lds, const Sched& S, const Epi& E) {
    int tid = threadIdx.x; asm volatile("" : "+v"(tid));
    const int wid = __builtin_amdgcn_readfirstlane(tid >> 6), lane = tid & 63, wr = wid >> 2, wc = wid & 3, fr = lane & 15, fq = lane >> 4;
    const size_t kstep = (size_t)(BK * 2);
    const unsigned ldsw = (unsigned)wid * 1024u;
    const int aoff = lds_byte(wr * 64 + fr, fq * 8), boff = lds_byte(wc * 32 + fr, fq * 8);
#define PG8_SA(b, h) (((b) * 2 + (h)) * HTB)
#define PG8_SB(b, h) ((4 + (b) * 2 + (h)) * HTB)
#define PG8_STAGE(bufoff, gbase, voff) do { _Pragma("unroll") for (int _i = 0; _i < 2; ++_i) \
        __builtin_amdgcn_global_load_lds((const unsigned*)((const char*)(gbase) + (voff)[_i]), (LAS unsigned*)(lds + (bufoff) + ldsw + _i * 8192), 16, 0, 0); } while (0)
#define PG8_LDA(dst, b, h) do { _Pragma("unroll") for (int m = 0; m < 4; ++m) _Pragma("unroll") for (int k = 0; k < 2; ++k) dst[m][k] = *(const LAS bf16x8*)(lds + PG8_SA(b, h) + aoff + m * 2048 + k * 1024); } while (0)
#define PG8_LDB(dst, b, h) do { _Pragma("unroll") for (int n = 0; n < 2; ++n) _Pragma("unroll") for (int k = 0; k < 2; ++k) dst[n][k] = *(const LAS bf16x8*)(lds + PG8_SB(b, h) + boff + n * 2048 + k * 1024); } while (0)
#define PG8_MMA(ai, bj, At, Bt) do { __builtin_amdgcn_s_setprio(1); _Pragma("unroll") for (int m = 0; m < 4; ++m) _Pragma("unroll") for (int n = 0; n < 2; ++n) _Pragma("unroll") for (int k = 0; k < 2; ++k) \
        acc[ai][bj][m][n] = __builtin_amdgcn_mfma_f32_16x16x32_bf16(Bt[n][k], At[m][k], acc[ai][bj][m][n], 0, 0, 0); __builtin_amdgcn_s_setprio(0); } while (0)
#define PG8_WAIT_V(n) asm volatile("s_waitcnt vmcnt(" #n ")" ::: "memory")
#define PG8_WAIT_L(n) asm volatile("s_waitcnt lgkmcnt(" #n ")" ::: "memory")
#define PG8_BAR __builtin_amdgcn_s_barrier()
#define PG8_SCHED __builtin_amdgcn_sched_barrier(0)
    GUnit cur, nxt; int ui = 0;
    if (!S.next(0, cur)) return;
    unsigned vA[2][2], vB[2][2];
    mkvoff<GATHER>(cur, vA, vB);
    f32x4 acc[2][2][4][2];
#pragma unroll
    for (int a = 0; a < 2; ++a)
#pragma unroll
        for (int b = 0; b < 2; ++b)
#pragma unroll
            for (int m = 0; m < 4; ++m)
#pragma unroll
                for (int n = 0; n < 2; ++n) acc[a][b][m][n] = (f32x4){0.f, 0.f, 0.f, 0.f};
    bf16x8 At[4][2], B0[2][2], B1[2][2];
    const char* cA = cur.A; const char* cB = cur.B;
    PG8_STAGE(PG8_SB(0, 0), cB, vB[0]); PG8_STAGE(PG8_SB(0, 1), cB, vB[1]); PG8_STAGE(PG8_SA(0, 0), cA, vA[0]); PG8_STAGE(PG8_SA(0, 1), cA, vA[1]);
    if (wr == 1) PG8_BAR;
    PG8_WAIT_V(2); PG8_BAR;
    PG8_STAGE(PG8_SB(1, 0), cB + kstep, vB[0]); PG8_STAGE(PG8_SA(1, 0), cA + kstep, vA[0]); PG8_STAGE(PG8_SB(1, 1), cB + kstep, vB[1]);
    PG8_WAIT_V(6); PG8_BAR;
    for (;;) {
        const bool has_next = S.next(ui + 1, nxt);
        const char* nA = has_next ? nxt.A : cA; const char* nB = has_next ? nxt.B : cB;
        const int nt = cur.nt;
        for (int t = 0; t < nt; t += 2) {
            const bool last = (t == nt - 2);
            const char* a1 = cA + (size_t)(t + 1) * kstep;
            const char* a2 = last ? nA : cA + (size_t)(t + 2) * kstep; const char* b2 = last ? nB : cB + (size_t)(t + 2) * kstep;
            const char* a3 = a2 + kstep; const char* b3 = b2 + kstep;
            PG8_LDB(B0, 0, 0); PG8_LDB(B1, 0, 1); PG8_SCHED; PG8_LDA(At, 0, 0); PG8_STAGE(PG8_SA(1, 1), a1, vA[1]);
            if (last && has_next) mkvoff<GATHER>(nxt, vA, vB);
            PG8_WAIT_V(8); PG8_WAIT_L(0); PG8_BAR; PG8_MMA(0, 0, At, B0); PG8_MMA(0, 1, At, B1); PG8_BAR; PG8_SCHED;
            PG8_LDA(At, 0, 1); PG8_STAGE(PG8_SB(0, 0), b2, vB[0]); PG8_STAGE(PG8_SB(0, 1), b2, vB[1]); PG8_STAGE(PG8_SA(0, 0), a2, vA[0]);
            PG8_WAIT_V(8); PG8_WAIT_L(0); PG8_BAR; PG8_MMA(1, 0, At, B0); PG8_MMA(1, 1, At, B1); PG8_BAR; PG8_SCHED;
            PG8_LDB(B0, 1, 0); PG8_LDB(B1, 1, 1); PG8_SCHED; PG8_LDA(At, 1, 0); PG8_STAGE(PG8_SA(0, 1), a2, vA[1]);
            PG8_WAIT_V(8); PG8_WAIT_L(0); PG8_BAR; PG8_MMA(0, 0, At, B0); PG8_MMA(0, 1, At, B1); PG8_BAR; PG8_SCHED;
            PG8_LDA(At, 1, 1); PG8_STAGE(PG8_SB(1, 0), b3, vB[0]); PG8_STAGE(PG8_SB(1, 1), b3, vB[1]); PG8_STAGE(PG8_SA(1, 0), a3, vA[0]);
            PG8_WAIT_V(8); PG8_WAIT_L(0); PG8_BAR; PG8_MMA(1, 0, At, B0); PG8_MMA(1, 1, At, B1); PG8_BAR; PG8_SCHED;
        }
        if (wr == 0) PG8_BAR;
        E(acc, cur, wr, wc, fr, fq);
        if (!has_next) break;
#pragma unroll
        for (int a = 0; a < 2; ++a)
#pragma unroll
            for (int b = 0; b < 2; ++b)
#pragma unroll
                for (int m = 0; m < 4; ++m)
#pragma unroll
                    for (int n = 0; n < 2; ++n) acc[a][b][m][n] = (f32x4){0.f, 0.f, 0.f, 0.f};
        cur = nxt; cA = nA; cB = nB; ++ui;
        if (wr == 1) PG8_BAR;
    }
    PG8_WAIT_V(0);
    PG8_BAR;
#undef PG8_SA
#undef PG8_SB
#undef PG8_STAGE
#undef PG8_LDA
#undef PG8_LDB
#undef PG8_MMA
#undef PG8_WAIT_V
#undef PG8_WAIT_L
#undef PG8_BAR
#undef PG8_SCHED
}
}
using pg8::GUnit;

namespace att {
constexpr int D = 128, NW = 8, QBLK = 32, KVBLK = 64;
constexpr float SCALE = 0.088388347648318440f;
constexpr float THR = 8.f;
constexpr int LDQ = DM, LDK = DM, LDO = 2 * DM;
constexpr size_t SHM_V = KVBLK * D * 2, SHM_K = KVBLK * D * 2, SHM_ATTN = 2 * SHM_V + 2 * SHM_K + NW * 64 * 4;
#define KSWZ(row, colB) ((row) * 256 + ((colB) ^ (((row) & 7) << 4)))
#define SBAR() __builtin_amdgcn_sched_barrier(0)
__device__ __forceinline__ int crow(int r, int hi) { return (r & 3) + 8 * (r >> 2) + 4 * hi; }
__device__ __forceinline__ unsigned cvtpk(float lo, float hi) { unsigned r; asm volatile("v_cvt_pk_bf16_f32 %0, %1, %2" : "=v"(r) : "v"(lo), "v"(hi)); return r; }
__device__ __forceinline__ void partialSM(f32x16& p0, f32x16& p1, float& m_reg, float& mn, float& alpha) {
  constexpr float C = SCALE * 1.4426950408889634f;
  float pmax = p0[0]; for (int r = 1; r < 16; ++r) pmax = fmaxf(pmax, p0[r]); for (int r = 0; r < 16; ++r) pmax = fmaxf(pmax, p1[r]);
  { auto rr = __builtin_amdgcn_permlane32_swap(__float_as_uint(pmax), __float_as_uint(pmax), false, false);
    pmax = fmaxf(__uint_as_float(rr[0]), __uint_as_float(rr[1])); }
  if (__builtin_expect(__all(pmax - m_reg <= THR / SCALE), 1)) { mn = m_reg; alpha = 1.f; }
  else { mn = fmaxf(m_reg, pmax); alpha = __builtin_amdgcn_exp2f((m_reg - mn) * C); m_reg = mn; }
  float mnC = -mn * C;
  for (int r = 0; r < 16; ++r) p0[r] = fmaf(p0[r], C, mnC); for (int r = 0; r < 16; ++r) p1[r] = fmaf(p1[r], C, mnC);
  for (int r = 0; r < 16; ++r) p0[r] = __builtin_amdgcn_exp2f(p0[r]);
}
__device__ __forceinline__ void finishSM(f32x16& p0, f32x16& p1, float alpha, float& l_reg, bf16x8& pa0, bf16x8& pa1, bf16x8& pa2, bf16x8& pa3) {
  for (int r = 0; r < 16; ++r) p1[r] = __builtin_amdgcn_exp2f(p1[r]);
  float ps = 0; for (int r = 0; r < 16; ++r) ps += p0[r]; for (int r = 0; r < 16; ++r) ps += p1[r];
  { auto rr = __builtin_amdgcn_permlane32_swap(__float_as_uint(ps), __float_as_uint(ps), false, false);
    ps = __uint_as_float(rr[0]) + __uint_as_float(rr[1]); }
  l_reg = l_reg * alpha + ps;
#define PK4(P, BASE, OUT) do { unsigned a0 = cvtpk(P[BASE + 0], P[BASE + 1]), a1 = cvtpk(P[BASE + 2], P[BASE + 3]);   \
    unsigned b0 = cvtpk(P[BASE + 4], P[BASE + 5]), b1 = cvtpk(P[BASE + 6], P[BASE + 7]);                              \
    auto r0 = __builtin_amdgcn_permlane32_swap(a0, b0, false, false); auto r1 = __builtin_amdgcn_permlane32_swap(a1, b1, false, false); \
    u32x4 w = {r0[0], r1[0], r0[1], r1[1]}; OUT = *reinterpret_cast<bf16x8*>(&w); } while (0)
  PK4(p0, 0, pa0); PK4(p0, 8, pa1); PK4(p1, 0, pa2); PK4(p1, 8, pa3);
#undef PK4
}
__device__ __forceinline__ void qkt(f32x16& p0, f32x16& p1, const bf16_t* Ks, const bf16x8* qr, int r32, int hi) {
  p0 = f32x16{}; p1 = f32x16{};
  for (int d0 = 0; d0 < 8; ++d0) { int cb = (d0 * 16 + hi * 8) * 2;
    bf16x8 b0 = *reinterpret_cast<const bf16x8*>((const char*)Ks + KSWZ(r32, cb));
    bf16x8 b1 = *reinterpret_cast<const bf16x8*>((const char*)Ks + KSWZ(32 + r32, cb));
    p0 = __builtin_amdgcn_mfma_f32_32x32x16_bf16(b0, qr[d0], p0, 0, 0, 0);
    p1 = __builtin_amdgcn_mfma_f32_32x32x16_bf16(b1, qr[d0], p1, 0, 0, 0); }
}
__device__ __forceinline__ int v_st(int k, int c) { const int kk = (k & ~0xC) | ((k & 4) << 1) | ((k & 8) >> 1); return ((kk >> 3) * 4 + (c >> 5)) * 512 + ((kk & 7) * 32 + (c & 31)) * 2; }
__device__ __forceinline__ int v_rd_base(int lane) { return ((lane & 3) << 3) | (((lane >> 2) & 3) << 6) | (((lane >> 4) & 1) << 5) | (((lane >> 5) & 1) << 8); }
constexpr int v_rd_off(int d0, int ks, int half) { return d0 * 512 + ks * 4096 + half * 2048; }
template <int OFF> __device__ __forceinline__ s16x4 tr_read(int vb) {
  s16x4 r; asm volatile("ds_read_b64_tr_b16 %0, %1 offset:%2" : "=&v"(r) : "v"(vb), "i"(OFF) : "memory"); return r;
}
template <int D0> __device__ __forceinline__ void pv_one(f32x16& od, int vb, bf16x8 pa0, bf16x8 pa1, bf16x8 pa2, bf16x8 pa3) {
  const s16x4 l0 = tr_read<v_rd_off(D0, 0, 0)>(vb), h0 = tr_read<v_rd_off(D0, 0, 1)>(vb), l1 = tr_read<v_rd_off(D0, 1, 0)>(vb), h1 = tr_read<v_rd_off(D0, 1, 1)>(vb);
  const s16x4 l2 = tr_read<v_rd_off(D0, 2, 0)>(vb), h2 = tr_read<v_rd_off(D0, 2, 1)>(vb), l3 = tr_read<v_rd_off(D0, 3, 0)>(vb), h3 = tr_read<v_rd_off(D0, 3, 1)>(vb);
  asm volatile("s_waitcnt lgkmcnt(0)" ::: "memory"); SBAR();
#define PK(L, H) (bf16x8){L[0], L[1], L[2], L[3], H[0], H[1], H[2], H[3]}
  od = __builtin_amdgcn_mfma_f32_32x32x16_bf16(pa0, PK(l0, h0), od, 0, 0, 0);
  od = __builtin_amdgcn_mfma_f32_32x32x16_bf16(pa1, PK(l1, h1), od, 0, 0, 0);
  od = __builtin_amdgcn_mfma_f32_32x32x16_bf16(pa2, PK(l2, h2), od, 0, 0, 0);
  od = __builtin_amdgcn_mfma_f32_32x32x16_bf16(pa3, PK(l3, h3), od, 0, 0, 0);
#undef PK
}
__device__ __forceinline__ void pv_d0(f32x16* o, int vb, bf16x8 pa0, bf16x8 pa1, bf16x8 pa2, bf16x8 pa3) {
  pv_one<0>(o[0], vb, pa0, pa1, pa2, pa3); pv_one<1>(o[1], vb, pa0, pa1, pa2, pa3); pv_one<2>(o[2], vb, pa0, pa1, pa2, pa3); pv_one<3>(o[3], vb, pa0, pa1, pa2, pa3);
}
__device__ __forceinline__ void attn_dense_body(const bf16_t* Qb, const bf16_t* Kh, const bf16_t* Vh, bf16_t* Ob, int seq, char* lds) {
  int tid = threadIdx.x; asm volatile("" : "+v"(tid));
  const int wid = tid >> 6, lane = tid & 63, r32 = lane & 31, hi = lane >> 5;
  bf16_t* V_lds = (bf16_t*)lds; bf16_t* K_lds = (bf16_t*)(lds + 2 * SHM_V);
  float* ws = (float*)(lds + 2 * SHM_V + 2 * SHM_K) + wid * 64; float* li_l = ws; float* al_l = ws + 32;
  float m_reg = -1e30f, l_reg = 0; f32x16 o[4] = {}; bf16x8 qr[8];
  const bf16_t* Qw = Qb + (long)(wid * QBLK + r32) * LDQ + hi * 8;
#pragma unroll
  for (int d0 = 0; d0 < 8; ++d0) qr[d0] = *reinterpret_cast<const bf16x8*>(Qw + d0 * 16);
  const int sr = tid >> 4, sc = (tid & 15) * 8, vst0 = v_st(sr, sc), vst1 = v_st(32 + sr, sc);
  const int vb0 = (int)(uintptr_t)V_lds + v_rd_base(lane);
  struct { bf16x8 vs0, vs1, ks0, ks1; } sr_[2];
  const unsigned goff = (unsigned)(sr * LDK + sc) * 2u;
#define SLOAD(i, k0) do { const char* vb_ = (const char*)Vh + (size_t)(k0) * (LDK * 2); const char* kb_ = (const char*)Kh + (size_t)(k0) * (LDK * 2); \
    sr_[i].vs0 = *reinterpret_cast<const bf16x8*>(vb_ + goff); sr_[i].vs1 = *reinterpret_cast<const bf16x8*>(vb_ + 32 * LDK * 2 + goff); \
    sr_[i].ks0 = *reinterpret_cast<const bf16x8*>(kb_ + goff); sr_[i].ks1 = *reinterpret_cast<const bf16x8*>(kb_ + 32 * LDK * 2 + goff); } while (0)
#define SWRITE(b, i) do { *(bf16x8*)((char*)V_lds + (b) * SHM_V + vst0) = sr_[i].vs0;          \
    *(bf16x8*)((char*)V_lds + (b) * SHM_V + vst1) = sr_[i].vs1; int kc = sc * 2;               \
    *(bf16x8*)((char*)K_lds + (b) * SHM_K + KSWZ(sr, kc)) = sr_[i].ks0;                       \
    *(bf16x8*)((char*)K_lds + (b) * SHM_K + KSWZ(32 + sr, kc)) = sr_[i].ks1; } while (0)
#define SWAIT() asm volatile("s_waitcnt vmcnt(4)" ::: "memory")
#define RESC(a) do { if (__any((a) < 1.f)) { if (hi == 0) al_l[r32] = (a); asm volatile("s_waitcnt lgkmcnt(0)" ::: "memory"); \
    for (int d = 0; d < 4; ++d) for (int r = 0; r < 16; ++r) o[d][r] *= al_l[crow(r, hi)]; } } while (0)
  f32x16 pA0, pA1, pB0, pB1; float mnA, mnB, alA, alB; bf16x8 pa0, pa1, pa2, pa3; const int NT = seq / KVBLK;
  constexpr int SE = 0, SO = 1;
  SLOAD(SE, 0); asm volatile("s_waitcnt vmcnt(0)" ::: "memory"); SWRITE(0, SE); __syncthreads();
  qkt(pA0, pA1, K_lds, qr, r32, hi); partialSM(pA0, pA1, m_reg, mnA, alA);
  SLOAD(SO, KVBLK); if (2 < NT) SLOAD(SE, 2 * KVBLK);
  SWAIT(); SWRITE(1, SO); __syncthreads();
  for (int j = 1; j + 1 < NT; j += 2) {
    SBAR(); qkt(pB0, pB1, (bf16_t*)((char*)K_lds + SHM_K), qr, r32, hi);
    finishSM(pA0, pA1, alA, l_reg, pa0, pa1, pa2, pa3); SBAR();
    SLOAD(SO, (j + 2) * KVBLK); SBAR();
    pv_d0(o, vb0, pa0, pa1, pa2, pa3); partialSM(pB0, pB1, m_reg, mnB, alB);
    __syncthreads(); SWAIT(); SWRITE(0, SE);
    RESC(alB); __syncthreads();
    SBAR(); qkt(pA0, pA1, K_lds, qr, r32, hi);
    finishSM(pB0, pB1, alB, l_reg, pa0, pa1, pa2, pa3); SBAR();
    if (j + 3 < NT) SLOAD(SE, (j + 3) * KVBLK); SBAR();
    pv_d0(o, vb0 + (int)SHM_V, pa0, pa1, pa2, pa3); partialSM(pA0, pA1, m_reg, mnA, alA);
    __syncthreads(); SWAIT(); SWRITE(1, SO);
    RESC(alA); __syncthreads();
  }
  SBAR(); qkt(pB0, pB1, (bf16_t*)((char*)K_lds + SHM_K), qr, r32, hi);
  finishSM(pA0, pA1, alA, l_reg, pa0, pa1, pa2, pa3); SBAR();
  pv_d0(o, vb0, pa0, pa1, pa2, pa3); partialSM(pB0, pB1, m_reg, mnB, alB);
  __syncthreads(); RESC(alB);
  finishSM(pB0, pB1, alB, l_reg, pa0, pa1, pa2, pa3); SBAR();
  pv_d0(o, vb0 + (int)SHM_V, pa0, pa1, pa2, pa3);
  if (hi == 0) li_l[r32] = l_reg; asm volatile("s_waitcnt lgkmcnt(0)" ::: "memory");
  float rli[16];
#pragma unroll
  for (int r = 0; r < 16; ++r) rli[r] = __builtin_amdgcn_rcpf(li_l[crow(r, hi)]);
  bf16_t* Ow = Ob + (long)(wid * QBLK) * LDO;
#pragma unroll
  for (int r = 0; r < 16; ++r) { int orow = crow(r, hi);
    for (int d0 = 0; d0 < 4; ++d0) Ow[(long)orow * LDO + d0 * 32 + r32] = (bf16_t)f2bf(o[d0][r] * rli[r]); }
#undef SLOAD
#undef SWRITE
#undef SWAIT
#undef RESC
}
#undef KSWZ
#undef SBAR
}

struct Args;
typedef const __attribute__((address_space(4))) Args* KArgsP;
struct Args {
    const float *x, *c, *ctx, *c_ctx, *norm1_w, *norm2_w, *w_mod, *b_mod, *even_w_in, *even_conv_w, *even_w_out, *odd_w_qkv, *odd_q_norm, *odd_k_norm,
                *lq1, *lk1, *lq2, *lk2, *subln_w, *odd_w_out, *moe_w_group, *moe_b_group, *moe_w_expert, *moe_b_expert, *moe_w_gate, *moe_w_up, *moe_w_down;
    float* out; unsigned char* ws; int ph_lo, ph_hi;
};

__device__ __forceinline__ KArgsP kargs() { KArgsP p = (KArgsP)__builtin_amdgcn_kernarg_segment_ptr(); asm volatile("" : "+s"(p)); return p; }

__device__ __forceinline__ void transpose_item(const float* W, int ldw, int K, bf16_t* WT, int dst_row0, int k0, int n0, LAS float* scr, int lane) {
#pragma unroll 8
    for (int i = 0; i < 32; ++i) { const int kk = 2 * i + (lane >> 5); scr[kk * 33 + (lane & 31)] = W[(size_t)(k0 + kk) * ldw + n0 + (lane & 31)]; }
    asm volatile("s_waitcnt lgkmcnt(0)" ::: "memory");
    const int c = lane & 7;
#pragma unroll
    for (int j = 0; j < 4; ++j) { const int n = (lane >> 3) + 8 * j; const LAS float* s = scr + (8 * c) * 33 + n;
        u32x4 o; o.x = pk2(s[0 * 33], s[1 * 33]); o.y = pk2(s[2 * 33], s[3 * 33]); o.z = pk2(s[4 * 33], s[5 * 33]); o.w = pk2(s[6 * 33], s[7 * 33]);
        *(u32x4*)(WT + (size_t)(dst_row0 + n) * K + k0 + 8 * c) = o; }
    asm volatile("s_waitcnt lgkmcnt(0)" ::: "memory");
}
__device__ __forceinline__ void moe_weight_items(const float* w_gate, const float* w_up, const float* w_down, unsigned char* ws, int l, int gw, int ngw, LAS float* scr, int lane) {
    bf16_t* WGU = (bf16_t*)(ws + WS_WGU); bf16_t* WD = (bf16_t*)(ws + WS_WD);
    constexpr int I_G = NEXP * 32 * 16, I_D = NEXP * 8 * 64;
    for (int it = gw; it < 2 * I_G + I_D; it += ngw) {
        if (it < 2 * I_G) { const int up = it >= I_G, r = up ? it - I_G : it, e = r / 512, kb = (r % 512) / 16, nb = r % 16;
            const float* W = (up ? w_up : w_gate) + ((size_t)l * NEXP + e) * DM * EFF;
            const int n0 = nb * 32, row0 = e * 1024 + (n0 >> 7) * 256 + up * 128 + (n0 & 127);
            transpose_item(W, EFF, DM, WGU, row0, kb * 64, n0, scr, lane);
        } else { const int r = it - 2 * I_G, e = r / 512, kb = (r % 512) / 64, nb = r % 64;
            const float* W = w_down + ((size_t)l * NEXP + e) * EFF * DM;
            transpose_item(W, DM, EFF, WD, e * DM + nb * 32, kb * 64, nb * 32, scr, lane); }
    }
}

struct SchedInProj {
    const char *u0, *win; char *P, *ztl, *ztc; int G, c;
    __device__ __forceinline__ bool next(int i, GUnit& u) const {
        const int L = i * G + c; if (L >= 816 + 544) return false;
        u.lda = DM * 2; u.ldb = DM * 2; u.nt = DM / 64; u.scale = 1.f;
        if (L < 816) { int pm, pn; pg8::tile_of(L, 68, 12, pm, pn);
            u.A = u0 + (size_t)pm * 256 * DM * 2; u.B = win + (size_t)pn * 256 * DM * 2; u.O = P + ((size_t)pm * 256 * 3072 + pn * 256) * 2; u.ldc = 3072;
        } else { int pm, pn; pg8::tile_of(L - 816, 8, 68, pm, pn);
            u.A = win + (size_t)(3072 + pm * 256) * DM * 2; u.B = u0 + (size_t)pn * 256 * DM * 2;
            const int g = pm >> 1, part = pm & 1, b = pn / 17, jt = pn % 17;
            if (jt == 0) { u.O = ztc + ((size_t)((b * 4 + g) * 256) * 512 + part * 256) * 2; u.ldc = 512; }
            else { u.O = ztl + ((size_t)((b * 4 + g) * 256) * 8192 + part * 4096 + (jt - 1) * 256) * 2; u.ldc = 8192; } }
        return true;
    }
};
struct SchedDFT {
    const char *cmat, *cmatc, *ztl, *ztc; char* ycat; int G, c;
    __device__ __forceinline__ bool next(int i, GUnit& u) const {
        const int L = i * G + c; if (L >= 272) return false;
        if (L < 256) { const int w = (L % 8) * 32 + L / 8, bg = w >> 4, pm = w & 15, b = bg >> 2, g = bg & 3;
            u.A = cmat + (size_t)pm * 256 * 16384; u.B = ztl + (size_t)bg * 256 * 16384; u.lda = 16384; u.ldb = 16384; u.nt = 128;
            u.O = ycat + ((size_t)(b * TPB + CTX + pm * 256) * DM + 1024 + g * 256) * 2; u.ldc = DM; u.scale = 1.0f / 1024.0f;
        } else { const int bg = L - 256, b = bg >> 2, g = bg & 3;
            u.A = cmatc; u.B = ztc + (size_t)bg * 256 * 1024; u.lda = 1024; u.ldb = 1024; u.nt = 8;
            u.O = ycat + ((size_t)(b * TPB) * DM + 1024 + g * 256) * 2; u.ldc = DM; u.scale = 1.0f / 256.0f; }
        return true;
    }
};
struct SchedOut0 {
    const char *ycat, *wout; const float *x, *ctx, *mod; char* h; int G, c;
    __device__ __forceinline__ bool next(int i, GUnit& u) const {
        const int L = i * G + c; if (L >= 68 * 8) return false;
        int pm, pn; pg8::tile_of(L, 68, 8, pm, pn);
        u.A = ycat + (size_t)pm * 256 * DM * 2; u.B = wout + (size_t)pn * 256 * DM * 2; u.lda = DM * 2; u.ldb = DM * 2; u.nt = DM / 64;
        const int b = pm / 17, jt = pm % 17, v = (jt == 0) ? 4 : b;
        u.src = (const char*)((jt == 0 ? ctx + (size_t)b * CTX * DM : x + ((size_t)b * SEQ + (jt - 1) * 256) * DM) + pn * 256);
        u.gate = mod + (size_t)v * MODSZ + 2 * DM + pn * 256;
        u.O = h + ((size_t)pm * 256 * DM + pn * 256) * 4;
        return true;
    }
};
struct SchedOut1 {
    const char *a, *wout; const float* mod; char* h; int G, c;
    __device__ __forceinline__ bool next(int i, GUnit& u) const {
        const int L = i * G + c; if (L >= 64 * 8) return false;
        int lt, pn; pg8::tile_of(L, 64, 8, lt, pn);
        const int b = lt >> 4, ut = b * 17 + 1 + (lt & 15);
        u.A = a + (size_t)ut * 256 * DM * 2; u.B = wout + (size_t)pn * 256 * DM * 2; u.lda = DM * 2; u.ldb = DM * 2; u.nt = DM / 64;
        u.O = h + ((size_t)ut * 256 * DM + pn * 256) * 4; u.src = u.O; u.gate = mod + (size_t)b * MODSZ + 2 * DM + pn * 256;
        return true;
    }
};
struct SchedQKV {
    const char *u1, *wqkv; char *q; int G, c;
    __device__ __forceinline__ bool next(int i, GUnit& u) const {
        const int L = i * G + c; if (L >= 1536 + 64) return false;
        int ut, pn;
        if (L < 1536) { int lt; pg8::tile_of(L, 64, 24, lt, pn); ut = (lt >> 4) * 17 + 1 + (lt & 15); }
        else { const int r = L - 1536; ut = (r & 3) * 17; pn = 8 + (r >> 2); }
        u.A = u1 + (size_t)ut * 256 * DM * 2; u.B = wqkv + (size_t)pn * 256 * DM * 2; u.lda = DM * 2; u.ldb = DM * 2; u.nt = DM / 64; u.scale = 1.f; u.ldc = DM;
        u.O = q + (size_t)(pn >> 3) * (WS_K - WS_Q) + ((size_t)ut * 256 * DM + (pn & 7) * 256) * 2;
        return true;
    }
};
struct MoeTiles {
    int cnt[NEXP]; int tb[NEXP + 1];
    __device__ __forceinline__ void init(const unsigned* cntp) {
        int s = 0;
#pragma unroll
        for (int e = 0; e < NEXP; ++e) { cnt[e] = __builtin_amdgcn_readfirstlane((int)cntp[e]); tb[e] = s; s += (cnt[e] + 255) >> 8; }
        tb[NEXP] = s;
    }
    __device__ __forceinline__ void find(int rtg, int& e, int& rt, int& gc) const {
        e = 0;
#pragma unroll
        for (int j = 1; j < NEXP; ++j) if (rtg >= tb[j]) e = j;
        int tbe = 0, ce = 0;
#pragma unroll
        for (int j = 0; j < NEXP; ++j) if (j == e) { tbe = tb[j]; ce = cnt[j]; }
        rt = rtg - tbe; gc = ce - rt * 256; if (gc > 256) gc = 256;
    }
};
struct SchedMoe1 {
    MoeTiles T; const char *v, *wgu; char* hid; const int* lst; int G, c;
    __device__ __forceinline__ bool next(int i, GUnit& u) const {
        const int L = i * G + c, nwg = T.tb[NEXP] * 4; if (L >= nwg) return false;
        const int w = pg8::xcd_remap(L, nwg), rtg = w >> 2, pn = w & 3; int e, rt, gc; T.find(rtg, e, rt, gc);
        u.A = v; u.lda = DM * 2; u.glist = lst + (size_t)e * LCAP + rt * 256; u.gcount = gc;
        u.B = wgu + ((size_t)e * 1024 + pn * 256) * DM * 2; u.ldb = DM * 2; u.nt = DM / 64;
        u.O = hid + ((size_t)rtg * 256 * EFF + pn * 128) * 2; u.ldc = EFF;
        return true;
    }
};
struct SchedMoe2 {
    MoeTiles T; const char *hid, *wd; const int* lst; int G, c;
    __device__ __forceinline__ bool next(int i, GUnit& u) const {
        const int L = i * G + c, nwg = T.tb[NEXP] * 8; if (L >= nwg) return false;
        const int w = pg8::xcd_remap(L, nwg), rtg = w >> 3, pn = w & 7; int e, rt, gc; T.find(rtg, e, rt, gc);
        u.A = hid + (size_t)rtg * 256 * EFF * 2; u.lda = EFF * 2; u.B = wd + ((size_t)e * DM + pn * 256) * EFF * 2; u.ldb = EFF * 2; u.nt = EFF / 64;
        u.glist = lst + (size_t)e * LCAP + rt * 256; u.gcount = gc; u.aux = pn;
        return true;
    }
};

__device__ __forceinline__ void row_info(int row, int& b, int& j) { b = row / TPB; j = row - b * TPB; }

__device__ __forceinline__ void norm_mod_store(const f32x4 (&v)[8], float rstd, const float* nw, const float* sc, const float* sh, bf16_t* orow, int lane) {
#pragma unroll
    for (int jj = 0; jj < 8; ++jj) { const int k = 4 * lane + 256 * jj;
        const f32x4 w = *(const f32x4*)(nw + k), s = *(const f32x4*)(sc + k), t = *(const f32x4*)(sh + k);
        const f32x4 y = v[jj] * rstd * w * (1.0f + s) + t;
        u32x2 o; o.x = pk2(y[0], y[1]); o.y = pk2(y[2], y[3]); *(u32x2*)(orow + k) = o; }
}

__device__ __forceinline__ void route_row(const LAS float* yl, const float* wg, const float* bg, const float* we, const float* be, int lane, int& e0, int& e1, float& w0, float& w1) {
    float lg[4] = {0.f, 0.f, 0.f, 0.f}; float le[16];
#pragma unroll
    for (int n = 0; n < 16; ++n) le[n] = 0.f;
#pragma unroll 1
    for (int jj = 0; jj < 8; ++jj) { const f32x4 y4 = *(const LAS f32x4*)(yl + 4 * lane + 256 * jj);
#pragma unroll
        for (int i = 0; i < 4; ++i) { const int k = 4 * lane + 256 * jj + i; const float xv = y4[i];
            const f32x4 g = *(const f32x4*)(wg + (size_t)k * 4);
#pragma unroll
            for (int n = 0; n < 4; ++n) lg[n] = fmaf(xv, g[n], lg[n]);
#pragma unroll
            for (int q = 0; q < 4; ++q) { const f32x4 ev = *(const f32x4*)(we + (size_t)k * 16 + 4 * q);
#pragma unroll
                for (int n = 0; n < 4; ++n) le[4 * q + n] = fmaf(xv, ev[n], le[4 * q + n]); } } }
#pragma unroll
    for (int n = 0; n < 4; ++n) lg[n] = wave_sum(lg[n]) + bg[n];
#pragma unroll
    for (int n = 0; n < 16; ++n) le[n] = wave_sum(le[n]) + be[n];
    int gi = 0; float gm = lg[0];
#pragma unroll
    for (int n = 1; n < 4; ++n) if (lg[n] > gm) { gm = lg[n]; gi = n; }
    float den = 0.f;
#pragma unroll
    for (int n = 0; n < 4; ++n) den += __expf(lg[n] - gm);
    const float gw = 1.0f / den;
    float s[4];
#pragma unroll
    for (int n = 0; n < 4; ++n) { const float m0 = (gi == 0) ? 1.f : 0.f, m1 = (gi == 1) ? 1.f : 0.f, m2 = (gi == 2) ? 1.f : 0.f, m3 = (gi == 3) ? 1.f : 0.f; s[n] = le[n] * m0 + le[4 + n] * m1 + le[8 + n] * m2 + le[12 + n] * m3; }
    int i0 = 0; float v0 = s[0];
#pragma unroll
    for (int n = 1; n < 4; ++n) if (s[n] > v0) { v0 = s[n]; i0 = n; }
    int i1 = -1; float v1 = -3.0e38f;
#pragma unroll
    for (int n = 0; n < 4; ++n) if (n != i0 && s[n] > v1) { v1 = s[n]; i1 = n; }
    const float ex = __expf(v1 - v0), inv = 1.0f / (1.0f + ex);
    e0 = gi * 4 + i0; e1 = gi * 4 + i1; w0 = inv * gw; w1 = ex * inv * gw;
}

__global__ void __launch_bounds__(NTHREADS, 2) fwd_kernel(Args a) {
    extern __shared__ __attribute__((aligned(16))) unsigned char lds_raw[];
    LAS unsigned char* lds = (LAS unsigned char*)lds_raw;
    cg::grid_group grid = cg::this_grid();
    const int G = gridDim.x, blk = blockIdx.x, ngw = G * NWAVES;
    const int lo = a.ph_lo, hi = a.ph_hi;
#define PHASE_BEGIN KArgsP ka = kargs(); unsigned char* ws = ka->ws; (void)ws; int tid = threadIdx.x; asm volatile("" : "+v"(tid)); const int lane = tid & 63, wave = __builtin_amdgcn_readfirstlane(tid >> 6), gw = blk * NWAVES + wave; (void)lane; (void)gw;
#define ctl ((unsigned*)(ws + WS_CTL))
#define mod ((float*)(ws + WS_MOD))
#define tokw ((float*)(ws + WS_TOKW))
#define list ((int*)(ws + WS_LIST))
#define WIN ((bf16_t*)(ws + WS_WIN))
#define WOUT0 ((bf16_t*)(ws + WS_WOUT0))
#define WQKV ((bf16_t*)(ws + WS_WQKV))
#define WOUT1 ((bf16_t*)(ws + WS_WOUT1))
#define CMAT ((bf16_t*)(ws + WS_CMAT))
#define CMATC ((bf16_t*)(ws + WS_CMATC))
#define H ((float*)(ws + WS_H))
#define U ((bf16_t*)(ws + WS_U))
#define PB ((bf16_t*)(ws + WS_P))
#define YCAT ((bf16_t*)(ws + WS_YCAT))
#define QB ((bf16_t*)(ws + WS_Q))
#define KB ((bf16_t*)(ws + WS_K))
#define VB ((bf16_t*)(ws + WS_V))
#define AB ((bf16_t*)(ws + WS_A))
#define YB ((bf16_t*)(ws + WS_Y))
#define OB ((bf16_t*)(ws + WS_O))
#ifndef PHMASK
#define PHMASK 0x3ffff
#endif
#define PHON(k) (((PHMASK) >> (k)) & 1)
#define IN(k) (lo <= (k) && (k) < hi)
#define SYNC(k) do { if (IN(k) && IN((k) + 1)) grid.sync(); } while (0)

    if (PHON(0) && IN(0)) { PHASE_BEGIN
        if (blk == 0 && tid < 64) ctl[tid] = 0u;
        if (blk < 192) {
            LAS float* sil = (LAS float*)lds; LAS float* red = (LAS float*)(lds + 40960);
            for (int i = tid; i < 5 * DM; i += NTHREADS) { const int v = i / DM, k = i % DM; sil[i] = silu_f(v < 4 ? ka->c[v * DM + k] : ka->c_ctx[k]); }
            __syncthreads();
            const int l = blk / 96, j0 = (blk % 96) * 128;
            const float* wp = ka->w_mod + (size_t)l * DM * MODSZ + j0 + 2 * lane;
            f32x2 acc[5];
#pragma unroll
            for (int v = 0; v < 5; ++v) acc[v] = (f32x2){0.f, 0.f};
#pragma unroll 8
            for (int k = wave * 256; k < wave * 256 + 256; ++k) { const f32x2 w = *(const f32x2*)(wp + (size_t)k * MODSZ);
#pragma unroll
                for (int v = 0; v < 5; ++v) { const float s = sil[v * DM + k]; acc[v].x = fmaf(s, w.x, acc[v].x); acc[v].y = fmaf(s, w.y, acc[v].y); } }
#pragma unroll
            for (int v = 0; v < 5; ++v) { red[(wave * 5 + v) * 128 + 2 * lane] = acc[v].x; red[(wave * 5 + v) * 128 + 2 * lane + 1] = acc[v].y; }
            __syncthreads();
            for (int i = tid; i < 5 * 128; i += NTHREADS) { const int v = i / 128, j = i % 128; float s = ka->b_mod[l * MODSZ + j0 + j];
#pragma unroll
                for (int w = 0; w < 8; ++w) s += red[(w * 5 + v) * 128 + j];
                mod[((size_t)l * 5 + v) * MODSZ + j0 + j] = s; }
            __syncthreads();
        }
        LAS float* tab = (LAS float*)(lds + 135168);
        if (tid < 256) tab[tid] = cospif((float)tid * (1.0f / 128.0f));
        __syncthreads();
        LAS float* scr = (LAS float*)(lds + wave * 16384);
        constexpr int I_IN = 32 * 96, I_O0 = 32 * 64, I_QKV = 32 * 192, I_O1 = 32 * 64;
        for (int it = gw; it < I_IN + I_O0 + I_QKV + I_O1; it += ngw) {
            int r = it;
            if (r < I_IN) { transpose_item(ka->even_w_in, 4096, DM, WIN, (r % 96) * 32, (r / 96) * 64, (r % 96) * 32, scr, lane); continue; } r -= I_IN;
            if (r < I_O0) { transpose_item(ka->even_w_out, DM, DM, WOUT0, (r % 64) * 32, (r / 64) * 64, (r % 64) * 32, scr, lane); continue; } r -= I_O0;
            if (r < I_QKV) { transpose_item(ka->odd_w_qkv, 6144, DM, WQKV, (r % 192) * 32, (r / 192) * 64, (r % 192) * 32, scr, lane); continue; } r -= I_QKV;
            transpose_item(ka->odd_w_out, DM, DM, WOUT1, (r % 64) * 32, (r / 64) * 64, (r % 64) * 32, scr, lane);
        }
        moe_weight_items(ka->moe_w_gate, ka->moe_w_up, ka->moe_w_down, ws, 0, gw, ngw, scr, lane);
        for (int it = gw; it < 8 * 8 * 64; it += ngw) {
            const int gp = it >> 9, m0 = ((it >> 6) & 7) * 32, k0 = (it & 63) * 32, g = gp >> 1, part = gp & 1;
            const int r = lane & 31, hh = lane >> 5;
            f32x16 d = {};
            const float* wrow = ka->even_w_in + (size_t)(k0 + r) * 4096 + 3072 + g * 256 + 8 * hh;
#pragma unroll 4
            for (int j0 = 0; j0 < 256; j0 += 16) {
                const f32x4 b0 = *(const f32x4*)(wrow + j0), b1 = *(const f32x4*)(wrow + j0 + 4);
                u32x4 bw = {pk2(b0[0], b0[1]), pk2(b0[2], b0[3]), pk2(b1[0], b1[1]), pk2(b1[2], b1[3])};
                float av[8];
#pragma unroll
                for (int jj = 0; jj < 8; ++jj) { const int p = ((m0 + r) * (j0 + 8 * hh + jj) - (part ? 64 : 0)) & 255; av[jj] = tab[p]; }
                u32x4 aw = {pk2(av[0], av[1]), pk2(av[2], av[3]), pk2(av[4], av[5]), pk2(av[6], av[7])};
                d = __builtin_amdgcn_mfma_f32_32x32x16_bf16(*reinterpret_cast<bf16x8*>(&aw), *reinterpret_cast<bf16x8*>(&bw), d, 0, 0, 0);
            }
#pragma unroll
            for (int q = 0; q < 16; ++q) { const int row = (q & 3) + 8 * (q >> 2) + 4 * hh;
                WIN[(size_t)(3072 + gp * 256 + m0 + row) * DM + k0 + r] = (bf16_t)f2bf(d[q]); }
        }
        for (int it = gw; it < 4096 + 256; it += ngw) {
            if (it < 4096) { const int k = it;
                for (int cb = lane; cb < 1024; cb += 64) { const int col0 = cb * 8, part = col0 >> 12, t0 = col0 & 4095; float f[8];
#pragma unroll
                    for (int i = 0; i < 8; ++i) { const int p = (k * (t0 + i)) & 4095; const float xx = (float)p * (1.0f / 2048.0f); f[i] = part ? -sinpif(xx) : cospif(xx); }
                    u32x4 o = {pk2(f[0], f[1]), pk2(f[2], f[3]), pk2(f[4], f[5]), pk2(f[6], f[7])};
                    *(u32x4*)(CMAT + (size_t)k * 8192 + col0) = o; }
            } else { const int k = it - 4096; const int col0 = lane * 8, part = col0 >> 8, t0 = col0 & 255; float f[8];
#pragma unroll
                for (int i = 0; i < 8; ++i) { const int p = (k * (t0 + i)) & 255; const float xx = (float)p * (1.0f / 128.0f); f[i] = part ? -sinpif(xx) : cospif(xx); }
                u32x4 o = {pk2(f[0], f[1]), pk2(f[2], f[3]), pk2(f[4], f[5]), pk2(f[6], f[7])};
                *(u32x4*)(CMATC + (size_t)k * 512 + col0) = o; }
        }
    }
    SYNC(0);

    if (PHON(1) && IN(1)) { PHASE_BEGIN
        for (int row = gw; row < NTOK; row += ngw) { int b, j; row_info(row, b, j);
            const float* src = (j < CTX) ? ka->ctx + ((size_t)b * CTX + j) * DM : ka->x + ((size_t)b * SEQ + (j - CTX)) * DM;
            const float* mv = mod + (size_t)(j < CTX ? 4 : b) * MODSZ;
            f32x4 v[8]; float ss = 0.f;
#pragma unroll
            for (int jj = 0; jj < 8; ++jj) { v[jj] = *(const f32x4*)(src + 4 * lane + 256 * jj); ss += v[jj][0] * v[jj][0] + v[jj][1] * v[jj][1] + v[jj][2] * v[jj][2] + v[jj][3] * v[jj][3]; }
            const float rstd = rsqrtf(wave_sum(ss) * (1.0f / DM) + EPS);
            norm_mod_store(v, rstd, ka->norm1_w, mv + DM, mv, U + (size_t)row * DM, lane);
        }
    }
    SYNC(1);

    if (PHON(2) && IN(2)) { PHASE_BEGIN
        SchedInProj S{(const char*)U, (const char*)WIN, (char*)PB, (char*)(ws + WS_ZTL), (char*)(ws + WS_ZTC), G, blk};
        pg8::gemm_phase<SchedInProj, pg8::EpiStore, false>(lds, S, pg8::EpiStore{});
    }
    SYNC(2);

    if (PHON(3) && IN(3)) { PHASE_BEGIN
        for (int it = blk * NTHREADS + tid; it < (NTOK / 16) * 128; it += G * NTHREADS) {
            const int chunk = it >> 7, oct = it & 127, r0 = chunk * 16, jm = r0 % TPB, ch0 = oct * 8;
            const bool hasprev = (jm != 0 && jm != CTX), hasnext = (((jm + 16) % TPB) != 0 && (jm + 16) != CTX);
            float w0[8], w1[8], w2[8];
#pragma unroll
            for (int i = 0; i < 8; ++i) { w0[i] = ka->even_conv_w[ch0 + i]; w1[i] = ka->even_conv_w[1024 + ch0 + i]; w2[i] = ka->even_conv_w[2048 + ch0 + i]; }
            float cp[8], cc[8], cn[8];
#define LOADCV(row_, o) do { const u32x4 cg_ = *(const u32x4*)(PB + (size_t)(row_) * 3072 + 1024 + ch0), vi = *(const u32x4*)(PB + (size_t)(row_) * 3072 + 2048 + ch0); \
                o[0] = bflo(cg_.x) * bflo(vi.x); o[1] = bfhi(cg_.x) * bfhi(vi.x); o[2] = bflo(cg_.y) * bflo(vi.y); o[3] = bfhi(cg_.y) * bfhi(vi.y); \
                o[4] = bflo(cg_.z) * bflo(vi.z); o[5] = bfhi(cg_.z) * bfhi(vi.z); o[6] = bflo(cg_.w) * bflo(vi.w); o[7] = bfhi(cg_.w) * bfhi(vi.w); } while (0)
            if (hasprev) LOADCV(r0 - 1, cp); else {
#pragma unroll
                for (int i = 0; i < 8; ++i) cp[i] = 0.f; }
            LOADCV(r0, cc);
            for (int rr = 0; rr < 16; ++rr) { const int row = r0 + rr;
                if (rr < 15 || hasnext) LOADCV(row + 1, cn); else {
#pragma unroll
                    for (int i = 0; i < 8; ++i) cn[i] = 0.f; }
                const u32x4 bg = *(const u32x4*)(PB + (size_t)row * 3072 + ch0);
                float bb[8] = {bflo(bg.x), bfhi(bg.x), bflo(bg.y), bfhi(bg.y), bflo(bg.z), bfhi(bg.z), bflo(bg.w), bfhi(bg.w)}; float y[8];
#pragma unroll
                for (int i = 0; i < 8; ++i) y[i] = bb[i] * (w0[i] * cp[i] + w1[i] * cc[i] + w2[i] * cn[i]);
                u32x4 o = {pk2(y[0], y[1]), pk2(y[2], y[3]), pk2(y[4], y[5]), pk2(y[6], y[7])};
                *(u32x4*)(YCAT + (size_t)row * DM + ch0) = o;
#pragma unroll
                for (int i = 0; i < 8; ++i) { cp[i] = cc[i]; cc[i] = cn[i]; } }
        }
        SchedDFT S{(const char*)CMAT, (const char*)CMATC, (const char*)(ws + WS_ZTL), (const char*)(ws + WS_ZTC), (char*)YCAT, G, blk};
        pg8::gemm_phase<SchedDFT, pg8::EpiStore, false>(lds, S, pg8::EpiStore{});
    }
    SYNC(3);

    if (PHON(4) && IN(4)) { PHASE_BEGIN
        SchedOut0 S{(const char*)YCAT, (const char*)WOUT0, ka->x, ka->ctx, mod, (char*)H, G, blk};
        pg8::gemm_phase<SchedOut0, pg8::EpiResid, false>(lds, S, pg8::EpiResid{});
    }
    SYNC(4);

#pragma unroll
    for (int l = 0; l < 2; ++l) {
        const int pb = (l == 0) ? 5 : 14;
#define cnt (ctl + 32 * l)
#define modl (mod + (size_t)l * 5 * MODSZ)
        if (PHON(5) && IN(pb)) { PHASE_BEGIN
            LAS int* ri = (LAS int*)lds;
            LAS int* lbase = (LAS int*)(lds + 2048);
            LAS float* yl = (LAS float*)(lds + 4096 + wave * 8192);
            const int rpb = (l == 0) ? 68 : 64;
            const float* wg = ka->moe_w_group + (size_t)l * DM * 4; const float* bgp = ka->moe_b_group + l * 4;
            const float* we = ka->moe_w_expert + (size_t)l * DM * 16; const float* bep = ka->moe_b_expert + l * 16;
            for (int i = wave; i < rpb; i += NWAVES) {
                const int li = blk * rpb + i; const int row = (l == 0) ? li : (li / SEQ) * TPB + CTX + (li % SEQ);
                int b, j; row_info(row, b, j);
                const float* mv = modl + (size_t)(j < CTX ? 4 : b) * MODSZ;
                const float* hrow = H + (size_t)row * DM;
                f32x4 v[8]; float ss = 0.f;
#pragma unroll
                for (int jj = 0; jj < 8; ++jj) { v[jj] = *(const f32x4*)(hrow + 4 * lane + 256 * jj); ss += v[jj][0] * v[jj][0] + v[jj][1] * v[jj][1] + v[jj][2] * v[jj][2] + v[jj][3] * v[jj][3]; }
                const float rstd = rsqrtf(wave_sum(ss) * (1.0f / DM) + EPS);
                const float* nw = ka->norm2_w + l * DM;
#pragma unroll
                for (int jj = 0; jj < 8; ++jj) { const int k = 4 * lane + 256 * jj;
                    const f32x4 w = *(const f32x4*)(nw + k), s = *(const f32x4*)(mv + 4 * DM + k), t = *(const f32x4*)(mv + 3 * DM + k);
                    v[jj] = v[jj] * rstd * w * (1.0f + s) + t;
                    *(LAS f32x4*)(yl + k) = v[jj];
                    u32x2 o; o.x = pk2(v[jj][0], v[jj][1]); o.y = pk2(v[jj][2], v[jj][3]); *(u32x2*)(U + (size_t)row * DM + k) = o; }
                asm volatile("s_waitcnt lgkmcnt(0)" ::: "memory");
                int e0, e1; float w0, w1; route_row(yl, wg, bgp, we, bep, lane, e0, e1, w0, w1);
                if (lane == 0) { ri[i * 4 + 0] = e0; ri[i * 4 + 1] = e1; ri[i * 4 + 2] = row * 2; ri[i * 4 + 3] = row * 2 + 1; tokw[row * 2] = w0; tokw[row * 2 + 1] = w1; }
            }
            __syncthreads();
            if (tid < NEXP) { int n = 0;
                for (int i = 0; i < rpb; ++i) { n += (ri[i * 4] == tid) + (ri[i * 4 + 1] == tid); }
                const int base = n ? (int)atomicAdd(cnt + tid, (unsigned)n) : 0; int p = 0;
                for (int i = 0; i < rpb; ++i) { if (ri[i * 4] == tid) list[(size_t)tid * LCAP + base + p++] = ri[i * 4 + 2]; if (ri[i * 4 + 1] == tid) list[(size_t)tid * LCAP + base + p++] = ri[i * 4 + 3]; }
                lbase[tid] = base; }
            __syncthreads();
        }
        SYNC(pb);
        if (PHON(6) && IN(pb + 1)) { PHASE_BEGIN
            SchedMoe1 S; S.T.init(cnt); S.v = (const char*)U; S.wgu = (const char*)(ws + WS_WGU); S.hid = (char*)(ws + WS_HID); S.lst = list; S.G = G; S.c = blk;
            pg8::gemm_phase<SchedMoe1, pg8::EpiSwiGLU, true>(lds, S, pg8::EpiSwiGLU{});
        }
        SYNC(pb + 1);
        if (PHON(7) && IN(pb + 2)) { PHASE_BEGIN
            SchedMoe2 S; S.T.init(cnt); S.hid = (const char*)(ws + WS_HID); S.wd = (const char*)(ws + WS_WD); S.lst = list; S.G = G; S.c = blk;
            pg8::gemm_phase<SchedMoe2, pg8::EpiScatter, false>(lds, S, pg8::EpiScatter{YB, tokw});
        }
        SYNC(pb + 2);
        if (l == 0) {
            if (PHON(8) && IN(8)) { PHASE_BEGIN
                const float* mod1 = mod + (size_t)5 * MODSZ;
                for (int row = gw; row < NTOK; row += ngw) { int b, j; row_info(row, b, j); const int vr = (j < CTX) ? 4 : b;
                    const float* g2 = modl + (size_t)vr * MODSZ + 5 * DM; const float* mv1 = mod1 + (size_t)vr * MODSZ;
                    float* hrow = H + (size_t)row * DM; const bf16_t* y0 = YB + (size_t)(row * 2) * DM; const bf16_t* y1 = y0 + DM;
                    f32x4 v[8]; float ss = 0.f;
#pragma unroll
                    for (int jj = 0; jj < 8; ++jj) { const int k = 4 * lane + 256 * jj; const f32x4 hv = *(const f32x4*)(hrow + k), g = *(const f32x4*)(g2 + k);
                        const u32x2 a0 = *(const u32x2*)(y0 + k), a1 = *(const u32x2*)(y1 + k);
                        f32x4 ys = {bflo(a0.x) + bflo(a1.x), bfhi(a0.x) + bfhi(a1.x), bflo(a0.y) + bflo(a1.y), bfhi(a0.y) + bfhi(a1.y)};
                        v[jj] = hv + g * ys; *(f32x4*)(hrow + k) = v[jj];
                        ss += v[jj][0] * v[jj][0] + v[jj][1] * v[jj][1] + v[jj][2] * v[jj][2] + v[jj][3] * v[jj][3]; }
                    const float rstd = rsqrtf(wave_sum(ss) * (1.0f / DM) + EPS);
                    norm_mod_store(v, rstd, ka->norm1_w + DM, mv1 + DM, mv1, U + (size_t)row * DM, lane);
                }
                moe_weight_items(ka->moe_w_gate, ka->moe_w_up, ka->moe_w_down, ws, 1, gw, ngw, (LAS float*)(lds + wave * 16384), lane);
            }
            SYNC(8);
            if (PHON(9) && IN(9)) { PHASE_BEGIN
                SchedQKV S{(const char*)U, (const char*)WQKV, (char*)QB, G, blk};
                pg8::gemm_phase<SchedQKV, pg8::EpiStore, false>(lds, S, pg8::EpiStore{});
            }
            SYNC(9);
            if (PHON(10) && IN(10)) { PHASE_BEGIN
                LAS float* rt = (LAS float*)lds;
                for (int i = tid; i < 64 * 32; i += NTHREADS) { const int pos = i >> 5, f = i & 31; const float inv = exp2f(-(float)f * 0.4152410118609203f); const float ang = (float)pos * inv;
                    float tr = ang * 0.15915494309189535f; tr -= floorf(tr); rt[2 * i] = __builtin_amdgcn_cosf(tr); rt[2 * i + 1] = __builtin_amdgcn_sinf(tr); }
                __syncthreads();
                const int hc = lane >> 2, q8 = (lane & 3) * 8;
                for (int it = gw; it < NLAT + NTOK; it += ngw) {
                    const bool isq = it < NLAT; int row;
                    if (isq) row = (it / SEQ) * TPB + CTX + (it % SEQ); else row = it - NLAT;
                    int b, j; row_info(row, b, j); const bool rope = (j >= CTX); const int t = j - CTX, prow = t >> 6, pcol = t & 63;
                    bf16_t* p = (isq ? QB : KB) + (size_t)row * DM + hc * 128; const float* nwp = isq ? ka->odd_q_norm : ka->odd_k_norm;
                    u32x4 raw[4]; float xv[4][8];
                    float ss = 0.f;
#pragma unroll
                    for (int s = 0; s < 4; ++s) { raw[s] = *(const u32x4*)(p + s * 32 + q8);
                        xv[s][0] = bflo(raw[s].x); xv[s][1] = bfhi(raw[s].x); xv[s][2] = bflo(raw[s].y); xv[s][3] = bfhi(raw[s].y); xv[s][4] = bflo(raw[s].z); xv[s][5] = bfhi(raw[s].z); xv[s][6] = bflo(raw[s].w); xv[s][7] = bfhi(raw[s].w);
#pragma unroll
                        for (int i = 0; i < 8; ++i) ss += xv[s][i] * xv[s][i]; }
                    ss += __shfl_xor(ss, 1); ss += __shfl_xor(ss, 2);
                    const float rstd = rsqrtf(ss * (1.0f / 128.0f) + EPS);
#pragma unroll
                    for (int s = 0; s < 4; ++s)
#pragma unroll
                        for (int i = 0; i < 8; ++i) xv[s][i] = xv[s][i] * rstd * nwp[s * 32 + q8 + i];
                    if (rope) {
#pragma unroll
                        for (int ax = 0; ax < 2; ++ax) { const int pos = ax ? pcol : prow;
#pragma unroll
                            for (int i = 0; i < 8; ++i) { const float cs = rt[2 * (pos * 32 + q8 + i)], sn = rt[2 * (pos * 32 + q8 + i) + 1];
                                const float x1 = xv[2 * ax][i], x2 = xv[2 * ax + 1][i]; xv[2 * ax][i] = x1 * cs - x2 * sn; xv[2 * ax + 1][i] = x2 * cs + x1 * sn; } }
                    }
#pragma unroll
                    for (int s = 0; s < 4; ++s) { u32x4 o = {pk2(xv[s][0], xv[s][1]), pk2(xv[s][2], xv[s][3]), pk2(xv[s][4], xv[s][5]), pk2(xv[s][6], xv[s][7])}; *(u32x4*)(p + s * 32 + q8) = o; }
                }
                __syncthreads();
            }
            SYNC(10);
            if (PHON(11) && IN(11)) { PHASE_BEGIN
                const int vcu = (blk % 8) * (G / 8) + blk / 8;
                for (int U0 = vcu; U0 < 2048; U0 += G) {
                    const int combo = U0 >> 4, qb = U0 & 15, vh = combo & 1, cp_ = (combo >> 1) & 1, hh = (combo >> 2) & 7, b = combo >> 5;
                    const bf16_t* Qp = QB + (size_t)(b * TPB + CTX + qb * 256) * DM + hh * 256 + cp_ * 128;
                    const bf16_t* Kp = KB + (size_t)(b * TPB) * DM + hh * 256 + cp_ * 128;
                    const bf16_t* Vp = VB + (size_t)(b * TPB) * DM + hh * 256 + vh * 128;
                    bf16_t* Op = OB + (size_t)(b * SEQ + qb * 256) * (2 * DM) + cp_ * DM + hh * 256 + vh * 128;
                    att::attn_dense_body(Qp, Kp, Vp, Op, TPB, (char*)lds_raw);
                    __syncthreads();
                }
            }
            SYNC(11);
            if (PHON(12) && IN(12)) { PHASE_BEGIN
                float d1 = ka->lq1[lane] * ka->lk1[lane] + ka->lq1[lane + 64] * ka->lk1[lane + 64], d2 = ka->lq2[lane] * ka->lk2[lane] + ka->lq2[lane + 64] * ka->lk2[lane + 64];
                d1 = wave_sum(d1); d2 = wave_sum(d2);
                const float lam_init = 0.8f - 0.6f * expf(-0.3f * 1.0f);
                const float lam = expf(d1) - expf(d2) + lam_init;
                const int hh = lane >> 3, e0 = (lane & 7) * 32;
                for (int li = gw; li < NLAT; li += ngw) {
                    const bf16_t* o1 = OB + (size_t)li * (2 * DM) + hh * 256 + e0; const bf16_t* o2 = o1 + DM;
                    float ov[32]; float ss = 0.f;
#pragma unroll
                    for (int s = 0; s < 4; ++s) { const u32x4 p1 = *(const u32x4*)(o1 + 8 * s), p2 = *(const u32x4*)(o2 + 8 * s);
                        ov[8 * s + 0] = bflo(p1.x) - lam * bflo(p2.x); ov[8 * s + 1] = bfhi(p1.x) - lam * bfhi(p2.x); ov[8 * s + 2] = bflo(p1.y) - lam * bflo(p2.y); ov[8 * s + 3] = bfhi(p1.y) - lam * bfhi(p2.y);
                        ov[8 * s + 4] = bflo(p1.z) - lam * bflo(p2.z); ov[8 * s + 5] = bfhi(p1.z) - lam * bfhi(p2.z); ov[8 * s + 6] = bflo(p1.w) - lam * bflo(p2.w); ov[8 * s + 7] = bfhi(p1.w) - lam * bfhi(p2.w); }
#pragma unroll
                    for (int i = 0; i < 32; ++i) ss += ov[i] * ov[i];
                    ss += __shfl_xor(ss, 1); ss += __shfl_xor(ss, 2); ss += __shfl_xor(ss, 4);
                    const float rs = rsqrtf(ss * (1.0f / 256.0f) + EPS) * (1.0f - lam_init);
                    const int row = (li / SEQ) * TPB + CTX + (li % SEQ);
                    bf16_t* ap = AB + (size_t)row * DM + hh * 256 + e0;
#pragma unroll
                    for (int s = 0; s < 4; ++s) { float y[8];
#pragma unroll
                        for (int i = 0; i < 8; ++i) y[i] = ov[8 * s + i] * rs * ka->subln_w[e0 + 8 * s + i];
                        u32x4 o = {pk2(y[0], y[1]), pk2(y[2], y[3]), pk2(y[4], y[5]), pk2(y[6], y[7])}; *(u32x4*)(ap + 8 * s) = o; }
                }
            }
            SYNC(12);
            if (PHON(13) && IN(13)) { PHASE_BEGIN
                SchedOut1 S{(const char*)AB, (const char*)WOUT1, mod + (size_t)5 * MODSZ, (char*)H, G, blk};
                pg8::gemm_phase<SchedOut1, pg8::EpiResid, false>(lds, S, pg8::EpiResid{});
            }
            SYNC(13);
        } else {
            if (PHON(17) && IN(17)) { PHASE_BEGIN
                for (int li = gw; li < NLAT; li += ngw) { const int b = li / SEQ, row = b * TPB + CTX + (li % SEQ);
                    const float* g2 = modl + (size_t)b * MODSZ + 5 * DM; const float* hrow = H + (size_t)row * DM; const bf16_t* y0 = YB + (size_t)(row * 2) * DM; const bf16_t* y1 = y0 + DM;
                    float* orow = ka->out + (size_t)li * DM;
#pragma unroll
                    for (int jj = 0; jj < 8; ++jj) { const int k = 4 * lane + 256 * jj; const f32x4 hv = *(const f32x4*)(hrow + k), g = *(const f32x4*)(g2 + k);
                        const u32x2 a0 = *(const u32x2*)(y0 + k), a1 = *(const u32x2*)(y1 + k);
                        f32x4 ys = {bflo(a0.x) + bflo(a1.x), bfhi(a0.x) + bfhi(a1.x), bflo(a0.y) + bflo(a1.y), bfhi(a0.y) + bfhi(a1.y)};
                        *(f32x4*)(orow + k) = hv + g * ys; }
                }
            }
        }
    }
#undef IN
#undef SYNC
#undef cnt
#undef modl
#undef ctl
#undef mod
#undef tokw
#undef list
#undef WIN
#undef WOUT0
#undef WQKV
#undef WOUT1
#undef CMAT
#undef CMATC
#undef H
#undef U
#undef PB
#undef YCAT
#undef QB
#undef KB
#undef VB
#undef AB
#undef YB
#undef OB
}

#ifndef N_LAUNCH_MODE
#define N_LAUNCH_MODE 1
#endif
extern "C" void kernel_launch(void* const* d_in, const int* in_sizes, int n_in, void* d_out, int out_size, void* d_ws, size_t ws_size, hipStream_t stream) {
    static int grid = 0;
    if (grid == 0) {
        if (n_in != 27 || out_size != NLAT * DM || ws_size < WS_END) { fprintf(stderr, "kernel_launch: unexpected shapes: n_in %d out %d ws %zu (need %zu)\n", n_in, out_size, ws_size, (size_t)WS_END); grid = -1; return; }
        int dev = 0, cus = 0, per_cu = 0;
        hipGetDevice(&dev); hipDeviceGetAttribute(&cus, hipDeviceAttributeMultiprocessorCount, dev);
        if (hipFuncSetAttribute((const void*)fwd_kernel, hipFuncAttributeMaxDynamicSharedMemorySize, LDS_BYTES) != hipSuccess) { fprintf(stderr, "kernel_launch: hipFuncSetAttribute failed\n"); grid = -1; return; }
        if (hipOccupancyMaxActiveBlocksPerMultiprocessor(&per_cu, (const void*)fwd_kernel, NTHREADS, LDS_BYTES) != hipSuccess || per_cu < 1) { fprintf(stderr, "kernel_launch: occupancy query says %d\n", per_cu); per_cu = 1; }
        (void)hipGetLastError();
        grid = cus;
        if (grid != 256) fprintf(stderr, "kernel_launch: note: %d CUs\n", grid);
    }
    if (grid < 0) return;
    Args a{};
    const float** ap = (const float**)&a;
    for (int i = 0; i < 27; ++i) ap[i] = (const float*)d_in[i];
    a.out = (float*)d_out; a.ws = (unsigned char*)d_ws;
#if N_LAUNCH_MODE == 1
    a.ph_lo = 0; a.ph_hi = 18;
    void* args[] = {&a};
    hipError_t e = hipLaunchCooperativeKernel((const void*)fwd_kernel, dim3(grid), dim3(NTHREADS), args, LDS_BYTES, stream);
    if (e != hipSuccess) fprintf(stderr, "cooperative launch failed: %s (grid %d)\n", hipGetErrorString(e), grid);
#else
    for (int p = 0; p < 18; ++p) { a.ph_lo = p; a.ph_hi = p + 1; void* args[] = {&a};
        hipError_t e = hipLaunchCooperativeKernel((const void*)fwd_kernel, dim3(grid), dim3(NTHREADS), args, LDS_BYTES, stream);
        if (e != hipSuccess) { fprintf(stderr, "launch %d failed: %s\n", p, hipGetErrorString(e)); break; } }
#endif
}
```

```cpp
#include <hip/hip_runtime.h>
#include <hip/hip_cooperative_groups.h>
#include <cstdio>
#include <cstdint>
namespace cg = cooperative_groups;
#ifndef PROBE
#define PROBE 0
#endif
#ifndef REPMASK
#define REPMASK 0x0
#endif
#define REPS(k) for (int rep_ = 0; rep_ <= ((REPMASK >> (k)) & 1); ++rep_)
#ifndef PA0
#define PA0 0
#define PA1 18
#define PB0 0
#define PB1 18
#endif

#define LAS __attribute__((address_space(3)))
typedef unsigned short bf16_t;
typedef short bf16x8 __attribute__((ext_vector_type(8)));
typedef short s16x4 __attribute__((ext_vector_type(4)));
typedef float f32x2 __attribute__((ext_vector_type(2)));
typedef float f32x4 __attribute__((ext_vector_type(4)));
typedef float f32x8 __attribute__((ext_vector_type(8)));
typedef float f32x16 __attribute__((ext_vector_type(16)));
typedef unsigned u32x2 __attribute__((ext_vector_type(2)));
typedef unsigned u32x4 __attribute__((ext_vector_type(4)));

constexpr int DM = 2048, NB = 4, SEQ = 4096, CTX = 256, TPB = SEQ + CTX  ;
constexpr int NTOK = NB * TPB  , NLAT = NB * SEQ  ;
constexpr int NEXP = 16, EFF = 512, LCAP = 2 * NTOK  ;
constexpr float EPS = 1e-6f;
constexpr int NWAVES = 8, NTHREADS = 512;
constexpr int LDS_BYTES = 155648;
constexpr int RING_BYTES = 131072;

constexpr size_t MiB = 1u << 20;
constexpr size_t WS_CTL = 0, WS_MOD = 1 * MiB, WS_TOKW = 2 * MiB, WS_LIST = 3 * MiB;
constexpr size_t WS_WIN = 6 * MiB, WS_WOUT0 = 26 * MiB, WS_WQKV = 34 * MiB, WS_WOUT1 = 58 * MiB, WS_WGU = 66 * MiB, WS_WD = 130 * MiB;
constexpr size_t WS_CMAT = 162 * MiB, WS_CMATC = 226 * MiB, WS_HID = 162 * MiB  ;
constexpr size_t WS_H = 227 * MiB, WS_U = 363 * MiB;
constexpr size_t WS_P = 431 * MiB, WS_ZTL = 533 * MiB, WS_ZTC = 597 * MiB, WS_YCAT = 601 * MiB;
constexpr size_t WS_Q = 431 * MiB, WS_K = 499 * MiB, WS_V = 567 * MiB, WS_A = 431 * MiB;
static_assert(WS_V - WS_K == WS_K - WS_Q, "QKV spacing");
constexpr size_t WS_Y = 669 * MiB, WS_O = 669 * MiB, WS_END = 805 * MiB;
constexpr int MODSZ = 6 * DM;

__device__ __forceinline__ unsigned f2bf(float f) { unsigned u = __builtin_bit_cast(unsigned, f); return (u + 0x7fffu + ((u >> 16) & 1u)) >> 16; }
__device__ __forceinline__ unsigned pk2(float lo, float hi) { return f2bf(lo) | (f2bf(hi) << 16); }
__device__ __forceinline__ float bflo(unsigned w) { return __uint_as_float(w << 16); }
__device__ __forceinline__ float bfhi(unsigned w) { return __uint_as_float(w & 0xffff0000u); }
__device__ __forceinline__ unsigned cvt_pk_bf16(float lo, float hi) { unsigned r; asm volatile("v_cvt_pk_bf16_f32 %0, %1, %2" : "=v"(r) : "v"(lo), "v"(hi)); return r; }
__device__ __forceinline__ float wave_sum(float v) {
#pragma unroll
    for (int o = 1; o < 64; o <<= 1) v += __shfl_xor(v, o);
    return v;
}
__device__ __forceinline__ float silu_f(float x) { return x * __builtin_amdgcn_rcpf(1.0f + __expf(-x)); }

namespace pg8 {
constexpr int BM = 256, BK = 64, HALF = 128, HTB = HALF * BK * 2, STAGE_BYTES = 8 * HTB, NXCD = 8, WGM = 8;
__host__ __device__ __forceinline__ int lds_byte(int r, int c) { const int st = (r >> 4) * 2 + (c >> 5), rr = r & 15, cc = c & 31, ob = rr * 64 + cc * 2; return st * 1024 + (ob ^ (((ob >> 9) & 1) << 5)); }
__host__ __device__ __forceinline__ void stage_rc(int b, int& R, int& C) { const int st = b / 1024, sb = b % 1024, swz = sb ^ (((sb >> 9) & 1) << 5); R = (st >> 1) * 16 + swz / 64; C = (st & 1) * 32 + (swz % 64) / 2; }
__host__ __device__ __forceinline__ int perm32(int rho) { const int n = rho >> 4, i = rho & 15; return 8 * (i >> 2) + 4 * n + (i & 3); }

struct GUnit {
    const char* A; const char* B; unsigned lda, ldb; int nt;
    char* O; int ldc; float scale;
    const char* src; const float* gate;
    const int* glist; int gcount;
    int aux;
};
__device__ __forceinline__ void tile_of(int L, int nM, int nN, int& pm, int& pn) {
    const int nwg = nM * nN; int wgid = L;
    { const int q = nwg / NXCD, r = nwg % NXCD, xcd = wgid % NXCD, off = wgid / NXCD; wgid = (xcd < r ? xcd * (q + 1) : r * (q + 1) + (xcd - r) * q) + off; }
    const int nig = WGM * nN, gid = wgid / nig, fm = gid * WGM, gsz = (nM - fm) < WGM ? (nM - fm) : WGM;
    pm = fm + ((wgid % nig) % gsz); pn = (wgid % nig) / gsz;
}
__device__ __forceinline__ int xcd_remap(int L, int nwg) {
    const int q = nwg / NXCD, r = nwg % NXCD, xcd = L % NXCD, off = L / NXCD; return (xcd < r ? xcd * (q + 1) : r * (q + 1) + (xcd - r) * q) + off;
}

struct EpiStore {
    __device__ __forceinline__ void operator()(const f32x4 (&acc)[2][2][4][2], const GUnit& u, int wr, int wc, int fr, int fq) const {
        const float sc = u.scale;
#pragma unroll
        for (int ai = 0; ai < 2; ++ai)
#pragma unroll
            for (int m = 0; m < 4; ++m) { bf16_t* rowp = (bf16_t*)u.O + (size_t)(ai * HALF + wr * 64 + m * 16 + fr) * u.ldc + wc * 32 + 8 * fq;
#pragma unroll
                for (int bj = 0; bj < 2; ++bj) { const f32x4 v0 = acc[ai][bj][m][0] * sc, v1 = acc[ai][bj][m][1] * sc;
                    u32x4 w; w.x = cvt_pk_bf16(v0[0], v0[1]); w.y = cvt_pk_bf16(v0[2], v0[3]); w.z = cvt_pk_bf16(v1[0], v1[1]); w.w = cvt_pk_bf16(v1[2], v1[3]);
                    *(u32x4*)(rowp + bj * HALF) = w; } }
    }
};
struct EpiSwiGLU {
    __device__ __forceinline__ void operator()(const f32x4 (&acc)[2][2][4][2], const GUnit& u, int wr, int wc, int fr, int fq) const {
#pragma unroll
        for (int ai = 0; ai < 2; ++ai)
#pragma unroll
            for (int m = 0; m < 4; ++m) { bf16_t* rowp = (bf16_t*)u.O + (size_t)(ai * HALF + wr * 64 + m * 16 + fr) * u.ldc + wc * 32 + 8 * fq;
                float h[8];
#pragma unroll
                for (int n = 0; n < 2; ++n)
#pragma unroll
                    for (int i = 0; i < 4; ++i) h[4 * n + i] = silu_f(acc[ai][0][m][n][i]) * acc[ai][1][m][n][i];
                u32x4 w; w.x = cvt_pk_bf16(h[0], h[1]); w.y = cvt_pk_bf16(h[2], h[3]); w.z = cvt_pk_bf16(h[4], h[5]); w.w = cvt_pk_bf16(h[6], h[7]);
                *(u32x4*)rowp = w; }
    }
};
struct EpiScatter {
    bf16_t* Y; const float* tokw;
    __device__ __forceinline__ void operator()(const f32x4 (&acc)[2][2][4][2], const GUnit& u, int wr, int wc, int fr, int fq) const {
#pragma unroll
        for (int ai = 0; ai < 2; ++ai)
#pragma unroll
            for (int m = 0; m < 4; ++m) { const int r = ai * HALF + wr * 64 + m * 16 + fr;
                if (r < u.gcount) { const int a = u.glist[r]; const float sc = tokw[a];
                    bf16_t* rowp = Y + (size_t)a * DM + u.aux * 256 + wc * 32 + 8 * fq;
#pragma unroll
                    for (int bj = 0; bj < 2; ++bj) { const f32x4 v0 = acc[ai][bj][m][0] * sc, v1 = acc[ai][bj][m][1] * sc;
                        u32x4 w; w.x = cvt_pk_bf16(v0[0], v0[1]); w.y = cvt_pk_bf16(v0[2], v0[3]); w.z = cvt_pk_bf16(v1[0], v1[1]); w.w = cvt_pk_bf16(v1[2], v1[3]);
                        *(u32x4*)(rowp + bj * HALF) = w; } } }
    }
};
struct EpiResid {
    __device__ __forceinline__ void operator()(const f32x4 (&acc)[2][2][4][2], const GUnit& u, int wr, int wc, int fr, int fq) const {
        f32x4 g[2][2];
#pragma unroll
        for (int bj = 0; bj < 2; ++bj)
#pragma unroll
            for (int n = 0; n < 2; ++n) g[bj][n] = *(const f32x4*)(u.gate + bj * HALF + wc * 32 + 8 * fq + 4 * n);
#pragma unroll
        for (int ai = 0; ai < 2; ++ai)
#pragma unroll
            for (int m = 0; m < 4; ++m) { const size_t off = (size_t)(ai * HALF + wr * 64 + m * 16 + fr) * DM + wc * 32 + 8 * fq;
#pragma unroll
                for (int bj = 0; bj < 2; ++bj)
#pragma unroll
                    for (int n = 0; n < 2; ++n) { const f32x4 s = *(const f32x4*)((const float*)u.src + off + bj * HALF + 4 * n);
                        *(f32x4*)((float*)u.O + off + bj * HALF + 4 * n) = s + g[bj][n] * acc[ai][bj][m][n]; } }
    }
};

template <bool GATHER>
__device__ __forceinline__ void mkvoff(const GUnit& u, unsigned (&vA)[2][2], unsigned (&vB)[2][2]) {
    int tid = threadIdx.x; asm volatile("" : "+v"(tid));
    int R0, C0, R1, C1; stage_rc(tid * 16, R0, C0); stage_rc(tid * 16 + 8192, R1, C1);
    const int Rb0 = (R0 & ~31) + perm32(R0 & 31), Rb1 = (R1 & ~31) + perm32(R1 & 31);
#pragma unroll
    for (int h = 0; h < 2; ++h) {
        if constexpr (GATHER) {
            const int r0 = h * HALF + R0, r1 = h * HALF + R1;
            const int t0 = (r0 < u.gcount) ? (u.glist[r0] >> 1) : 0, t1 = (r1 < u.gcount) ? (u.glist[r1] >> 1) : 0;
            vA[h][0] = (unsigned)t0 * u.lda + (unsigned)C0 * 2u; vA[h][1] = (unsigned)t1 * u.lda + (unsigned)C1 * 2u;
        } else {
            vA[h][0] = (unsigned)(h * HALF + R0) * u.lda + (unsigned)C0 * 2u; vA[h][1] = (unsigned)(h * HALF + R1) * u.lda + (unsigned)C1 * 2u;
        }
        vB[h][0] = (unsigned)(h * HALF + Rb0) * u.ldb + (unsigned)C0 * 2u; vB[h][1] = (unsigned)(h * HALF + Rb1) * u.ldb + (unsigned)C1 * 2u;
    }
}

template <class Sched, class Epi, bool GATHER>
__device__ __forceinline__ void gemm_phase(LAS unsigned char* lds, const Sched& S, const Epi& E) {
    int tid = threadIdx.x; asm volatile("" : "+v"(tid));
    const int wid = __builtin_amdgcn_readfirstlane(tid >> 6), lane = tid & 63, wr = wid >> 2, wc = wid & 3, fr = lane & 15, fq = lane >> 4;
    const size_t kstep = (size_t)(BK * 2);
    const unsigned ldsw = (unsigned)wid * 1024u;
    const int aoff = lds_byte(wr * 64 + fr, fq * 8), boff = lds_byte(wc * 32 + fr, fq * 8);
#define PG8_SA(b, h) (((b) * 2 + (h)) * HTB)
#define PG8_SB(b, h) ((4 + (b) * 2 + (h)) * HTB)
#define PG8_STAGE(bufoff, gbase, voff) do { _Pragma("unroll") for (int _i = 0; _i < 2; ++_i) \
        __builtin_amdgcn_global_load_lds((const unsigned*)((const char*)(gbase) + (voff)[_i]), (LAS unsigned*)(lds + (bufoff) + ldsw + _i * 8192), 16, 0, 0); } while (0)
#define PG8_LDA(dst, b, h) do { _Pragma("unroll") for (int m = 0; m < 4; ++m) _Pragma("unroll") for (int k = 0; k < 2; ++k) dst[m][k] = *(const LAS bf16x8*)(lds + PG8_SA(b, h) + aoff + m * 2048 + k * 1024); } while (0)
#define PG8_LDB(dst, b, h) do { _Pragma("unroll") for (int n = 0; n < 2; ++n) _Pragma("unroll") for (int k = 0; k < 2; ++k) dst[n][k] = *(const LAS bf16x8*)(lds + PG8_SB(b, h) + boff + n * 2048 + k * 1024); } while (0)
#define PG8_MMA(ai, bj, At, Bt) do { __builtin_amdgcn_s_setprio(1); _Pragma("unroll") for (int m = 0; m < 4; ++m) _Pragma("unroll") for (int n = 0; n < 2; ++n) _Pragma("unroll") for (int k = 0; k < 2; ++k) \
        acc[ai][bj][m][n] = __builtin_amdgcn_mfma_f32_16x16x32_bf16(Bt[n][k], At[m][k], acc[ai][bj][m][n], 0, 0, 0); __builtin_amdgcn_s_setprio(0); } while (0)
#define PG8_WAIT_V(n) asm volatile("s_waitcnt vmcnt(" #n ")" ::: "memory")
#define PG8_WAIT_L(n) asm volatile("s_waitcnt lgkmcnt(" #n ")" ::: "memory")
#define PG8_BAR __builtin_amdgcn_s_barrier()
#define PG8_SCHED __builtin_amdgcn_sched_barrier(0)
    GUnit cur, nxt; int ui = 0;
    if (!S.next(0, cur)) return;
    unsigned vA[2][2], vB[2][2];
    mkvoff<GATHER>(cur, vA, vB);
    f32x4 acc[2][2][4][2];
#pragma unroll
    for (int a = 0; a < 2; ++a)
#pragma unroll
        for (int b = 0; b < 2; ++b)
#pragma unroll
            for (int m = 0; m < 4; ++m)
#pragma unroll
                for (int n = 0; n < 2; ++n) acc[a][b][m][n] = (f32x4){0.f, 0.f, 0.f, 0.f};
    bf16x8 At[4][2], B0[2][2], B1[2][2];
    const char* cA = cur.A; const char* cB = cur.B;
    PG8_STAGE(PG8_SB(0, 0), cB, vB[0]); PG8_STAGE(PG8_SB(0, 1), cB, vB[1]); PG8_STAGE(PG8_SA(0, 0), cA, vA[0]); PG8_STAGE(PG8_SA(0, 1), cA, vA[1]);
    if (wr == 1) PG8_BAR;
    PG8_WAIT_V(2); PG8_BAR;
    PG8_STAGE(PG8_SB(1, 0), cB + kstep, vB[0]); PG8_STAGE(PG8_SA(1, 0), cA + kstep, vA[0]); PG8_STAGE(PG8_SB(1, 1), cB + kstep, vB[1]);
    PG8_WAIT_V(6); PG8_BAR;
    for (;;) {
        const bool has_next = S.next(ui + 1, nxt);
        const char* nA = has_next ? nxt.A : cA; const char* nB = has_next ? nxt.B : cB;
        const int nt = cur.nt;
        for (int t = 0; t < nt; t += 2) {
            const bool last = (t == nt - 2);
            const char* a1 = cA + (size_t)(t + 1) * kstep;
            const char* a2 = last ? nA : cA + (size_t)(t + 2) * kstep; const char* b2 = last ? nB : cB + (size_t)(t + 2) * kstep;
            const char* a3 = a2 + kstep; const char* b3 = b2 + kstep;
            PG8_LDB(B0, 0, 0); PG8_LDB(B1, 0, 1); PG8_SCHED; PG8_LDA(At, 0, 0); PG8_STAGE(PG8_SA(1, 1), a1, vA[1]);
            if (last && has_next) mkvoff<GATHER>(nxt, vA, vB);
            PG8_WAIT_V(8); PG8_WAIT_L(0); PG8_BAR; PG8_MMA(0, 0, At, B0); PG8_MMA(0, 1, At, B1); PG8_BAR; PG8_SCHED;
            PG8_LDA(At, 0, 1); PG8_STAGE(PG8_SB(0, 0), b2, vB[0]); PG8_STAGE(PG8_SB(0, 1), b2, vB[1]); PG8_STAGE(PG8_SA(0, 0), a2, vA[0]);
            PG8_WAIT_V(8); PG8_WAIT_L(0); PG8_BAR; PG8_MMA(1, 0, At, B0); PG8_MMA(1, 1, At, B1); PG8_BAR; PG8_SCHED;
            PG8_LDB(B0, 1, 0); PG8_LDB(B1, 1, 1); PG8_SCHED; PG8_LDA(At, 1, 0); PG8_STAGE(PG8_SA(0, 1), a2, vA[1]);
            PG8_WAIT_V(8); PG8_WAIT_L(0); PG8_BAR; PG8_MMA(0, 0, At, B0); PG8_MMA(0, 1, At, B1); PG8_BAR; PG8_SCHED;
            PG8_LDA(At, 1, 1); PG8_STAGE(PG8_SB(1, 0), b3, vB[0]); PG8_STAGE(PG8_SB(1, 1), b3, vB[1]); PG8_STAGE(PG8_SA(1, 0), a3, vA[0]);
            PG8_WAIT_V(8); PG8_WAIT_L(0); PG8_BAR; PG8_MMA(1, 0, At, B0); PG8_MMA(1, 1, At, B1); PG8_BAR; PG8_SCHED;
        }
        if (wr == 0) PG8_BAR;
        E(acc, cur, wr, wc, fr, fq);
        if (!has_next) break;
#pragma unroll
        for (int a = 0; a < 2; ++a)
#pragma unroll
            for (int b = 0; b < 2; ++b)
#pragma unroll
                for (int m = 0; m < 4; ++m)
#pragma unroll
                    for (int n = 0; n < 2; ++n) acc[a][b][m][n] = (f32x4){0.f, 0.f, 0.f, 0.f};
        cur = nxt; cA = nA; cB = nB; ++ui;
        if (wr == 1) PG8_BAR;
    }
    PG8_WAIT_V(0);
    PG8_BAR;
#undef PG8_SA
#undef PG8_SB
#undef PG8_STAGE
#undef PG8_LDA
#undef PG8_LDB
#undef PG8_MMA
#undef PG8_WAIT_V
#undef PG8_WAIT_L
#undef PG8_BAR
#undef PG8_SCHED
}
}
using pg8::GUnit;

namespace att {
constexpr int D = 128, NW = 8, QBLK = 32, KVBLK = 64;
constexpr float SCALE = 0.088388347648318440f;
constexpr float THR = 8.f;
constexpr int LDQ = DM, LDK = DM, LDO = 2 * DM;
constexpr size_t SHM_V = KVBLK * D * 2, SHM_K = KVBLK * D * 2, SHM_ATTN = 2 * SHM_V + 2 * SHM_K + NW * 64 * 4;
#define KSWZ(row, colB) ((row) * 256 + ((colB) ^ (((row) & 7) << 4)))
#define SBAR() __builtin_amdgcn_sched_barrier(0)
__device__ __forceinline__ int crow(int r, int hi) { return (r & 3) + 8 * (r >> 2) + 4 * hi; }
__device__ __forceinline__ unsigned cvtpk(float lo, float hi) { unsigned r; asm volatile("v_cvt_pk_bf16_f32 %0, %1, %2" : "=v"(r) : "v"(lo), "v"(hi)); return r; }
__device__ __forceinline__ void partialSM(f32x16& p0, f32x16& p1, float& m_reg, float& mn, float& alpha) {
  constexpr float C = SCALE * 1.4426950408889634f;
  float pmax = p0[0]; for (int r = 1; r < 16; ++r) pmax = fmaxf(pmax, p0[r]); for (int r = 0; r < 16; ++r) pmax = fmaxf(pmax, p1[r]);
  { auto rr = __builtin_amdgcn_permlane32_swap(__float_as_uint(pmax), __float_as_uint(pmax), false, false);
    pmax = fmaxf(__uint_as_float(rr[0]), __uint_as_float(rr[1])); }
  if (__builtin_expect(__all(pmax - m_reg <= THR / SCALE), 1)) { mn = m_reg; alpha = 1.f; }
  else { mn = fmaxf(m_reg, pmax); alpha = __builtin_amdgcn_exp2f((m_reg - mn) * C); m_reg = mn; }
  float mnC = -mn * C;
  for (int r = 0; r < 16; ++r) p0[r] = fmaf(p0[r], C, mnC); for (int r = 0; r < 16; ++r) p1[r] = fmaf(p1[r], C, mnC);
  for (int r = 0; r < 16; ++r) p0[r] = __builtin_amdgcn_exp2f(p0[r]);
}
__device__ __forceinline__ void finishSM(f32x16& p0, f32x16& p1, float alpha, float& l_reg, bf16x8& pa0, bf16x8& pa1, bf16x8& pa2, bf16x8& pa3) {
  for (int r = 0; r < 16; ++r) p1[r] = __builtin_amdgcn_exp2f(p1[r]);
  float ps = 0; for (int r = 0; r < 16; ++r) ps += p0[r]; for (int r = 0; r < 16; ++r) ps += p1[r];
  { auto rr = __builtin_amdgcn_permlane32_swap(__float_as_uint(ps), __float_as_uint(ps), false, false);
    ps = __uint_as_float(rr[0]) + __uint_as_float(rr[1]); }
  l_reg = l_reg * alpha + ps;
#define PK4(P, BASE, OUT) do { unsigned a0 = cvtpk(P[BASE + 0], P[BASE + 1]), a1 = cvtpk(P[BASE + 2], P[BASE + 3]);   \
    unsigned b0 = cvtpk(P[BASE + 4], P[BASE + 5]), b1 = cvtpk(P[BASE + 6], P[BASE + 7]);                              \
    auto r0 = __builtin_amdgcn_permlane32_swap(a0, b0, false, false); auto r1 = __builtin_amdgcn_permlane32_swap(a1, b1, false, false); \
    u32x4 w = {r0[0], r1[0], r0[1], r1[1]}; OUT = *reinterpret_cast<bf16x8*>(&w); } while (0)
  PK4(p0, 0, pa0); PK4(p0, 8, pa1); PK4(p1, 0, pa2); PK4(p1, 8, pa3);
#undef PK4
}
__device__ __forceinline__ void qkt(f32x16& p0, f32x16& p1, const bf16_t* Ks, const bf16x8* qr, int r32, int hi) {
  p0 = f32x16{}; p1 = f32x16{};
  for (int d0 = 0; d0 < 8; ++d0) { int cb = (d0 * 16 + hi * 8) * 2;
    bf16x8 b0 = *reinterpret_cast<const bf16x8*>((const char*)Ks + KSWZ(r32, cb));
    bf16x8 b1 = *reinterpret_cast<const bf16x8*>((const char*)Ks + KSWZ(32 + r32, cb));
    p0 = __builtin_amdgcn_mfma_f32_32x32x16_bf16(b0, qr[d0], p0, 0, 0, 0);
    p1 = __builtin_amdgcn_mfma_f32_32x32x16_bf16(b1, qr[d0], p1, 0, 0, 0); }
}
__device__ __forceinline__ int v_st(int k, int c) { const int kk = (k & ~0xC) | ((k & 4) << 1) | ((k & 8) >> 1); return ((kk >> 3) * 4 + (c >> 5)) * 512 + ((kk & 7) * 32 + (c & 31)) * 2; }
__device__ __forceinline__ int v_rd_base(int lane) { return ((lane & 3) << 3) | (((lane >> 2) & 3) << 6) | (((lane >> 4) & 1) << 5) | (((lane >> 5) & 1) << 8); }
constexpr int v_rd_off(int d0, int ks, int half) { return d0 * 512 + ks * 4096 + half * 2048; }
template <int OFF> __device__ __forceinline__ s16x4 tr_read(int vb) {
  s16x4 r; asm volatile("ds_read_b64_tr_b16 %0, %1 offset:%2" : "=&v"(r) : "v"(vb), "i"(OFF) : "memory"); return r;
}
template <int D0> __device__ __forceinline__ void pv_one(f32x16& od, int vb, bf16x8 pa0, bf16x8 pa1, bf16x8 pa2, bf16x8 pa3) {
  const s16x4 l0 = tr_read<v_rd_off(D0, 0, 0)>(vb), h0 = tr_read<v_rd_off(D0, 0, 1)>(vb), l1 = tr_read<v_rd_off(D0, 1, 0)>(vb), h1 = tr_read<v_rd_off(D0, 1, 1)>(vb);
  const s16x4 l2 = tr_read<v_rd_off(D0, 2, 0)>(vb), h2 = tr_read<v_rd_off(D0, 2, 1)>(vb), l3 = tr_read<v_rd_off(D0, 3, 0)>(vb), h3 = tr_read<v_rd_off(D0, 3, 1)>(vb);
  asm volatile("s_waitcnt lgkmcnt(0)" ::: "memory"); SBAR();
#define PK(L, H) (bf16x8){L[0], L[1], L[2], L[3], H[0], H[1], H[2], H[3]}
  od = __builtin_amdgcn_mfma_f32_32x32x16_bf16(pa0, PK(l0, h0), od, 0, 0, 0);
  od = __builtin_amdgcn_mfma_f32_32x32x16_bf16(pa1, PK(l1, h1), od, 0, 0, 0);
  od = __builtin_amdgcn_mfma_f32_32x32x16_bf16(pa2, PK(l2, h2), od, 0, 0, 0);
  od = __builtin_amdgcn_mfma_f32_32x32x16_bf16(pa3, PK(l3, h3), od, 0, 0, 0);
#undef PK
}
__device__ __forceinline__ void pv_d0(f32x16* o, int vb, bf16x8 pa0, bf16x8 pa1, bf16x8 pa2, bf16x8 pa3) {
  pv_one<0>(o[0], vb, pa0, pa1, pa2, pa3); pv_one<1>(o[1], vb, pa0, pa1, pa2, pa3); pv_one<2>(o[2], vb, pa0, pa1, pa2, pa3); pv_one<3>(o[3], vb, pa0, pa1, pa2, pa3);
}
__device__ __forceinline__ void attn_dense_body(const bf16_t* Qb, const bf16_t* Kh, const bf16_t* Vh, bf16_t* Ob, int seq, char* lds) {
  int tid = threadIdx.x; asm volatile("" : "+v"(tid));
  const int wid = tid >> 6, lane = tid & 63, r32 = lane & 31, hi = lane >> 5;
  bf16_t* V_lds = (bf16_t*)lds; bf16_t* K_lds = (bf16_t*)(lds + 2 * SHM_V);
  float* ws = (float*)(lds + 2 * SHM_V + 2 * SHM_K) + wid * 64; float* li_l = ws; float* al_l = ws + 32;
  float m_reg = -1e30f, l_reg = 0; f32x16 o[4] = {}; bf16x8 qr[8];
  const bf16_t* Qw = Qb + (long)(wid * QBLK + r32) * LDQ + hi * 8;
#pragma unroll
  for (int d0 = 0; d0 < 8; ++d0) qr[d0] = *reinterpret_cast<const bf16x8*>(Qw + d0 * 16);
  const int sr = tid >> 4, sc = (tid & 15) * 8, vst0 = v_st(sr, sc), vst1 = v_st(32 + sr, sc);
  const int vb0 = (int)(uintptr_t)V_lds + v_rd_base(lane);
  struct { bf16x8 vs0, vs1, ks0, ks1; } sr_[2];
  const unsigned goff = (unsigned)(sr * LDK + sc) * 2u;
#define SLOAD(i, k0) do { const char* vb_ = (const char*)Vh + (size_t)(k0) * (LDK * 2); const char* kb_ = (const char*)Kh + (size_t)(k0) * (LDK * 2); \
    sr_[i].vs0 = *reinterpret_cast<const bf16x8*>(vb_ + goff); sr_[i].vs1 = *reinterpret_cast<const bf16x8*>(vb_ + 32 * LDK * 2 + goff); \
    sr_[i].ks0 = *reinterpret_cast<const bf16x8*>(kb_ + goff); sr_[i].ks1 = *reinterpret_cast<const bf16x8*>(kb_ + 32 * LDK * 2 + goff); } while (0)
#define SWRITE(b, i) do { *(bf16x8*)((char*)V_lds + (b) * SHM_V + vst0) = sr_[i].vs0;          \
    *(bf16x8*)((char*)V_lds + (b) * SHM_V + vst1) = sr_[i].vs1; int kc = sc * 2;               \
    *(bf16x8*)((char*)K_lds + (b) * SHM_K + KSWZ(sr, kc)) = sr_[i].ks0;                       \
    *(bf16x8*)((char*)K_lds + (b) * SHM_K + KSWZ(32 + sr, kc)) = sr_[i].ks1; } while (0)
#define SWAIT() asm volatile("s_waitcnt vmcnt(4)" ::: "memory")
#define RESC(a) do { if (__any((a) < 1.f)) { if (hi == 0) al_l[r32] = (a); asm volatile("s_waitcnt lgkmcnt(0)" ::: "memory"); \
    for (int d = 0; d < 4; ++d) for (int r = 0; r < 16; ++r) o[d][r] *= al_l[crow(r, hi)]; } } while (0)
  f32x16 pA0, pA1, pB0, pB1; float mnA, mnB, alA, alB; bf16x8 pa0, pa1, pa2, pa3; const int NT = seq / KVBLK;
  constexpr int SE = 0, SO = 1;
  SLOAD(SE, 0); asm volatile("s_waitcnt vmcnt(0)" ::: "memory"); SWRITE(0, SE); __syncthreads();
  qkt(pA0, pA1, K_lds, qr, r32, hi); partialSM(pA0, pA1, m_reg, mnA, alA);
  SLOAD(SO, KVBLK); if (2 < NT) SLOAD(SE, 2 * KVBLK);
  SWAIT(); SWRITE(1, SO); __syncthreads();
  for (int j = 1; j + 1 < NT; j += 2) {
    SBAR(); qkt(pB0, pB1, (bf16_t*)((char*)K_lds + SHM_K), qr, r32, hi);
    finishSM(pA0, pA1, alA, l_reg, pa0, pa1, pa2, pa3); SBAR();
    SLOAD(SO, (j + 2) * KVBLK); SBAR();
    pv_d0(o, vb0, pa0, pa1, pa2, pa3); partialSM(pB0, pB1, m_reg, mnB, alB);
    __syncthreads(); SWAIT(); SWRITE(0, SE);
    RESC(alB); __syncthreads();
    SBAR(); qkt(pA0, pA1, K_lds, qr, r32, hi);
    finishSM(pB0, pB1, alB, l_reg, pa0, pa1, pa2, pa3); SBAR();
    if (j + 3 < NT) SLOAD(SE, (j + 3) * KVBLK); SBAR();
    pv_d0(o, vb0 + (int)SHM_V, pa0, pa1, pa2, pa3); partialSM(pA0, pA1, m_reg, mnA, alA);
    __syncthreads(); SWAIT(); SWRITE(1, SO);
    RESC(alA); __syncthreads();
  }
  SBAR(); qkt(pB0, pB1, (bf16_t*)((char*)K_lds + SHM_K), qr, r32, hi);
  finishSM(pA0, pA1, alA, l_reg, pa0, pa1, pa2, pa3); SBAR();
  pv_d0(o, vb0, pa0, pa1, pa2, pa3); partialSM(pB0, pB1, m_reg, mnB, alB);
  __syncthreads(); RESC(alB);
  finishSM(pB0, pB1, alB, l_reg, pa0, pa1, pa2, pa3); SBAR();
  pv_d0(o, vb0 + (int)SHM_V, pa0, pa1, pa2, pa3);
  if (hi == 0) li_l[r32] = l_reg; asm volatile("s_waitcnt lgkmcnt(0)" ::: "memory");
  float rli[16];
#pragma unroll
  for (int r = 0; r < 16; ++r) rli[r] = __builtin_amdgcn_rcpf(li_l[crow(r, hi)]);
  bf16_t* Ow = Ob + (long)(wid * QBLK) * LDO;
#pragma unroll
  for (int r = 0; r < 16; ++r) { int orow = crow(r, hi);
    for (int d0 = 0; d0 < 4; ++d0) Ow[(long)orow * LDO + d0 * 32 + r32] = (bf16_t)f2bf(o[d0][r] * rli[r]); }
#undef SLOAD
#undef SWRITE
#undef SWAIT
#undef RESC
}
#undef KSWZ
#undef SBAR
}


#define XB_TMO      128
#define XB_XCNT(j)  (256  + 64 * (j))
#define XB_XSUB(j)  (1280 + 64 * (j))
#define XB_XGEN(j)  (2304 + 64 * (j))
#define XB_TOP      3328
#define XB_TOPGEN   3392
#define XCD_BAR_WORDS 3456
#define XB_SPIN_CAP (1u << 18)
__device__ __forceinline__ unsigned xb_ld(unsigned* p)              { return __hip_atomic_load(p, __ATOMIC_RELAXED, __HIP_MEMORY_SCOPE_AGENT); }
__device__ __forceinline__ unsigned xb_add(unsigned* p, unsigned v) { return __hip_atomic_fetch_add(p, v, __ATOMIC_RELAXED, __HIP_MEMORY_SCOPE_AGENT); }
__device__ __forceinline__ unsigned xb_xcc_id() { return (unsigned)__builtin_amdgcn_s_getreg((3 << 11) | 20) & 0xFu; }
#define XB_SPIN(cond, bar) do { unsigned _sp = 0; while (cond) { __builtin_amdgcn_s_sleep(1); \
    if ((++_sp & 255u) == 0u) { if (xb_ld(&(bar)[XB_TMO])) break; if (_sp > XB_SPIN_CAP) { atomicAdd(&(bar)[XB_TMO], 1u); break; } } } } while (0)
__device__ __forceinline__ void xcd_barrier_complete(unsigned* bar, unsigned x, unsigned& nloc, unsigned& nx) {
    const unsigned G = gridDim.x * gridDim.y * gridDim.z;
    unsigned sum, cnt, mine, sp = 0u;
    for (;;) {
        sum = 0u; cnt = 0u; mine = 0u;
#pragma unroll
        for (unsigned j = 0; j < 16; ++j) { const unsigned c = xb_ld(&bar[XB_XCNT(j)]); sum += c; cnt += (c > 0u) ? 1u : 0u; mine = (j == x) ? c : mine; }
        if (sum == G) break;
        __builtin_amdgcn_s_sleep(1);
        if ((++sp & 255u) == 0u) { if (xb_ld(&bar[XB_TMO])) break; if (sp > XB_SPIN_CAP) { atomicAdd(&bar[XB_TMO], 1u); break; } }
    }
    nloc = mine > 0u ? mine : 1u; nx = cnt > 0u ? cnt : 1u;
}
__device__ __forceinline__ void xcd_barrier(unsigned* bar, volatile LAS unsigned* st) {
    asm volatile("s_waitcnt vmcnt(0)" ::: "memory");
    __syncthreads();
    if (threadIdx.x == 0) {
        const unsigned x = xb_xcc_id();
        __builtin_amdgcn_s_waitcnt(0);
        unsigned nloc = st[0], nx = st[1];
        if (nloc == 0u) { xcd_barrier_complete(bar, x, nloc, nx); st[0] = nloc; st[1] = nx; }
        const unsigned old = xb_add(&bar[XB_XSUB(x)], 1u);
        const unsigned gen = old / nloc;
        if (old + 1u == (gen + 1u) * nloc) {
            __builtin_amdgcn_fence(__ATOMIC_RELEASE, "agent");
            asm volatile("s_waitcnt vmcnt(0)" ::: "memory");
            const unsigned og = xb_add(&bar[XB_TOP], 1u);
            const unsigned tg = og / nx;
            if (og + 1u == (tg + 1u) * nx) xb_add(&bar[XB_TOPGEN], 1u);
            else XB_SPIN(xb_ld(&bar[XB_TOPGEN]) == tg, bar);
            __builtin_amdgcn_fence(__ATOMIC_ACQUIRE, "agent");
            xb_add(&bar[XB_XGEN(x)], 1u);
            asm volatile("s_waitcnt vmcnt(0)" ::: "memory");
        } else {
            XB_SPIN(xb_ld(&bar[XB_XGEN(x)]) == gen, bar);
            __builtin_amdgcn_fence(__ATOMIC_ACQUIRE, "agent");
            asm volatile("s_waitcnt vmcnt(0)" ::: "memory");
        }
    }
    __syncthreads();
}

struct Args;
typedef const __attribute__((address_space(4))) Args* KArgsP;
struct Args {
    const float *x, *c, *ctx, *c_ctx, *norm1_w, *norm2_w, *w_mod, *b_mod, *even_w_in, *even_conv_w, *even_w_out, *odd_w_qkv, *odd_q_norm, *odd_k_norm,
                *lq1, *lk1, *lq2, *lk2, *subln_w, *odd_w_out, *moe_w_group, *moe_b_group, *moe_w_expert, *moe_b_expert, *moe_w_gate, *moe_w_up, *moe_w_down;
    float* out; unsigned char* ws; int ph_lo, ph_hi;
};

__device__ __forceinline__ KArgsP kargs() { KArgsP p = (KArgsP)__builtin_amdgcn_kernarg_segment_ptr(); asm volatile("" : "+s"(p)); return p; }

__device__ __forceinline__ void transpose_item(const float* W, int ldw, int K, bf16_t* WT, int dst_row0, int k0, int n0, LAS float* scr, int lane) {
#pragma unroll 8
    for (int i = 0; i < 32; ++i) { const int kk = 2 * i + (lane >> 5); scr[kk * 33 + (lane & 31)] = W[(size_t)(k0 + kk) * ldw + n0 + (lane & 31)]; }
    asm volatile("s_waitcnt lgkmcnt(0)" ::: "memory");
    const int c = lane & 7;
#pragma unroll
    for (int j = 0; j < 4; ++j) { const int n = (lane >> 3) + 8 * j; const LAS float* s = scr + (8 * c) * 33 + n;
        u32x4 o; o.x = pk2(s[0 * 33], s[1 * 33]); o.y = pk2(s[2 * 33], s[3 * 33]); o.z = pk2(s[4 * 33], s[5 * 33]); o.w = pk2(s[6 * 33], s[7 * 33]);
        *(u32x4*)(WT + (size_t)(dst_row0 + n) * K + k0 + 8 * c) = o; }
    asm volatile("s_waitcnt lgkmcnt(0)" ::: "memory");
}
__device__ __forceinline__ void moe_weight_items(const float* w_gate, const float* w_up, const float* w_down, unsigned char* ws, int l, int gw, int ngw, LAS float* scr, int lane) {
    bf16_t* WGU = (bf16_t*)(ws + WS_WGU); bf16_t* WD = (bf16_t*)(ws + WS_WD);
    constexpr int I_G = NEXP * 32 * 16, I_D = NEXP * 8 * 64;
    for (int it = gw; it < 2 * I_G + I_D; it += ngw) {
        if (it < 2 * I_G) { const int up = it >= I_G, r = up ? it - I_G : it, e = r / 512, kb = (r % 512) / 16, nb = r % 16;
            const float* W = (up ? w_up : w_gate) + ((size_t)l * NEXP + e) * DM * EFF;
            const int n0 = nb * 32, row0 = e * 1024 + (n0 >> 7) * 256 + up * 128 + (n0 & 127);
            transpose_item(W, EFF, DM, WGU, row0, kb * 64, n0, scr, lane);
        } else { const int r = it - 2 * I_G, e = r / 512, kb = (r % 512) / 64, nb = r % 64;
            const float* W = w_down + ((size_t)l * NEXP + e) * EFF * DM;
            transpose_item(W, DM, EFF, WD, e * DM + nb * 32, kb * 64, nb * 32, scr, lane); }
    }
}

struct SchedInProj {
    const char *u0, *win; char *P, *ztl, *ztc; int G, c;
    __device__ __forceinline__ bool next(int i, GUnit& u) const {
        const int L = i * G + c; if (L >= 816 + 544) return false;
        u.lda = DM * 2; u.ldb = DM * 2; u.nt = DM / 64; u.scale = 1.f;
        if (L < 816) { int pm, pn; pg8::tile_of(L, 68, 12, pm, pn);
            u.A = u0 + (size_t)pm * 256 * DM * 2; u.B = win + (size_t)pn * 256 * DM * 2; u.O = P + ((size_t)pm * 256 * 3072 + pn * 256) * 2; u.ldc = 3072;
        } else { int pm, pn; pg8::tile_of(L - 816, 8, 68, pm, pn);
            u.A = win + (size_t)(3072 + pm * 256) * DM * 2; u.B = u0 + (size_t)pn * 256 * DM * 2;
            const int g = pm >> 1, part = pm & 1, b = pn / 17, jt = pn % 17;
            if (jt == 0) { u.O = ztc + ((size_t)((b * 4 + g) * 256) * 512 + part * 256) * 2; u.ldc = 512; }
            else { u.O = ztl + ((size_t)((b * 4 + g) * 256) * 8192 + part * 4096 + (jt - 1) * 256) * 2; u.ldc = 8192; } }
        return true;
    }
};
struct SchedDFT {
    const char *cmat, *cmatc, *ztl, *ztc; char* ycat; int G, c;
    __device__ __forceinline__ bool next(int i, GUnit& u) const {
        const int L = i * G + c; if (L >= 272) return false;
        if (L < 256) { const int w = (L % 8) * 32 + L / 8, bg = w >> 4, pm = w & 15, b = bg >> 2, g = bg & 3;
            u.A = cmat + (size_t)pm * 256 * 16384; u.B = ztl + (size_t)bg * 256 * 16384; u.lda = 16384; u.ldb = 16384; u.nt = 128;
            u.O = ycat + ((size_t)(b * TPB + CTX + pm * 256) * DM + 1024 + g * 256) * 2; u.ldc = DM; u.scale = 1.0f / 1024.0f;
        } else { const int bg = L - 256, b = bg >> 2, g = bg & 3;
            u.A = cmatc; u.B = ztc + (size_t)bg * 256 * 1024; u.lda = 1024; u.ldb = 1024; u.nt = 8;
            u.O = ycat + ((size_t)(b * TPB) * DM + 1024 + g * 256) * 2; u.ldc = DM; u.scale = 1.0f / 256.0f; }
        return true;
    }
};
struct SchedOut0 {
    const char *ycat, *wout; const float *x, *ctx, *mod; char* h; int G, c;
    __device__ __forceinline__ bool next(int i, GUnit& u) const {
        const int L = i * G + c; if (L >= 68 * 8) return false;
        int pm, pn; pg8::tile_of(L, 68, 8, pm, pn);
        u.A = ycat + (size_t)pm * 256 * DM * 2; u.B = wout + (size_t)pn * 256 * DM * 2; u.lda = DM * 2; u.ldb = DM * 2; u.nt = DM / 64;
        const int b = pm / 17, jt = pm % 17, v = (jt == 0) ? 4 : b;
        u.src = (const char*)((jt == 0 ? ctx + (size_t)b * CTX * DM : x + ((size_t)b * SEQ + (jt - 1) * 256) * DM) + pn * 256);
        u.gate = mod + (size_t)v * MODSZ + 2 * DM + pn * 256;
        u.O = h + ((size_t)pm * 256 * DM + pn * 256) * 4;
        return true;
    }
};
struct SchedOut1 {
    const char *a, *wout; const float* mod; char* h; int G, c;
    __device__ __forceinline__ bool next(int i, GUnit& u) const {
        const int L = i * G + c; if (L >= 64 * 8) return false;
        int lt, pn; pg8::tile_of(L, 64, 8, lt, pn);
        const int b = lt >> 4, ut = b * 17 + 1 + (lt & 15);
        u.A = a + (size_t)ut * 256 * DM * 2; u.B = wout + (size_t)pn * 256 * DM * 2; u.lda = DM * 2; u.ldb = DM * 2; u.nt = DM / 64;
        u.O = h + ((size_t)ut * 256 * DM + pn * 256) * 4; u.src = u.O; u.gate = mod + (size_t)b * MODSZ + 2 * DM + pn * 256;
        return true;
    }
};
struct SchedQKV {
    const char *u1, *wqkv; char *q; int G, c;
    __device__ __forceinline__ bool next(int i, GUnit& u) const {
        const int L = i * G + c; if (L >= 1536 + 64) return false;
        int ut, pn;
        if (L < 1536) { int lt; pg8::tile_of(L, 64, 24, lt, pn); ut = (lt >> 4) * 17 + 1 + (lt & 15); }
        else { const int r = L - 1536; ut = (r & 3) * 17; pn = 8 + (r >> 2); }
        u.A = u1 + (size_t)ut * 256 * DM * 2; u.B = wqkv + (size_t)pn * 256 * DM * 2; u.lda = DM * 2; u.ldb = DM * 2; u.nt = DM / 64; u.scale = 1.f; u.ldc = DM;
        u.O = q + (size_t)(pn >> 3) * (WS_K - WS_Q) + ((size_t)ut * 256 * DM + (pn & 7) * 256) * 2;
        return true;
    }
};
struct MoeTiles {
    const LAS int* tab;
    __device__ __forceinline__ void init(LAS int* t, const unsigned* cntp) {
        tab = t;
        if (threadIdx.x == 0) { int s = 0;
            for (int e = 0; e < NEXP; ++e) { const int c = (int)cntp[e]; t[e] = c; t[16 + e] = s; s += (c + 255) >> 8; }
            t[32] = s; }
        __syncthreads();
    }
    __device__ __forceinline__ int total() const { return __builtin_amdgcn_readfirstlane(tab[32]); }
    __device__ __forceinline__ void find(int rtg, int& e, int& rt, int& gc) const {
        int ee = 0;
#pragma unroll
        for (int j = 1; j < NEXP; ++j) if (rtg >= tab[16 + j]) ee = j;
        e = __builtin_amdgcn_readfirstlane(ee);
        const int tbe = __builtin_amdgcn_readfirstlane(tab[16 + e]), ce = __builtin_amdgcn_readfirstlane(tab[e]);
        rt = rtg - tbe; gc = ce - rt * 256; if (gc > 256) gc = 256;
    }
};
struct SchedMoe1 {
    MoeTiles T; const char *v, *wgu; char* hid; const int* lst; int G, c;
    __device__ __forceinline__ bool next(int i, GUnit& u) const {
        const int L = i * G + c, nwg = T.total() * 4; if (L >= nwg) return false;
        const int w = pg8::xcd_remap(L, nwg), rtg = w >> 2, pn = w & 3; int e, rt, gc; T.find(rtg, e, rt, gc);
        u.A = v; u.lda = DM * 2; u.glist = lst + (size_t)e * LCAP + rt * 256; u.gcount = gc;
        u.B = wgu + ((size_t)e * 1024 + pn * 256) * DM * 2; u.ldb = DM * 2; u.nt = DM / 64;
        u.O = hid + ((size_t)rtg * 256 * EFF + pn * 128) * 2; u.ldc = EFF;
        return true;
    }
};
struct SchedMoe2 {
    MoeTiles T; const char *hid, *wd; const int* lst; int G, c;
    __device__ __forceinline__ bool next(int i, GUnit& u) const {
        const int L = i * G + c, nwg = T.total() * 8; if (L >= nwg) return false;
        const int w = pg8::xcd_remap(L, nwg), rtg = w >> 3, pn = w & 7; int e, rt, gc; T.find(rtg, e, rt, gc);
        u.A = hid + (size_t)rtg * 256 * EFF * 2; u.lda = EFF * 2; u.B = wd + ((size_t)e * DM + pn * 256) * EFF * 2; u.ldb = EFF * 2; u.nt = EFF / 64;
        u.glist = lst + (size_t)e * LCAP + rt * 256; u.gcount = gc; u.aux = pn;
        return true;
    }
};

__device__ __forceinline__ void row_info(int row, int& b, int& j) { b = row / TPB; j = row - b * TPB; }

__device__ __forceinline__ void norm_mod_store(const f32x4 (&v)[8], float rstd, const float* nw, const float* sc, const float* sh, bf16_t* orow, int lane) {
#pragma unroll
    for (int jj = 0; jj < 8; ++jj) { const int k = 4 * lane + 256 * jj;
        const f32x4 w = *(const f32x4*)(nw + k), s = *(const f32x4*)(sc + k), t = *(const f32x4*)(sh + k);
        const f32x4 y = v[jj] * rstd * w * (1.0f + s) + t;
        u32x2 o; o.x = pk2(y[0], y[1]); o.y = pk2(y[2], y[3]); *(u32x2*)(orow + k) = o; }
}

__device__ __forceinline__ void route_row(const LAS float* yl, const float* wg, const float* bg, const float* we, const float* be, int lane, int& e0, int& e1, float& w0, float& w1) {
    float lg[4] = {0.f, 0.f, 0.f, 0.f}; float le[16];
#pragma unroll
    for (int n = 0; n < 16; ++n) le[n] = 0.f;
#pragma unroll 1
    for (int jj = 0; jj < 8; ++jj) { const f32x4 y4 = *(const LAS f32x4*)(yl + 4 * lane + 256 * jj);
#pragma unroll
        for (int i = 0; i < 4; ++i) { const int k = 4 * lane + 256 * jj + i; const float xv = y4[i];
            const f32x4 g = *(const f32x4*)(wg + (size_t)k * 4);
#pragma unroll
            for (int n = 0; n < 4; ++n) lg[n] = fmaf(xv, g[n], lg[n]);
#pragma unroll
            for (int q = 0; q < 4; ++q) { const f32x4 ev = *(const f32x4*)(we + (size_t)k * 16 + 4 * q);
#pragma unroll
                for (int n = 0; n < 4; ++n) le[4 * q + n] = fmaf(xv, ev[n], le[4 * q + n]); } } }
#pragma unroll
    for (int n = 0; n < 4; ++n) lg[n] = wave_sum(lg[n]) + bg[n];
#pragma unroll
    for (int n = 0; n < 16; ++n) le[n] = wave_sum(le[n]) + be[n];
    int gi = 0; float gm = lg[0];
#pragma unroll
    for (int n = 1; n < 4; ++n) if (lg[n] > gm) { gm = lg[n]; gi = n; }
    float den = 0.f;
#pragma unroll
    for (int n = 0; n < 4; ++n) den += __expf(lg[n] - gm);
    const float gw = 1.0f / den;
    float s[4];
#pragma unroll
    for (int n = 0; n < 4; ++n) { const float m0 = (gi == 0) ? 1.f : 0.f, m1 = (gi == 1) ? 1.f : 0.f, m2 = (gi == 2) ? 1.f : 0.f, m3 = (gi == 3) ? 1.f : 0.f; s[n] = le[n] * m0 + le[4 + n] * m1 + le[8 + n] * m2 + le[12 + n] * m3; }
    int i0 = 0; float v0 = s[0];
#pragma unroll
    for (int n = 1; n < 4; ++n) if (s[n] > v0) { v0 = s[n]; i0 = n; }
    int i1 = -1; float v1 = -3.0e38f;
#pragma unroll
    for (int n = 0; n < 4; ++n) if (n != i0 && s[n] > v1) { v1 = s[n]; i1 = n; }
    const float ex = __expf(v1 - v0), inv = 1.0f / (1.0f + ex);
    e0 = gi * 4 + i0; e1 = gi * 4 + i1; w0 = inv * gw; w1 = ex * inv * gw;
}

__global__ void __launch_bounds__(NTHREADS, 2) fwd_kernel(Args a) {
    extern __shared__ __attribute__((aligned(16))) unsigned char lds_raw[];
    LAS unsigned char* lds = (LAS unsigned char*)lds_raw;
    cg::grid_group grid = cg::this_grid();
    const int G = gridDim.x, blk = blockIdx.x, ngw = G * NWAVES;
    const int lo = a.ph_lo, hi = a.ph_hi;
    if (threadIdx.x < 2) ((LAS unsigned*)(lds + RING_BYTES + 512))[threadIdx.x] = 0u;
    __syncthreads();
#define TS(k) do { if (PROBE && blockIdx.x == 0 && threadIdx.x == 0) { const unsigned long long t_ = __builtin_amdgcn_s_memrealtime(); unsigned long long* tp_ = (unsigned long long*)(kargs()->ws + WS_CTL + 1024); \
        if ((k) == PA0) tp_[0] = t_; if ((k) == PA1) tp_[1] = t_; if ((k) == PB0) tp_[2] = t_; if ((k) == PB1) tp_[3] = t_; } } while (0)
#define PHASE_BEGIN KArgsP ka = kargs(); unsigned char* ws = ka->ws; (void)ws; int tid = threadIdx.x; asm volatile("" : "+v"(tid)); const int lane = tid & 63, wave = __builtin_amdgcn_readfirstlane(tid >> 6), gw = blk * NWAVES + wave; (void)lane; (void)gw;
#define ctl ((unsigned*)(ws + WS_CTL))
#define mod ((float*)(ws + WS_MOD))
#define tokw ((float*)(ws + WS_TOKW))
#define list ((int*)(ws + WS_LIST))
#define WIN ((bf16_t*)(ws + WS_WIN))
#define WOUT0 ((bf16_t*)(ws + WS_WOUT0))
#define WQKV ((bf16_t*)(ws + WS_WQKV))
#define WOUT1 ((bf16_t*)(ws + WS_WOUT1))
#define CMAT ((bf16_t*)(ws + WS_CMAT))
#define CMATC ((bf16_t*)(ws + WS_CMATC))
#define H ((float*)(ws + WS_H))
#define U ((bf16_t*)(ws + WS_U))
#define PB ((bf16_t*)(ws + WS_P))
#define YCAT ((bf16_t*)(ws + WS_YCAT))
#define QB ((bf16_t*)(ws + WS_Q))
#define KB ((bf16_t*)(ws + WS_K))
#define VB ((bf16_t*)(ws + WS_V))
#define AB ((bf16_t*)(ws + WS_A))
#define YB ((bf16_t*)(ws + WS_Y))
#define OB ((bf16_t*)(ws + WS_O))
#ifndef PHMASK
#define PHMASK 0x3ffff
#endif
#define PHON(k) (((PHMASK) >> (k)) & 1)
#define IN(k) (lo <= (k) && (k) < hi)
#ifndef XSYNC
#define XSYNC 0
#endif
#define BARW ((unsigned*)(kargs()->ws + WS_CTL) + 4096)
#define BARST ((volatile LAS unsigned*)(lds + RING_BYTES + 512))
#define SYNC(k) do { if (IN(k) && IN((k) + 1)) { \
        if ((k) == 0) { grid.sync(); if (threadIdx.x == 0) (void)xb_add(&BARW[XB_XCNT(xb_xcc_id())], 1u); }     \
        else xcd_barrier(BARW, BARST); \
        if ((k) == 1) for (int xs_ = 0; xs_ < XSYNC; ++xs_) xcd_barrier(BARW, BARST); } } while (0)

    TS(0);
    if (PHON(0) && IN(0)) REPS(0) { PHASE_BEGIN
        if (blk == 0) { if (tid < 64) ctl[tid] = 0u;
            for (int i = tid; i < XCD_BAR_WORDS; i += NTHREADS) (ctl + 4096)[i] = 0u; }
        if (blk < 192) {
            LAS float* sil = (LAS float*)lds; LAS float* red = (LAS float*)(lds + 40960);
            for (int i = tid; i < 5 * DM; i += NTHREADS) { const int v = i / DM, k = i % DM; sil[i] = silu_f(v < 4 ? ka->c[v * DM + k] : ka->c_ctx[k]); }
            __syncthreads();
            const int l = blk / 96, j0 = (blk % 96) * 128;
            const float* wp = ka->w_mod + (size_t)l * DM * MODSZ + j0 + 2 * lane;
            f32x2 acc[5];
#pragma unroll
            for (int v = 0; v < 5; ++v) acc[v] = (f32x2){0.f, 0.f};
#pragma unroll 8
            for (int k = wave * 256; k < wave * 256 + 256; ++k) { const f32x2 w = *(const f32x2*)(wp + (size_t)k * MODSZ);
#pragma unroll
                for (int v = 0; v < 5; ++v) { const float s = sil[v * DM + k]; acc[v].x = fmaf(s, w.x, acc[v].x); acc[v].y = fmaf(s, w.y, acc[v].y); } }
#pragma unroll
            for (int v = 0; v < 5; ++v) { red[(wave * 5 + v) * 128 + 2 * lane] = acc[v].x; red[(wave * 5 + v) * 128 + 2 * lane + 1] = acc[v].y; }
            __syncthreads();
            for (int i = tid; i < 5 * 128; i += NTHREADS) { const int v = i / 128, j = i % 128; float s = ka->b_mod[l * MODSZ + j0 + j];
#pragma unroll
                for (int w = 0; w < 8; ++w) s += red[(w * 5 + v) * 128 + j];
                mod[((size_t)l * 5 + v) * MODSZ + j0 + j] = s; }
            __syncthreads();
        }
        LAS float* tab = (LAS float*)(lds + 135168);
        if (tid < 256) tab[tid] = cospif((float)tid * (1.0f / 128.0f));
        __syncthreads();
        LAS float* scr = (LAS float*)(lds + wave * 16384);
        constexpr int I_IN = 32 * 96, I_O0 = 32 * 64, I_QKV = 32 * 192, I_O1 = 32 * 64;
        for (int it = gw; it < I_IN + I_O0 + I_QKV + I_O1; it += ngw) {
            int r = it;
            if (r < I_IN) { transpose_item(ka->even_w_in, 4096, DM, WIN, (r % 96) * 32, (r / 96) * 64, (r % 96) * 32, scr, lane); continue; } r -= I_IN;
            if (r < I_O0) { transpose_item(ka->even_w_out, DM, DM, WOUT0, (r % 64) * 32, (r / 64) * 64, (r % 64) * 32, scr, lane); continue; } r -= I_O0;
            if (r < I_QKV) { transpose_item(ka->odd_w_qkv, 6144, DM, WQKV, (r % 192) * 32, (r / 192) * 64, (r % 192) * 32, scr, lane); continue; } r -= I_QKV;
            transpose_item(ka->odd_w_out, DM, DM, WOUT1, (r % 64) * 32, (r / 64) * 64, (r % 64) * 32, scr, lane);
        }
        moe_weight_items(ka->moe_w_gate, ka->moe_w_up, ka->moe_w_down, ws, 0, gw, ngw, scr, lane);
        for (int it = gw; it < 8 * 8 * 64; it += ngw) {
            const int gp = it >> 9, m0 = ((it >> 6) & 7) * 32, k0 = (it & 63) * 32, g = gp >> 1, part = gp & 1;
            const int r = lane & 31, hh = lane >> 5;
            f32x16 d = {};
            const float* wrow = ka->even_w_in + (size_t)(k0 + r) * 4096 + 3072 + g * 256 + 8 * hh;
#pragma unroll 4
            for (int j0 = 0; j0 < 256; j0 += 16) {
                const f32x4 b0 = *(const f32x4*)(wrow + j0), b1 = *(const f32x4*)(wrow + j0 + 4);
                u32x4 bw = {pk2(b0[0], b0[1]), pk2(b0[2], b0[3]), pk2(b1[0], b1[1]), pk2(b1[2], b1[3])};
                float av[8];
#pragma unroll
                for (int jj = 0; jj < 8; ++jj) { const int p = ((m0 + r) * (j0 + 8 * hh + jj) - (part ? 64 : 0)) & 255; av[jj] = tab[p]; }
                u32x4 aw = {pk2(av[0], av[1]), pk2(av[2], av[3]), pk2(av[4], av[5]), pk2(av[6], av[7])};
                d = __builtin_amdgcn_mfma_f32_32x32x16_bf16(*reinterpret_cast<bf16x8*>(&aw), *reinterpret_cast<bf16x8*>(&bw), d, 0, 0, 0);
            }
#pragma unroll
            for (int q = 0; q < 16; ++q) { const int row = (q & 3) + 8 * (q >> 2) + 4 * hh;
                WIN[(size_t)(3072 + gp * 256 + m0 + row) * DM + k0 + r] = (bf16_t)f2bf(d[q]); }
        }
        for (int it = gw; it < 4096 + 256; it += ngw) {
            if (it < 4096) { const int k = it;
                for (int cb = lane; cb < 1024; cb += 64) { const int col0 = cb * 8, part = col0 >> 12, t0 = col0 & 4095; float f[8];
#pragma unroll
                    for (int i = 0; i < 8; ++i) { const int p = (k * (t0 + i)) & 4095; const float xx = (float)p * (1.0f / 2048.0f); f[i] = part ? -sinpif(xx) : cospif(xx); }
                    u32x4 o = {pk2(f[0], f[1]), pk2(f[2], f[3]), pk2(f[4], f[5]), pk2(f[6], f[7])};
                    *(u32x4*)(CMAT + (size_t)k * 8192 + col0) = o; }
            } else { const int k = it - 4096; const int col0 = lane * 8, part = col0 >> 8, t0 = col0 & 255; float f[8];
#pragma unroll
                for (int i = 0; i < 8; ++i) { const int p = (k * (t0 + i)) & 255; const float xx = (float)p * (1.0f / 128.0f); f[i] = part ? -sinpif(xx) : cospif(xx); }
                u32x4 o = {pk2(f[0], f[1]), pk2(f[2], f[3]), pk2(f[4], f[5]), pk2(f[6], f[7])};
                *(u32x4*)(CMATC + (size_t)k * 512 + col0) = o; }
        }
    }
    SYNC(0);

    TS(1);
    if (PHON(1) && IN(1)) REPS(1) { PHASE_BEGIN
        for (int row = gw; row < NTOK; row += ngw) { int b, j; row_info(row, b, j);
            const float* src = (j < CTX) ? ka->ctx + ((size_t)b * CTX + j) * DM : ka->x + ((size_t)b * SEQ + (j - CTX)) * DM;
            const float* mv = mod + (size_t)(j < CTX ? 4 : b) * MODSZ;
            f32x4 v[8]; float ss = 0.f;
#pragma unroll
            for (int jj = 0; jj < 8; ++jj) { v[jj] = *(const f32x4*)(src + 4 * lane + 256 * jj); ss += v[jj][0] * v[jj][0] + v[jj][1] * v[jj][1] + v[jj][2] * v[jj][2] + v[jj][3] * v[jj][3]; }
            const float rstd = rsqrtf(wave_sum(ss) * (1.0f / DM) + EPS);
            norm_mod_store(v, rstd, ka->norm1_w, mv + DM, mv, U + (size_t)row * DM, lane);
        }
    }
    SYNC(1);

    TS(2);
    if (PHON(2) && IN(2)) REPS(2) { PHASE_BEGIN
        SchedInProj S{(const char*)U, (const char*)WIN, (char*)PB, (char*)(ws + WS_ZTL), (char*)(ws + WS_ZTC), G, blk};
        pg8::gemm_phase<SchedInProj, pg8::EpiStore, false>(lds, S, pg8::EpiStore{});
    }
    SYNC(2);

    TS(3);
    if (PHON(3) && IN(3)) REPS(3) { PHASE_BEGIN
        for (int it = blk * NTHREADS + tid; it < (NTOK / 16) * 128; it += G * NTHREADS) {
            const int chunk = it >> 7, oct = it & 127, r0 = chunk * 16, jm = r0 % TPB, ch0 = oct * 8;
            const bool hasprev = (jm != 0 && jm != CTX), hasnext = (((jm + 16) % TPB) != 0 && (jm + 16) != CTX);
            float w0[8], w1[8], w2[8];
#pragma unroll
            for (int i = 0; i < 8; ++i) { w0[i] = ka->even_conv_w[ch0 + i]; w1[i] = ka->even_conv_w[1024 + ch0 + i]; w2[i] = ka->even_conv_w[2048 + ch0 + i]; }
            float cp[8], cc[8], cn[8];
#define LOADCV(row_, o) do { const u32x4 cg_ = *(const u32x4*)(PB + (size_t)(row_) * 3072 + 1024 + ch0), vi = *(const u32x4*)(PB + (size_t)(row_) * 3072 + 2048 + ch0); \
                o[0] = bflo(cg_.x) * bflo(vi.x); o[1] = bfhi(cg_.x) * bfhi(vi.x); o[2] = bflo(cg_.y) * bflo(vi.y); o[3] = bfhi(cg_.y) * bfhi(vi.y); \
                o[4] = bflo(cg_.z) * bflo(vi.z); o[5] = bfhi(cg_.z) * bfhi(vi.z); o[6] = bflo(cg_.w) * bflo(vi.w); o[7] = bfhi(cg_.w) * bfhi(vi.w); } while (0)
            if (hasprev) LOADCV(r0 - 1, cp); else {
#pragma unroll
                for (int i = 0; i < 8; ++i) cp[i] = 0.f; }
            LOADCV(r0, cc);
            for (int rr = 0; rr < 16; ++rr) { const int row = r0 + rr;
                if (rr < 15 || hasnext) LOADCV(row + 1, cn); else {
#pragma unroll
                    for (int i = 0; i < 8; ++i) cn[i] = 0.f; }
                const u32x4 bg = *(const u32x4*)(PB + (size_t)row * 3072 + ch0);
                float bb[8] = {bflo(bg.x), bfhi(bg.x), bflo(bg.y), bfhi(bg.y), bflo(bg.z), bfhi(bg.z), bflo(bg.w), bfhi(bg.w)}; float y[8];
#pragma unroll
                for (int i = 0; i < 8; ++i) y[i] = bb[i] * (w0[i] * cp[i] + w1[i] * cc[i] + w2[i] * cn[i]);
                u32x4 o = {pk2(y[0], y[1]), pk2(y[2], y[3]), pk2(y[4], y[5]), pk2(y[6], y[7])};
                *(u32x4*)(YCAT + (size_t)row * DM + ch0) = o;
#pragma unroll
                for (int i = 0; i < 8; ++i) { cp[i] = cc[i]; cc[i] = cn[i]; } }
        }
        SchedDFT S{(const char*)CMAT, (const char*)CMATC, (const char*)(ws + WS_ZTL), (const char*)(ws + WS_ZTC), (char*)YCAT, G, blk};
        pg8::gemm_phase<SchedDFT, pg8::EpiStore, false>(lds, S, pg8::EpiStore{});
    }
    SYNC(3);

    TS(4);
    if (PHON(4) && IN(4)) REPS(4) { PHASE_BEGIN
        SchedOut0 S{(const char*)YCAT, (const char*)WOUT0, ka->x, ka->ctx, mod, (char*)H, G, blk};
        pg8::gemm_phase<SchedOut0, pg8::EpiResid, false>(lds, S, pg8::EpiResid{});
    }
    SYNC(4);

#pragma unroll
    for (int l = 0; l < 2; ++l) {
        const int pb = (l == 0) ? 5 : 14;
#define cnt (ctl + 32 * l)
#define modl (mod + (size_t)l * 5 * MODSZ)
        TS(pb);
        if (PHON(5) && IN(pb)) REPS(5) { PHASE_BEGIN
            LAS int* ri = (LAS int*)lds;
            LAS int* lbase = (LAS int*)(lds + 2048);
            LAS float* yl = (LAS float*)(lds + 4096 + wave * 8192);
            const int rpb = (l == 0) ? 68 : 64;
            const float* wg = ka->moe_w_group + (size_t)l * DM * 4; const float* bgp = ka->moe_b_group + l * 4;
            const float* we = ka->moe_w_expert + (size_t)l * DM * 16; const float* bep = ka->moe_b_expert + l * 16;
            for (int i = wave; i < rpb; i += NWAVES) {
                const int li = blk * rpb + i; const int row = (l == 0) ? li : (li / SEQ) * TPB + CTX + (li % SEQ);
                int b, j; row_info(row, b, j);
                const float* mv = modl + (size_t)(j < CTX ? 4 : b) * MODSZ;
                const float* hrow = H + (size_t)row * DM;
                f32x4 v[8]; float ss = 0.f;
#pragma unroll
                for (int jj = 0; jj < 8; ++jj) { v[jj] = *(const f32x4*)(hrow + 4 * lane + 256 * jj); ss += v[jj][0] * v[jj][0] + v[jj][1] * v[jj][1] + v[jj][2] * v[jj][2] + v[jj][3] * v[jj][3]; }
                const float rstd = rsqrtf(wave_sum(ss) * (1.0f / DM) + EPS);
                const float* nw = ka->norm2_w + l * DM;
#pragma unroll
                for (int jj = 0; jj < 8; ++jj) { const int k = 4 * lane + 256 * jj;
                    const f32x4 w = *(const f32x4*)(nw + k), s = *(const f32x4*)(mv + 4 * DM + k), t = *(const f32x4*)(mv + 3 * DM + k);
                    v[jj] = v[jj] * rstd * w * (1.0f + s) + t;
                    *(LAS f32x4*)(yl + k) = v[jj];
                    u32x2 o; o.x = pk2(v[jj][0], v[jj][1]); o.y = pk2(v[jj][2], v[jj][3]); *(u32x2*)(U + (size_t)row * DM + k) = o; }
                asm volatile("s_waitcnt lgkmcnt(0)" ::: "memory");
                int e0, e1; float w0, w1; route_row(yl, wg, bgp, we, bep, lane, e0, e1, w0, w1);
                if (lane == 0) { ri[i * 4 + 0] = e0; ri[i * 4 + 1] = e1; ri[i * 4 + 2] = row * 2; ri[i * 4 + 3] = row * 2 + 1; tokw[row * 2] = w0; tokw[row * 2 + 1] = w1; }
            }
            __syncthreads();
            if (tid < NEXP) { int n = 0;
                for (int i = 0; i < rpb; ++i) { n += (ri[i * 4] == tid) + (ri[i * 4 + 1] == tid); }
                int* lp = list + (rep_ ? (int)((WS_END - WS_LIST) / 4) : 0); const int base = n ? (int)atomicAdd(cnt + 16 * rep_ + tid, (unsigned)n) : 0; int p = 0;
                for (int i = 0; i < rpb; ++i) { if (ri[i * 4] == tid) lp[(size_t)tid * LCAP + base + p++] = ri[i * 4 + 2]; if (ri[i * 4 + 1] == tid) lp[(size_t)tid * LCAP + base + p++] = ri[i * 4 + 3]; }
                lbase[tid] = base; }
            __syncthreads();
        }
        SYNC(pb);
        TS(pb + 1);
        if (PHON(6) && IN(pb + 1)) REPS(6) { PHASE_BEGIN
            SchedMoe1 S; S.T.init((LAS int*)(lds + RING_BYTES), cnt); S.v = (const char*)U; S.wgu = (const char*)(ws + WS_WGU); S.hid = (char*)(ws + WS_HID); S.lst = list; S.G = G; S.c = blk;
            pg8::gemm_phase<SchedMoe1, pg8::EpiSwiGLU, true>(lds, S, pg8::EpiSwiGLU{});
        }
        SYNC(pb + 1);
        TS(pb + 2);
        if (PHON(7) && IN(pb + 2)) REPS(7) { PHASE_BEGIN
            SchedMoe2 S; S.T.init((LAS int*)(lds + RING_BYTES), cnt); S.hid = (const char*)(ws + WS_HID); S.wd = (const char*)(ws + WS_WD); S.lst = list; S.G = G; S.c = blk;
            pg8::gemm_phase<SchedMoe2, pg8::EpiScatter, false>(lds, S, pg8::EpiScatter{YB, tokw});
        }
        SYNC(pb + 2);
        if (l == 0) {
            TS(8);
    if (PHON(8) && IN(8)) { PHASE_BEGIN
                const float* mod1 = mod + (size_t)5 * MODSZ;
                for (int row = gw; row < NTOK; row += ngw) { int b, j; row_info(row, b, j); const int vr = (j < CTX) ? 4 : b;
                    const float* g2 = modl + (size_t)vr * MODSZ + 5 * DM; const float* mv1 = mod1 + (size_t)vr * MODSZ;
                    float* hrow = H + (size_t)row * DM; const bf16_t* y0 = YB + (size_t)(row * 2) * DM; const bf16_t* y1 = y0 + DM;
                    f32x4 v[8]; float ss = 0.f;
#pragma unroll
                    for (int jj = 0; jj < 8; ++jj) { const int k = 4 * lane + 256 * jj; const f32x4 hv = *(const f32x4*)(hrow + k), g = *(const f32x4*)(g2 + k);
                        const u32x2 a0 = *(const u32x2*)(y0 + k), a1 = *(const u32x2*)(y1 + k);
                        f32x4 ys = {bflo(a0.x) + bflo(a1.x), bfhi(a0.x) + bfhi(a1.x), bflo(a0.y) + bflo(a1.y), bfhi(a0.y) + bfhi(a1.y)};
                        v[jj] = hv + g * ys; *(f32x4*)(hrow + k) = v[jj];
                        ss += v[jj][0] * v[jj][0] + v[jj][1] * v[jj][1] + v[jj][2] * v[jj][2] + v[jj][3] * v[jj][3]; }
                    const float rstd = rsqrtf(wave_sum(ss) * (1.0f / DM) + EPS);
                    norm_mod_store(v, rstd, ka->norm1_w + DM, mv1 + DM, mv1, U + (size_t)row * DM, lane);
                }
                moe_weight_items(ka->moe_w_gate, ka->moe_w_up, ka->moe_w_down, ws, 1, gw, ngw, (LAS float*)(lds + wave * 16384), lane);
            }
            SYNC(8);
            TS(9);
    if (PHON(9) && IN(9)) REPS(9) { PHASE_BEGIN
                SchedQKV S{(const char*)U, (const char*)WQKV, (char*)QB, G, blk};
                pg8::gemm_phase<SchedQKV, pg8::EpiStore, false>(lds, S, pg8::EpiStore{});
            }
            SYNC(9);
            TS(10);
    if (PHON(10) && IN(10)) { PHASE_BEGIN
                LAS float* rt = (LAS float*)lds;
                for (int i = tid; i < 64 * 32; i += NTHREADS) { const int pos = i >> 5, f = i & 31; const float inv = exp2f(-(float)f * 0.4152410118609203f); const float ang = (float)pos * inv;
                    float tr = ang * 0.15915494309189535f; tr -= floorf(tr); rt[2 * i] = __builtin_amdgcn_cosf(tr); rt[2 * i + 1] = __builtin_amdgcn_sinf(tr); }
                __syncthreads();
                const int hc = lane >> 2, q8 = (lane & 3) * 8;
                for (int it = gw; it < NLAT + NTOK; it += ngw) {
                    const bool isq = it < NLAT; int row;
                    if (isq) row = (it / SEQ) * TPB + CTX + (it % SEQ); else row = it - NLAT;
                    int b, j; row_info(row, b, j); const bool rope = (j >= CTX); const int t = j - CTX, prow = t >> 6, pcol = t & 63;
                    bf16_t* p = (isq ? QB : KB) + (size_t)row * DM + hc * 128; const float* nwp = isq ? ka->odd_q_norm : ka->odd_k_norm;
                    u32x4 raw[4]; float xv[4][8];
                    float ss = 0.f;
#pragma unroll
                    for (int s = 0; s < 4; ++s) { raw[s] = *(const u32x4*)(p + s * 32 + q8);
                        xv[s][0] = bflo(raw[s].x); xv[s][1] = bfhi(raw[s].x); xv[s][2] = bflo(raw[s].y); xv[s][3] = bfhi(raw[s].y); xv[s][4] = bflo(raw[s].z); xv[s][5] = bfhi(raw[s].z); xv[s][6] = bflo(raw[s].w); xv[s][7] = bfhi(raw[s].w);
#pragma unroll
                        for (int i = 0; i < 8; ++i) ss += xv[s][i] * xv[s][i]; }
                    ss += __shfl_xor(ss, 1); ss += __shfl_xor(ss, 2);
                    const float rstd = rsqrtf(ss * (1.0f / 128.0f) + EPS);
#pragma unroll
                    for (int s = 0; s < 4; ++s)
#pragma unroll
                        for (int i = 0; i < 8; ++i) xv[s][i] = xv[s][i] * rstd * nwp[s * 32 + q8 + i];
                    if (rope) {
#pragma unroll
                        for (int ax = 0; ax < 2; ++ax) { const int pos = ax ? pcol : prow;
#pragma unroll
                            for (int i = 0; i < 8; ++i) { const float cs = rt[2 * (pos * 32 + q8 + i)], sn = rt[2 * (pos * 32 + q8 + i) + 1];
                                const float x1 = xv[2 * ax][i], x2 = xv[2 * ax + 1][i]; xv[2 * ax][i] = x1 * cs - x2 * sn; xv[2 * ax + 1][i] = x2 * cs + x1 * sn; } }
                    }
#pragma unroll
                    for (int s = 0; s < 4; ++s) { u32x4 o = {pk2(xv[s][0], xv[s][1]), pk2(xv[s][2], xv[s][3]), pk2(xv[s][4], xv[s][5]), pk2(xv[s][6], xv[s][7])}; *(u32x4*)(p + s * 32 + q8) = o; }
                }
                __syncthreads();
            }
            SYNC(10);
            TS(11);
    if (PHON(11) && IN(11)) REPS(11) { PHASE_BEGIN
                const int vcu = (blk % 8) * (G / 8) + blk / 8;
                for (int U0 = vcu; U0 < 2048; U0 += G) {
                    const int combo = U0 >> 4, qb = U0 & 15, vh = combo & 1, cp_ = (combo >> 1) & 1, hh = (combo >> 2) & 7, b = combo >> 5;
                    const bf16_t* Qp = QB + (size_t)(b * TPB + CTX + qb * 256) * DM + hh * 256 + cp_ * 128;
                    const bf16_t* Kp = KB + (size_t)(b * TPB) * DM + hh * 256 + cp_ * 128;
                    const bf16_t* Vp = VB + (size_t)(b * TPB) * DM + hh * 256 + vh * 128;
                    bf16_t* Op = OB + (size_t)(b * SEQ + qb * 256) * (2 * DM) + cp_ * DM + hh * 256 + vh * 128;
                    att::attn_dense_body(Qp, Kp, Vp, Op, TPB, (char*)lds_raw);
                    __syncthreads();
                }
            }
            SYNC(11);
            TS(12);
    if (PHON(12) && IN(12)) REPS(12) { PHASE_BEGIN
                float d1 = ka->lq1[lane] * ka->lk1[lane] + ka->lq1[lane + 64] * ka->lk1[lane + 64], d2 = ka->lq2[lane] * ka->lk2[lane] + ka->lq2[lane + 64] * ka->lk2[lane + 64];
                d1 = wave_sum(d1); d2 = wave_sum(d2);
                const float lam_init = 0.8f - 0.6f * expf(-0.3f * 1.0f);
                const float lam = expf(d1) - expf(d2) + lam_init;
                const int hh = lane >> 3, e0 = (lane & 7) * 32;
                for (int li = gw; li < NLAT; li += ngw) {
                    const bf16_t* o1 = OB + (size_t)li * (2 * DM) + hh * 256 + e0; const bf16_t* o2 = o1 + DM;
                    float ov[32]; float ss = 0.f;
#pragma unroll
                    for (int s = 0; s < 4; ++s) { const u32x4 p1 = *(const u32x4*)(o1 + 8 * s), p2 = *(const u32x4*)(o2 + 8 * s);
                        ov[8 * s + 0] = bflo(p1.x) - lam * bflo(p2.x); ov[8 * s + 1] = bfhi(p1.x) - lam * bfhi(p2.x); ov[8 * s + 2] = bflo(p1.y) - lam * bflo(p2.y); ov[8 * s + 3] = bfhi(p1.y) - lam * bfhi(p2.y);
                        ov[8 * s + 4] = bflo(p1.z) - lam * bflo(p2.z); ov[8 * s + 5] = bfhi(p1.z) - lam * bfhi(p2.z); ov[8 * s + 6] = bflo(p1.w) - lam * bflo(p2.w); ov[8 * s + 7] = bfhi(p1.w) - lam * bfhi(p2.w); }
#pragma unroll
                    for (int i = 0; i < 32; ++i) ss += ov[i] * ov[i];
                    ss += __shfl_xor(ss, 1); ss += __shfl_xor(ss, 2); ss += __shfl_xor(ss, 4);
                    const float rs = rsqrtf(ss * (1.0f / 256.0f) + EPS) * (1.0f - lam_init);
                    const int row = (li / SEQ) * TPB + CTX + (li % SEQ);
                    bf16_t* ap = AB + (size_t)row * DM + hh * 256 + e0;
#pragma unroll
                    for (int s = 0; s < 4; ++s) { float y[8];
#pragma unroll
                        for (int i = 0; i < 8; ++i) y[i] = ov[8 * s + i] * rs * ka->subln_w[e0 + 8 * s + i];
                        u32x4 o = {pk2(y[0], y[1]), pk2(y[2], y[3]), pk2(y[4], y[5]), pk2(y[6], y[7])}; *(u32x4*)(ap + 8 * s) = o; }
                }
            }
            SYNC(12);
            TS(13);
    if (PHON(13) && IN(13)) { PHASE_BEGIN
                SchedOut1 S{(const char*)AB, (const char*)WOUT1, mod + (size_t)5 * MODSZ, (char*)H, G, blk};
                pg8::gemm_phase<SchedOut1, pg8::EpiResid, false>(lds, S, pg8::EpiResid{});
            }
            SYNC(13);
        } else {
            TS(17);
    if (PHON(17) && IN(17)) REPS(17) { PHASE_BEGIN
                for (int li = gw; li < NLAT; li += ngw) { const int b = li / SEQ, row = b * TPB + CTX + (li % SEQ);
                    const float* g2 = modl + (size_t)b * MODSZ + 5 * DM; const float* hrow = H + (size_t)row * DM; const bf16_t* y0 = YB + (size_t)(row * 2) * DM; const bf16_t* y1 = y0 + DM;
                    float* orow = ka->out + (size_t)li * DM;
#pragma unroll
                    for (int jj = 0; jj < 8; ++jj) { const int k = 4 * lane + 256 * jj; const f32x4 hv = *(const f32x4*)(hrow + k), g = *(const f32x4*)(g2 + k);
                        const u32x2 a0 = *(const u32x2*)(y0 + k), a1 = *(const u32x2*)(y1 + k);
                        f32x4 ys = {bflo(a0.x) + bflo(a1.x), bfhi(a0.x) + bfhi(a1.x), bflo(a0.y) + bflo(a1.y), bfhi(a0.y) + bfhi(a1.y)};
                        f32x4 res = hv + g * ys;
#if PROBE
                        { const unsigned long long* tp_ = (const unsigned long long*)(ws + WS_CTL + 1024); const float c2 = (float)(tp_[3] - tp_[2]) * 1e-4f, w1 = (float)(tp_[1] - tp_[0]) * 1e-2f;
                          res = (f32x4){c2, c2, c2, c2}; if (li == 0 && k == 0) res[0] = w1; }
#endif
                        *(f32x4*)(orow + k) = res; }
                }
            }
        }
    }
    TS(18);
#undef IN
#undef SYNC
#undef cnt
#undef modl
#undef ctl
#undef mod
#undef tokw
#undef list
#undef WIN
#undef WOUT0
#undef WQKV
#undef WOUT1
#undef CMAT
#undef CMATC
#undef H
#undef U
#undef PB
#undef YCAT
#undef QB
#undef KB
#undef VB
#undef AB
#undef YB
#undef OB
}

#ifndef N_LAUNCH_MODE
#define N_LAUNCH_MODE 1
#endif
extern "C" void kernel_launch(void* const* d_in, const int* in_sizes, int n_in, void* d_out, int out_size, void* d_ws, size_t ws_size, hipStream_t stream) {
    static int grid = 0;
    if (grid == 0) {
        if (n_in != 27 || out_size != NLAT * DM || ws_size < WS_END) { fprintf(stderr, "kernel_launch: unexpected shapes: n_in %d out %d ws %zu (need %zu)\n", n_in, out_size, ws_size, (size_t)WS_END); grid = -1; return; }
        int dev = 0, cus = 0, per_cu = 0;
        hipGetDevice(&dev); hipDeviceGetAttribute(&cus, hipDeviceAttributeMultiprocessorCount, dev);
        if (hipFuncSetAttribute((const void*)fwd_kernel, hipFuncAttributeMaxDynamicSharedMemorySize, LDS_BYTES) != hipSuccess) { fprintf(stderr, "kernel_launch: hipFuncSetAttribute failed\n"); grid = -1; return; }
        if (hipOccupancyMaxActiveBlocksPerMultiprocessor(&per_cu, (const void*)fwd_kernel, NTHREADS, LDS_BYTES) != hipSuccess || per_cu < 1) { fprintf(stderr, "kernel_launch: occupancy query says %d\n", per_cu); per_cu = 1; }
        (void)hipGetLastError();
        grid = cus;
        if (grid != 256) fprintf(stderr, "kernel_launch: note: %d CUs\n", grid);
    }
    if (grid < 0) return;
    Args a{};
    const float** ap = (const float**)&a;
    for (int i = 0; i < 27; ++i) ap[i] = (const float*)d_in[i];
    a.out = (float*)d_out; a.ws = (unsigned char*)d_ws;
#if N_LAUNCH_MODE == 1
    a.ph_lo = 0; a.ph_hi = 18;
    void* args[] = {&a};
    hipError_t e = hipLaunchCooperativeKernel((const void*)fwd_kernel, dim3(grid), dim3(NTHREADS), args, LDS_BYTES, stream);
    if (e != hipSuccess) fprintf(stderr, "cooperative launch failed: %s (grid %d)\n", hipGetErrorString(e), grid);
#else
    for (int p = 0; p < 18; ++p) { a.ph_lo = p; a.ph_hi = p + 1; void* args[] = {&a};
        hipError_t e = hipLaunchCooperativeKernel((const void*)fwd_kernel, dim3(grid), dim3(NTHREADS), args, LDS_BYTES, stream);
        if (e != hipSuccess) { fprintf(stderr, "launch %d failed: %s\n", p, hipGetErrorString(e)); break; } }
#endif
}
```

```cpp
#include <hip/hip_runtime.h>
#include <hip/hip_cooperative_groups.h>
#include <cstdio>
#include <cstdint>
namespace cg = cooperative_groups;
#ifndef PROBE
#define PROBE 0
#endif
#ifndef REPMASK
#define REPMASK 0x0
#endif
#define REPS(k) for (int rep_ = 0; rep_ <= ((REPMASK >> (k)) & 1); ++rep_)
#ifndef PA0
#define PA0 0
#define PA1 18
#define PB0 0
#define PB1 18
#endif

#define LAS __attribute__((address_space(3)))
typedef unsigned short bf16_t;
typedef short bf16x8 __attribute__((ext_vector_type(8)));
typedef short s16x4 __attribute__((ext_vector_type(4)));
typedef float f32x2 __attribute__((ext_vector_type(2)));
typedef float f32x4 __attribute__((ext_vector_type(4)));
typedef float f32x8 __attribute__((ext_vector_type(8)));
typedef float f32x16 __attribute__((ext_vector_type(16)));
typedef unsigned u32x2 __attribute__((ext_vector_type(2)));
typedef unsigned u32x4 __attribute__((ext_vector_type(4)));

constexpr int DM = 2048, NB = 4, SEQ = 4096, CTX = 256, TPB = SEQ + CTX  ;
constexpr int NTOK = NB * TPB  , NLAT = NB * SEQ  ;
constexpr int NEXP = 16, EFF = 512, LCAP = 2 * NTOK  ;
constexpr float EPS = 1e-6f;
constexpr int NWAVES = 8, NTHREADS = 512;
constexpr int LDS_BYTES = 155648;
constexpr int RING_BYTES = 131072;

constexpr size_t MiB = 1u << 20;
constexpr size_t WS_CTL = 0, WS_MOD = 1 * MiB, WS_TOKW = 2 * MiB, WS_LIST = 3 * MiB;
constexpr size_t WS_WIN = 6 * MiB, WS_WOUT0 = 26 * MiB, WS_WQKV = 34 * MiB, WS_WOUT1 = 58 * MiB, WS_WGU = 66 * MiB, WS_WD = 130 * MiB;
constexpr size_t WS_CMAT = 162 * MiB, WS_CMATC = 226 * MiB, WS_HID = 162 * MiB  ;
constexpr size_t WS_H = 227 * MiB, WS_U = 363 * MiB;
constexpr size_t WS_P = 431 * MiB, WS_ZTL = 533 * MiB, WS_ZTC = 597 * MiB, WS_YCAT = 601 * MiB;
constexpr size_t WS_Q = 431 * MiB, WS_K = 499 * MiB, WS_V = 567 * MiB, WS_A = 431 * MiB;
static_assert(WS_V - WS_K == WS_K - WS_Q, "QKV spacing");
constexpr size_t WS_Y = 669 * MiB, WS_O = 669 * MiB, WS_END = 805 * MiB;
constexpr int MODSZ = 6 * DM;

typedef const __attribute__((address_space(1))) float* gcf;
typedef __attribute__((address_space(1))) bf16_t* gbf;
__device__ __forceinline__ unsigned f2bf(float f) { unsigned u = __builtin_bit_cast(unsigned, f); return (u + 0x7fffu + ((u >> 16) & 1u)) >> 16; }
__device__ __forceinline__ unsigned pk2(float lo, float hi) { return f2bf(lo) | (f2bf(hi) << 16); }
__device__ __forceinline__ float bflo(unsigned w) { return __uint_as_float(w << 16); }
__device__ __forceinline__ float bfhi(unsigned w) { return __uint_as_float(w & 0xffff0000u); }
__device__ __forceinline__ unsigned cvt_pk_bf16(float lo, float hi) { unsigned r; asm volatile("v_cvt_pk_bf16_f32 %0, %1, %2" : "=v"(r) : "v"(lo), "v"(hi)); return r; }
__device__ __forceinline__ float wave_sum(float v) {
#pragma unroll
    for (int o = 1; o < 64; o <<= 1) v += __shfl_xor(v, o);
    return v;
}
__device__ __forceinline__ float silu_f(float x) { return x * __builtin_amdgcn_rcpf(1.0f + __expf(-x)); }

namespace pg8 {
constexpr int BM = 256, BK = 64, HALF = 128, HTB = HALF * BK * 2, STAGE_BYTES = 8 * HTB, NXCD = 8, WGM = 8;
__host__ __device__ __forceinline__ int lds_byte(int r, int c) { const int st = (r >> 4) * 2 + (c >> 5), rr = r & 15, cc = c & 31, ob = rr * 64 + cc * 2; return st * 1024 + (ob ^ (((ob >> 9) & 1) << 5)); }
__host__ __device__ __forceinline__ void stage_rc(int b, int& R, int& C) { const int st = b / 1024, sb = b % 1024, swz = sb ^ (((sb >> 9) & 1) << 5); R = (st >> 1) * 16 + swz / 64; C = (st & 1) * 32 + (swz % 64) / 2; }
__host__ __device__ __forceinline__ int perm32(int rho) { const int n = rho >> 4, i = rho & 15; return 8 * (i >> 2) + 4 * n + (i & 3); }

struct GUnit {
    const char* A; const char* B; unsigned lda, ldb; int nt;
    char* O; int ldc; float scale;
    const char* src; const float* gate;
    const int* glist; int gcount;
    int aux;
};
__device__ __forceinline__ void tile_of(int L, int nM, int nN, int& pm, int& pn) {
    const int nwg = nM * nN; int wgid = L;
    { const int q = nwg / NXCD, r = nwg % NXCD, xcd = wgid % NXCD, off = wgid / NXCD; wgid = (xcd < r ? xcd * (q + 1) : r * (q + 1) + (xcd - r) * q) + off; }
    const int nig = WGM * nN, gid = wgid / nig, fm = gid * WGM, gsz = (nM - fm) < WGM ? (nM - fm) : WGM;
    pm = fm + ((wgid % nig) % gsz); pn = (wgid % nig) / gsz;
}
__device__ __forceinline__ int xcd_remap(int L, int nwg) {
    const int q = nwg / NXCD, r = nwg % NXCD, xcd = L % NXCD, off = L / NXCD; return (xcd < r ? xcd * (q + 1) : r * (q + 1) + (xcd - r) * q) + off;
}

struct EpiStore {
    __device__ __forceinline__ void operator()(const f32x4 (&acc)[2][2][4][2], const GUnit& u, int wr, int wc, int fr, int fq) const {
        const float sc = u.scale;
#pragma unroll
        for (int ai = 0; ai < 2; ++ai)
#pragma unroll
            for (int m = 0; m < 4; ++m) { bf16_t* rowp = (bf16_t*)u.O + (size_t)(ai * HALF + wr * 64 + m * 16 + fr) * u.ldc + wc * 32 + 8 * fq;
#pragma unroll
                for (int bj = 0; bj < 2; ++bj) { const f32x4 v0 = acc[ai][bj][m][0] * sc, v1 = acc[ai][bj][m][1] * sc;
                    u32x4 w; w.x = cvt_pk_bf16(v0[0], v0[1]); w.y = cvt_pk_bf16(v0[2], v0[3]); w.z = cvt_pk_bf16(v1[0], v1[1]); w.w = cvt_pk_bf16(v1[2], v1[3]);
                    *(u32x4*)(rowp + bj * HALF) = w; } }
    }
};
struct EpiSwiGLU {
    __device__ __forceinline__ void operator()(const f32x4 (&acc)[2][2][4][2], const GUnit& u, int wr, int wc, int fr, int fq) const {
#pragma unroll
        for (int ai = 0; ai < 2; ++ai)
#pragma unroll
            for (int m = 0; m < 4; ++m) { bf16_t* rowp = (bf16_t*)u.O + (size_t)(ai * HALF + wr * 64 + m * 16 + fr) * u.ldc + wc * 32 + 8 * fq;
                float h[8];
#pragma unroll
                for (int n = 0; n < 2; ++n)
#pragma unroll
                    for (int i = 0; i < 4; ++i) h[4 * n + i] = silu_f(acc[ai][0][m][n][i]) * acc[ai][1][m][n][i];
                u32x4 w; w.x = cvt_pk_bf16(h[0], h[1]); w.y = cvt_pk_bf16(h[2], h[3]); w.z = cvt_pk_bf16(h[4], h[5]); w.w = cvt_pk_bf16(h[6], h[7]);
                *(u32x4*)rowp = w; }
    }
};
struct EpiScatter {
    bf16_t* Y; const float* tokw;
    __device__ __forceinline__ void operator()(const f32x4 (&acc)[2][2][4][2], const GUnit& u, int wr, int wc, int fr, int fq) const {
#pragma unroll
        for (int ai = 0; ai < 2; ++ai)
#pragma unroll
            for (int m = 0; m < 4; ++m) { const int r = ai * HALF + wr * 64 + m * 16 + fr;
                if (r < u.gcount) { const int a = u.glist[r]; const float sc = tokw[a];
                    bf16_t* rowp = Y + (size_t)a * DM + u.aux * 256 + wc * 32 + 8 * fq;
#pragma unroll
                    for (int bj = 0; bj < 2; ++bj) { const f32x4 v0 = acc[ai][bj][m][0] * sc, v1 = acc[ai][bj][m][1] * sc;
                        u32x4 w; w.x = cvt_pk_bf16(v0[0], v0[1]); w.y = cvt_pk_bf16(v0[2], v0[3]); w.z = cvt_pk_bf16(v1[0], v1[1]); w.w = cvt_pk_bf16(v1[2], v1[3]);
                        *(u32x4*)(rowp + bj * HALF) = w; } } }
    }
};
struct EpiResid {
    __device__ __forceinline__ void operator()(const f32x4 (&acc)[2][2][4][2], const GUnit& u, int wr, int wc, int fr, int fq) const {
        f32x4 g[2][2];
#pragma unroll
        for (int bj = 0; bj < 2; ++bj)
#pragma unroll
            for (int n = 0; n < 2; ++n) g[bj][n] = *(const f32x4*)(u.gate + bj * HALF + wc * 32 + 8 * fq + 4 * n);
#pragma unroll
        for (int ai = 0; ai < 2; ++ai)
#pragma unroll
            for (int m = 0; m < 4; ++m) { const size_t off = (size_t)(ai * HALF + wr * 64 + m * 16 + fr) * DM + wc * 32 + 8 * fq;
#pragma unroll
                for (int bj = 0; bj < 2; ++bj)
#pragma unroll
                    for (int n = 0; n < 2; ++n) { const f32x4 s = *(const f32x4*)((const float*)u.src + off + bj * HALF + 4 * n);
                        *(f32x4*)((float*)u.O + off + bj * HALF + 4 * n) = s + g[bj][n] * acc[ai][bj][m][n]; } }
    }
};

template <bool GATHER>
__device__ __forceinline__ void mkvoff(const GUnit& u, unsigned (&vA)[2][2], unsigned (&vB)[2][2]) {
    int tid = threadIdx.x; asm volatile("" : "+v"(tid));
    int R0, C0, R1, C1; stage_rc(tid * 16, R0, C0); stage_rc(tid * 16 + 8192, R1, C1);
    const int Rb0 = (R0 & ~31) + perm32(R0 & 31), Rb1 = (R1 & ~31) + perm32(R1 & 31);
#pragma unroll
    for (int h = 0; h < 2; ++h) {
        if constexpr (GATHER) {
            const int r0 = h * HALF + R0, r1 = h * HALF + R1;
            const int t0 = (r0 < u.gcount) ? (u.glist[r0] >> 1) : 0, t1 = (r1 < u.gcount) ? (u.glist[r1] >> 1) : 0;
            vA[h][0] = (unsigned)t0 * u.lda + (unsigned)C0 * 2u; vA[h][1] = (unsigned)t1 * u.lda + (unsigned)C1 * 2u;
        } else {
            vA[h][0] = (unsigned)(h * HALF + R0) * u.lda + (unsigned)C0 * 2u; vA[h][1] = (unsigned)(h * HALF + R1) * u.lda + (unsigned)C1 * 2u;
        }
        vB[h][0] = (unsigned)(h * HALF + Rb0) * u.ldb + (unsigned)C0 * 2u; vB[h][1] = (unsigned)(h * HALF + Rb1) * u.ldb + (unsigned)C1 * 2u;
    }
}

template <class Sched, class Epi, bool GATHER>
__device__ __forceinline__ void gemm_phase(LAS unsigned char* lds, const Sched& S, const Epi& E) {
    int tid = threadIdx.x; asm volatile("" : "+v"(tid));
    const int wid = __builtin_amdgcn_readfirstlane(tid >> 6), lane = tid & 63, wr = wid >> 2, wc = wid & 3, fr = lane & 15, fq = lane >> 4;
    const size_t kstep = (size_t)(BK * 2);
    const unsigned ldsw = (unsigned)wid * 1024u;
    const int aoff = lds_byte(wr * 64 + fr, fq * 8), boff = lds_byte(wc * 32 + fr, fq * 8);
#define PG8_SA(b, h) (((b) * 2 + (h)) * HTB)
#define PG8_SB(b, h) ((4 + (b) * 2 + (h)) * HTB)
#define PG8_STAGE(bufoff, gbase, voff) do { _Pragma("unroll") for (int _i = 0; _i < 2; ++_i) \
        __builtin_amdgcn_global_load_lds((const unsigned*)((const char*)(gbase) + (voff)[_i]), (LAS unsigned*)(lds + (bufoff) + ldsw + _i * 8192), 16, 0, 0); } while (0)
#define PG8_LDA(dst, b, h) do { _Pragma("unroll") for (int m = 0; m < 4; ++m) _Pragma("unroll") for (int k = 0; k < 2; ++k) dst[m][k] = *(const LAS bf16x8*)(lds + PG8_SA(b, h) + aoff + m * 2048 + k * 1024); } while (0)
#define PG8_LDB(dst, b, h) do { _Pragma("unroll") for (int n = 0; n < 2; ++n) _Pragma("unroll") for (int k = 0; k < 2; ++k) dst[n][k] = *(const LAS bf16x8*)(lds + PG8_SB(b, h) + boff + n * 2048 + k * 1024); } while (0)
#define PG8_MMA(ai, bj, At, Bt) do { __builtin_amdgcn_s_setprio(1); _Pragma("unroll") for (int m = 0; m < 4; ++m) _Pragma("unroll") for (int n = 0; n < 2; ++n) _Pragma("unroll") for (int k = 0; k < 2; ++k) \
        acc[ai][bj][m][n] = __builtin_amdgcn_mfma_f32_16x16x32_bf16(Bt[n][k], At[m][k], acc[ai][bj][m][n], 0, 0, 0); __builtin_amdgcn_s_setprio(0); } while (0)
#define PG8_WAIT_V(n) asm volatile("s_waitcnt vmcnt(" #n ")" ::: "memory")
#define PG8_WAIT_L(n) asm volatile("s_waitcnt lgkmcnt(" #n ")" ::: "memory")
#define PG8_BAR __builtin_amdgcn_s_barrier()
#define PG8_SCHED __builtin_amdgcn_sched_barrier(0)
    GUnit cur, nxt; int ui = 0;
    if (!S.next(0, cur)) return;
    unsigned vA[2][2], vB[2][2];
    mkvoff<GATHER>(cur, vA, vB);
    f32x4 acc[2][2][4][2];
#pragma unroll
    for (int a = 0; a < 2; ++a)
#pragma unroll
        for (int b = 0; b < 2; ++b)
#pragma unroll
            for (int m = 0; m < 4; ++m)
#pragma unroll
                for (int n = 0; n < 2; ++n) acc[a][b][m][n] = (f32x4){0.f, 0.f, 0.f, 0.f};
    bf16x8 At[4][2], B0[2][2], B1[2][2];
    const char* cA = cur.A; const char* cB = cur.B;
    PG8_STAGE(PG8_SB(0, 0), cB, vB[0]); PG8_STAGE(PG8_SB(0, 1), cB, vB[1]); PG8_STAGE(PG8_SA(0, 0), cA, vA[0]); PG8_STAGE(PG8_SA(0, 1), cA, vA[1]);
    if (wr == 1) PG8_BAR;
    PG8_WAIT_V(2); PG8_BAR;
    PG8_STAGE(PG8_SB(1, 0), cB + kstep, vB[0]); PG8_STAGE(PG8_SA(1, 0), cA + kstep, vA[0]); PG8_STAGE(PG8_SB(1, 1), cB + kstep, vB[1]);
    PG8_WAIT_V(6); PG8_BAR;
    for (;;) {
        const bool has_next = S.next(ui + 1, nxt);
        const char* nA = has_next ? nxt.A : cA; const char* nB = has_next ? nxt.B : cB;
        const int nt = cur.nt;
        for (int t = 0; t < nt; t += 2) {
            const bool last = (t == nt - 2);
            const char* a1 = cA + (size_t)(t + 1) * kstep;
            const char* a2 = last ? nA : cA + (size_t)(t + 2) * kstep; const char* b2 = last ? nB : cB + (size_t)(t + 2) * kstep;
            const char* a3 = a2 + kstep; const char* b3 = b2 + kstep;
            PG8_LDB(B0, 0, 0); PG8_LDB(B1, 0, 1); PG8_SCHED; PG8_LDA(At, 0, 0); PG8_STAGE(PG8_SA(1, 1), a1, vA[1]);
            if (last && has_next) mkvoff<GATHER>(nxt, vA, vB);
            PG8_WAIT_V(8); PG8_WAIT_L(0); PG8_BAR; PG8_MMA(0, 0, At, B0); PG8_MMA(0, 1, At, B1); PG8_BAR; PG8_SCHED;
            PG8_LDA(At, 0, 1); PG8_STAGE(PG8_SB(0, 0), b2, vB[0]); PG8_STAGE(PG8_SB(0, 1), b2, vB[1]); PG8_STAGE(PG8_SA(0, 0), a2, vA[0]);
            PG8_WAIT_V(8); PG8_WAIT_L(0); PG8_BAR; PG8_MMA(1, 0, At, B0); PG8_MMA(1, 1, At, B1); PG8_BAR; PG8_SCHED;
            PG8_LDB(B0, 1, 0); PG8_LDB(B1, 1, 1); PG8_SCHED; PG8_LDA(At, 1, 0); PG8_STAGE(PG8_SA(0, 1), a2, vA[1]);
            PG8_WAIT_V(8); PG8_WAIT_L(0); PG8_BAR; PG8_MMA(0, 0, At, B0); PG8_MMA(0, 1, At, B1); PG8_BAR; PG8_SCHED;
            PG8_LDA(At, 1, 1); PG8_STAGE(PG8_SB(1, 0), b3, vB[0]); PG8_STAGE(PG8_SB(1, 1), b3, vB[1]); PG8_STAGE(PG8_SA(1, 0), a3, vA[0]);
            PG8_WAIT_V(8); PG8_WAIT_L(0); PG8_BAR; PG8_MMA(1, 0, At, B0); PG8_MMA(1, 1, At, B1); PG8_BAR; PG8_SCHED;
        }
        if (wr == 0) PG8_BAR;
        E(acc, cur, wr, wc, fr, fq);
        if (!has_next) break;
#pragma unroll
        for (int a = 0; a < 2; ++a)
#pragma unroll
            for (int b = 0; b < 2; ++b)
#pragma unroll
                for (int m = 0; m < 4; ++m)
#pragma unroll
                    for (int n = 0; n < 2; ++n) acc[a][b][m][n] = (f32x4){0.f, 0.f, 0.f, 0.f};
        cur = nxt; cA = nA; cB = nB; ++ui;
        if (wr == 1) PG8_BAR;
    }
    PG8_WAIT_V(0);
    PG8_BAR;
#undef PG8_SA
#undef PG8_SB
#undef PG8_STAGE
#undef PG8_LDA
#undef PG8_LDB
#undef PG8_MMA
#undef PG8_WAIT_V
#undef PG8_WAIT_L
#undef PG8_BAR
#undef PG8_SCHED
}
}
using pg8::GUnit;

namespace att {
constexpr int D = 128, NW = 8, QBLK = 32, KVBLK = 64;
constexpr float SCALE = 0.088388347648318440f;
constexpr float THR = 8.f;
constexpr int LDQ = DM, LDK = DM, LDO = 2 * DM;
constexpr size_t SHM_V = KVBLK * D * 2, SHM_K = KVBLK * D * 2, SHM_ATTN = 2 * SHM_V + 2 * SHM_K + NW * 64 * 4;
#define KSWZ(row, colB) ((row) * 256 + ((colB) ^ (((row) & 7) << 4)))
#define SBAR() __builtin_amdgcn_sched_barrier(0)
__device__ __forceinline__ int crow(int r, int hi) { return (r & 3) + 8 * (r >> 2) + 4 * hi; }
__device__ __forceinline__ unsigned cvtpk(float lo, float hi) { unsigned r; asm volatile("v_cvt_pk_bf16_f32 %0, %1, %2" : "=v"(r) : "v"(lo), "v"(hi)); return r; }
__device__ __forceinline__ void partialSM(f32x16& p0, f32x16& p1, float& m_reg, float& mn, float& alpha) {
  constexpr float C = SCALE * 1.4426950408889634f;
  float pmax = p0[0]; for (int r = 1; r < 16; ++r) pmax = fmaxf(pmax, p0[r]); for (int r = 0; r < 16; ++r) pmax = fmaxf(pmax, p1[r]);
  { auto rr = __builtin_amdgcn_permlane32_swap(__float_as_uint(pmax), __float_as_uint(pmax), false, false);
    pmax = fmaxf(__uint_as_float(rr[0]), __uint_as_float(rr[1])); }
  if (__builtin_expect(__all(pmax - m_reg <= THR / SCALE), 1)) { mn = m_reg; alpha = 1.f; }
  else { mn = fmaxf(m_reg, pmax); alpha = __builtin_amdgcn_exp2f((m_reg - mn) * C); m_reg = mn; }
  float mnC = -mn * C;
  for (int r = 0; r < 16; ++r) p0[r] = fmaf(p0[r], C, mnC); for (int r = 0; r < 16; ++r) p1[r] = fmaf(p1[r], C, mnC);
  for (int r = 0; r < 16; ++r) p0[r] = __builtin_amdgcn_exp2f(p0[r]);
}
__device__ __forceinline__ void finishSM(f32x16& p0, f32x16& p1, float alpha, float& l_reg, bf16x8& pa0, bf16x8& pa1, bf16x8& pa2, bf16x8& pa3) {
  for (int r = 0; r < 16; ++r) p1[r] = __builtin_amdgcn_exp2f(p1[r]);
  float ps = 0; for (int r = 0; r < 16; ++r) ps += p0[r]; for (int r = 0; r < 16; ++r) ps += p1[r];
  { auto rr = __builtin_amdgcn_permlane32_swap(__float_as_uint(ps), __float_as_uint(ps), false, false);
    ps = __uint_as_float(rr[0]) + __uint_as_float(rr[1]); }
  l_reg = l_reg * alpha + ps;
#define PK4(P, BASE, OUT) do { unsigned a0 = cvtpk(P[BASE + 0], P[BASE + 1]), a1 = cvtpk(P[BASE + 2], P[BASE + 3]);   \
    unsigned b0 = cvtpk(P[BASE + 4], P[BASE + 5]), b1 = cvtpk(P[BASE + 6], P[BASE + 7]);                              \
    auto r0 = __builtin_amdgcn_permlane32_swap(a0, b0, false, false); auto r1 = __builtin_amdgcn_permlane32_swap(a1, b1, false, false); \
    u32x4 w = {r0[0], r1[0], r0[1], r1[1]}; OUT = *reinterpret_cast<bf16x8*>(&w); } while (0)
  PK4(p0, 0, pa0); PK4(p0, 8, pa1); PK4(p1, 0, pa2); PK4(p1, 8, pa3);
#undef PK4
}
__device__ __forceinline__ void qkt(f32x16& p0, f32x16& p1, const bf16_t* Ks, const bf16x8* qr, int r32, int hi) {
  p0 = f32x16{}; p1 = f32x16{};
  for (int d0 = 0; d0 < 8; ++d0) { int cb = (d0 * 16 + hi * 8) * 2;
    bf16x8 b0 = *reinterpret_cast<const bf16x8*>((const char*)Ks + KSWZ(r32, cb));
    bf16x8 b1 = *reinterpret_cast<const bf16x8*>((const char*)Ks + KSWZ(32 + r32, cb));
    p0 = __builtin_amdgcn_mfma_f32_32x32x16_bf16(b0, qr[d0], p0, 0, 0, 0);
    p1 = __builtin_amdgcn_mfma_f32_32x32x16_bf16(b1, qr[d0], p1, 0, 0, 0); }
}
__device__ __forceinline__ int v_st(int k, int c) { const int kk = (k & ~0xC) | ((k & 4) << 1) | ((k & 8) >> 1); return ((kk >> 3) * 4 + (c >> 5)) * 512 + ((kk & 7) * 32 + (c & 31)) * 2; }
__device__ __forceinline__ int v_rd_base(int lane) { return ((lane & 3) << 3) | (((lane >> 2) & 3) << 6) | (((lane >> 4) & 1) << 5) | (((lane >> 5) & 1) << 8); }
constexpr int v_rd_off(int d0, int ks, int half) { return d0 * 512 + ks * 4096 + half * 2048; }
template <int OFF> __device__ __forceinline__ s16x4 tr_read(int vb) {
  s16x4 r; asm volatile("ds_read_b64_tr_b16 %0, %1 offset:%2" : "=&v"(r) : "v"(vb), "i"(OFF) : "memory"); return r;
}
template <int D0> __device__ __forceinline__ void pv_one(f32x16& od, int vb, bf16x8 pa0, bf16x8 pa1, bf16x8 pa2, bf16x8 pa3) {
  const s16x4 l0 = tr_read<v_rd_off(D0, 0, 0)>(vb), h0 = tr_read<v_rd_off(D0, 0, 1)>(vb), l1 = tr_read<v_rd_off(D0, 1, 0)>(vb), h1 = tr_read<v_rd_off(D0, 1, 1)>(vb);
  const s16x4 l2 = tr_read<v_rd_off(D0, 2, 0)>(vb), h2 = tr_read<v_rd_off(D0, 2, 1)>(vb), l3 = tr_read<v_rd_off(D0, 3, 0)>(vb), h3 = tr_read<v_rd_off(D0, 3, 1)>(vb);
  asm volatile("s_waitcnt lgkmcnt(0)" ::: "memory"); SBAR();
#define PK(L, H) (bf16x8){L[0], L[1], L[2], L[3], H[0], H[1], H[2], H[3]}
  od = __builtin_amdgcn_mfma_f32_32x32x16_bf16(pa0, PK(l0, h0), od, 0, 0, 0);
  od = __builtin_amdgcn_mfma_f32_32x32x16_bf16(pa1, PK(l1, h1), od, 0, 0, 0);
  od = __builtin_amdgcn_mfma_f32_32x32x16_bf16(pa2, PK(l2, h2), od, 0, 0, 0);
  od = __builtin_amdgcn_mfma_f32_32x32x16_bf16(pa3, PK(l3, h3), od, 0, 0, 0);
#undef PK
}
__device__ __forceinline__ void pv_d0(f32x16* o, int vb, bf16x8 pa0, bf16x8 pa1, bf16x8 pa2, bf16x8 pa3) {
  pv_one<0>(o[0], vb, pa0, pa1, pa2, pa3); pv_one<1>(o[1], vb, pa0, pa1, pa2, pa3); pv_one<2>(o[2], vb, pa0, pa1, pa2, pa3); pv_one<3>(o[3], vb, pa0, pa1, pa2, pa3);
}
__device__ __forceinline__ void attn_dense_body(const bf16_t* Qb, const bf16_t* Kh, const bf16_t* Vh, bf16_t* Ob, int seq, char* lds) {
  int tid = threadIdx.x; asm volatile("" : "+v"(tid));
  const int wid = tid >> 6, lane = tid & 63, r32 = lane & 31, hi = lane >> 5;
  bf16_t* V_lds = (bf16_t*)lds; bf16_t* K_lds = (bf16_t*)(lds + 2 * SHM_V);
  float* ws = (float*)(lds + 2 * SHM_V + 2 * SHM_K) + wid * 64; float* li_l = ws; float* al_l = ws + 32;
  float m_reg = -1e30f, l_reg = 0; f32x16 o[4] = {}; bf16x8 qr[8];
  const bf16_t* Qw = Qb + (long)(wid * QBLK + r32) * LDQ + hi * 8;
#pragma unroll
  for (int d0 = 0; d0 < 8; ++d0) qr[d0] = *reinterpret_cast<const bf16x8*>(Qw + d0 * 16);
  const int sr = tid >> 4, sc = (tid & 15) * 8, vst0 = v_st(sr, sc), vst1 = v_st(32 + sr, sc);
  const int vb0 = (int)(uintptr_t)V_lds + v_rd_base(lane);
  struct { bf16x8 vs0, vs1, ks0, ks1; } sr_[2];
  const unsigned goff = (unsigned)(sr * LDK + sc) * 2u;
#define SLOAD(i, k0) do { const char* vb_ = (const char*)Vh + (size_t)(k0) * (LDK * 2); const char* kb_ = (const char*)Kh + (size_t)(k0) * (LDK * 2); \
    sr_[i].vs0 = *reinterpret_cast<const bf16x8*>(vb_ + goff); sr_[i].vs1 = *reinterpret_cast<const bf16x8*>(vb_ + 32 * LDK * 2 + goff); \
    sr_[i].ks0 = *reinterpret_cast<const bf16x8*>(kb_ + goff); sr_[i].ks1 = *reinterpret_cast<const bf16x8*>(kb_ + 32 * LDK * 2 + goff); } while (0)
#define SWRITE(b, i) do { *(bf16x8*)((char*)V_lds + (b) * SHM_V + vst0) = sr_[i].vs0;          \
    *(bf16x8*)((char*)V_lds + (b) * SHM_V + vst1) = sr_[i].vs1; int kc = sc * 2;               \
    *(bf16x8*)((char*)K_lds + (b) * SHM_K + KSWZ(sr, kc)) = sr_[i].ks0;                       \
    *(bf16x8*)((char*)K_lds + (b) * SHM_K + KSWZ(32 + sr, kc)) = sr_[i].ks1; } while (0)
#define SWAIT() asm volatile("s_waitcnt vmcnt(4)" ::: "memory")
#define RESC(a) do { if (__any((a) < 1.f)) { if (hi == 0) al_l[r32] = (a); asm volatile("s_waitcnt lgkmcnt(0)" ::: "memory"); \
    for (int d = 0; d < 4; ++d) for (int r = 0; r < 16; ++r) o[d][r] *= al_l[crow(r, hi)]; } } while (0)
  f32x16 pA0, pA1, pB0, pB1; float mnA, mnB, alA, alB; bf16x8 pa0, pa1, pa2, pa3; const int NT = seq / KVBLK;
  constexpr int SE = 0, SO = 1;
  SLOAD(SE, 0); asm volatile("s_waitcnt vmcnt(0)" ::: "memory"); SWRITE(0, SE); __syncthreads();
  qkt(pA0, pA1, K_lds, qr, r32, hi); partialSM(pA0, pA1, m_reg, mnA, alA);
  SLOAD(SO, KVBLK); if (2 < NT) SLOAD(SE, 2 * KVBLK);
  SWAIT(); SWRITE(1, SO); __syncthreads();
  for (int j = 1; j + 1 < NT; j += 2) {
    SBAR(); qkt(pB0, pB1, (bf16_t*)((char*)K_lds + SHM_K), qr, r32, hi);
    finishSM(pA0, pA1, alA, l_reg, pa0, pa1, pa2, pa3); SBAR();
    SLOAD(SO, (j + 2) * KVBLK); SBAR();
    pv_d0(o, vb0, pa0, pa1, pa2, pa3); partialSM(pB0, pB1, m_reg, mnB, alB);
    __syncthreads(); SWAIT(); SWRITE(0, SE);
    RESC(alB); __syncthreads();
    SBAR(); qkt(pA0, pA1, K_lds, qr, r32, hi);
    finishSM(pB0, pB1, alB, l_reg, pa0, pa1, pa2, pa3); SBAR();
    if (j + 3 < NT) SLOAD(SE, (j + 3) * KVBLK); SBAR();
    pv_d0(o, vb0 + (int)SHM_V, pa0, pa1, pa2, pa3); partialSM(pA0, pA1, m_reg, mnA, alA);
    __syncthreads(); SWAIT(); SWRITE(1, SO);
    RESC(alA); __syncthreads();
  }
  SBAR(); qkt(pB0, pB1, (bf16_t*)((char*)K_lds + SHM_K), qr, r32, hi);
  finishSM(pA0, pA1, alA, l_reg, pa0, pa1, pa2, pa3); SBAR();
  pv_d0(o, vb0, pa0, pa1, pa2, pa3); partialSM(pB0, pB1, m_reg, mnB, alB);
  __syncthreads(); RESC(alB);
  finishSM(pB0, pB1, alB, l_reg, pa0, pa1, pa2, pa3); SBAR();
  pv_d0(o, vb0 + (int)SHM_V, pa0, pa1, pa2, pa3);
  if (hi == 0) li_l[r32] = l_reg; asm volatile("s_waitcnt lgkmcnt(0)" ::: "memory");
  float rli[16];
#pragma unroll
  for (int r = 0; r < 16; ++r) rli[r] = __builtin_amdgcn_rcpf(li_l[crow(r, hi)]);
  bf16_t* Ow = Ob + (long)(wid * QBLK) * LDO;
#pragma unroll
  for (int r = 0; r < 16; ++r) { int orow = crow(r, hi);
    for (int d0 = 0; d0 < 4; ++d0) Ow[(long)orow * LDO + d0 * 32 + r32] = (bf16_t)f2bf(o[d0][r] * rli[r]); }
#undef SLOAD
#undef SWRITE
#undef SWAIT
#undef RESC
}
#undef KSWZ
#undef SBAR
}


#define XB_TMO      128
#define XB_XCNT(j)  (256  + 64 * (j))
#define XB_XSUB(j)  (1280 + 64 * (j))
#define XB_XGEN(j)  (2304 + 64 * (j))
#define XB_TOP      3328
#define XB_TOPGEN   3392
#define XCD_BAR_WORDS 3456
#define XB_SPIN_CAP (1u << 18)
__device__ __forceinline__ unsigned xb_ld(unsigned* p)              { return __hip_atomic_load(p, __ATOMIC_RELAXED, __HIP_MEMORY_SCOPE_AGENT); }
__device__ __forceinline__ unsigned xb_add(unsigned* p, unsigned v) { return __hip_atomic_fetch_add(p, v, __ATOMIC_RELAXED, __HIP_MEMORY_SCOPE_AGENT); }
__device__ __forceinline__ unsigned xb_xcc_id() { return (unsigned)__builtin_amdgcn_s_getreg((3 << 11) | 20) & 0xFu; }
#define XB_SPIN(cond, bar) do { unsigned _sp = 0; while (cond) { __builtin_amdgcn_s_sleep(1); \
    if ((++_sp & 255u) == 0u) { if (xb_ld(&(bar)[XB_TMO])) break; if (_sp > XB_SPIN_CAP) { atomicAdd(&(bar)[XB_TMO], 1u); break; } } } } while (0)
__device__ __forceinline__ void xcd_barrier_complete(unsigned* bar, unsigned x, unsigned& nloc, unsigned& nx) {
    const unsigned G = gridDim.x * gridDim.y * gridDim.z;
    unsigned sum, cnt, mine, sp = 0u;
    for (;;) {
        sum = 0u; cnt = 0u; mine = 0u;
#pragma unroll
        for (unsigned j = 0; j < 16; ++j) { const unsigned c = xb_ld(&bar[XB_XCNT(j)]); sum += c; cnt += (c > 0u) ? 1u : 0u; mine = (j == x) ? c : mine; }
        if (sum == G) break;
        __builtin_amdgcn_s_sleep(1);
        if ((++sp & 255u) == 0u) { if (xb_ld(&bar[XB_TMO])) break; if (sp > XB_SPIN_CAP) { atomicAdd(&bar[XB_TMO], 1u); break; } }
    }
    nloc = mine > 0u ? mine : 1u; nx = cnt > 0u ? cnt : 1u;
}
__device__ __forceinline__ void xcd_barrier(unsigned* bar, volatile LAS unsigned* st) {
    asm volatile("s_waitcnt vmcnt(0)" ::: "memory");
    __syncthreads();
    if (threadIdx.x == 0) {
        const unsigned x = xb_xcc_id();
        __builtin_amdgcn_s_waitcnt(0);
        unsigned nloc = st[0], nx = st[1];
        if (nloc == 0u) { xcd_barrier_complete(bar, x, nloc, nx); st[0] = nloc; st[1] = nx; }
        const unsigned old = xb_add(&bar[XB_XSUB(x)], 1u);
        const unsigned gen = old / nloc;
        if (old + 1u == (gen + 1u) * nloc) {
            __builtin_amdgcn_fence(__ATOMIC_RELEASE, "agent");
            asm volatile("s_waitcnt vmcnt(0)" ::: "memory");
            const unsigned og = xb_add(&bar[XB_TOP], 1u);
            const unsigned tg = og / nx;
            if (og + 1u == (tg + 1u) * nx) xb_add(&bar[XB_TOPGEN], 1u);
            else XB_SPIN(xb_ld(&bar[XB_TOPGEN]) == tg, bar);
            __builtin_amdgcn_fence(__ATOMIC_ACQUIRE, "agent");
            xb_add(&bar[XB_XGEN(x)], 1u);
            asm volatile("s_waitcnt vmcnt(0)" ::: "memory");
        } else {
            XB_SPIN(xb_ld(&bar[XB_XGEN(x)]) == gen, bar);
            __builtin_amdgcn_fence(__ATOMIC_ACQUIRE, "agent");
            asm volatile("s_waitcnt vmcnt(0)" ::: "memory");
        }
    }
    __syncthreads();
}

struct Args;
typedef const __attribute__((address_space(4))) Args* KArgsP;
struct Args {
    const float *x, *c, *ctx, *c_ctx, *norm1_w, *norm2_w, *w_mod, *b_mod, *even_w_in, *even_conv_w, *even_w_out, *odd_w_qkv, *odd_q_norm, *odd_k_norm,
                *lq1, *lk1, *lq2, *lk2, *subln_w, *odd_w_out, *moe_w_group, *moe_b_group, *moe_w_expert, *moe_b_expert, *moe_w_gate, *moe_w_up, *moe_w_down;
    float* out; unsigned char* ws; int ph_lo, ph_hi;
};

__device__ __forceinline__ KArgsP kargs() { KArgsP p = (KArgsP)__builtin_amdgcn_kernarg_segment_ptr(); asm volatile("" : "+s"(p)); return p; }

__device__ __forceinline__ void transpose_item(const float* W, int ldw, int K, bf16_t* WT, int dst_row0, int k0, int n0, LAS float* scr, int lane) {
#pragma unroll 8
    for (int i = 0; i < 32; ++i) { const int kk = 2 * i + (lane >> 5); scr[kk * 33 + (lane & 31)] = W[(size_t)(k0 + kk) * ldw + n0 + (lane & 31)]; }
    asm volatile("s_waitcnt lgkmcnt(0)" ::: "memory");
    const int c = lane & 7;
#pragma unroll
    for (int j = 0; j < 4; ++j) { const int n = (lane >> 3) + 8 * j; const LAS float* s = scr + (8 * c) * 33 + n;
        u32x4 o; o.x = pk2(s[0 * 33], s[1 * 33]); o.y = pk2(s[2 * 33], s[3 * 33]); o.z = pk2(s[4 * 33], s[5 * 33]); o.w = pk2(s[6 * 33], s[7 * 33]);
        *(u32x4*)(WT + (size_t)(dst_row0 + n) * K + k0 + 8 * c) = o; }
    asm volatile("s_waitcnt lgkmcnt(0)" ::: "memory");
}
__device__ __forceinline__ void moe_weight_items(const float* w_gate, const float* w_up, const float* w_down, unsigned char* ws, int l, int gw, int ngw, LAS float* scr, int lane) {
    bf16_t* WGU = (bf16_t*)(ws + WS_WGU); bf16_t* WD = (bf16_t*)(ws + WS_WD);
    constexpr int I_G = NEXP * 32 * 16, I_D = NEXP * 8 * 64;
    for (int it = gw; it < 2 * I_G + I_D; it += ngw) {
        if (it < 2 * I_G) { const int up = it >= I_G, r = up ? it - I_G : it, e = r / 512, kb = (r % 512) / 16, nb = r % 16;
            const float* W = (up ? w_up : w_gate) + ((size_t)l * NEXP + e) * DM * EFF;
            const int n0 = nb * 32, row0 = e * 1024 + (n0 >> 7) * 256 + up * 128 + (n0 & 127);
            transpose_item(W, EFF, DM, WGU, row0, kb * 64, n0, scr, lane);
        } else { const int r = it - 2 * I_G, e = r / 512, kb = (r % 512) / 64, nb = r % 64;
            const float* W = w_down + ((size_t)l * NEXP + e) * EFF * DM;
            transpose_item(W, DM, EFF, WD, e * DM + nb * 32, kb * 64, nb * 32, scr, lane); }
    }
}

struct SchedInProj {
    const char *u0, *win; char *P, *ztl, *ztc; int G, c;
    __device__ __forceinline__ bool next(int i, GUnit& u) const {
        const int L = i * G + c; if (L >= 816 + 544) return false;
        u.lda = DM * 2; u.ldb = DM * 2; u.nt = DM / 64; u.scale = 1.f;
        if (L < 816) { int pm, pn; pg8::tile_of(L, 68, 12, pm, pn);
            u.A = u0 + (size_t)pm * 256 * DM * 2; u.B = win + (size_t)pn * 256 * DM * 2; u.O = P + ((size_t)pm * 256 * 3072 + pn * 256) * 2; u.ldc = 3072;
        } else { int pm, pn; pg8::tile_of(L - 816, 8, 68, pm, pn);
            u.A = win + (size_t)(3072 + pm * 256) * DM * 2; u.B = u0 + (size_t)pn * 256 * DM * 2;
            const int g = pm >> 1, part = pm & 1, b = pn / 17, jt = pn % 17;
            if (jt == 0) { u.O = ztc + ((size_t)((b * 4 + g) * 256) * 512 + part * 256) * 2; u.ldc = 512; }
            else { u.O = ztl + ((size_t)((b * 4 + g) * 256) * 8192 + part * 4096 + (jt - 1) * 256) * 2; u.ldc = 8192; } }
        return true;
    }
};
struct SchedDFT {
    const char *cmat, *cmatc, *ztl, *ztc; char* ycat; int G, c;
    __device__ __forceinline__ bool next(int i, GUnit& u) const {
        const int L = i * G + c; if (L >= 272) return false;
        if (L < 256) { const int w = (L % 8) * 32 + L / 8, bg = w >> 4, pm = w & 15, b = bg >> 2, g = bg & 3;
            u.A = cmat + (size_t)pm * 256 * 16384; u.B = ztl + (size_t)bg * 256 * 16384; u.lda = 16384; u.ldb = 16384; u.nt = 128;
            u.O = ycat + ((size_t)(b * TPB + CTX + pm * 256) * DM + 1024 + g * 256) * 2; u.ldc = DM; u.scale = 1.0f / 1024.0f;
        } else { const int bg = L - 256, b = bg >> 2, g = bg & 3;
            u.A = cmatc; u.B = ztc + (size_t)bg * 256 * 1024; u.lda = 1024; u.ldb = 1024; u.nt = 8;
            u.O = ycat + ((size_t)(b * TPB) * DM + 1024 + g * 256) * 2; u.ldc = DM; u.scale = 1.0f / 256.0f; }
        return true;
    }
};
struct SchedOut0 {
    const char *ycat, *wout; const float *x, *ctx, *mod; char* h; int G, c;
    __device__ __forceinline__ bool next(int i, GUnit& u) const {
        const int L = i * G + c; if (L >= 68 * 8) return false;
        int pm, pn; pg8::tile_of(L, 68, 8, pm, pn);
        u.A = ycat + (size_t)pm * 256 * DM * 2; u.B = wout + (size_t)pn * 256 * DM * 2; u.lda = DM * 2; u.ldb = DM * 2; u.nt = DM / 64;
        const int b = pm / 17, jt = pm % 17, v = (jt == 0) ? 4 : b;
        u.src = (const char*)((jt == 0 ? ctx + (size_t)b * CTX * DM : x + ((size_t)b * SEQ + (jt - 1) * 256) * DM) + pn * 256);
        u.gate = mod + (size_t)v * MODSZ + 2 * DM + pn * 256;
        u.O = h + ((size_t)pm * 256 * DM + pn * 256) * 4;
        return true;
    }
};
struct SchedOut1 {
    const char *a, *wout; const float* mod; char* h; int G, c;
    __device__ __forceinline__ bool next(int i, GUnit& u) const {
        const int L = i * G + c; if (L >= 64 * 8) return false;
        int lt, pn; pg8::tile_of(L, 64, 8, lt, pn);
        const int b = lt >> 4, ut = b * 17 + 1 + (lt & 15);
        u.A = a + (size_t)ut * 256 * DM * 2; u.B = wout + (size_t)pn * 256 * DM * 2; u.lda = DM * 2; u.ldb = DM * 2; u.nt = DM / 64;
        u.O = h + ((size_t)ut * 256 * DM + pn * 256) * 4; u.src = u.O; u.gate = mod + (size_t)b * MODSZ + 2 * DM + pn * 256;
        return true;
    }
};
struct SchedQKV {
    const char *u1, *wqkv; char *q; int G, c;
    __device__ __forceinline__ bool next(int i, GUnit& u) const {
        const int L = i * G + c; if (L >= 1536 + 64) return false;
        int ut, pn;
        if (L < 1536) { int lt; pg8::tile_of(L, 64, 24, lt, pn); ut = (lt >> 4) * 17 + 1 + (lt & 15); }
        else { const int r = L - 1536; ut = (r & 3) * 17; pn = 8 + (r >> 2); }
        u.A = u1 + (size_t)ut * 256 * DM * 2; u.B = wqkv + (size_t)pn * 256 * DM * 2; u.lda = DM * 2; u.ldb = DM * 2; u.nt = DM / 64; u.scale = 1.f; u.ldc = DM;
        u.O = q + (size_t)(pn >> 3) * (WS_K - WS_Q) + ((size_t)ut * 256 * DM + (pn & 7) * 256) * 2;
        return true;
    }
};
struct MoeTiles {
    const LAS int* tab;
    __device__ __forceinline__ void init(LAS int* t, const unsigned* cntp) {
        tab = t;
        if (threadIdx.x == 0) { int s = 0;
            for (int e = 0; e < NEXP; ++e) { const int c = (int)cntp[e]; t[e] = c; t[16 + e] = s; s += (c + 255) >> 8; }
            t[32] = s; }
        __syncthreads();
    }
    __device__ __forceinline__ int total() const { return __builtin_amdgcn_readfirstlane(tab[32]); }
    __device__ __forceinline__ void find(int rtg, int& e, int& rt, int& gc) const {
        int ee = 0;
#pragma unroll
        for (int j = 1; j < NEXP; ++j) if (rtg >= tab[16 + j]) ee = j;
        e = __builtin_amdgcn_readfirstlane(ee);
        const int tbe = __builtin_amdgcn_readfirstlane(tab[16 + e]), ce = __builtin_amdgcn_readfirstlane(tab[e]);
        rt = rtg - tbe; gc = ce - rt * 256; if (gc > 256) gc = 256;
    }
};
struct SchedMoe1 {
    MoeTiles T; const char *v, *wgu; char* hid; const int* lst; int G, c;
    __device__ __forceinline__ bool next(int i, GUnit& u) const {
        const int L = i * G + c, nwg = T.total() * 4; if (L >= nwg) return false;
        const int w = pg8::xcd_remap(L, nwg), rtg = w >> 2, pn = w & 3; int e, rt, gc; T.find(rtg, e, rt, gc);
        u.A = v; u.lda = DM * 2; u.glist = lst + (size_t)e * LCAP + rt * 256; u.gcount = gc;
        u.B = wgu + ((size_t)e * 1024 + pn * 256) * DM * 2; u.ldb = DM * 2; u.nt = DM / 64;
        u.O = hid + ((size_t)rtg * 256 * EFF + pn * 128) * 2; u.ldc = EFF;
        return true;
    }
};
struct SchedMoe2 {
    MoeTiles T; const char *hid, *wd; const int* lst; int G, c;
    __device__ __forceinline__ bool next(int i, GUnit& u) const {
        const int L = i * G + c, nwg = T.total() * 8; if (L >= nwg) return false;
        const int w = pg8::xcd_remap(L, nwg), rtg = w >> 3, pn = w & 7; int e, rt, gc; T.find(rtg, e, rt, gc);
        u.A = hid + (size_t)rtg * 256 * EFF * 2; u.lda = EFF * 2; u.B = wd + ((size_t)e * DM + pn * 256) * EFF * 2; u.ldb = EFF * 2; u.nt = EFF / 64;
        u.glist = lst + (size_t)e * LCAP + rt * 256; u.gcount = gc; u.aux = pn;
        return true;
    }
};

__device__ __forceinline__ void row_info(int row, int& b, int& j) { b = row / TPB; j = row - b * TPB; }

__device__ __forceinline__ void norm_mod_store(const f32x4 (&v)[8], float rstd, const float* nw, const float* sc, const float* sh, bf16_t* orow, int lane) {
#pragma unroll
    for (int jj = 0; jj < 8; ++jj) { const int k = 4 * lane + 256 * jj;
        const f32x4 w = *(const f32x4*)(nw + k), s = *(const f32x4*)(sc + k), t = *(const f32x4*)(sh + k);
        const f32x4 y = v[jj] * rstd * w * (1.0f + s) + t;
        u32x2 o; o.x = pk2(y[0], y[1]); o.y = pk2(y[2], y[3]); *(u32x2*)(orow + k) = o; }
}

__device__ __forceinline__ void route_row(const LAS float* yl, const float* wg, const float* bg, const float* we, const float* be, int lane, int& e0, int& e1, float& w0, float& w1) {
    float lg[4] = {0.f, 0.f, 0.f, 0.f}; float le[16];
#pragma unroll
    for (int n = 0; n < 16; ++n) le[n] = 0.f;
#pragma unroll 1
    for (int jj = 0; jj < 8; ++jj) { const f32x4 y4 = *(const LAS f32x4*)(yl + 4 * lane + 256 * jj);
#pragma unroll
        for (int i = 0; i < 4; ++i) { const int k = 4 * lane + 256 * jj + i; const float xv = y4[i];
            const f32x4 g = *(const f32x4*)(wg + (size_t)k * 4);
#pragma unroll
            for (int n = 0; n < 4; ++n) lg[n] = fmaf(xv, g[n], lg[n]);
#pragma unroll
            for (int q = 0; q < 4; ++q) { const f32x4 ev = *(const f32x4*)(we + (size_t)k * 16 + 4 * q);
#pragma unroll
                for (int n = 0; n < 4; ++n) le[4 * q + n] = fmaf(xv, ev[n], le[4 * q + n]); } } }
#pragma unroll
    for (int n = 0; n < 4; ++n) lg[n] = wave_sum(lg[n]) + bg[n];
#pragma unroll
    for (int n = 0; n < 16; ++n) le[n] = wave_sum(le[n]) + be[n];
    int gi = 0; float gm = lg[0];
#pragma unroll
    for (int n = 1; n < 4; ++n) if (lg[n] > gm) { gm = lg[n]; gi = n; }
    float den = 0.f;
#pragma unroll
    for (int n = 0; n < 4; ++n) den += __expf(lg[n] - gm);
    const float gw = 1.0f / den;
    float s[4];
#pragma unroll
    for (int n = 0; n < 4; ++n) { const float m0 = (gi == 0) ? 1.f : 0.f, m1 = (gi == 1) ? 1.f : 0.f, m2 = (gi == 2) ? 1.f : 0.f, m3 = (gi == 3) ? 1.f : 0.f; s[n] = le[n] * m0 + le[4 + n] * m1 + le[8 + n] * m2 + le[12 + n] * m3; }
    int i0 = 0; float v0 = s[0];
#pragma unroll
    for (int n = 1; n < 4; ++n) if (s[n] > v0) { v0 = s[n]; i0 = n; }
    int i1 = -1; float v1 = -3.0e38f;
#pragma unroll
    for (int n = 0; n < 4; ++n) if (n != i0 && s[n] > v1) { v1 = s[n]; i1 = n; }
    const float ex = __expf(v1 - v0), inv = 1.0f / (1.0f + ex);
    e0 = gi * 4 + i0; e1 = gi * 4 + i1; w0 = inv * gw; w1 = ex * inv * gw;
}

#define PHASE_BEGIN KArgsP ka = kargs(); unsigned char* ws = ka->ws; (void)ws; int tid = threadIdx.x; asm volatile("" : "+v"(tid)); const int lane = tid & 63, wave = __builtin_amdgcn_readfirstlane(tid >> 6), gw = blk * NWAVES + wave; (void)lane; (void)gw;
#define ctl ((unsigned*)(ws + WS_CTL))
#define mod ((float*)(ws + WS_MOD))
#define tokw ((float*)(ws + WS_TOKW))
#define list ((int*)(ws + WS_LIST))
#define WIN ((bf16_t*)(ws + WS_WIN))
#define WOUT0 ((bf16_t*)(ws + WS_WOUT0))
#define WQKV ((bf16_t*)(ws + WS_WQKV))
#define WOUT1 ((bf16_t*)(ws + WS_WOUT1))
#define CMAT ((bf16_t*)(ws + WS_CMAT))
#define CMATC ((bf16_t*)(ws + WS_CMATC))
#define H ((float*)(ws + WS_H))
#define U ((bf16_t*)(ws + WS_U))
#define PB ((bf16_t*)(ws + WS_P))
#define YCAT ((bf16_t*)(ws + WS_YCAT))
#define QB ((bf16_t*)(ws + WS_Q))
#define KB ((bf16_t*)(ws + WS_K))
#define VB ((bf16_t*)(ws + WS_V))
#define AB ((bf16_t*)(ws + WS_A))
#define YB ((bf16_t*)(ws + WS_Y))
#define OB ((bf16_t*)(ws + WS_O))
#ifndef PHMASK
#define PHMASK 0x3ffff
#endif
#define PHON(k) (((PHMASK) >> (k)) & 1)
#define IN(k) (lo <= (k) && (k) < hi)
#ifndef XSYNC
#define XSYNC 0
#endif
#define BARW ((unsigned*)(kargs()->ws + WS_CTL) + 4096)
#define BARST ((volatile LAS unsigned*)(lds + RING_BYTES + 512))
#define SYNC(k) do { if (IN(k) && IN((k) + 1)) { \
        if ((k) == 0) { grid.sync(); if (threadIdx.x == 0) (void)xb_add(&BARW[XB_XCNT(xb_xcc_id())], 1u); }     \
        else xcd_barrier(BARW, BARST); \
        if ((k) == 1) for (int xs_ = 0; xs_ < XSYNC; ++xs_) xcd_barrier(BARW, BARST); } } while (0)
#define TS(k) do { if (PROBE && blockIdx.x == 0 && threadIdx.x == 0) { const unsigned long long t_ = __builtin_amdgcn_s_memrealtime(); unsigned long long* tp_ = (unsigned long long*)(kargs()->ws + WS_CTL + 1024); \
        if ((k) == PA0) tp_[0] = t_; if ((k) == PA1) tp_[1] = t_; if ((k) == PB0) tp_[2] = t_; if ((k) == PB1) tp_[3] = t_; } } while (0)
template <int l>
__device__ __forceinline__ void moe_layer(cg::grid_group& grid, LAS unsigned char* lds, int lo, int hi, int G, int blk) {
    const int pb = (l == 0) ? 5 : 14;
#define cnt (ctl + 32 * l)
#define modl (mod + (size_t)l * 5 * MODSZ)
        TS(pb);
        if (PHON(5) && IN(pb)) REPS(5) { PHASE_BEGIN
            LAS int* ri = (LAS int*)lds;
            LAS float* part = (LAS float*)(lds + 4096);
            LAS float* ssq = (LAS float*)(lds + 16384);
            LAS float* rstdL = (LAS float*)(lds + 16896);
            LAS float* red = (LAS float*)(lds + 17408);
            const int ntiles = (l == 0 ? NTOK : NLAT) / 16, t0 = (ntiles * blk) / G, t1 = (ntiles * (blk + 1)) / G;
            const float* wg = ka->moe_w_group + (size_t)l * DM * 4; const float* bgp = ka->moe_b_group + l * 4;
            const float* we = ka->moe_w_expert + (size_t)l * DM * 16; const float* bep = ka->moe_b_expert + l * 16;
            const float* nw = ka->norm2_w + l * DM;
            const float* cbuf = (const float*)(ctl + 8192) + (size_t)l * 5 * 32;
            const int r = lane & 15, q = lane >> 4, K0 = wave * 256;
            float Be[16][4], Bg[16][4]; int curv = -1;
            for (int t = t0; t < t1; ++t) {
                const int row0 = (l == 0) ? t * 16 : ((t * 16) / SEQ) * TPB + CTX + ((t * 16) % SEQ);
                int b, j; row_info(row0, b, j); const int v = (j < CTX) ? 4 : b;
                const float* mv = modl + (size_t)v * MODSZ;
                if (v != curv) { curv = v;
                    gcf wep = (gcf)(we + (size_t)(K0 + 4 * q) * 16 + r); gcf wgp = (gcf)(wg + (size_t)(K0 + 4 * q) * 4 + (r & 3));
                    gcf nwp = (gcf)(nw + K0 + 4 * q); gcf scp = (gcf)(mv + 4 * DM + K0 + 4 * q); const float gmask = (r < 4) ? 1.f : 0.f;
#pragma unroll
                    for (int c = 0; c < 16; ++c) { const f32x4 w4 = *(const __attribute__((address_space(1))) f32x4*)nwp, s4 = *(const __attribute__((address_space(1))) f32x4*)scp;
#pragma unroll
                        for (int s_ = 0; s_ < 4; ++s_) { const float av = w4[s_] * (1.0f + s4[s_]); Be[c][s_] = av * wep[s_ * 16]; Bg[c][s_] = av * gmask * wgp[s_ * 4]; }
                        wep += 256; wgp += 64; nwp += 16; scp += 16; asm volatile("" : "+v"(wep), "+v"(wgp), "+v"(nwp), "+v"(scp) :: "memory"); } }
                const float* hrow = H + (size_t)(row0 + r) * DM + K0 + 4 * q;
                f32x4 ae = {0.f, 0.f, 0.f, 0.f}, ag = {0.f, 0.f, 0.f, 0.f}; float ss = 0.f;
#pragma unroll
                for (int hf = 0; hf < 2; ++hf) { f32x4 Av[8];
#pragma unroll
                    for (int c = 0; c < 8; ++c) Av[c] = *(const f32x4*)(hrow + 16 * (8 * hf + c));
#pragma unroll
                    for (int c = 0; c < 8; ++c)
#pragma unroll
                        for (int s_ = 0; s_ < 4; ++s_) { const float x = Av[c][s_]; ss = fmaf(x, x, ss);
                            ae = __builtin_amdgcn_mfma_f32_16x16x4f32(x, Be[8 * hf + c][s_], ae, 0, 0, 0); ag = __builtin_amdgcn_mfma_f32_16x16x4f32(x, Bg[8 * hf + c][s_], ag, 0, 0, 0); }
                    asm volatile("" ::: "memory"); }
                ss += __shfl_xor(ss, 16); ss += __shfl_xor(ss, 32);
                if (q == 0) ssq[wave * 16 + r] = ss;
#pragma unroll
                for (int g_ = 0; g_ < 4; ++g_) { part[(wave * 16 + 4 * q + g_) * 20 + r] = ae[g_]; if (r < 4) part[(wave * 16 + 4 * q + g_) * 20 + 16 + r] = ag[g_]; }
                __syncthreads();
                if (tid < 320) { float p = 0.f;
#pragma unroll
                    for (int w = 0; w < 8; ++w) p += part[w * 320 + tid];
                    red[tid] = p; }
                __syncthreads();
                if (tid < 16) { float sum = 0.f;
#pragma unroll
                    for (int w = 0; w < 8; ++w) sum += ssq[w * 16 + tid];
                    const float rstd = rsqrtf(sum * (1.0f / DM) + EPS); rstdL[tid] = rstd;
                    float lg[20];
#pragma unroll
                    for (int n = 0; n < 20; ++n) lg[n] = rstd * red[tid * 20 + n] + cbuf[v * 32 + n];
                    int gi = 0; float gm = lg[16];
#pragma unroll
                    for (int n = 1; n < 4; ++n) if (lg[16 + n] > gm) { gm = lg[16 + n]; gi = n; }
                    float den = 0.f;
#pragma unroll
                    for (int n = 0; n < 4; ++n) den += __expf(lg[16 + n] - gm);
                    const float gwt = 1.0f / den; float sv[4];
#pragma unroll
                    for (int n = 0; n < 4; ++n) { const float m0 = (gi == 0) ? 1.f : 0.f, m1 = (gi == 1) ? 1.f : 0.f, m2 = (gi == 2) ? 1.f : 0.f, m3 = (gi == 3) ? 1.f : 0.f; sv[n] = lg[n] * m0 + lg[4 + n] * m1 + lg[8 + n] * m2 + lg[12 + n] * m3; }
                    int i0 = 0; float v0 = sv[0];
#pragma unroll
                    for (int n = 1; n < 4; ++n) if (sv[n] > v0) { v0 = sv[n]; i0 = n; }
                    int i1 = -1; float v1 = -3.0e38f;
#pragma unroll
                    for (int n = 0; n < 4; ++n) if (n != i0 && sv[n] > v1) { v1 = sv[n]; i1 = n; }
                    const float ex = __expf(v1 - v0), inv = 1.0f / (1.0f + ex);
                    const int row = row0 + tid, ix = (t - t0) * 16 + tid;
                    ri[ix * 4 + 0] = gi * 4 + i0; ri[ix * 4 + 1] = gi * 4 + i1; ri[ix * 4 + 2] = row * 2; ri[ix * 4 + 3] = row * 2 + 1;
                    tokw[row * 2] = inv * gwt; tokw[row * 2 + 1] = ex * inv * gwt; }
                __syncthreads();
                { const float rstd = rstdL[r]; gbf up = (gbf)(U + (size_t)(row0 + r) * DM + K0 + 4 * q); gcf hp = (gcf)hrow;
                    gcf nwp = (gcf)(nw + K0 + 4 * q); gcf scp = (gcf)(mv + 4 * DM + K0 + 4 * q); gcf shp = (gcf)(mv + 3 * DM + K0 + 4 * q);
#pragma unroll
                    for (int c = 0; c < 16; ++c) { typedef const __attribute__((address_space(1))) f32x4* g4; const f32x4 w4 = *(g4)nwp, s4 = *(g4)scp, t4 = *(g4)shp;
                        const f32x4 y = *(g4)hp * rstd * w4 * (1.0f + s4) + t4;
                        u32x2 o; o.x = pk2(y[0], y[1]); o.y = pk2(y[2], y[3]); *(__attribute__((address_space(1))) u32x2*)up = o;
                        nwp += 16; scp += 16; shp += 16; hp += 16; up += 16;
                        if ((c & 3) == 3) asm volatile("" : "+v"(nwp), "+v"(scp), "+v"(shp), "+v"(hp), "+v"(up) :: "memory"); } }
            }
            __syncthreads();
            const int nrb = (t1 - t0) * 16;
            if (tid < NEXP) { int n = 0;
                for (int i = 0; i < nrb; ++i) { n += (ri[i * 4] == tid) + (ri[i * 4 + 1] == tid); }
                int* lp = list + (rep_ ? (int)((WS_END - WS_LIST) / 4) : 0); const int base = n ? (int)atomicAdd(cnt + 16 * rep_ + tid, (unsigned)n) : 0; int p = 0;
                for (int i = 0; i < nrb; ++i) { if (ri[i * 4] == tid) lp[(size_t)tid * LCAP + base + p++] = ri[i * 4 + 2]; if (ri[i * 4 + 1] == tid) lp[(size_t)tid * LCAP + base + p++] = ri[i * 4 + 3]; } }
            __syncthreads();
        }
        SYNC(pb);
        TS(pb + 1);
        if (PHON(6) && IN(pb + 1)) REPS(6) { PHASE_BEGIN
            SchedMoe1 S; S.T.init((LAS int*)(lds + RING_BYTES), cnt); S.v = (const char*)U; S.wgu = (const char*)(ws + WS_WGU); S.hid = (char*)(ws + WS_HID); S.lst = list; S.G = G; S.c = blk;
            pg8::gemm_phase<SchedMoe1, pg8::EpiSwiGLU, true>(lds, S, pg8::EpiSwiGLU{});
        }
        SYNC(pb + 1);
        TS(pb + 2);
        if (PHON(7) && IN(pb + 2)) REPS(7) { PHASE_BEGIN
            SchedMoe2 S; S.T.init((LAS int*)(lds + RING_BYTES), cnt); S.hid = (const char*)(ws + WS_HID); S.wd = (const char*)(ws + WS_WD); S.lst = list; S.G = G; S.c = blk;
            pg8::gemm_phase<SchedMoe2, pg8::EpiScatter, false>(lds, S, pg8::EpiScatter{YB, tokw});
        }
        SYNC(pb + 2);
}

__global__ void __launch_bounds__(NTHREADS, 2) fwd_kernel(Args a) {
    extern __shared__ __attribute__((aligned(16))) unsigned char lds_raw[];
    LAS unsigned char* lds = (LAS unsigned char*)lds_raw;
    cg::grid_group grid = cg::this_grid();
    const int G = gridDim.x, blk = blockIdx.x, ngw = G * NWAVES;
    const int lo = a.ph_lo, hi = a.ph_hi;
    if (threadIdx.x < 2) ((LAS unsigned*)(lds + RING_BYTES + 512))[threadIdx.x] = 0u;
    __syncthreads();


    TS(0);
    if (PHON(0) && IN(0)) REPS(0) { PHASE_BEGIN
        if (blk == 0) { if (tid < 64) ctl[tid] = 0u;
            for (int i = tid; i < XCD_BAR_WORDS; i += NTHREADS) (ctl + 4096)[i] = 0u; }
        if (blk < 192) {
            LAS float* sil = (LAS float*)lds; LAS float* red = (LAS float*)(lds + 40960);
            for (int i = tid; i < 5 * DM; i += NTHREADS) { const int v = i / DM, k = i % DM; sil[i] = silu_f(v < 4 ? ka->c[v * DM + k] : ka->c_ctx[k]); }
            __syncthreads();
            const int l = blk / 96, j0 = (blk % 96) * 128;
            const float* wp = ka->w_mod + (size_t)l * DM * MODSZ + j0 + 2 * lane;
            f32x2 acc[5];
#pragma unroll
            for (int v = 0; v < 5; ++v) acc[v] = (f32x2){0.f, 0.f};
#pragma unroll 8
            for (int k = wave * 256; k < wave * 256 + 256; ++k) { const f32x2 w = *(const f32x2*)(wp + (size_t)k * MODSZ);
#pragma unroll
                for (int v = 0; v < 5; ++v) { const float s = sil[v * DM + k]; acc[v].x = fmaf(s, w.x, acc[v].x); acc[v].y = fmaf(s, w.y, acc[v].y); } }
#pragma unroll
            for (int v = 0; v < 5; ++v) { red[(wave * 5 + v) * 128 + 2 * lane] = acc[v].x; red[(wave * 5 + v) * 128 + 2 * lane + 1] = acc[v].y; }
            __syncthreads();
            for (int i = tid; i < 5 * 128; i += NTHREADS) { const int v = i / 128, j = i % 128; float s = ka->b_mod[l * MODSZ + j0 + j];
#pragma unroll
                for (int w = 0; w < 8; ++w) s += red[(w * 5 + v) * 128 + j];
                mod[((size_t)l * 5 + v) * MODSZ + j0 + j] = s; }
            __syncthreads();
        }
        LAS float* tab = (LAS float*)(lds + 135168);
        if (tid < 256) tab[tid] = cospif((float)tid * (1.0f / 128.0f));
        __syncthreads();
        LAS float* scr = (LAS float*)(lds + wave * 16384);
        constexpr int I_IN = 32 * 96, I_O0 = 32 * 64, I_QKV = 32 * 192, I_O1 = 32 * 64;
        for (int it = gw; it < I_IN + I_O0 + I_QKV + I_O1; it += ngw) {
            int r = it;
            if (r < I_IN) { transpose_item(ka->even_w_in, 4096, DM, WIN, (r % 96) * 32, (r / 96) * 64, (r % 96) * 32, scr, lane); continue; } r -= I_IN;
            if (r < I_O0) { transpose_item(ka->even_w_out, DM, DM, WOUT0, (r % 64) * 32, (r / 64) * 64, (r % 64) * 32, scr, lane); continue; } r -= I_O0;
            if (r < I_QKV) { transpose_item(ka->odd_w_qkv, 6144, DM, WQKV, (r % 192) * 32, (r / 192) * 64, (r % 192) * 32, scr, lane); continue; } r -= I_QKV;
            transpose_item(ka->odd_w_out, DM, DM, WOUT1, (r % 64) * 32, (r / 64) * 64, (r % 64) * 32, scr, lane);
        }
        moe_weight_items(ka->moe_w_gate, ka->moe_w_up, ka->moe_w_down, ws, 0, gw, ngw, scr, lane);
        for (int it = gw; it < 8 * 8 * 64; it += ngw) {
            const int gp = it >> 9, m0 = ((it >> 6) & 7) * 32, k0 = (it & 63) * 32, g = gp >> 1, part = gp & 1;
            const int r = lane & 31, hh = lane >> 5;
            f32x16 d = {};
            const float* wrow = ka->even_w_in + (size_t)(k0 + r) * 4096 + 3072 + g * 256 + 8 * hh;
#pragma unroll 4
            for (int j0 = 0; j0 < 256; j0 += 16) {
                const f32x4 b0 = *(const f32x4*)(wrow + j0), b1 = *(const f32x4*)(wrow + j0 + 4);
                u32x4 bw = {pk2(b0[0], b0[1]), pk2(b0[2], b0[3]), pk2(b1[0], b1[1]), pk2(b1[2], b1[3])};
                float av[8];
#pragma unroll
                for (int jj = 0; jj < 8; ++jj) { const int p = ((m0 + r) * (j0 + 8 * hh + jj) - (part ? 64 : 0)) & 255; av[jj] = tab[p]; }
                u32x4 aw = {pk2(av[0], av[1]), pk2(av[2], av[3]), pk2(av[4], av[5]), pk2(av[6], av[7])};
                d = __builtin_amdgcn_mfma_f32_32x32x16_bf16(*reinterpret_cast<bf16x8*>(&aw), *reinterpret_cast<bf16x8*>(&bw), d, 0, 0, 0);
            }
#pragma unroll
            for (int q = 0; q < 16; ++q) { const int row = (q & 3) + 8 * (q >> 2) + 4 * hh;
                WIN[(size_t)(3072 + gp * 256 + m0 + row) * DM + k0 + r] = (bf16_t)f2bf(d[q]); }
        }
        for (int it = gw; it < 4096 + 256; it += ngw) {
            if (it < 4096) { const int k = it;
                for (int cb = lane; cb < 1024; cb += 64) { const int col0 = cb * 8, part = col0 >> 12, t0 = col0 & 4095; float f[8];
#pragma unroll
                    for (int i = 0; i < 8; ++i) { const int p = (k * (t0 + i)) & 4095; const float xx = (float)p * (1.0f / 2048.0f); f[i] = part ? -sinpif(xx) : cospif(xx); }
                    u32x4 o = {pk2(f[0], f[1]), pk2(f[2], f[3]), pk2(f[4], f[5]), pk2(f[6], f[7])};
                    *(u32x4*)(CMAT + (size_t)k * 8192 + col0) = o; }
            } else { const int k = it - 4096; const int col0 = lane * 8, part = col0 >> 8, t0 = col0 & 255; float f[8];
#pragma unroll
                for (int i = 0; i < 8; ++i) { const int p = (k * (t0 + i)) & 255; const float xx = (float)p * (1.0f / 128.0f); f[i] = part ? -sinpif(xx) : cospif(xx); }
                u32x4 o = {pk2(f[0], f[1]), pk2(f[2], f[3]), pk2(f[4], f[5]), pk2(f[6], f[7])};
                *(u32x4*)(CMATC + (size_t)k * 512 + col0) = o; }
        }
    }
    SYNC(0);

    TS(1);
    if (PHON(1) && IN(1)) REPS(1) { PHASE_BEGIN
        if (gw < 200) { const int l_ = gw / 100, v_ = (gw % 100) / 20, n_ = gw % 20;
            const float* sh = mod + ((size_t)l_ * 5 + v_) * MODSZ + 3 * DM; float acc_ = 0.f;
            for (int k = lane; k < DM; k += 64) acc_ += sh[k] * (n_ < 16 ? ka->moe_w_expert[((size_t)l_ * DM + k) * 16 + n_] : ka->moe_w_group[((size_t)l_ * DM + k) * 4 + (n_ - 16)]);
            acc_ = wave_sum(acc_);
            if (lane == 0) ((float*)(ctl + 8192))[(l_ * 5 + v_) * 32 + n_] = acc_ + (n_ < 16 ? ka->moe_b_expert[l_ * 16 + n_] : ka->moe_b_group[l_ * 4 + n_ - 16]); }
        for (int row = gw; row < NTOK; row += ngw) { int b, j; row_info(row, b, j);
            const float* src = (j < CTX) ? ka->ctx + ((size_t)b * CTX + j) * DM : ka->x + ((size_t)b * SEQ + (j - CTX)) * DM;
            const float* mv = mod + (size_t)(j < CTX ? 4 : b) * MODSZ;
            f32x4 v[8]; float ss = 0.f;
#pragma unroll
            for (int jj = 0; jj < 8; ++jj) { v[jj] = *(const f32x4*)(src + 4 * lane + 256 * jj); ss += v[jj][0] * v[jj][0] + v[jj][1] * v[jj][1] + v[jj][2] * v[jj][2] + v[jj][3] * v[jj][3]; }
            const float rstd = rsqrtf(wave_sum(ss) * (1.0f / DM) + EPS);
            norm_mod_store(v, rstd, ka->norm1_w, mv + DM, mv, U + (size_t)row * DM, lane);
        }
    }
    SYNC(1);

    TS(2);
    if (PHON(2) && IN(2)) REPS(2) { PHASE_BEGIN
        SchedInProj S{(const char*)U, (const char*)WIN, (char*)PB, (char*)(ws + WS_ZTL), (char*)(ws + WS_ZTC), G, blk};
        pg8::gemm_phase<SchedInProj, pg8::EpiStore, false>(lds, S, pg8::EpiStore{});
    }
    SYNC(2);

    TS(3);
    if (PHON(3) && IN(3)) REPS(3) { PHASE_BEGIN
        for (int it = blk * NTHREADS + tid; it < (NTOK / 16) * 128; it += G * NTHREADS) {
            const int chunk = it >> 7, oct = it & 127, r0 = chunk * 16, jm = r0 % TPB, ch0 = oct * 8;
            const bool hasprev = (jm != 0 && jm != CTX), hasnext = (((jm + 16) % TPB) != 0 && (jm + 16) != CTX);
            float w0[8], w1[8], w2[8];
#pragma unroll
            for (int i = 0; i < 8; ++i) { w0[i] = ka->even_conv_w[ch0 + i]; w1[i] = ka->even_conv_w[1024 + ch0 + i]; w2[i] = ka->even_conv_w[2048 + ch0 + i]; }
            float cp[8], cc[8], cn[8];
#define LOADCV(row_, o) do { const u32x4 cg_ = *(const u32x4*)(PB + (size_t)(row_) * 3072 + 1024 + ch0), vi = *(const u32x4*)(PB + (size_t)(row_) * 3072 + 2048 + ch0); \
                o[0] = bflo(cg_.x) * bflo(vi.x); o[1] = bfhi(cg_.x) * bfhi(vi.x); o[2] = bflo(cg_.y) * bflo(vi.y); o[3] = bfhi(cg_.y) * bfhi(vi.y); \
                o[4] = bflo(cg_.z) * bflo(vi.z); o[5] = bfhi(cg_.z) * bfhi(vi.z); o[6] = bflo(cg_.w) * bflo(vi.w); o[7] = bfhi(cg_.w) * bfhi(vi.w); } while (0)
            if (hasprev) LOADCV(r0 - 1, cp); else {
#pragma unroll
                for (int i = 0; i < 8; ++i) cp[i] = 0.f; }
            LOADCV(r0, cc);
            for (int rr = 0; rr < 16; ++rr) { const int row = r0 + rr;
                if (rr < 15 || hasnext) LOADCV(row + 1, cn); else {
#pragma unroll
                    for (int i = 0; i < 8; ++i) cn[i] = 0.f; }
                const u32x4 bg = *(const u32x4*)(PB + (size_t)row * 3072 + ch0);
                float bb[8] = {bflo(bg.x), bfhi(bg.x), bflo(bg.y), bfhi(bg.y), bflo(bg.z), bfhi(bg.z), bflo(bg.w), bfhi(bg.w)}; float y[8];
#pragma unroll
                for (int i = 0; i < 8; ++i) y[i] = bb[i] * (w0[i] * cp[i] + w1[i] * cc[i] + w2[i] * cn[i]);
                u32x4 o = {pk2(y[0], y[1]), pk2(y[2], y[3]), pk2(y[4], y[5]), pk2(y[6], y[7])};
                *(u32x4*)(YCAT + (size_t)row * DM + ch0) = o;
#pragma unroll
                for (int i = 0; i < 8; ++i) { cp[i] = cc[i]; cc[i] = cn[i]; } }
        }
        SchedDFT S{(const char*)CMAT, (const char*)CMATC, (const char*)(ws + WS_ZTL), (const char*)(ws + WS_ZTC), (char*)YCAT, G, blk};
        pg8::gemm_phase<SchedDFT, pg8::EpiStore, false>(lds, S, pg8::EpiStore{});
    }
    SYNC(3);

    TS(4);
    if (PHON(4) && IN(4)) REPS(4) { PHASE_BEGIN
        SchedOut0 S{(const char*)YCAT, (const char*)WOUT0, ka->x, ka->ctx, mod, (char*)H, G, blk};
        pg8::gemm_phase<SchedOut0, pg8::EpiResid, false>(lds, S, pg8::EpiResid{});
    }
    SYNC(4);

    moe_layer<0>(grid, lds, lo, hi, G, blk);
    { constexpr int l = 0; (void)l;
            TS(8);
    if (PHON(8) && IN(8)) { PHASE_BEGIN
                const float* mod1 = mod + (size_t)5 * MODSZ;
                for (int row = gw; row < NTOK; row += ngw) { int b, j; row_info(row, b, j); const int vr = (j < CTX) ? 4 : b;
                    const float* g2 = modl + (size_t)vr * MODSZ + 5 * DM; const float* mv1 = mod1 + (size_t)vr * MODSZ;
                    float* hrow = H + (size_t)row * DM; const bf16_t* y0 = YB + (size_t)(row * 2) * DM; const bf16_t* y1 = y0 + DM;
                    f32x4 v[8]; float ss = 0.f;
#pragma unroll
                    for (int jj = 0; jj < 8; ++jj) { const int k = 4 * lane + 256 * jj; const f32x4 hv = *(const f32x4*)(hrow + k), g = *(const f32x4*)(g2 + k);
                        const u32x2 a0 = *(const u32x2*)(y0 + k), a1 = *(const u32x2*)(y1 + k);
                        f32x4 ys = {bflo(a0.x) + bflo(a1.x), bfhi(a0.x) + bfhi(a1.x), bflo(a0.y) + bflo(a1.y), bfhi(a0.y) + bfhi(a1.y)};
                        v[jj] = hv + g * ys; *(f32x4*)(hrow + k) = v[jj];
                        ss += v[jj][0] * v[jj][0] + v[jj][1] * v[jj][1] + v[jj][2] * v[jj][2] + v[jj][3] * v[jj][3]; }
                    const float rstd = rsqrtf(wave_sum(ss) * (1.0f / DM) + EPS);
                    norm_mod_store(v, rstd, ka->norm1_w + DM, mv1 + DM, mv1, U + (size_t)row * DM, lane);
                }
                moe_weight_items(ka->moe_w_gate, ka->moe_w_up, ka->moe_w_down, ws, 1, gw, ngw, (LAS float*)(lds + wave * 16384), lane);
            }
            SYNC(8);
            TS(9);
    if (PHON(9) && IN(9)) REPS(9) { PHASE_BEGIN
                SchedQKV S{(const char*)U, (const char*)WQKV, (char*)QB, G, blk};
                pg8::gemm_phase<SchedQKV, pg8::EpiStore, false>(lds, S, pg8::EpiStore{});
            }
            SYNC(9);
            TS(10);
    if (PHON(10) && IN(10)) { PHASE_BEGIN
                LAS float* rt = (LAS float*)lds;
                for (int i = tid; i < 64 * 32; i += NTHREADS) { const int pos = i >> 5, f = i & 31; const float inv = exp2f(-(float)f * 0.4152410118609203f); const float ang = (float)pos * inv;
                    float tr = ang * 0.15915494309189535f; tr -= floorf(tr); rt[2 * i] = __builtin_amdgcn_cosf(tr); rt[2 * i + 1] = __builtin_amdgcn_sinf(tr); }
                __syncthreads();
                const int hc = lane >> 2, q8 = (lane & 3) * 8;
                for (int it = gw; it < NLAT + NTOK; it += ngw) {
                    const bool isq = it < NLAT; int row;
                    if (isq) row = (it / SEQ) * TPB + CTX + (it % SEQ); else row = it - NLAT;
                    int b, j; row_info(row, b, j); const bool rope = (j >= CTX); const int t = j - CTX, prow = t >> 6, pcol = t & 63;
                    bf16_t* p = (isq ? QB : KB) + (size_t)row * DM + hc * 128; const float* nwp = isq ? ka->odd_q_norm : ka->odd_k_norm;
                    u32x4 raw[4]; float xv[4][8];
                    float ss = 0.f;
#pragma unroll
                    for (int s = 0; s < 4; ++s) { raw[s] = *(const u32x4*)(p + s * 32 + q8);
                        xv[s][0] = bflo(raw[s].x); xv[s][1] = bfhi(raw[s].x); xv[s][2] = bflo(raw[s].y); xv[s][3] = bfhi(raw[s].y); xv[s][4] = bflo(raw[s].z); xv[s][5] = bfhi(raw[s].z); xv[s][6] = bflo(raw[s].w); xv[s][7] = bfhi(raw[s].w);
#pragma unroll
                        for (int i = 0; i < 8; ++i) ss += xv[s][i] * xv[s][i]; }
                    ss += __shfl_xor(ss, 1); ss += __shfl_xor(ss, 2);
                    const float rstd = rsqrtf(ss * (1.0f / 128.0f) + EPS);
#pragma unroll
                    for (int s = 0; s < 4; ++s)
#pragma unroll
                        for (int i = 0; i < 8; ++i) xv[s][i] = xv[s][i] * rstd * nwp[s * 32 + q8 + i];
                    if (rope) {
#pragma unroll
                        for (int ax = 0; ax < 2; ++ax) { const int pos = ax ? pcol : prow;
#pragma unroll
                            for (int i = 0; i < 8; ++i) { const float cs = rt[2 * (pos * 32 + q8 + i)], sn = rt[2 * (pos * 32 + q8 + i) + 1];
                                const float x1 = xv[2 * ax][i], x2 = xv[2 * ax + 1][i]; xv[2 * ax][i] = x1 * cs - x2 * sn; xv[2 * ax + 1][i] = x2 * cs + x1 * sn; } }
                    }
#pragma unroll
                    for (int s = 0; s < 4; ++s) { u32x4 o = {pk2(xv[s][0], xv[s][1]), pk2(xv[s][2], xv[s][3]), pk2(xv[s][4], xv[s][5]), pk2(xv[s][6], xv[s][7])}; *(u32x4*)(p + s * 32 + q8) = o; }
                }
                __syncthreads();
            }
            SYNC(10);
            TS(11);
    if (PHON(11) && IN(11)) REPS(11) { PHASE_BEGIN
                const int vcu = (blk % 8) * (G / 8) + blk / 8;
                for (int U0 = vcu; U0 < 2048; U0 += G) {
                    const int combo = U0 >> 4, qb = U0 & 15, vh = combo & 1, cp_ = (combo >> 1) & 1, hh = (combo >> 2) & 7, b = combo >> 5;
                    const bf16_t* Qp = QB + (size_t)(b * TPB + CTX + qb * 256) * DM + hh * 256 + cp_ * 128;
                    const bf16_t* Kp = KB + (size_t)(b * TPB) * DM + hh * 256 + cp_ * 128;
                    const bf16_t* Vp = VB + (size_t)(b * TPB) * DM + hh * 256 + vh * 128;
                    bf16_t* Op = OB + (size_t)(b * SEQ + qb * 256) * (2 * DM) + cp_ * DM + hh * 256 + vh * 128;
                    att::attn_dense_body(Qp, Kp, Vp, Op, TPB, (char*)lds_raw);
                    __syncthreads();
                }
            }
            SYNC(11);
            TS(12);
    if (PHON(12) && IN(12)) REPS(12) { PHASE_BEGIN
                float d1 = ka->lq1[lane] * ka->lk1[lane] + ka->lq1[lane + 64] * ka->lk1[lane + 64], d2 = ka->lq2[lane] * ka->lk2[lane] + ka->lq2[lane + 64] * ka->lk2[lane + 64];
                d1 = wave_sum(d1); d2 = wave_sum(d2);
                const float lam_init = 0.8f - 0.6f * expf(-0.3f * 1.0f);
                const float lam = expf(d1) - expf(d2) + lam_init;
                const int hh = lane >> 3, e0 = (lane & 7) * 32;
                for (int li = gw; li < NLAT; li += ngw) {
                    const bf16_t* o1 = OB + (size_t)li * (2 * DM) + hh * 256 + e0; const bf16_t* o2 = o1 + DM;
                    float ov[32]; float ss = 0.f;
#pragma unroll
                    for (int s = 0; s < 4; ++s) { const u32x4 p1 = *(const u32x4*)(o1 + 8 * s), p2 = *(const u32x4*)(o2 + 8 * s);
                        ov[8 * s + 0] = bflo(p1.x) - lam * bflo(p2.x); ov[8 * s + 1] = bfhi(p1.x) - lam * bfhi(p2.x); ov[8 * s + 2] = bflo(p1.y) - lam * bflo(p2.y); ov[8 * s + 3] = bfhi(p1.y) - lam * bfhi(p2.y);
                        ov[8 * s + 4] = bflo(p1.z) - lam * bflo(p2.z); ov[8 * s + 5] = bfhi(p1.z) - lam * bfhi(p2.z); ov[8 * s + 6] = bflo(p1.w) - lam * bflo(p2.w); ov[8 * s + 7] = bfhi(p1.w) - lam * bfhi(p2.w); }
#pragma unroll
                    for (int i = 0; i < 32; ++i) ss += ov[i] * ov[i];
                    ss += __shfl_xor(ss, 1); ss += __shfl_xor(ss, 2); ss += __shfl_xor(ss, 4);
                    const float rs = rsqrtf(ss * (1.0f / 256.0f) + EPS) * (1.0f - lam_init);
                    const int row = (li / SEQ) * TPB + CTX + (li % SEQ);
                    bf16_t* ap = AB + (size_t)row * DM + hh * 256 + e0;
#pragma unroll
                    for (int s = 0; s < 4; ++s) { float y[8];
#pragma unroll
                        for (int i = 0; i < 8; ++i) y[i] = ov[8 * s + i] * rs * ka->subln_w[e0 + 8 * s + i];
                        u32x4 o = {pk2(y[0], y[1]), pk2(y[2], y[3]), pk2(y[4], y[5]), pk2(y[6], y[7])}; *(u32x4*)(ap + 8 * s) = o; }
                }
            }
            SYNC(12);
            TS(13);
    if (PHON(13) && IN(13)) { PHASE_BEGIN
                SchedOut1 S{(const char*)AB, (const char*)WOUT1, mod + (size_t)5 * MODSZ, (char*)H, G, blk};
                pg8::gemm_phase<SchedOut1, pg8::EpiResid, false>(lds, S, pg8::EpiResid{});
            }
            SYNC(13);
    }
    moe_layer<1>(grid, lds, lo, hi, G, blk);
    { constexpr int l = 1; (void)l;
            TS(17);
    if (PHON(17) && IN(17)) REPS(17) { PHASE_BEGIN
                for (int li = gw; li < NLAT; li += ngw) { const int b = li / SEQ, row = b * TPB + CTX + (li % SEQ);
                    const float* g2 = modl + (size_t)b * MODSZ + 5 * DM; const float* hrow = H + (size_t)row * DM; const bf16_t* y0 = YB + (size_t)(row * 2) * DM; const bf16_t* y1 = y0 + DM;
                    float* orow = ka->out + (size_t)li * DM;
#pragma unroll
                    for (int jj = 0; jj < 8; ++jj) { const int k = 4 * lane + 256 * jj; const f32x4 hv = *(const f32x4*)(hrow + k), g = *(const f32x4*)(g2 + k);
                        const u32x2 a0 = *(const u32x2*)(y0 + k), a1 = *(const u32x2*)(y1 + k);
                        f32x4 ys = {bflo(a0.x) + bflo(a1.x), bfhi(a0.x) + bfhi(a1.x), bflo(a0.y) + bflo(a1.y), bfhi(a0.y) + bfhi(a1.y)};
                        f32x4 res = hv + g * ys;
#if PROBE
                        { const unsigned long long* tp_ = (const unsigned long long*)(ws + WS_CTL + 1024); const float c2 = (float)(tp_[3] - tp_[2]) * 1e-4f, w1 = (float)(tp_[1] - tp_[0]) * 1e-2f;
                          res = (f32x4){c2, c2, c2, c2}; if (li == 0 && k == 0) res[0] = w1; }
#endif
                        *(f32x4*)(orow + k) = res; }
                }
            }
    }
    TS(18);
#undef IN
#undef SYNC
#undef cnt
#undef modl
#undef ctl
#undef mod
#undef tokw
#undef list
#undef WIN
#undef WOUT0
#undef WQKV
#undef WOUT1
#undef CMAT
#undef CMATC
#undef H
#undef U
#undef PB
#undef YCAT
#undef QB
#undef KB
#undef VB
#undef AB
#undef YB
#undef OB
}

#ifndef N_LAUNCH_MODE
#define N_LAUNCH_MODE 1
#endif
extern "C" void kernel_launch(void* const* d_in, const int* in_sizes, int n_in, void* d_out, int out_size, void* d_ws, size_t ws_size, hipStream_t stream) {
    static int grid = 0;
    if (grid == 0) {
        if (n_in != 27 || out_size != NLAT * DM || ws_size < WS_END) { fprintf(stderr, "kernel_launch: unexpected shapes: n_in %d out %d ws %zu (need %zu)\n", n_in, out_size, ws_size, (size_t)WS_END); grid = -1; return; }
        int dev = 0, cus = 0, per_cu = 0;
        hipGetDevice(&dev); hipDeviceGetAttribute(&cus, hipDeviceAttributeMultiprocessorCount, dev);
        if (hipFuncSetAttribute((const void*)fwd_kernel, hipFuncAttributeMaxDynamicSharedMemorySize, LDS_BYTES) != hipSuccess) { fprintf(stderr, "kernel_launch: hipFuncSetAttribute failed\n"); grid = -1; return; }
        if (hipOccupancyMaxActiveBlocksPerMultiprocessor(&per_cu, (const void*)fwd_kernel, NTHREADS, LDS_BYTES) != hipSuccess || per_cu < 1) { fprintf(stderr, "kernel_launch: occupancy query says %d\n", per_cu); per_cu = 1; }
        (void)hipGetLastError();
        grid = cus;
        if (grid != 256) fprintf(stderr, "kernel_launch: note: %d CUs\n", grid);
    }
    if (grid < 0) return;
    Args a{};
    const float** ap = (const float**)&a;
    for (int i = 0; i < 27; ++i) ap[i] = (const float*)d_in[i];
    a.out = (float*)d_out; a.ws = (unsigned char*)d_ws;
#if N_LAUNCH_MODE == 1
    a.ph_lo = 0; a.ph_hi = 18;
    void* args[] = {&a};
    hipError_t e = hipLaunchCooperativeKernel((const void*)fwd_kernel, dim3(grid), dim3(NTHREADS), args, LDS_BYTES, stream);
    if (e != hipSuccess) fprintf(stderr, "cooperative launch failed: %s (grid %d)\n", hipGetErrorString(e), grid);
#else
    for (int p = 0; p < 18; ++p) { a.ph_lo = p; a.ph_hi = p + 1; void* args[] = {&a};
        hipError_t e = hipLaunchCooperativeKernel((const void*)fwd_kernel, dim3(grid), dim3(NTHREADS), args, LDS_BYTES, stream);
        if (e != hipSuccess) { fprintf(stderr, "launch %d failed: %s\n", p, hipGetErrorString(e)); break; } }
#endif
}
```

```cpp
#include <hip/hip_runtime.h>
#include <hip/hip_cooperative_groups.h>
#include <cstdio>
#include <cstdint>
namespace cg = cooperative_groups;
#ifndef PROBE
#define PROBE 0
#endif
#ifndef REPMASK
#define REPMASK 0x0
#endif
#define REPS(k) for (int rep_ = 0; rep_ <= ((REPMASK >> (k)) & 1); ++rep_)
#ifndef PA0
#define PA0 0
#define PA1 18
#define PB0 0
#define PB1 18
#endif

#define LAS __attribute__((address_space(3)))
typedef unsigned short bf16_t;
typedef short bf16x8 __attribute__((ext_vector_type(8)));
typedef short s16x4 __attribute__((ext_vector_type(4)));
typedef float f32x2 __attribute__((ext_vector_type(2)));
typedef float f32x4 __attribute__((ext_vector_type(4)));
typedef float f32x8 __attribute__((ext_vector_type(8)));
typedef float f32x16 __attribute__((ext_vector_type(16)));
typedef unsigned u32x2 __attribute__((ext_vector_type(2)));
typedef unsigned u32x4 __attribute__((ext_vector_type(4)));

constexpr int DM = 2048, NB = 4, SEQ = 4096, CTX = 256, TPB = SEQ + CTX  ;
constexpr int NTOK = NB * TPB  , NLAT = NB * SEQ  ;
constexpr int NEXP = 16, EFF = 512, LCAP = 2 * NTOK  ;
constexpr float EPS = 1e-6f;
constexpr int NWAVES = 8, NTHREADS = 512;
constexpr int LDS_BYTES = 155648;
constexpr int RING_BYTES = 131072;

constexpr size_t MiB = 1u << 20;
constexpr size_t WS_CTL = 0, WS_MOD = 1 * MiB, WS_TOKW = 2 * MiB, WS_LIST = 3 * MiB;
constexpr size_t WS_WIN = 6 * MiB, WS_WOUT0 = 26 * MiB, WS_WQKV = 34 * MiB, WS_WOUT1 = 58 * MiB, WS_WGU = 66 * MiB, WS_WD = 130 * MiB;
constexpr size_t WS_CMAT = 162 * MiB, WS_CMATC = 226 * MiB, WS_HID = 162 * MiB  ;
constexpr size_t WS_H = 227 * MiB, WS_U = 363 * MiB;
constexpr size_t WS_P = 431 * MiB, WS_ZTL = 533 * MiB, WS_ZTC = 597 * MiB, WS_YCAT = 601 * MiB;
constexpr size_t WS_Q = 431 * MiB, WS_K = 499 * MiB, WS_V = 567 * MiB, WS_A = 431 * MiB;
static_assert(WS_V - WS_K == WS_K - WS_Q, "QKV spacing");
constexpr size_t WS_Y = 669 * MiB, WS_O = 669 * MiB, WS_END = 805 * MiB;
constexpr int MODSZ = 6 * DM;

typedef const __attribute__((address_space(1))) float* gcf;
typedef __attribute__((address_space(1))) bf16_t* gbf;
__device__ __forceinline__ unsigned f2bf(float f) { unsigned u = __builtin_bit_cast(unsigned, f); return (u + 0x7fffu + ((u >> 16) & 1u)) >> 16; }
__device__ __forceinline__ unsigned pk2(float lo, float hi) { return f2bf(lo) | (f2bf(hi) << 16); }
__device__ __forceinline__ float bflo(unsigned w) { return __uint_as_float(w << 16); }
__device__ __forceinline__ float bfhi(unsigned w) { return __uint_as_float(w & 0xffff0000u); }
__device__ __forceinline__ unsigned cvt_pk_bf16(float lo, float hi) { unsigned r; asm volatile("v_cvt_pk_bf16_f32 %0, %1, %2" : "=v"(r) : "v"(lo), "v"(hi)); return r; }
__device__ __forceinline__ float wave_sum(float v) {
#pragma unroll
    for (int o = 1; o < 64; o <<= 1) v += __shfl_xor(v, o);
    return v;
}
__device__ __forceinline__ float silu_f(float x) { return x * __builtin_amdgcn_rcpf(1.0f + __expf(-x)); }

namespace pg8 {
constexpr int BM = 256, BK = 64, HALF = 128, HTB = HALF * BK * 2, STAGE_BYTES = 8 * HTB, NXCD = 8, WGM = 8;
__host__ __device__ __forceinline__ int lds_byte(int r, int c) { const int st = (r >> 4) * 2 + (c >> 5), rr = r & 15, cc = c & 31, ob = rr * 64 + cc * 2; return st * 1024 + (ob ^ (((ob >> 9) & 1) << 5)); }
__host__ __device__ __forceinline__ void stage_rc(int b, int& R, int& C) { const int st = b / 1024, sb = b % 1024, swz = sb ^ (((sb >> 9) & 1) << 5); R = (st >> 1) * 16 + swz / 64; C = (st & 1) * 32 + (swz % 64) / 2; }
__host__ __device__ __forceinline__ int perm32(int rho) { const int n = rho >> 4, i = rho & 15; return 8 * (i >> 2) + 4 * n + (i & 3); }

struct GUnit {
    const char* A; const char* B; unsigned lda, ldb; int nt;
    char* O; int ldc; float scale;
    const char* src; const float* gate;
    const int* glist; int gcount;
    int aux;
};
__device__ __forceinline__ void tile_of(int L, int nM, int nN, int& pm, int& pn) {
    const int nwg = nM * nN; int wgid = L;
    { const int q = nwg / NXCD, r = nwg % NXCD, xcd = wgid % NXCD, off = wgid / NXCD; wgid = (xcd < r ? xcd * (q + 1) : r * (q + 1) + (xcd - r) * q) + off; }
    const int nig = WGM * nN, gid = wgid / nig, fm = gid * WGM, gsz = (nM - fm) < WGM ? (nM - fm) : WGM;
    pm = fm + ((wgid % nig) % gsz); pn = (wgid % nig) / gsz;
}
__device__ __forceinline__ int xcd_remap(int L, int nwg) {
    const int q = nwg / NXCD, r = nwg % NXCD, xcd = L % NXCD, off = L / NXCD; return (xcd < r ? xcd * (q + 1) : r * (q + 1) + (xcd - r) * q) + off;
}

struct EpiStore {
    __device__ __forceinline__ void operator()(const f32x4 (&acc)[2][2][4][2], const GUnit& u, int wr, int wc, int fr, int fq) const {
        const float sc = u.scale;
#pragma unroll
        for (int ai = 0; ai < 2; ++ai)
#pragma unroll
            for (int m = 0; m < 4; ++m) { bf16_t* rowp = (bf16_t*)u.O + (size_t)(ai * HALF + wr * 64 + m * 16 + fr) * u.ldc + wc * 32 + 8 * fq;
#pragma unroll
                for (int bj = 0; bj < 2; ++bj) { const f32x4 v0 = acc[ai][bj][m][0] * sc, v1 = acc[ai][bj][m][1] * sc;
                    u32x4 w; w.x = cvt_pk_bf16(v0[0], v0[1]); w.y = cvt_pk_bf16(v0[2], v0[3]); w.z = cvt_pk_bf16(v1[0], v1[1]); w.w = cvt_pk_bf16(v1[2], v1[3]);
                    *(u32x4*)(rowp + bj * HALF) = w; } }
    }
};
struct EpiSwiGLU {
    __device__ __forceinline__ void operator()(const f32x4 (&acc)[2][2][4][2], const GUnit& u, int wr, int wc, int fr, int fq) const {
#pragma unroll
        for (int ai = 0; ai < 2; ++ai)
#pragma unroll
            for (int m = 0; m < 4; ++m) { bf16_t* rowp = (bf16_t*)u.O + (size_t)(ai * HALF + wr * 64 + m * 16 + fr) * u.ldc + wc * 32 + 8 * fq;
                float h[8];
#pragma unroll
                for (int n = 0; n < 2; ++n)
#pragma unroll
                    for (int i = 0; i < 4; ++i) h[4 * n + i] = silu_f(acc[ai][0][m][n][i]) * acc[ai][1][m][n][i];
                u32x4 w; w.x = cvt_pk_bf16(h[0], h[1]); w.y = cvt_pk_bf16(h[2], h[3]); w.z = cvt_pk_bf16(h[4], h[5]); w.w = cvt_pk_bf16(h[6], h[7]);
                *(u32x4*)rowp = w; }
    }
};
struct EpiScatter {
    bf16_t* Y; const float* tokw;
    __device__ __forceinline__ void operator()(const f32x4 (&acc)[2][2][4][2], const GUnit& u, int wr, int wc, int fr, int fq) const {
#pragma unroll
        for (int ai = 0; ai < 2; ++ai)
#pragma unroll
            for (int m = 0; m < 4; ++m) { const int r = ai * HALF + wr * 64 + m * 16 + fr;
                if (r < u.gcount) { const int a = u.glist[r]; const float sc = tokw[a];
                    bf16_t* rowp = Y + (size_t)a * DM + u.aux * 256 + wc * 32 + 8 * fq;
#pragma unroll
                    for (int bj = 0; bj < 2; ++bj) { const f32x4 v0 = acc[ai][bj][m][0] * sc, v1 = acc[ai][bj][m][1] * sc;
                        u32x4 w; w.x = cvt_pk_bf16(v0[0], v0[1]); w.y = cvt_pk_bf16(v0[2], v0[3]); w.z = cvt_pk_bf16(v1[0], v1[1]); w.w = cvt_pk_bf16(v1[2], v1[3]);
                        *(u32x4*)(rowp + bj * HALF) = w; } } }
    }
};
struct EpiResid {
    __device__ __forceinline__ void operator()(const f32x4 (&acc)[2][2][4][2], const GUnit& u, int wr, int wc, int fr, int fq) const {
        f32x4 g[2][2];
#pragma unroll
        for (int bj = 0; bj < 2; ++bj)
#pragma unroll
            for (int n = 0; n < 2; ++n) g[bj][n] = *(const f32x4*)(u.gate + bj * HALF + wc * 32 + 8 * fq + 4 * n);
#pragma unroll
        for (int ai = 0; ai < 2; ++ai)
#pragma unroll
            for (int m = 0; m < 4; ++m) { const size_t off = (size_t)(ai * HALF + wr * 64 + m * 16 + fr) * DM + wc * 32 + 8 * fq;
#pragma unroll
                for (int bj = 0; bj < 2; ++bj)
#pragma unroll
                    for (int n = 0; n < 2; ++n) { const f32x4 s = *(const f32x4*)((const float*)u.src + off + bj * HALF + 4 * n);
                        *(f32x4*)((float*)u.O + off + bj * HALF + 4 * n) = s + g[bj][n] * acc[ai][bj][m][n]; } }
    }
};

template <bool GATHER>
__device__ __forceinline__ void mkvoff(const GUnit& u, unsigned (&vA)[2][2], unsigned (&vB)[2][2]) {
    int tid = threadIdx.x; asm volatile("" : "+v"(tid));
    int R0, C0, R1, C1; stage_rc(tid * 16, R0, C0); stage_rc(tid * 16 + 8192, R1, C1);
    const int Rb0 = (R0 & ~31) + perm32(R0 & 31), Rb1 = (R1 & ~31) + perm32(R1 & 31);
#pragma unroll
    for (int h = 0; h < 2; ++h) {
        if constexpr (GATHER) {
            const int r0 = h * HALF + R0, r1 = h * HALF + R1;
            const int t0 = (r0 < u.gcount) ? (u.glist[r0] >> 1) : 0, t1 = (r1 < u.gcount) ? (u.glist[r1] >> 1) : 0;
            vA[h][0] = (unsigned)t0 * u.lda + (unsigned)C0 * 2u; vA[h][1] = (unsigned)t1 * u.lda + (unsigned)C1 * 2u;
        } else {
            vA[h][0] = (unsigned)(h * HALF + R0) * u.lda + (unsigned)C0 * 2u; vA[h][1] = (unsigned)(h * HALF + R1) * u.lda + (unsigned)C1 * 2u;
        }
        vB[h][0] = (unsigned)(h * HALF + Rb0) * u.ldb + (unsigned)C0 * 2u; vB[h][1] = (unsigned)(h * HALF + Rb1) * u.ldb + (unsigned)C1 * 2u;
    }
}

template <class Sched, class Epi, bool GATHER>
__device__ __forceinline__ void gemm_phase(LAS unsigned char* lds, const Sched& S, const Epi& E) {
    int tid = threadIdx.x; asm volatile("" : "+v"(tid));
    const int wid = __builtin_amdgcn_readfirstlane(tid >> 6), lane = tid & 63, wr = wid >> 2, wc = wid & 3, fr = lane & 15, fq = lane >> 4;
    const size_t kstep = (size_t)(BK * 2);
    const unsigned ldsw = (unsigned)wid * 1024u;
    const int aoff = lds_byte(wr * 64 + fr, fq * 8), boff = lds_byte(wc * 32 + fr, fq * 8);
#define PG8_SA(b, h) (((b) * 2 + (h)) * HTB)
#define PG8_SB(b, h) ((4 + (b) * 2 + (h)) * HTB)
#define PG8_STAGE(bufoff, gbase, voff) do { _Pragma("unroll") for (int _i = 0; _i < 2; ++_i) \
        __builtin_amdgcn_global_load_lds((const unsigned*)((const char*)(gbase) + (voff)[_i]), (LAS unsigned*)(lds + (bufoff) + ldsw + _i * 8192), 16, 0, 0); } while (0)
#define PG8_LDA(dst, b, h) do { _Pragma("unroll") for (int m = 0; m < 4; ++m) _Pragma("unroll") for (int k = 0; k < 2; ++k) dst[m][k] = *(const LAS bf16x8*)(lds + PG8_SA(b, h) + aoff + m * 2048 + k * 1024); } while (0)
#define PG8_LDB(dst, b, h) do { _Pragma("unroll") for (int n = 0; n < 2; ++n) _Pragma("unroll") for (int k = 0; k < 2; ++k) dst[n][k] = *(const LAS bf16x8*)(lds + PG8_SB(b, h) + boff + n * 2048 + k * 1024); } while (0)
#define PG8_MMA(ai, bj, At, Bt) do { __builtin_amdgcn_s_setprio(1); _Pragma("unroll") for (int m = 0; m < 4; ++m) _Pragma("unroll") for (int n = 0; n < 2; ++n) _Pragma("unroll") for (int k = 0; k < 2; ++k) \
        acc[ai][bj][m][n] = __builtin_amdgcn_mfma_f32_16x16x32_bf16(Bt[n][k], At[m][k], acc[ai][bj][m][n], 0, 0, 0); __builtin_amdgcn_s_setprio(0); } while (0)
#define PG8_WAIT_V(n) asm volatile("s_waitcnt vmcnt(" #n ")" ::: "memory")
#define PG8_WAIT_L(n) asm volatile("s_waitcnt lgkmcnt(" #n ")" ::: "memory")
#define PG8_BAR __builtin_amdgcn_s_barrier()
#define PG8_SCHED __builtin_amdgcn_sched_barrier(0)
    GUnit cur, nxt; int ui = 0;
    if (!S.next(0, cur)) return;
    unsigned vA[2][2], vB[2][2];
    mkvoff<GATHER>(cur, vA, vB);
    f32x4 acc[2][2][4][2];
#pragma unroll
    for (int a = 0; a < 2; ++a)
#pragma unroll
        for (int b = 0; b < 2; ++b)
#pragma unroll
            for (int m = 0; m < 4; ++m)
#pragma unroll
                for (int n = 0; n < 2; ++n) acc[a][b][m][n] = (f32x4){0.f, 0.f, 0.f, 0.f};
    bf16x8 At[4][2], B0[2][2], B1[2][2];
    const char* cA = cur.A; const char* cB = cur.B;
    PG8_STAGE(PG8_SB(0, 0), cB, vB[0]); PG8_STAGE(PG8_SB(0, 1), cB, vB[1]); PG8_STAGE(PG8_SA(0, 0), cA, vA[0]); PG8_STAGE(PG8_SA(0, 1), cA, vA[1]);
    if (wr == 1) PG8_BAR;
    PG8_WAIT_V(2); PG8_BAR;
    PG8_STAGE(PG8_SB(1, 0), cB + kstep, vB[0]); PG8_STAGE(PG8_SA(1, 0), cA + kstep, vA[0]); PG8_STAGE(PG8_SB(1, 1), cB + kstep, vB[1]);
    PG8_WAIT_V(6); PG8_BAR;
    for (;;) {
        const bool has_next = S.next(ui + 1, nxt);
        const char* nA = has_next ? nxt.A : cA; const char* nB = has_next ? nxt.B : cB;
        const int nt = cur.nt;
        for (int t = 0; t < nt; t += 2) {
            const bool last = (t == nt - 2);
            const char* a1 = cA + (size_t)(t + 1) * kstep;
            const char* a2 = last ? nA : cA + (size_t)(t + 2) * kstep; const char* b2 = last ? nB : cB + (size_t)(t + 2) * kstep;
            const char* a3 = a2 + kstep; const char* b3 = b2 + kstep;
            PG8_LDB(B0, 0, 0); PG8_LDB(B1, 0, 1); PG8_SCHED; PG8_LDA(At, 0, 0); PG8_STAGE(PG8_SA(1, 1), a1, vA[1]);
            if (last && has_next) mkvoff<GATHER>(nxt, vA, vB);
            PG8_WAIT_V(8); PG8_WAIT_L(0); PG8_BAR; PG8_MMA(0, 0, At, B0); PG8_MMA(0, 1, At, B1); PG8_BAR; PG8_SCHED;
            PG8_LDA(At, 0, 1); PG8_STAGE(PG8_SB(0, 0), b2, vB[0]); PG8_STAGE(PG8_SB(0, 1), b2, vB[1]); PG8_STAGE(PG8_SA(0, 0), a2, vA[0]);
            PG8_WAIT_V(8); PG8_WAIT_L(0); PG8_BAR; PG8_MMA(1, 0, At, B0); PG8_MMA(1, 1, At, B1); PG8_BAR; PG8_SCHED;
            PG8_LDB(B0, 1, 0); PG8_LDB(B1, 1, 1); PG8_SCHED; PG8_LDA(At, 1, 0); PG8_STAGE(PG8_SA(0, 1), a2, vA[1]);
            PG8_WAIT_V(8); PG8_WAIT_L(0); PG8_BAR; PG8_MMA(0, 0, At, B0); PG8_MMA(0, 1, At, B1); PG8_BAR; PG8_SCHED;
            PG8_LDA(At, 1, 1); PG8_STAGE(PG8_SB(1, 0), b3, vB[0]); PG8_STAGE(PG8_SB(1, 1), b3, vB[1]); PG8_STAGE(PG8_SA(1, 0), a3, vA[0]);
            PG8_WAIT_V(8); PG8_WAIT_L(0); PG8_BAR; PG8_MMA(1, 0, At, B0); PG8_MMA(1, 1, At, B1); PG8_BAR; PG8_SCHED;
        }
        if (wr == 0) PG8_BAR;
        E(acc, cur, wr, wc, fr, fq);
        if (!has_next) break;
#pragma unroll
        for (int a = 0; a < 2; ++a)
#pragma unroll
            for (int b = 0; b < 2; ++b)
#pragma unroll
                for (int m = 0; m < 4; ++m)
#pragma unroll
                    for (int n = 0; n < 2; ++n) acc[a][b][m][n] = (f32x4){0.f, 0.f, 0.f, 0.f};
        cur = nxt; cA = nA; cB = nB; ++ui;
        if (wr == 1) PG8_BAR;
    }
    PG8_WAIT_V(0);
    PG8_BAR;
#undef PG8_SA
#undef PG8_SB
#undef PG8_STAGE
#undef PG8_LDA
#undef PG8_LDB
#undef PG8_MMA
#undef PG8_WAIT_V
#undef PG8_WAIT_L
#undef PG8_BAR
#undef PG8_SCHED
}
}
using pg8::GUnit;

namespace att {
constexpr int D = 128, NW = 8, QBLK = 32, KVBLK = 64;
constexpr float SCALE = 0.088388347648318440f;
constexpr float THR = 8.f;
constexpr int LDQ = DM, LDK = DM, LDO = 2 * DM;
constexpr size_t SHM_V = KVBLK * D * 2, SHM_K = KVBLK * D * 2, SHM_ATTN = 2 * SHM_V + 2 * SHM_K + NW * 64 * 4;
#define KSWZ(row, colB) ((row) * 256 + ((colB) ^ (((row) & 7) << 4)))
#define SBAR() __builtin_amdgcn_sched_barrier(0)
__device__ __forceinline__ int crow(int r, int hi) { return (r & 3) + 8 * (r >> 2) + 4 * hi; }
__device__ __forceinline__ unsigned cvtpk(float lo, float hi) { unsigned r; asm volatile("v_cvt_pk_bf16_f32 %0, %1, %2" : "=v"(r) : "v"(lo), "v"(hi)); return r; }
__device__ __forceinline__ void partialSM(f32x16& p0, f32x16& p1, float mnC) {
  constexpr float C = SCALE * 1.4426950408889634f;
  for (int r = 0; r < 16; ++r) p0[r] = fmaf(p0[r], C, mnC); for (int r = 0; r < 16; ++r) p1[r] = fmaf(p1[r], C, mnC);
  for (int r = 0; r < 16; ++r) p0[r] = __builtin_amdgcn_exp2f(p0[r]);
}
__device__ __forceinline__ void finishSM(f32x16& p0, f32x16& p1, float& l_reg, bf16x8& pa0, bf16x8& pa1, bf16x8& pa2, bf16x8& pa3) {
  for (int r = 0; r < 16; ++r) p1[r] = __builtin_amdgcn_exp2f(p1[r]);
  float ps = 0; for (int r = 0; r < 16; ++r) ps += p0[r]; for (int r = 0; r < 16; ++r) ps += p1[r];
  l_reg += ps;
#define PK4(P, BASE, OUT) do { unsigned a0 = cvtpk(P[BASE + 0], P[BASE + 1]), a1 = cvtpk(P[BASE + 2], P[BASE + 3]);   \
    unsigned b0 = cvtpk(P[BASE + 4], P[BASE + 5]), b1 = cvtpk(P[BASE + 6], P[BASE + 7]);                              \
    auto r0 = __builtin_amdgcn_permlane32_swap(a0, b0, false, false); auto r1 = __builtin_amdgcn_permlane32_swap(a1, b1, false, false); \
    u32x4 w = {r0[0], r1[0], r0[1], r1[1]}; OUT = *reinterpret_cast<bf16x8*>(&w); } while (0)
  PK4(p0, 0, pa0); PK4(p0, 8, pa1); PK4(p1, 0, pa2); PK4(p1, 8, pa3);
#undef PK4
}
__device__ __forceinline__ void qkt(f32x16& p0, f32x16& p1, const bf16_t* Ks, const bf16x8* qr, int r32, int hi) {
  p0 = f32x16{}; p1 = f32x16{};
  for (int d0 = 0; d0 < 8; ++d0) { int cb = (d0 * 16 + hi * 8) * 2;
    bf16x8 b0 = *reinterpret_cast<const bf16x8*>((const char*)Ks + KSWZ(r32, cb));
    bf16x8 b1 = *reinterpret_cast<const bf16x8*>((const char*)Ks + KSWZ(32 + r32, cb));
    p0 = __builtin_amdgcn_mfma_f32_32x32x16_bf16(b0, qr[d0], p0, 0, 0, 0);
    p1 = __builtin_amdgcn_mfma_f32_32x32x16_bf16(b1, qr[d0], p1, 0, 0, 0); }
}
__device__ __forceinline__ int v_st(int k, int c) { const int kk = (k & ~0xC) | ((k & 4) << 1) | ((k & 8) >> 1); return ((kk >> 3) * 4 + (c >> 5)) * 512 + ((kk & 7) * 32 + (c & 31)) * 2; }
__device__ __forceinline__ int v_rd_base(int lane) { return ((lane & 3) << 3) | (((lane >> 2) & 3) << 6) | (((lane >> 4) & 1) << 5) | (((lane >> 5) & 1) << 8); }
constexpr int v_rd_off(int d0, int ks, int half) { return d0 * 512 + ks * 4096 + half * 2048; }
template <int OFF> __device__ __forceinline__ s16x4 tr_read(int vb) {
  s16x4 r; asm volatile("ds_read_b64_tr_b16 %0, %1 offset:%2" : "=&v"(r) : "v"(vb), "i"(OFF) : "memory"); return r;
}
template <int D0> __device__ __forceinline__ void pv_one(f32x16& od, int vb, bf16x8 pa0, bf16x8 pa1, bf16x8 pa2, bf16x8 pa3) {
  const s16x4 l0 = tr_read<v_rd_off(D0, 0, 0)>(vb), h0 = tr_read<v_rd_off(D0, 0, 1)>(vb), l1 = tr_read<v_rd_off(D0, 1, 0)>(vb), h1 = tr_read<v_rd_off(D0, 1, 1)>(vb);
  const s16x4 l2 = tr_read<v_rd_off(D0, 2, 0)>(vb), h2 = tr_read<v_rd_off(D0, 2, 1)>(vb), l3 = tr_read<v_rd_off(D0, 3, 0)>(vb), h3 = tr_read<v_rd_off(D0, 3, 1)>(vb);
  asm volatile("s_waitcnt lgkmcnt(0)" ::: "memory"); SBAR();
#define PK(L, H) (bf16x8){L[0], L[1], L[2], L[3], H[0], H[1], H[2], H[3]}
  od = __builtin_amdgcn_mfma_f32_32x32x16_bf16(pa0, PK(l0, h0), od, 0, 0, 0);
  od = __builtin_amdgcn_mfma_f32_32x32x16_bf16(pa1, PK(l1, h1), od, 0, 0, 0);
  od = __builtin_amdgcn_mfma_f32_32x32x16_bf16(pa2, PK(l2, h2), od, 0, 0, 0);
  od = __builtin_amdgcn_mfma_f32_32x32x16_bf16(pa3, PK(l3, h3), od, 0, 0, 0);
#undef PK
}
__device__ __forceinline__ void pv_d0(f32x16* o, int vb, bf16x8 pa0, bf16x8 pa1, bf16x8 pa2, bf16x8 pa3) {
  pv_one<0>(o[0], vb, pa0, pa1, pa2, pa3); pv_one<1>(o[1], vb, pa0, pa1, pa2, pa3); pv_one<2>(o[2], vb, pa0, pa1, pa2, pa3); pv_one<3>(o[3], vb, pa0, pa1, pa2, pa3);
}
__device__ __forceinline__ void attn_dense_body(const bf16_t* Qb, const bf16_t* Kh, const bf16_t* Vh, bf16_t* Ob, int seq, char* lds, float mnC) {
  int tid = threadIdx.x; asm volatile("" : "+v"(tid));
  const int wid = tid >> 6, lane = tid & 63, r32 = lane & 31, hi = lane >> 5;
  bf16_t* V_lds = (bf16_t*)lds; bf16_t* K_lds = (bf16_t*)(lds + 2 * SHM_V);
  float* ws = (float*)(lds + 2 * SHM_V + 2 * SHM_K) + wid * 64; float* li_l = ws;
  float l_reg = 0; f32x16 o[4] = {}; bf16x8 qr[8];
  const bf16_t* Qw = Qb + (long)(wid * QBLK + r32) * LDQ + hi * 8;
#pragma unroll
  for (int d0 = 0; d0 < 8; ++d0) qr[d0] = *reinterpret_cast<const bf16x8*>(Qw + d0 * 16);
  const int sr = tid >> 4, sc = (tid & 15) * 8, vst0 = v_st(sr, sc), vst1 = v_st(32 + sr, sc);
  const int vb0 = (int)(uintptr_t)V_lds + v_rd_base(lane);
  struct { bf16x8 vs0, vs1, ks0, ks1; } sr_[1];
  const unsigned goff = (unsigned)(sr * LDK + sc) * 2u;
#define SLOAD(i, k0) do { const char* vb_ = (const char*)Vh + (size_t)(k0) * (LDK * 2); const char* kb_ = (const char*)Kh + (size_t)(k0) * (LDK * 2); \
    sr_[i].vs0 = *reinterpret_cast<const bf16x8*>(vb_ + goff); sr_[i].vs1 = *reinterpret_cast<const bf16x8*>(vb_ + 32 * LDK * 2 + goff); \
    sr_[i].ks0 = *reinterpret_cast<const bf16x8*>(kb_ + goff); sr_[i].ks1 = *reinterpret_cast<const bf16x8*>(kb_ + 32 * LDK * 2 + goff); } while (0)
#define SWRITE(b, i) do { *(bf16x8*)((char*)V_lds + (b) * SHM_V + vst0) = sr_[i].vs0;          \
    *(bf16x8*)((char*)V_lds + (b) * SHM_V + vst1) = sr_[i].vs1; int kc = sc * 2;               \
    *(bf16x8*)((char*)K_lds + (b) * SHM_K + KSWZ(sr, kc)) = sr_[i].ks0;                       \
    *(bf16x8*)((char*)K_lds + (b) * SHM_K + KSWZ(32 + sr, kc)) = sr_[i].ks1; } while (0)
#define SWAIT() asm volatile("s_waitcnt vmcnt(0)" ::: "memory")
  f32x16 pA0, pA1, pB0, pB1; bf16x8 pa0, pa1, pa2, pa3; const int NT = seq / KVBLK;
  constexpr int SE = 0, SO = 0;
  SLOAD(SE, 0); asm volatile("s_waitcnt vmcnt(0)" ::: "memory"); SWRITE(0, SE); __syncthreads();
  qkt(pA0, pA1, K_lds, qr, r32, hi); partialSM(pA0, pA1, mnC);
  SLOAD(SO, KVBLK);
  SWAIT(); SWRITE(1, SO); __syncthreads();
  for (int j = 1; j + 1 < NT; j += 2) {
    SBAR(); qkt(pB0, pB1, (bf16_t*)((char*)K_lds + SHM_K), qr, r32, hi);
    finishSM(pA0, pA1, l_reg, pa0, pa1, pa2, pa3); SBAR();
    SLOAD(SO, (j + 1) * KVBLK); SBAR();
    pv_d0(o, vb0, pa0, pa1, pa2, pa3); partialSM(pB0, pB1, mnC);
    __syncthreads(); SWAIT(); SWRITE(0, SE);
    __syncthreads();
    SBAR(); qkt(pA0, pA1, K_lds, qr, r32, hi);
    finishSM(pB0, pB1, l_reg, pa0, pa1, pa2, pa3); SBAR();
    SLOAD(SE, (j + 2) * KVBLK); SBAR();
    pv_d0(o, vb0 + (int)SHM_V, pa0, pa1, pa2, pa3); partialSM(pA0, pA1, mnC);
    __syncthreads(); SWAIT(); SWRITE(1, SO);
    __syncthreads();
  }
  SBAR(); qkt(pB0, pB1, (bf16_t*)((char*)K_lds + SHM_K), qr, r32, hi);
  finishSM(pA0, pA1, l_reg, pa0, pa1, pa2, pa3); SBAR();
  pv_d0(o, vb0, pa0, pa1, pa2, pa3); partialSM(pB0, pB1, mnC);
  __syncthreads();
  finishSM(pB0, pB1, l_reg, pa0, pa1, pa2, pa3); SBAR();
  pv_d0(o, vb0 + (int)SHM_V, pa0, pa1, pa2, pa3);
  { auto rr = __builtin_amdgcn_permlane32_swap(__float_as_uint(l_reg), __float_as_uint(l_reg), false, false); l_reg = __uint_as_float(rr[0]) + __uint_as_float(rr[1]); }
  if (hi == 0) li_l[r32] = l_reg; asm volatile("s_waitcnt lgkmcnt(0)" ::: "memory");
  float rli[16];
#pragma unroll
  for (int r = 0; r < 16; ++r) rli[r] = __builtin_amdgcn_rcpf(li_l[crow(r, hi)]);
  bf16_t* Ow = Ob + (long)(wid * QBLK) * LDO;
#pragma unroll
  for (int r = 0; r < 16; ++r) { int orow = crow(r, hi);
    for (int d0 = 0; d0 < 4; ++d0) Ow[(long)orow * LDO + d0 * 32 + r32] = (bf16_t)f2bf(o[d0][r] * rli[r]); }
#undef SLOAD
#undef SWRITE
#undef SWAIT
}
#undef KSWZ
#undef SBAR
}


#define XB_TMO      128
#define XB_XCNT(j)  (256  + 64 * (j))
#define XB_XSUB(j)  (1280 + 64 * (j))
#define XB_XGEN(j)  (2304 + 64 * (j))
#define XB_TOP      3328
#define XB_TOPGEN   3392
#define XCD_BAR_WORDS 3456
#define XB_SPIN_CAP (1u << 18)
__device__ __forceinline__ unsigned xb_ld(unsigned* p)              { return __hip_atomic_load(p, __ATOMIC_RELAXED, __HIP_MEMORY_SCOPE_AGENT); }
__device__ __forceinline__ unsigned xb_add(unsigned* p, unsigned v) { return __hip_atomic_fetch_add(p, v, __ATOMIC_RELAXED, __HIP_MEMORY_SCOPE_AGENT); }
__device__ __forceinline__ unsigned xb_xcc_id() { return (unsigned)__builtin_amdgcn_s_getreg((3 << 11) | 20) & 0xFu; }
#define XB_SPIN(cond, bar) do { unsigned _sp = 0; while (cond) { __builtin_amdgcn_s_sleep(1); \
    if ((++_sp & 255u) == 0u) { if (xb_ld(&(bar)[XB_TMO])) break; if (_sp > XB_SPIN_CAP) { atomicAdd(&(bar)[XB_TMO], 1u); break; } } } } while (0)
__device__ __forceinline__ void xcd_barrier_complete(unsigned* bar, unsigned x, unsigned& nloc, unsigned& nx) {
    const unsigned G = gridDim.x * gridDim.y * gridDim.z;
    unsigned sum, cnt, mine, sp = 0u;
    for (;;) {
        sum = 0u; cnt = 0u; mine = 0u;
#pragma unroll
        for (unsigned j = 0; j < 16; ++j) { const unsigned c = xb_ld(&bar[XB_XCNT(j)]); sum += c; cnt += (c > 0u) ? 1u : 0u; mine = (j == x) ? c : mine; }
        if (sum == G) break;
        __builtin_amdgcn_s_sleep(1);
        if ((++sp & 255u) == 0u) { if (xb_ld(&bar[XB_TMO])) break; if (sp > XB_SPIN_CAP) { atomicAdd(&bar[XB_TMO], 1u); break; } }
    }
    nloc = mine > 0u ? mine : 1u; nx = cnt > 0u ? cnt : 1u;
}
__device__ __forceinline__ void xcd_barrier(unsigned* bar, volatile LAS unsigned* st) {
    asm volatile("s_waitcnt vmcnt(0)" ::: "memory");
    __syncthreads();
    if (threadIdx.x == 0) {
        const unsigned x = xb_xcc_id();
        __builtin_amdgcn_s_waitcnt(0);
        unsigned nloc = st[0], nx = st[1];
        if (nloc == 0u) { xcd_barrier_complete(bar, x, nloc, nx); st[0] = nloc; st[1] = nx; }
        const unsigned old = xb_add(&bar[XB_XSUB(x)], 1u);
        const unsigned gen = old / nloc;
        if (old + 1u == (gen + 1u) * nloc) {
            __builtin_amdgcn_fence(__ATOMIC_RELEASE, "agent");
            asm volatile("s_waitcnt vmcnt(0)" ::: "memory");
            const unsigned og = xb_add(&bar[XB_TOP], 1u);
            const unsigned tg = og / nx;
            if (og + 1u == (tg + 1u) * nx) xb_add(&bar[XB_TOPGEN], 1u);
            else XB_SPIN(xb_ld(&bar[XB_TOPGEN]) == tg, bar);
            __builtin_amdgcn_fence(__ATOMIC_ACQUIRE, "agent");
            xb_add(&bar[XB_XGEN(x)], 1u);
            asm volatile("s_waitcnt vmcnt(0)" ::: "memory");
        } else {
            XB_SPIN(xb_ld(&bar[XB_XGEN(x)]) == gen, bar);
            __builtin_amdgcn_fence(__ATOMIC_ACQUIRE, "agent");
            asm volatile("s_waitcnt vmcnt(0)" ::: "memory");
        }
    }
    __syncthreads();
}

struct Args;
typedef const __attribute__((address_space(4))) Args* KArgsP;
struct Args {
    const float *x, *c, *ctx, *c_ctx, *norm1_w, *norm2_w, *w_mod, *b_mod, *even_w_in, *even_conv_w, *even_w_out, *odd_w_qkv, *odd_q_norm, *odd_k_norm,
                *lq1, *lk1, *lq2, *lk2, *subln_w, *odd_w_out, *moe_w_group, *moe_b_group, *moe_w_expert, *moe_b_expert, *moe_w_gate, *moe_w_up, *moe_w_down;
    float* out; unsigned char* ws; int ph_lo, ph_hi;
};

__device__ __forceinline__ KArgsP kargs() { KArgsP p = (KArgsP)__builtin_amdgcn_kernarg_segment_ptr(); asm volatile("" : "+s"(p)); return p; }

__device__ __forceinline__ void transpose_item(const float* W, int ldw, int K, bf16_t* WT, int dst_row0, int k0, int n0, LAS float* scr, int lane) {
#pragma unroll 8
    for (int i = 0; i < 32; ++i) { const int kk = 2 * i + (lane >> 5); scr[kk * 33 + (lane & 31)] = W[(size_t)(k0 + kk) * ldw + n0 + (lane & 31)]; }
    asm volatile("s_waitcnt lgkmcnt(0)" ::: "memory");
    const int c = lane & 7;
#pragma unroll
    for (int j = 0; j < 4; ++j) { const int n = (lane >> 3) + 8 * j; const LAS float* s = scr + (8 * c) * 33 + n;
        u32x4 o; o.x = pk2(s[0 * 33], s[1 * 33]); o.y = pk2(s[2 * 33], s[3 * 33]); o.z = pk2(s[4 * 33], s[5 * 33]); o.w = pk2(s[6 * 33], s[7 * 33]);
        *(u32x4*)(WT + (size_t)(dst_row0 + n) * K + k0 + 8 * c) = o; }
    asm volatile("s_waitcnt lgkmcnt(0)" ::: "memory");
}
__device__ __forceinline__ void moe_weight_items(const float* w_gate, const float* w_up, const float* w_down, unsigned char* ws, int l, int gw, int ngw, LAS float* scr, int lane) {
    bf16_t* WGU = (bf16_t*)(ws + WS_WGU); bf16_t* WD = (bf16_t*)(ws + WS_WD);
    constexpr int I_G = NEXP * 32 * 16, I_D = NEXP * 8 * 64;
    for (int it = gw; it < 2 * I_G + I_D; it += ngw) {
        if (it < 2 * I_G) { const int up = it >= I_G, r = up ? it - I_G : it, e = r / 512, kb = (r % 512) / 16, nb = r % 16;
            const float* W = (up ? w_up : w_gate) + ((size_t)l * NEXP + e) * DM * EFF;
            const int n0 = nb * 32, row0 = e * 1024 + (n0 >> 7) * 256 + up * 128 + (n0 & 127);
            transpose_item(W, EFF, DM, WGU, row0, kb * 64, n0, scr, lane);
        } else { const int r = it - 2 * I_G, e = r / 512, kb = (r % 512) / 64, nb = r % 64;
            const float* W = w_down + ((size_t)l * NEXP + e) * EFF * DM;
            transpose_item(W, DM, EFF, WD, e * DM + nb * 32, kb * 64, nb * 32, scr, lane); }
    }
}

struct SchedInProj {
    const char *u0, *win; char *P, *ztl, *ztc; int G, c;
    __device__ __forceinline__ bool next(int i, GUnit& u) const {
        const int L = i * G + c; if (L >= 816 + 544) return false;
        u.lda = DM * 2; u.ldb = DM * 2; u.nt = DM / 64; u.scale = 1.f;
        if (L < 816) { int pm, pn; pg8::tile_of(L, 68, 12, pm, pn);
            u.A = u0 + (size_t)pm * 256 * DM * 2; u.B = win + (size_t)pn * 256 * DM * 2; u.O = P + ((size_t)pm * 256 * 3072 + pn * 256) * 2; u.ldc = 3072;
        } else { int pm, pn; pg8::tile_of(L - 816, 8, 68, pm, pn);
            u.A = win + (size_t)(3072 + pm * 256) * DM * 2; u.B = u0 + (size_t)pn * 256 * DM * 2;
            const int g = pm >> 1, part = pm & 1, b = pn / 17, jt = pn % 17;
            if (jt == 0) { u.O = ztc + ((size_t)((b * 4 + g) * 256) * 512 + part * 256) * 2; u.ldc = 512; }
            else { u.O = ztl + ((size_t)((b * 4 + g) * 256) * 8192 + part * 4096 + (jt - 1) * 256) * 2; u.ldc = 8192; } }
        return true;
    }
};
struct SchedDFT {
    const char *cmat, *cmatc, *ztl, *ztc; char* ycat; int G, c;
    __device__ __forceinline__ bool next(int i, GUnit& u) const {
        const int L = i * G + c; if (L >= 272) return false;
        if (L < 256) { const int w = (L % 8) * 32 + L / 8, bg = w >> 4, pm = w & 15, b = bg >> 2, g = bg & 3;
            u.A = cmat + (size_t)pm * 256 * 16384; u.B = ztl + (size_t)bg * 256 * 16384; u.lda = 16384; u.ldb = 16384; u.nt = 128;
            u.O = ycat + ((size_t)(b * TPB + CTX + pm * 256) * DM + 1024 + g * 256) * 2; u.ldc = DM; u.scale = 1.0f / 1024.0f;
        } else { const int bg = L - 256, b = bg >> 2, g = bg & 3;
            u.A = cmatc; u.B = ztc + (size_t)bg * 256 * 1024; u.lda = 1024; u.ldb = 1024; u.nt = 8;
            u.O = ycat + ((size_t)(b * TPB) * DM + 1024 + g * 256) * 2; u.ldc = DM; u.scale = 1.0f / 256.0f; }
        return true;
    }
};
struct SchedOut0 {
    const char *ycat, *wout; const float *x, *ctx, *mod; char* h; int G, c;
    __device__ __forceinline__ bool next(int i, GUnit& u) const {
        const int L = i * G + c; if (L >= 68 * 8) return false;
        int pm, pn; pg8::tile_of(L, 68, 8, pm, pn);
        u.A = ycat + (size_t)pm * 256 * DM * 2; u.B = wout + (size_t)pn * 256 * DM * 2; u.lda = DM * 2; u.ldb = DM * 2; u.nt = DM / 64;
        const int b = pm / 17, jt = pm % 17, v = (jt == 0) ? 4 : b;
        u.src = (const char*)((jt == 0 ? ctx + (size_t)b * CTX * DM : x + ((size_t)b * SEQ + (jt - 1) * 256) * DM) + pn * 256);
        u.gate = mod + (size_t)v * MODSZ + 2 * DM + pn * 256;
        u.O = h + ((size_t)pm * 256 * DM + pn * 256) * 4;
        return true;
    }
};
struct SchedOut1 {
    const char *a, *wout; const float* mod; char* h; int G, c;
    __device__ __forceinline__ bool next(int i, GUnit& u) const {
        const int L = i * G + c; if (L >= 64 * 8) return false;
        int lt, pn; pg8::tile_of(L, 64, 8, lt, pn);
        const int b = lt >> 4, ut = b * 17 + 1 + (lt & 15);
        u.A = a + (size_t)ut * 256 * DM * 2; u.B = wout + (size_t)pn * 256 * DM * 2; u.lda = DM * 2; u.ldb = DM * 2; u.nt = DM / 64;
        u.O = h + ((size_t)ut * 256 * DM + pn * 256) * 4; u.src = u.O; u.gate = mod + (size_t)b * MODSZ + 2 * DM + pn * 256;
        return true;
    }
};
struct SchedQKV {
    const char *u1, *wqkv; char *q; int G, c;
    __device__ __forceinline__ bool next(int i, GUnit& u) const {
        const int L = i * G + c; if (L >= 1536 + 64) return false;
        int ut, pn;
        if (L < 1536) { int lt; pg8::tile_of(L, 64, 24, lt, pn); ut = (lt >> 4) * 17 + 1 + (lt & 15); }
        else { const int r = L - 1536; ut = (r & 3) * 17; pn = 8 + (r >> 2); }
        u.A = u1 + (size_t)ut * 256 * DM * 2; u.B = wqkv + (size_t)pn * 256 * DM * 2; u.lda = DM * 2; u.ldb = DM * 2; u.nt = DM / 64; u.scale = 1.f; u.ldc = DM;
        u.O = q + (size_t)(pn >> 3) * (WS_K - WS_Q) + ((size_t)ut * 256 * DM + (pn & 7) * 256) * 2;
        return true;
    }
};
struct MoeTiles {
    const LAS int* tab;
    __device__ __forceinline__ void init(LAS int* t, const unsigned* cntp) {
        tab = t;
        if (threadIdx.x == 0) { int s = 0;
            for (int e = 0; e < NEXP; ++e) { const int c = (int)cntp[e]; t[e] = c; t[16 + e] = s; s += (c + 255) >> 8; }
            t[32] = s; }
        __syncthreads();
    }
    __device__ __forceinline__ int total() const { return __builtin_amdgcn_readfirstlane(tab[32]); }
    __device__ __forceinline__ void find(int rtg, int& e, int& rt, int& gc) const {
        int ee = 0;
#pragma unroll
        for (int j = 1; j < NEXP; ++j) if (rtg >= tab[16 + j]) ee = j;
        e = __builtin_amdgcn_readfirstlane(ee);
        const int tbe = __builtin_amdgcn_readfirstlane(tab[16 + e]), ce = __builtin_amdgcn_readfirstlane(tab[e]);
        rt = rtg - tbe; gc = ce - rt * 256; if (gc > 256) gc = 256;
    }
};
struct SchedMoe1 {
    MoeTiles T; const char *v, *wgu; char* hid; const int* lst; int G, c;
    __device__ __forceinline__ bool next(int i, GUnit& u) const {
        const int L = i * G + c, nwg = T.total() * 4; if (L >= nwg) return false;
        const int w = pg8::xcd_remap(L, nwg), rtg = w >> 2, pn = w & 3; int e, rt, gc; T.find(rtg, e, rt, gc);
        u.A = v; u.lda = DM * 2; u.glist = lst + (size_t)e * LCAP + rt * 256; u.gcount = gc;
        u.B = wgu + ((size_t)e * 1024 + pn * 256) * DM * 2; u.ldb = DM * 2; u.nt = DM / 64;
        u.O = hid + ((size_t)rtg * 256 * EFF + pn * 128) * 2; u.ldc = EFF;
        return true;
    }
};
struct SchedMoe2 {
    MoeTiles T; const char *hid, *wd; const int* lst; int G, c;
    __device__ __forceinline__ bool next(int i, GUnit& u) const {
        const int L = i * G + c, nwg = T.total() * 8; if (L >= nwg) return false;
        const int w = pg8::xcd_remap(L, nwg), rtg = w >> 3, pn = w & 7; int e, rt, gc; T.find(rtg, e, rt, gc);
        u.A = hid + (size_t)rtg * 256 * EFF * 2; u.lda = EFF * 2; u.B = wd + ((size_t)e * DM + pn * 256) * EFF * 2; u.ldb = EFF * 2; u.nt = EFF / 64;
        u.glist = lst + (size_t)e * LCAP + rt * 256; u.gcount = gc; u.aux = pn;
        return true;
    }
};

__device__ __forceinline__ void row_info(int row, int& b, int& j) { b = row / TPB; j = row - b * TPB; }

__device__ __forceinline__ void norm_mod_store(const f32x4 (&v)[8], float rstd, const float* nw, const float* sc, const float* sh, bf16_t* orow, int lane) {
#pragma unroll
    for (int jj = 0; jj < 8; ++jj) { const int k = 4 * lane + 256 * jj;
        const f32x4 w = *(const f32x4*)(nw + k), s = *(const f32x4*)(sc + k), t = *(const f32x4*)(sh + k);
        const f32x4 y = v[jj] * rstd * w * (1.0f + s) + t;
        u32x2 o; o.x = pk2(y[0], y[1]); o.y = pk2(y[2], y[3]); *(u32x2*)(orow + k) = o; }
}

__device__ __forceinline__ void route_row(const LAS float* yl, const float* wg, const float* bg, const float* we, const float* be, int lane, int& e0, int& e1, float& w0, float& w1) {
    float lg[4] = {0.f, 0.f, 0.f, 0.f}; float le[16];
#pragma unroll
    for (int n = 0; n < 16; ++n) le[n] = 0.f;
#pragma unroll 1
    for (int jj = 0; jj < 8; ++jj) { const f32x4 y4 = *(const LAS f32x4*)(yl + 4 * lane + 256 * jj);
#pragma unroll
        for (int i = 0; i < 4; ++i) { const int k = 4 * lane + 256 * jj + i; const float xv = y4[i];
            const f32x4 g = *(const f32x4*)(wg + (size_t)k * 4);
#pragma unroll
            for (int n = 0; n < 4; ++n) lg[n] = fmaf(xv, g[n], lg[n]);
#pragma unroll
            for (int q = 0; q < 4; ++q) { const f32x4 ev = *(const f32x4*)(we + (size_t)k * 16 + 4 * q);
#pragma unroll
                for (int n = 0; n < 4; ++n) le[4 * q + n] = fmaf(xv, ev[n], le[4 * q + n]); } } }
#pragma unroll
    for (int n = 0; n < 4; ++n) lg[n] = wave_sum(lg[n]) + bg[n];
#pragma unroll
    for (int n = 0; n < 16; ++n) le[n] = wave_sum(le[n]) + be[n];
    int gi = 0; float gm = lg[0];
#pragma unroll
    for (int n = 1; n < 4; ++n) if (lg[n] > gm) { gm = lg[n]; gi = n; }
    float den = 0.f;
#pragma unroll
    for (int n = 0; n < 4; ++n) den += __expf(lg[n] - gm);
    const float gw = 1.0f / den;
    float s[4];
#pragma unroll
    for (int n = 0; n < 4; ++n) { const float m0 = (gi == 0) ? 1.f : 0.f, m1 = (gi == 1) ? 1.f : 0.f, m2 = (gi == 2) ? 1.f : 0.f, m3 = (gi == 3) ? 1.f : 0.f; s[n] = le[n] * m0 + le[4 + n] * m1 + le[8 + n] * m2 + le[12 + n] * m3; }
    int i0 = 0; float v0 = s[0];
#pragma unroll
    for (int n = 1; n < 4; ++n) if (s[n] > v0) { v0 = s[n]; i0 = n; }
    int i1 = -1; float v1 = -3.0e38f;
#pragma unroll
    for (int n = 0; n < 4; ++n) if (n != i0 && s[n] > v1) { v1 = s[n]; i1 = n; }
    const float ex = __expf(v1 - v0), inv = 1.0f / (1.0f + ex);
    e0 = gi * 4 + i0; e1 = gi * 4 + i1; w0 = inv * gw; w1 = ex * inv * gw;
}

#define PHASE_BEGIN KArgsP ka = kargs(); unsigned char* ws = ka->ws; (void)ws; int tid = threadIdx.x; asm volatile("" : "+v"(tid)); const int lane = tid & 63, wave = __builtin_amdgcn_readfirstlane(tid >> 6), gw = blk * NWAVES + wave; (void)lane; (void)gw;
#define ctl ((unsigned*)(ws + WS_CTL))
#define mod ((float*)(ws + WS_MOD))
#define tokw ((float*)(ws + WS_TOKW))
#define list ((int*)(ws + WS_LIST))
#define WIN ((bf16_t*)(ws + WS_WIN))
#define WOUT0 ((bf16_t*)(ws + WS_WOUT0))
#define WQKV ((bf16_t*)(ws + WS_WQKV))
#define WOUT1 ((bf16_t*)(ws + WS_WOUT1))
#define CMAT ((bf16_t*)(ws + WS_CMAT))
#define CMATC ((bf16_t*)(ws + WS_CMATC))
#define H ((float*)(ws + WS_H))
#define U ((bf16_t*)(ws + WS_U))
#define PB ((bf16_t*)(ws + WS_P))
#define YCAT ((bf16_t*)(ws + WS_YCAT))
#define QB ((bf16_t*)(ws + WS_Q))
#define KB ((bf16_t*)(ws + WS_K))
#define VB ((bf16_t*)(ws + WS_V))
#define AB ((bf16_t*)(ws + WS_A))
#define YB ((bf16_t*)(ws + WS_Y))
#define OB ((bf16_t*)(ws + WS_O))
#ifndef PHMASK
#define PHMASK 0x3ffff
#endif
#define PHON(k) (((PHMASK) >> (k)) & 1)
#define IN(k) (lo <= (k) && (k) < hi)
#ifndef XSYNC
#define XSYNC 0
#endif
#define BARW ((unsigned*)(kargs()->ws + WS_CTL) + 4096)
#define BARST ((volatile LAS unsigned*)(lds + RING_BYTES + 512))
#define SYNC(k) do { if (IN(k) && IN((k) + 1)) { \
        if ((k) == 0) { grid.sync(); if (threadIdx.x == 0) (void)xb_add(&BARW[XB_XCNT(xb_xcc_id())], 1u); }     \
        else xcd_barrier(BARW, BARST); \
        if ((k) == 1) for (int xs_ = 0; xs_ < XSYNC; ++xs_) xcd_barrier(BARW, BARST); } } while (0)
#define TS(k) do { if (PROBE && blockIdx.x == 0 && threadIdx.x == 0) { const unsigned long long t_ = __builtin_amdgcn_s_memrealtime(); unsigned long long* tp_ = (unsigned long long*)(kargs()->ws + WS_CTL + 1024); \
        if ((k) == PA0) tp_[0] = t_; if ((k) == PA1) tp_[1] = t_; if ((k) == PB0) tp_[2] = t_; if ((k) == PB1) tp_[3] = t_; } } while (0)
template <int l>
__device__ __forceinline__ void moe_layer(cg::grid_group& grid, LAS unsigned char* lds, int lo, int hi, int G, int blk) {
    const int pb = (l == 0) ? 5 : 14;
#define cnt (ctl + 32 * l)
#define modl (mod + (size_t)l * 5 * MODSZ)
        TS(pb);
        if (PHON(5) && IN(pb)) REPS(5) { PHASE_BEGIN
            LAS int* ri = (LAS int*)lds;
            LAS float* part = (LAS float*)(lds + 4096);
            LAS float* ssq = (LAS float*)(lds + 16384);
            LAS float* rstdL = (LAS float*)(lds + 16896);
            LAS float* red = (LAS float*)(lds + 17408);
            const int ntiles = (l == 0 ? NTOK : NLAT) / 16, t0 = (ntiles * blk) / G, t1 = (ntiles * (blk + 1)) / G;
            const float* wg = ka->moe_w_group + (size_t)l * DM * 4; const float* bgp = ka->moe_b_group + l * 4;
            const float* we = ka->moe_w_expert + (size_t)l * DM * 16; const float* bep = ka->moe_b_expert + l * 16;
            const float* nw = ka->norm2_w + l * DM;
            const float* cbuf = (const float*)(ctl + 8192) + (size_t)l * 5 * 32;
            const int r = lane & 15, q = lane >> 4, K0 = wave * 256;
            float Be[16][4], Bg[16][4]; int curv = -1;
            for (int t = t0; t < t1; ++t) {
                const int row0 = (l == 0) ? t * 16 : ((t * 16) / SEQ) * TPB + CTX + ((t * 16) % SEQ);
                int b, j; row_info(row0, b, j); const int v = (j < CTX) ? 4 : b;
                const float* mv = modl + (size_t)v * MODSZ;
                if (v != curv) { curv = v;
                    gcf wep = (gcf)(we + (size_t)(K0 + 4 * q) * 16 + r); gcf wgp = (gcf)(wg + (size_t)(K0 + 4 * q) * 4 + (r & 3));
                    gcf nwp = (gcf)(nw + K0 + 4 * q); gcf scp = (gcf)(mv + 4 * DM + K0 + 4 * q); const float gmask = (r < 4) ? 1.f : 0.f;
#pragma unroll
                    for (int c = 0; c < 16; ++c) { const f32x4 w4 = *(const __attribute__((address_space(1))) f32x4*)nwp, s4 = *(const __attribute__((address_space(1))) f32x4*)scp;
#pragma unroll
                        for (int s_ = 0; s_ < 4; ++s_) { const float av = w4[s_] * (1.0f + s4[s_]); Be[c][s_] = av * wep[s_ * 16]; Bg[c][s_] = av * gmask * wgp[s_ * 4]; }
                        wep += 256; wgp += 64; nwp += 16; scp += 16; asm volatile("" : "+v"(wep), "+v"(wgp), "+v"(nwp), "+v"(scp) :: "memory"); } }
                const float* hrow = H + (size_t)(row0 + r) * DM + K0 + 4 * q;
                f32x4 ae = {0.f, 0.f, 0.f, 0.f}, ag = {0.f, 0.f, 0.f, 0.f}; float ss = 0.f;
#pragma unroll
                for (int hf = 0; hf < 2; ++hf) { f32x4 Av[8];
#pragma unroll
                    for (int c = 0; c < 8; ++c) Av[c] = *(const f32x4*)(hrow + 16 * (8 * hf + c));
#pragma unroll
                    for (int c = 0; c < 8; ++c)
#pragma unroll
                        for (int s_ = 0; s_ < 4; ++s_) { const float x = Av[c][s_]; ss = fmaf(x, x, ss);
                            ae = __builtin_amdgcn_mfma_f32_16x16x4f32(x, Be[8 * hf + c][s_], ae, 0, 0, 0); ag = __builtin_amdgcn_mfma_f32_16x16x4f32(x, Bg[8 * hf + c][s_], ag, 0, 0, 0); }
                    asm volatile("" ::: "memory"); }
                ss += __shfl_xor(ss, 16); ss += __shfl_xor(ss, 32);
                if (q == 0) ssq[wave * 16 + r] = ss;
#pragma unroll
                for (int g_ = 0; g_ < 4; ++g_) { part[(wave * 16 + 4 * q + g_) * 20 + r] = ae[g_]; if (r < 4) part[(wave * 16 + 4 * q + g_) * 20 + 16 + r] = ag[g_]; }
                __syncthreads();
                if (tid < 320) { float p = 0.f;
#pragma unroll
                    for (int w = 0; w < 8; ++w) p += part[w * 320 + tid];
                    red[tid] = p; }
                __syncthreads();
                if (tid < 16) { float sum = 0.f;
#pragma unroll
                    for (int w = 0; w < 8; ++w) sum += ssq[w * 16 + tid];
                    const float rstd = rsqrtf(sum * (1.0f / DM) + EPS); rstdL[tid] = rstd;
                    float lg[20];
#pragma unroll
                    for (int n = 0; n < 20; ++n) lg[n] = rstd * red[tid * 20 + n] + cbuf[v * 32 + n];
                    int gi = 0; float gm = lg[16];
#pragma unroll
                    for (int n = 1; n < 4; ++n) if (lg[16 + n] > gm) { gm = lg[16 + n]; gi = n; }
                    float den = 0.f;
#pragma unroll
                    for (int n = 0; n < 4; ++n) den += __expf(lg[16 + n] - gm);
                    const float gwt = 1.0f / den; float sv[4];
#pragma unroll
                    for (int n = 0; n < 4; ++n) { const float m0 = (gi == 0) ? 1.f : 0.f, m1 = (gi == 1) ? 1.f : 0.f, m2 = (gi == 2) ? 1.f : 0.f, m3 = (gi == 3) ? 1.f : 0.f; sv[n] = lg[n] * m0 + lg[4 + n] * m1 + lg[8 + n] * m2 + lg[12 + n] * m3; }
                    int i0 = 0; float v0 = sv[0];
#pragma unroll
                    for (int n = 1; n < 4; ++n) if (sv[n] > v0) { v0 = sv[n]; i0 = n; }
                    int i1 = -1; float v1 = -3.0e38f;
#pragma unroll
                    for (int n = 0; n < 4; ++n) if (n != i0 && sv[n] > v1) { v1 = sv[n]; i1 = n; }
                    const float ex = __expf(v1 - v0), inv = 1.0f / (1.0f + ex);
                    const int row = row0 + tid, ix = (t - t0) * 16 + tid;
                    ri[ix * 4 + 0] = gi * 4 + i0; ri[ix * 4 + 1] = gi * 4 + i1; ri[ix * 4 + 2] = row * 2; ri[ix * 4 + 3] = row * 2 + 1;
                    tokw[row * 2] = inv * gwt; tokw[row * 2 + 1] = ex * inv * gwt; }
                __syncthreads();
                { const float rstd = rstdL[r]; gbf up = (gbf)(U + (size_t)(row0 + r) * DM + K0 + 4 * q); gcf hp = (gcf)hrow;
                    gcf nwp = (gcf)(nw + K0 + 4 * q); gcf scp = (gcf)(mv + 4 * DM + K0 + 4 * q); gcf shp = (gcf)(mv + 3 * DM + K0 + 4 * q);
#pragma unroll
                    for (int c = 0; c < 16; ++c) { typedef const __attribute__((address_space(1))) f32x4* g4; const f32x4 w4 = *(g4)nwp, s4 = *(g4)scp, t4 = *(g4)shp;
                        const f32x4 y = *(g4)hp * rstd * w4 * (1.0f + s4) + t4;
                        u32x2 o; o.x = pk2(y[0], y[1]); o.y = pk2(y[2], y[3]); *(__attribute__((address_space(1))) u32x2*)up = o;
                        nwp += 16; scp += 16; shp += 16; hp += 16; up += 16;
                        if ((c & 3) == 3) asm volatile("" : "+v"(nwp), "+v"(scp), "+v"(shp), "+v"(hp), "+v"(up) :: "memory"); } }
            }
            __syncthreads();
            const int nrb = (t1 - t0) * 16;
            if (tid < NEXP) { int n = 0;
                for (int i = 0; i < nrb; ++i) { n += (ri[i * 4] == tid) + (ri[i * 4 + 1] == tid); }
                int* lp = list + (rep_ ? (int)((WS_END - WS_LIST) / 4) : 0); const int base = n ? (int)atomicAdd(cnt + 16 * rep_ + tid, (unsigned)n) : 0; int p = 0;
                for (int i = 0; i < nrb; ++i) { if (ri[i * 4] == tid) lp[(size_t)tid * LCAP + base + p++] = ri[i * 4 + 2]; if (ri[i * 4 + 1] == tid) lp[(size_t)tid * LCAP + base + p++] = ri[i * 4 + 3]; } }
            __syncthreads();
        }
        SYNC(pb);
        TS(pb + 1);
        if (PHON(6) && IN(pb + 1)) REPS(6) { PHASE_BEGIN
            SchedMoe1 S; S.T.init((LAS int*)(lds + RING_BYTES), cnt); S.v = (const char*)U; S.wgu = (const char*)(ws + WS_WGU); S.hid = (char*)(ws + WS_HID); S.lst = list; S.G = G; S.c = blk;
            pg8::gemm_phase<SchedMoe1, pg8::EpiSwiGLU, true>(lds, S, pg8::EpiSwiGLU{});
        }
        SYNC(pb + 1);
        TS(pb + 2);
        if (PHON(7) && IN(pb + 2)) REPS(7) { PHASE_BEGIN
            SchedMoe2 S; S.T.init((LAS int*)(lds + RING_BYTES), cnt); S.hid = (const char*)(ws + WS_HID); S.wd = (const char*)(ws + WS_WD); S.lst = list; S.G = G; S.c = blk;
            pg8::gemm_phase<SchedMoe2, pg8::EpiScatter, false>(lds, S, pg8::EpiScatter{YB, tokw});
        }
        SYNC(pb + 2);
}

__global__ void __launch_bounds__(NTHREADS, 2) fwd_kernel(Args a) {
    extern __shared__ __attribute__((aligned(16))) unsigned char lds_raw[];
    LAS unsigned char* lds = (LAS unsigned char*)lds_raw;
    cg::grid_group grid = cg::this_grid();
    const int G = gridDim.x, blk = blockIdx.x, ngw = G * NWAVES;
    const int lo = a.ph_lo, hi = a.ph_hi;
    if (threadIdx.x < 2) ((LAS unsigned*)(lds + RING_BYTES + 512))[threadIdx.x] = 0u;
    __syncthreads();


    TS(0);
    if (PHON(0) && IN(0)) REPS(0) { PHASE_BEGIN
        if (blk == 0) { if (tid < 64) ctl[tid] = 0u;
            for (int i = tid; i < XCD_BAR_WORDS; i += NTHREADS) (ctl + 4096)[i] = 0u; }
        if (blk < 192) {
            LAS float* sil = (LAS float*)lds; LAS float* red = (LAS float*)(lds + 40960);
            for (int i = tid; i < 5 * DM; i += NTHREADS) { const int v = i / DM, k = i % DM; sil[i] = silu_f(v < 4 ? ka->c[v * DM + k] : ka->c_ctx[k]); }
            __syncthreads();
            const int l = blk / 96, j0 = (blk % 96) * 128;
            const float* wp = ka->w_mod + (size_t)l * DM * MODSZ + j0 + 2 * lane;
            f32x2 acc[5];
#pragma unroll
            for (int v = 0; v < 5; ++v) acc[v] = (f32x2){0.f, 0.f};
#pragma unroll 8
            for (int k = wave * 256; k < wave * 256 + 256; ++k) { const f32x2 w = *(const f32x2*)(wp + (size_t)k * MODSZ);
#pragma unroll
                for (int v = 0; v < 5; ++v) { const float s = sil[v * DM + k]; acc[v].x = fmaf(s, w.x, acc[v].x); acc[v].y = fmaf(s, w.y, acc[v].y); } }
#pragma unroll
            for (int v = 0; v < 5; ++v) { red[(wave * 5 + v) * 128 + 2 * lane] = acc[v].x; red[(wave * 5 + v) * 128 + 2 * lane + 1] = acc[v].y; }
            __syncthreads();
            for (int i = tid; i < 5 * 128; i += NTHREADS) { const int v = i / 128, j = i % 128; float s = ka->b_mod[l * MODSZ + j0 + j];
#pragma unroll
                for (int w = 0; w < 8; ++w) s += red[(w * 5 + v) * 128 + j];
                mod[((size_t)l * 5 + v) * MODSZ + j0 + j] = s; }
            __syncthreads();
        }
        LAS float* tab = (LAS float*)(lds + 135168);
        if (tid < 256) tab[tid] = cospif((float)tid * (1.0f / 128.0f));
        __syncthreads();
        LAS float* scr = (LAS float*)(lds + wave * 16384);
        constexpr int I_IN = 32 * 96, I_O0 = 32 * 64, I_QKV = 32 * 192, I_O1 = 32 * 64;
        for (int it = gw; it < I_IN + I_O0 + I_QKV + I_O1; it += ngw) {
            int r = it;
            if (r < I_IN) { transpose_item(ka->even_w_in, 4096, DM, WIN, (r % 96) * 32, (r / 96) * 64, (r % 96) * 32, scr, lane); continue; } r -= I_IN;
            if (r < I_O0) { transpose_item(ka->even_w_out, DM, DM, WOUT0, (r % 64) * 32, (r / 64) * 64, (r % 64) * 32, scr, lane); continue; } r -= I_O0;
            if (r < I_QKV) { transpose_item(ka->odd_w_qkv, 6144, DM, WQKV, (r % 192) * 32, (r / 192) * 64, (r % 192) * 32, scr, lane); continue; } r -= I_QKV;
            transpose_item(ka->odd_w_out, DM, DM, WOUT1, (r % 64) * 32, (r / 64) * 64, (r % 64) * 32, scr, lane);
        }
        moe_weight_items(ka->moe_w_gate, ka->moe_w_up, ka->moe_w_down, ws, 0, gw, ngw, scr, lane);
        for (int it = gw; it < 8 * 8 * 64; it += ngw) {
            const int gp = it >> 9, m0 = ((it >> 6) & 7) * 32, k0 = (it & 63) * 32, g = gp >> 1, part = gp & 1;
            const int r = lane & 31, hh = lane >> 5;
            f32x16 d = {};
            const float* wrow = ka->even_w_in + (size_t)(k0 + r) * 4096 + 3072 + g * 256 + 8 * hh;
#pragma unroll 4
            for (int j0 = 0; j0 < 256; j0 += 16) {
                const f32x4 b0 = *(const f32x4*)(wrow + j0), b1 = *(const f32x4*)(wrow + j0 + 4);
                u32x4 bw = {pk2(b0[0], b0[1]), pk2(b0[2], b0[3]), pk2(b1[0], b1[1]), pk2(b1[2], b1[3])};
                float av[8];
#pragma unroll
                for (int jj = 0; jj < 8; ++jj) { const int p = ((m0 + r) * (j0 + 8 * hh + jj) - (part ? 64 : 0)) & 255; av[jj] = tab[p]; }
                u32x4 aw = {pk2(av[0], av[1]), pk2(av[2], av[3]), pk2(av[4], av[5]), pk2(av[6], av[7])};
                d = __builtin_amdgcn_mfma_f32_32x32x16_bf16(*reinterpret_cast<bf16x8*>(&aw), *reinterpret_cast<bf16x8*>(&bw), d, 0, 0, 0);
            }
#pragma unroll
            for (int q = 0; q < 16; ++q) { const int row = (q & 3) + 8 * (q >> 2) + 4 * hh;
                WIN[(size_t)(3072 + gp * 256 + m0 + row) * DM + k0 + r] = (bf16_t)f2bf(d[q]); }
        }
        for (int it = gw; it < 4096 + 256; it += ngw) {
            if (it < 4096) { const int k = it;
                for (int cb = lane; cb < 1024; cb += 64) { const int col0 = cb * 8, part = col0 >> 12, t0 = col0 & 4095; float f[8];
#pragma unroll
                    for (int i = 0; i < 8; ++i) { const int p = (k * (t0 + i)) & 4095; const float xx = (float)p * (1.0f / 2048.0f); f[i] = part ? -sinpif(xx) : cospif(xx); }
                    u32x4 o = {pk2(f[0], f[1]), pk2(f[2], f[3]), pk2(f[4], f[5]), pk2(f[6], f[7])};
                    *(u32x4*)(CMAT + (size_t)k * 8192 + col0) = o; }
            } else { const int k = it - 4096; const int col0 = lane * 8, part = col0 >> 8, t0 = col0 & 255; float f[8];
#pragma unroll
                for (int i = 0; i < 8; ++i) { const int p = (k * (t0 + i)) & 255; const float xx = (float)p * (1.0f / 128.0f); f[i] = part ? -sinpif(xx) : cospif(xx); }
                u32x4 o = {pk2(f[0], f[1]), pk2(f[2], f[3]), pk2(f[4], f[5]), pk2(f[6], f[7])};
                *(u32x4*)(CMATC + (size_t)k * 512 + col0) = o; }
        }
    }
    SYNC(0);

    TS(1);
    if (PHON(1) && IN(1)) REPS(1) { PHASE_BEGIN
        if (gw < 200) { const int l_ = gw / 100, v_ = (gw % 100) / 20, n_ = gw % 20;
            const float* sh = mod + ((size_t)l_ * 5 + v_) * MODSZ + 3 * DM; float acc_ = 0.f;
            for (int k = lane; k < DM; k += 64) acc_ += sh[k] * (n_ < 16 ? ka->moe_w_expert[((size_t)l_ * DM + k) * 16 + n_] : ka->moe_w_group[((size_t)l_ * DM + k) * 4 + (n_ - 16)]);
            acc_ = wave_sum(acc_);
            if (lane == 0) ((float*)(ctl + 8192))[(l_ * 5 + v_) * 32 + n_] = acc_ + (n_ < 16 ? ka->moe_b_expert[l_ * 16 + n_] : ka->moe_b_group[l_ * 4 + n_ - 16]); }
        for (int row = gw; row < NTOK; row += ngw) { int b, j; row_info(row, b, j);
            const float* src = (j < CTX) ? ka->ctx + ((size_t)b * CTX + j) * DM : ka->x + ((size_t)b * SEQ + (j - CTX)) * DM;
            const float* mv = mod + (size_t)(j < CTX ? 4 : b) * MODSZ;
            f32x4 v[8]; float ss = 0.f;
#pragma unroll
            for (int jj = 0; jj < 8; ++jj) { v[jj] = *(const f32x4*)(src + 4 * lane + 256 * jj); ss += v[jj][0] * v[jj][0] + v[jj][1] * v[jj][1] + v[jj][2] * v[jj][2] + v[jj][3] * v[jj][3]; }
            const float rstd = rsqrtf(wave_sum(ss) * (1.0f / DM) + EPS);
            norm_mod_store(v, rstd, ka->norm1_w, mv + DM, mv, U + (size_t)row * DM, lane);
        }
    }
    SYNC(1);

    TS(2);
    if (PHON(2) && IN(2)) REPS(2) { PHASE_BEGIN
        SchedInProj S{(const char*)U, (const char*)WIN, (char*)PB, (char*)(ws + WS_ZTL), (char*)(ws + WS_ZTC), G, blk};
        pg8::gemm_phase<SchedInProj, pg8::EpiStore, false>(lds, S, pg8::EpiStore{});
    }
    SYNC(2);

    TS(3);
    if (PHON(3) && IN(3)) REPS(3) { PHASE_BEGIN
        for (int it = blk * NTHREADS + tid; it < (NTOK / 16) * 128; it += G * NTHREADS) {
            const int chunk = it >> 7, oct = it & 127, r0 = chunk * 16, jm = r0 % TPB, ch0 = oct * 8;
            const bool hasprev = (jm != 0 && jm != CTX), hasnext = (((jm + 16) % TPB) != 0 && (jm + 16) != CTX);
            float w0[8], w1[8], w2[8];
#pragma unroll
            for (int i = 0; i < 8; ++i) { w0[i] = ka->even_conv_w[ch0 + i]; w1[i] = ka->even_conv_w[1024 + ch0 + i]; w2[i] = ka->even_conv_w[2048 + ch0 + i]; }
            float cp[8], cc[8], cn[8];
#define LOADCV(row_, o) do { const u32x4 cg_ = *(const u32x4*)(PB + (size_t)(row_) * 3072 + 1024 + ch0), vi = *(const u32x4*)(PB + (size_t)(row_) * 3072 + 2048 + ch0); \
                o[0] = bflo(cg_.x) * bflo(vi.x); o[1] = bfhi(cg_.x) * bfhi(vi.x); o[2] = bflo(cg_.y) * bflo(vi.y); o[3] = bfhi(cg_.y) * bfhi(vi.y); \
                o[4] = bflo(cg_.z) * bflo(vi.z); o[5] = bfhi(cg_.z) * bfhi(vi.z); o[6] = bflo(cg_.w) * bflo(vi.w); o[7] = bfhi(cg_.w) * bfhi(vi.w); } while (0)
            if (hasprev) LOADCV(r0 - 1, cp); else {
#pragma unroll
                for (int i = 0; i < 8; ++i) cp[i] = 0.f; }
            LOADCV(r0, cc);
            for (int rr = 0; rr < 16; ++rr) { const int row = r0 + rr;
                if (rr < 15 || hasnext) LOADCV(row + 1, cn); else {
#pragma unroll
                    for (int i = 0; i < 8; ++i) cn[i] = 0.f; }
                const u32x4 bg = *(const u32x4*)(PB + (size_t)row * 3072 + ch0);
                float bb[8] = {bflo(bg.x), bfhi(bg.x), bflo(bg.y), bfhi(bg.y), bflo(bg.z), bfhi(bg.z), bflo(bg.w), bfhi(bg.w)}; float y[8];
#pragma unroll
                for (int i = 0; i < 8; ++i) y[i] = bb[i] * (w0[i] * cp[i] + w1[i] * cc[i] + w2[i] * cn[i]);
                u32x4 o = {pk2(y[0], y[1]), pk2(y[2], y[3]), pk2(y[4], y[5]), pk2(y[6], y[7])};
                *(u32x4*)(YCAT + (size_t)row * DM + ch0) = o;
#pragma unroll
                for (int i = 0; i < 8; ++i) { cp[i] = cc[i]; cc[i] = cn[i]; } }
        }
        SchedDFT S{(const char*)CMAT, (const char*)CMATC, (const char*)(ws + WS_ZTL), (const char*)(ws + WS_ZTC), (char*)YCAT, G, blk};
        pg8::gemm_phase<SchedDFT, pg8::EpiStore, false>(lds, S, pg8::EpiStore{});
    }
    SYNC(3);

    TS(4);
    if (PHON(4) && IN(4)) REPS(4) { PHASE_BEGIN
        SchedOut0 S{(const char*)YCAT, (const char*)WOUT0, ka->x, ka->ctx, mod, (char*)H, G, blk};
        pg8::gemm_phase<SchedOut0, pg8::EpiResid, false>(lds, S, pg8::EpiResid{});
    }
    SYNC(4);

    moe_layer<0>(grid, lds, lo, hi, G, blk);
    { constexpr int l = 0; (void)l;
            TS(8);
    if (PHON(8) && IN(8)) { PHASE_BEGIN
                const float* mod1 = mod + (size_t)5 * MODSZ;
                for (int row = gw; row < NTOK; row += ngw) { int b, j; row_info(row, b, j); const int vr = (j < CTX) ? 4 : b;
                    const float* g2 = modl + (size_t)vr * MODSZ + 5 * DM; const float* mv1 = mod1 + (size_t)vr * MODSZ;
                    float* hrow = H + (size_t)row * DM; const bf16_t* y0 = YB + (size_t)(row * 2) * DM; const bf16_t* y1 = y0 + DM;
                    f32x4 v[8]; float ss = 0.f;
#pragma unroll
                    for (int jj = 0; jj < 8; ++jj) { const int k = 4 * lane + 256 * jj; const f32x4 hv = *(const f32x4*)(hrow + k), g = *(const f32x4*)(g2 + k);
                        const u32x2 a0 = *(const u32x2*)(y0 + k), a1 = *(const u32x2*)(y1 + k);
                        f32x4 ys = {bflo(a0.x) + bflo(a1.x), bfhi(a0.x) + bfhi(a1.x), bflo(a0.y) + bflo(a1.y), bfhi(a0.y) + bfhi(a1.y)};
                        v[jj] = hv + g * ys; *(f32x4*)(hrow + k) = v[jj];
                        ss += v[jj][0] * v[jj][0] + v[jj][1] * v[jj][1] + v[jj][2] * v[jj][2] + v[jj][3] * v[jj][3]; }
                    const float rstd = rsqrtf(wave_sum(ss) * (1.0f / DM) + EPS);
                    norm_mod_store(v, rstd, ka->norm1_w + DM, mv1 + DM, mv1, U + (size_t)row * DM, lane);
                }
                moe_weight_items(ka->moe_w_gate, ka->moe_w_up, ka->moe_w_down, ws, 1, gw, ngw, (LAS float*)(lds + wave * 16384), lane);
            }
            SYNC(8);
            TS(9);
    if (PHON(9) && IN(9)) REPS(9) { PHASE_BEGIN
                SchedQKV S{(const char*)U, (const char*)WQKV, (char*)QB, G, blk};
                pg8::gemm_phase<SchedQKV, pg8::EpiStore, false>(lds, S, pg8::EpiStore{});
            }
            SYNC(9);
            TS(10);
    if (PHON(10) && IN(10)) { PHASE_BEGIN
                LAS float* rt = (LAS float*)lds;
                for (int i = tid; i < 64 * 32; i += NTHREADS) { const int pos = i >> 5, f = i & 31; const float inv = exp2f(-(float)f * 0.4152410118609203f); const float ang = (float)pos * inv;
                    float tr = ang * 0.15915494309189535f; tr -= floorf(tr); rt[2 * i] = __builtin_amdgcn_cosf(tr); rt[2 * i + 1] = __builtin_amdgcn_sinf(tr); }
                __syncthreads();
                const int hc = lane >> 2, q8 = (lane & 3) * 8;
                for (int it = gw; it < NLAT + NTOK; it += ngw) {
                    const bool isq = it < NLAT; int row;
                    if (isq) row = (it / SEQ) * TPB + CTX + (it % SEQ); else row = it - NLAT;
                    int b, j; row_info(row, b, j); const bool rope = (j >= CTX); const int t = j - CTX, prow = t >> 6, pcol = t & 63;
                    bf16_t* p = (isq ? QB : KB) + (size_t)row * DM + hc * 128; const float* nwp = isq ? ka->odd_q_norm : ka->odd_k_norm;
                    u32x4 raw[4]; float xv[4][8];
                    float ss = 0.f;
#pragma unroll
                    for (int s = 0; s < 4; ++s) { raw[s] = *(const u32x4*)(p + s * 32 + q8);
                        xv[s][0] = bflo(raw[s].x); xv[s][1] = bfhi(raw[s].x); xv[s][2] = bflo(raw[s].y); xv[s][3] = bfhi(raw[s].y); xv[s][4] = bflo(raw[s].z); xv[s][5] = bfhi(raw[s].z); xv[s][6] = bflo(raw[s].w); xv[s][7] = bfhi(raw[s].w);
#pragma unroll
                        for (int i = 0; i < 8; ++i) ss += xv[s][i] * xv[s][i]; }
                    ss += __shfl_xor(ss, 1); ss += __shfl_xor(ss, 2);
                    const float rstd = rsqrtf(ss * (1.0f / 128.0f) + EPS);
#pragma unroll
                    for (int s = 0; s < 4; ++s)
#pragma unroll
                        for (int i = 0; i < 8; ++i) xv[s][i] = xv[s][i] * rstd * nwp[s * 32 + q8 + i];
                    if (rope) {
#pragma unroll
                        for (int ax = 0; ax < 2; ++ax) { const int pos = ax ? pcol : prow;
#pragma unroll
                            for (int i = 0; i < 8; ++i) { const float cs = rt[2 * (pos * 32 + q8 + i)], sn = rt[2 * (pos * 32 + q8 + i) + 1];
                                const float x1 = xv[2 * ax][i], x2 = xv[2 * ax + 1][i]; xv[2 * ax][i] = x1 * cs - x2 * sn; xv[2 * ax + 1][i] = x2 * cs + x1 * sn; } }
                    }
#pragma unroll
                    for (int s = 0; s < 4; ++s) { u32x4 o = {pk2(xv[s][0], xv[s][1]), pk2(xv[s][2], xv[s][3]), pk2(xv[s][4], xv[s][5]), pk2(xv[s][6], xv[s][7])}; *(u32x4*)(p + s * 32 + q8) = o; }
                }
                __syncthreads();
            }
            SYNC(10);
            TS(11);
    if (PHON(11) && IN(11)) REPS(11) { PHASE_BEGIN
                const int vcu = (blk % 8) * (G / 8) + blk / 8;
                float mq = fmaxf(fabsf(ka->odd_q_norm[lane]), fabsf(ka->odd_q_norm[lane + 64])), mk = fmaxf(fabsf(ka->odd_k_norm[lane]), fabsf(ka->odd_k_norm[lane + 64]));
#pragma unroll
                for (int o_ = 1; o_ < 64; o_ <<= 1) { mq = fmaxf(mq, __shfl_xor(mq, o_)); mk = fmaxf(mk, __shfl_xor(mk, o_)); }
                const float mnC = -(128.0f * att::SCALE * mq * mk) * 1.4426950408889634f;
                for (int U0 = vcu; U0 < 2048; U0 += G) {
                    const int combo = U0 >> 4, qb = U0 & 15, vh = combo & 1, cp_ = (combo >> 1) & 1, hh = (combo >> 2) & 7, b = combo >> 5;
                    const bf16_t* Qp = QB + (size_t)(b * TPB + CTX + qb * 256) * DM + hh * 256 + cp_ * 128;
                    const bf16_t* Kp = KB + (size_t)(b * TPB) * DM + hh * 256 + cp_ * 128;
                    const bf16_t* Vp = VB + (size_t)(b * TPB) * DM + hh * 256 + vh * 128;
                    bf16_t* Op = OB + (size_t)(b * SEQ + qb * 256) * (2 * DM) + cp_ * DM + hh * 256 + vh * 128;
                    att::attn_dense_body(Qp, Kp, Vp, Op, TPB, (char*)lds_raw, mnC);
                    __syncthreads();
                }
            }
            SYNC(11);
            TS(12);
    if (PHON(12) && IN(12)) REPS(12) { PHASE_BEGIN
                float d1 = ka->lq1[lane] * ka->lk1[lane] + ka->lq1[lane + 64] * ka->lk1[lane + 64], d2 = ka->lq2[lane] * ka->lk2[lane] + ka->lq2[lane + 64] * ka->lk2[lane + 64];
                d1 = wave_sum(d1); d2 = wave_sum(d2);
                const float lam_init = 0.8f - 0.6f * expf(-0.3f * 1.0f);
                const float lam = expf(d1) - expf(d2) + lam_init;
                const int hh = lane >> 3, e0 = (lane & 7) * 32;
                for (int li = gw; li < NLAT; li += ngw) {
                    const bf16_t* o1 = OB + (size_t)li * (2 * DM) + hh * 256 + e0; const bf16_t* o2 = o1 + DM;
                    float ov[32]; float ss = 0.f;
#pragma unroll
                    for (int s = 0; s < 4; ++s) { const u32x4 p1 = *(const u32x4*)(o1 + 8 * s), p2 = *(const u32x4*)(o2 + 8 * s);
                        ov[8 * s + 0] = bflo(p1.x) - lam * bflo(p2.x); ov[8 * s + 1] = bfhi(p1.x) - lam * bfhi(p2.x); ov[8 * s + 2] = bflo(p1.y) - lam * bflo(p2.y); ov[8 * s + 3] = bfhi(p1.y) - lam * bfhi(p2.y);
                        ov[8 * s + 4] = bflo(p1.z) - lam * bflo(p2.z); ov[8 * s + 5] = bfhi(p1.z) - lam * bfhi(p2.z); ov[8 * s + 6] = bflo(p1.w) - lam * bflo(p2.w); ov[8 * s + 7] = bfhi(p1.w) - lam * bfhi(p2.w); }
#pragma unroll
                    for (int i = 0; i < 32; ++i) ss += ov[i] * ov[i];
                    ss += __shfl_xor(ss, 1); ss += __shfl_xor(ss, 2); ss += __shfl_xor(ss, 4);
                    const float rs = rsqrtf(ss * (1.0f / 256.0f) + EPS) * (1.0f - lam_init);
                    const int row = (li / SEQ) * TPB + CTX + (li % SEQ);
                    bf16_t* ap = AB + (size_t)row * DM + hh * 256 + e0;
#pragma unroll
                    for (int s = 0; s < 4; ++s) { float y[8];
#pragma unroll
                        for (int i = 0; i < 8; ++i) y[i] = ov[8 * s + i] * rs * ka->subln_w[e0 + 8 * s + i];
                        u32x4 o = {pk2(y[0], y[1]), pk2(y[2], y[3]), pk2(y[4], y[5]), pk2(y[6], y[7])}; *(u32x4*)(ap + 8 * s) = o; }
                }
            }
            SYNC(12);
            TS(13);
    if (PHON(13) && IN(13)) { PHASE_BEGIN
                SchedOut1 S{(const char*)AB, (const char*)WOUT1, mod + (size_t)5 * MODSZ, (char*)H, G, blk};
                pg8::gemm_phase<SchedOut1, pg8::EpiResid, false>(lds, S, pg8::EpiResid{});
            }
            SYNC(13);
    }
    moe_layer<1>(grid, lds, lo, hi, G, blk);
    { constexpr int l = 1; (void)l;
            TS(17);
    if (PHON(17) && IN(17)) REPS(17) { PHASE_BEGIN
                for (int li = gw; li < NLAT; li += ngw) { const int b = li / SEQ, row = b * TPB + CTX + (li % SEQ);
                    const float* g2 = modl + (size_t)b * MODSZ + 5 * DM; const float* hrow = H + (size_t)row * DM; const bf16_t* y0 = YB + (size_t)(row * 2) * DM; const bf16_t* y1 = y0 + DM;
                    float* orow = ka->out + (size_t)li * DM;
#pragma unroll
                    for (int jj = 0; jj < 8; ++jj) { const int k = 4 * lane + 256 * jj; const f32x4 hv = *(const f32x4*)(hrow + k), g = *(const f32x4*)(g2 + k);
                        const u32x2 a0 = *(const u32x2*)(y0 + k), a1 = *(const u32x2*)(y1 + k);
                        f32x4 ys = {bflo(a0.x) + bflo(a1.x), bfhi(a0.x) + bfhi(a1.x), bflo(a0.y) + bflo(a1.y), bfhi(a0.y) + bfhi(a1.y)};
                        f32x4 res = hv + g * ys;
#if PROBE
                        { const unsigned long long* tp_ = (const unsigned long long*)(ws + WS_CTL + 1024); const float c2 = (float)(tp_[3] - tp_[2]) * 1e-4f, w1 = (float)(tp_[1] - tp_[0]) * 1e-2f;
                          res = (f32x4){c2, c2, c2, c2}; if (li == 0 && k == 0) res[0] = w1; }
#endif
                        *(f32x4*)(orow + k) = res; }
                }
            }
    }
    TS(18);
#undef IN
#undef SYNC
#undef cnt
#undef modl
#undef ctl
#undef mod
#undef tokw
#undef list
#undef WIN
#undef WOUT0
#undef WQKV
#undef WOUT1
#undef CMAT
#undef CMATC
#undef H
#undef U
#undef PB
#undef YCAT
#undef QB
#undef KB
#undef VB
#undef AB
#undef YB
#undef OB
}

#ifndef N_LAUNCH_MODE
#define N_LAUNCH_MODE 1
#endif
extern "C" void kernel_launch(void* const* d_in, const int* in_sizes, int n_in, void* d_out, int out_size, void* d_ws, size_t ws_size, hipStream_t stream) {
    static int grid = 0;
    if (grid == 0) {
        if (n_in != 27 || out_size != NLAT * DM || ws_size < WS_END) { fprintf(stderr, "kernel_launch: unexpected shapes: n_in %d out %d ws %zu (need %zu)\n", n_in, out_size, ws_size, (size_t)WS_END); grid = -1; return; }
        int dev = 0, cus = 0, per_cu = 0;
        hipGetDevice(&dev); hipDeviceGetAttribute(&cus, hipDeviceAttributeMultiprocessorCount, dev);
        if (hipFuncSetAttribute((const void*)fwd_kernel, hipFuncAttributeMaxDynamicSharedMemorySize, LDS_BYTES) != hipSuccess) { fprintf(stderr, "kernel_launch: hipFuncSetAttribute failed\n"); grid = -1; return; }
        if (hipOccupancyMaxActiveBlocksPerMultiprocessor(&per_cu, (const void*)fwd_kernel, NTHREADS, LDS_BYTES) != hipSuccess || per_cu < 1) { fprintf(stderr, "kernel_launch: occupancy query says %d\n", per_cu); per_cu = 1; }
        (void)hipGetLastError();
        grid = cus;
        if (grid != 256) fprintf(stderr, "kernel_launch: note: %d CUs\n", grid);
    }
    if (grid < 0) return;
    Args a{};
    const float** ap = (const float**)&a;
    for (int i = 0; i < 27; ++i) ap[i] = (const float*)d_in[i];
    a.out = (float*)d_out; a.ws = (unsigned char*)d_ws;
#if N_LAUNCH_MODE == 1
    a.ph_lo = 0; a.ph_hi = 18;
    void* args[] = {&a};
    hipError_t e = hipLaunchCooperativeKernel((const void*)fwd_kernel, dim3(grid), dim3(NTHREADS), args, LDS_BYTES, stream);
    if (e != hipSuccess) fprintf(stderr, "cooperative launch failed: %s (grid %d)\n", hipGetErrorString(e), grid);
#else
    for (int p = 0; p < 18; ++p) { a.ph_lo = p; a.ph_hi = p + 1; void* args[] = {&a};
        hipError_t e = hipLaunchCooperativeKernel((const void*)fwd_kernel, dim3(grid), dim3(NTHREADS), args, LDS_BYTES, stream);
        if (e != hipSuccess) { fprintf(stderr, "launch %d failed: %s\n", p, hipGetErrorString(e)); break; } }
#endif
}
```

```cpp
#include <hip/hip_runtime.h>
#include <hip/hip_cooperative_groups.h>
#include <cstdio>
#include <cstdint>
namespace cg = cooperative_groups;
#ifndef PROBE
#define PROBE 0
#endif
#ifndef REPMASK
#define REPMASK 0x0
#endif
#define REPS(k) for (int rep_ = 0; rep_ <= ((REPMASK >> (k)) & 1); ++rep_)
#ifndef PA0
#define PA0 0
#define PA1 18
#define PB0 0
#define PB1 18
#endif

#define LAS __attribute__((address_space(3)))
typedef unsigned short bf16_t;
typedef short bf16x8 __attribute__((ext_vector_type(8)));
typedef short s16x4 __attribute__((ext_vector_type(4)));
typedef float f32x2 __attribute__((ext_vector_type(2)));
typedef float f32x4 __attribute__((ext_vector_type(4)));
typedef float f32x8 __attribute__((ext_vector_type(8)));
typedef float f32x16 __attribute__((ext_vector_type(16)));
typedef unsigned u32x2 __attribute__((ext_vector_type(2)));
typedef unsigned u32x4 __attribute__((ext_vector_type(4)));

constexpr int DM = 2048, NB = 4, SEQ = 4096, CTX = 256, TPB = SEQ + CTX  ;
constexpr int NTOK = NB * TPB  , NLAT = NB * SEQ  ;
constexpr int NEXP = 16, EFF = 512, LCAP = 2 * NTOK  ;
constexpr float EPS = 1e-6f;
constexpr int NWAVES = 8, NTHREADS = 512;
constexpr int LDS_BYTES = 155648;
constexpr int RING_BYTES = 131072;

constexpr size_t MiB = 1u << 20;
constexpr size_t WS_CTL = 0, WS_MOD = 1 * MiB, WS_TOKW = 2 * MiB, WS_LIST = 3 * MiB;
constexpr size_t WS_WIN = 6 * MiB, WS_WOUT0 = 26 * MiB, WS_WQKV = 34 * MiB, WS_WOUT1 = 58 * MiB, WS_WGU = 66 * MiB, WS_WD = 130 * MiB;
constexpr size_t WS_CMAT = 162 * MiB, WS_CMATC = 226 * MiB, WS_HID = 162 * MiB  ;
constexpr size_t WS_H = 227 * MiB, WS_U = 363 * MiB;
constexpr size_t WS_P = 431 * MiB, WS_ZTL = 533 * MiB, WS_ZTC = 597 * MiB, WS_YCAT = 601 * MiB;
constexpr size_t WS_Q = 431 * MiB, WS_K = 499 * MiB, WS_V = 567 * MiB, WS_A = 431 * MiB;
static_assert(WS_V - WS_K == WS_K - WS_Q, "QKV spacing");
constexpr size_t WS_Y = 669 * MiB, WS_O = 669 * MiB, WS_MB = 805 * MiB, WS_END = 809 * MiB;
constexpr size_t WS_UF = 162 * MiB  , WS_MA = 226 * MiB + 512 * 1024;
constexpr int MODSZ = 6 * DM;

typedef const __attribute__((address_space(1))) float* gcf;
typedef __attribute__((address_space(1))) bf16_t* gbf;
__device__ __forceinline__ unsigned f2bf(float f) { unsigned u = __builtin_bit_cast(unsigned, f); return (u + 0x7fffu + ((u >> 16) & 1u)) >> 16; }
__device__ __forceinline__ unsigned pk2(float lo, float hi) { return f2bf(lo) | (f2bf(hi) << 16); }
__device__ __forceinline__ float bflo(unsigned w) { return __uint_as_float(w << 16); }
__device__ __forceinline__ float bfhi(unsigned w) { return __uint_as_float(w & 0xffff0000u); }
__device__ __forceinline__ unsigned cvt_pk_bf16(float lo, float hi) { unsigned r; asm volatile("v_cvt_pk_bf16_f32 %0, %1, %2" : "=v"(r) : "v"(lo), "v"(hi)); return r; }
__device__ __forceinline__ float wave_sum(float v) {
#pragma unroll
    for (int o = 1; o < 64; o <<= 1) v += __shfl_xor(v, o);
    return v;
}
__device__ __forceinline__ float silu_f(float x) { return x * __builtin_amdgcn_rcpf(1.0f + __expf(-x)); }

namespace pg8 {
constexpr int BM = 256, BK = 64, HALF = 128, HTB = HALF * BK * 2, STAGE_BYTES = 8 * HTB, NXCD = 8, WGM = 8;
__host__ __device__ __forceinline__ int lds_byte(int r, int c) { const int st = (r >> 4) * 2 + (c >> 5), rr = r & 15, cc = c & 31, ob = rr * 64 + cc * 2; return st * 1024 + (ob ^ (((ob >> 9) & 1) << 5)); }
__host__ __device__ __forceinline__ void stage_rc(int b, int& R, int& C) { const int st = b / 1024, sb = b % 1024, swz = sb ^ (((sb >> 9) & 1) << 5); R = (st >> 1) * 16 + swz / 64; C = (st & 1) * 32 + (swz % 64) / 2; }
__host__ __device__ __forceinline__ int perm32(int rho) { const int n = rho >> 4, i = rho & 15; return 8 * (i >> 2) + 4 * n + (i & 3); }

struct GUnit {
    const char* A; const char* B; unsigned lda, ldb; int nt;
    char* O; int ldc; float scale;
    int rs1, rs2, cs, nrow, bperm;
    const char* src; const float* gate;
    const int* glist; int gcount;
    int aux;
};
__device__ __forceinline__ void tile_of(int L, int nM, int nN, int& pm, int& pn) {
    const int nwg = nM * nN; int wgid = L;
    { const int q = nwg / NXCD, r = nwg % NXCD, xcd = wgid % NXCD, off = wgid / NXCD; wgid = (xcd < r ? xcd * (q + 1) : r * (q + 1) + (xcd - r) * q) + off; }
    const int nig = WGM * nN, gid = wgid / nig, fm = gid * WGM, gsz = (nM - fm) < WGM ? (nM - fm) : WGM;
    pm = fm + ((wgid % nig) % gsz); pn = (wgid % nig) / gsz;
}
__device__ __forceinline__ int xcd_remap(int L, int nwg) {
    const int q = nwg / NXCD, r = nwg % NXCD, xcd = L % NXCD, off = L / NXCD; return (xcd < r ? xcd * (q + 1) : r * (q + 1) + (xcd - r) * q) + off;
}

struct EpiStore {
    __device__ __forceinline__ void operator()(const f32x4 (&acc)[2][2][4][2], const GUnit& u, int wr, int wc, int fr, int fq) const {
        const float sc = u.scale;
#pragma unroll
        for (int ai = 0; ai < 2; ++ai) { if (ai * HALF >= u.nrow) break;
#pragma unroll
            for (int m = 0; m < 4; ++m) { bf16_t* rowp = (bf16_t*)u.O + (size_t)(2 * ai + wr) * u.rs1 + (size_t)(m * 16 + fr) * u.rs2 + (wc >> 1) * u.cs + (wc & 1) * 32 + 8 * fq;
#pragma unroll
                for (int bj = 0; bj < 2; ++bj) { const f32x4 v0 = acc[ai][bj][m][0] * sc, v1 = acc[ai][bj][m][1] * sc;
                    u32x4 w; w.x = cvt_pk_bf16(v0[0], v0[1]); w.y = cvt_pk_bf16(v0[2], v0[3]); w.z = cvt_pk_bf16(v1[0], v1[1]); w.w = cvt_pk_bf16(v1[2], v1[3]);
                    *(u32x4*)(rowp + (size_t)bj * 2 * u.cs) = w; } } }
    }
};
struct EpiSwiGLU {
    __device__ __forceinline__ void operator()(const f32x4 (&acc)[2][2][4][2], const GUnit& u, int wr, int wc, int fr, int fq) const {
#pragma unroll
        for (int ai = 0; ai < 2; ++ai)
#pragma unroll
            for (int m = 0; m < 4; ++m) { bf16_t* rowp = (bf16_t*)u.O + (size_t)(ai * HALF + wr * 64 + m * 16 + fr) * u.ldc + wc * 32 + 8 * fq;
                float h[8];
#pragma unroll
                for (int n = 0; n < 2; ++n)
#pragma unroll
                    for (int i = 0; i < 4; ++i) h[4 * n + i] = silu_f(acc[ai][0][m][n][i]) * acc[ai][1][m][n][i];
                u32x4 w; w.x = cvt_pk_bf16(h[0], h[1]); w.y = cvt_pk_bf16(h[2], h[3]); w.z = cvt_pk_bf16(h[4], h[5]); w.w = cvt_pk_bf16(h[6], h[7]);
                *(u32x4*)rowp = w; }
    }
};
struct EpiScatter {
    bf16_t* Y; const float* tokw;
    __device__ __forceinline__ void operator()(const f32x4 (&acc)[2][2][4][2], const GUnit& u, int wr, int wc, int fr, int fq) const {
#pragma unroll
        for (int ai = 0; ai < 2; ++ai)
#pragma unroll
            for (int m = 0; m < 4; ++m) { const int r = ai * HALF + wr * 64 + m * 16 + fr;
                if (r < u.gcount) { const int a = u.glist[r]; const float sc = tokw[a];
                    bf16_t* rowp = Y + (size_t)a * DM + u.aux * 256 + wc * 32 + 8 * fq;
#pragma unroll
                    for (int bj = 0; bj < 2; ++bj) { const f32x4 v0 = acc[ai][bj][m][0] * sc, v1 = acc[ai][bj][m][1] * sc;
                        u32x4 w; w.x = cvt_pk_bf16(v0[0], v0[1]); w.y = cvt_pk_bf16(v0[2], v0[3]); w.z = cvt_pk_bf16(v1[0], v1[1]); w.w = cvt_pk_bf16(v1[2], v1[3]);
                        *(u32x4*)(rowp + bj * HALF) = w; } } }
    }
};
struct EpiResid {
    __device__ __forceinline__ void operator()(const f32x4 (&acc)[2][2][4][2], const GUnit& u, int wr, int wc, int fr, int fq) const {
        f32x4 g[2][2];
#pragma unroll
        for (int bj = 0; bj < 2; ++bj)
#pragma unroll
            for (int n = 0; n < 2; ++n) g[bj][n] = *(const f32x4*)(u.gate + bj * HALF + wc * 32 + 8 * fq + 4 * n);
#pragma unroll
        for (int ai = 0; ai < 2; ++ai)
#pragma unroll
            for (int m = 0; m < 4; ++m) { const size_t off = (size_t)(ai * HALF + wr * 64 + m * 16 + fr) * DM + wc * 32 + 8 * fq;
#pragma unroll
                for (int bj = 0; bj < 2; ++bj)
#pragma unroll
                    for (int n = 0; n < 2; ++n) { const f32x4 s = *(const f32x4*)((const float*)u.src + off + bj * HALF + 4 * n);
                        *(f32x4*)((float*)u.O + off + bj * HALF + 4 * n) = s + g[bj][n] * acc[ai][bj][m][n]; } }
    }
};

template <bool GATHER>
__device__ __forceinline__ void mkvoff(const GUnit& u, unsigned (&vA)[2][2], unsigned (&vB)[2][2]) {
    int tid = threadIdx.x; asm volatile("" : "+v"(tid));
    int R0, C0, R1, C1; stage_rc(tid * 16, R0, C0); stage_rc(tid * 16 + 8192, R1, C1);
    const int Rb0 = (R0 & ~31) + perm32(R0 & 31), Rb1 = (R1 & ~31) + perm32(R1 & 31);
#pragma unroll
    for (int h = 0; h < 2; ++h) {
        if constexpr (GATHER) {
            const int r0 = h * HALF + R0, r1 = h * HALF + R1;
            const int t0 = (r0 < u.gcount) ? (u.glist[r0] >> 1) : 0, t1 = (r1 < u.gcount) ? (u.glist[r1] >> 1) : 0;
            vA[h][0] = (unsigned)t0 * u.lda + (unsigned)C0 * 2u; vA[h][1] = (unsigned)t1 * u.lda + (unsigned)C1 * 2u;
        } else {
            vA[h][0] = (unsigned)(h * HALF + R0) * u.lda + (unsigned)C0 * 2u; vA[h][1] = (unsigned)(h * HALF + R1) * u.lda + (unsigned)C1 * 2u;
        }
        int n0 = h * HALF + Rb0, n1 = h * HALF + Rb1; if (u.bperm) { n0 = 64 * (n0 & 63) + (n0 >> 6); n1 = 64 * (n1 & 63) + (n1 >> 6); }
        vB[h][0] = (unsigned)n0 * u.ldb + (unsigned)C0 * 2u; vB[h][1] = (unsigned)n1 * u.ldb + (unsigned)C1 * 2u;
    }
}

template <class Sched, class Epi, bool GATHER>
__device__ __forceinline__ void gemm_phase(LAS unsigned char* lds, const Sched& S, const Epi& E) {
    int tid = threadIdx.x; asm volatile("" : "+v"(tid));
    const int wid = __builtin_amdgcn_readfirstlane(tid >> 6), lane = tid & 63, wr = wid >> 2, wc = wid & 3, fr = lane & 15, fq = lane >> 4;
    const size_t kstep = (size_t)(BK * 2);
    const unsigned ldsw = (unsigned)wid * 1024u;
    const int aoff = lds_byte(wr * 64 + fr, fq * 8), boff = lds_byte(wc * 32 + fr, fq * 8);
#define PG8_SA(b, h) (((b) * 2 + (h)) * HTB)
#define PG8_SB(b, h) ((4 + (b) * 2 + (h)) * HTB)
#define PG8_STAGE(bufoff, gbase, voff) do { _Pragma("unroll") for (int _i = 0; _i < 2; ++_i) \
        __builtin_amdgcn_global_load_lds((const unsigned*)((const char*)(gbase) + (voff)[_i]), (LAS unsigned*)(lds + (bufoff) + ldsw + _i * 8192), 16, 0, 0); } while (0)
#define PG8_LDA(dst, b, h) do { _Pragma("unroll") for (int m = 0; m < 4; ++m) _Pragma("unroll") for (int k = 0; k < 2; ++k) dst[m][k] = *(const LAS bf16x8*)(lds + PG8_SA(b, h) + aoff + m * 2048 + k * 1024); } while (0)
#define PG8_LDB(dst, b, h) do { _Pragma("unroll") for (int n = 0; n < 2; ++n) _Pragma("unroll") for (int k = 0; k < 2; ++k) dst[n][k] = *(const LAS bf16x8*)(lds + PG8_SB(b, h) + boff + n * 2048 + k * 1024); } while (0)
#define PG8_MMA(ai, bj, At, Bt) do { __builtin_amdgcn_s_setprio(1); _Pragma("unroll") for (int m = 0; m < 4; ++m) _Pragma("unroll") for (int n = 0; n < 2; ++n) _Pragma("unroll") for (int k = 0; k < 2; ++k) \
        acc[ai][bj][m][n] = __builtin_amdgcn_mfma_f32_16x16x32_bf16(Bt[n][k], At[m][k], acc[ai][bj][m][n], 0, 0, 0); __builtin_amdgcn_s_setprio(0); } while (0)
#define PG8_WAIT_V(n) asm volatile("s_waitcnt vmcnt(" #n ")" ::: "memory")
#define PG8_WAIT_L(n) asm volatile("s_waitcnt lgkmcnt(" #n ")" ::: "memory")
#define PG8_BAR __builtin_amdgcn_s_barrier()
#define PG8_SCHED __builtin_amdgcn_sched_barrier(0)
    GUnit cur, nxt; int ui = 0;
    if (!S.next(0, cur)) return;
    unsigned vA[2][2], vB[2][2];
    mkvoff<GATHER>(cur, vA, vB);
    f32x4 acc[2][2][4][2];
#pragma unroll
    for (int a = 0; a < 2; ++a)
#pragma unroll
        for (int b = 0; b < 2; ++b)
#pragma unroll
            for (int m = 0; m < 4; ++m)
#pragma unroll
                for (int n = 0; n < 2; ++n) acc[a][b][m][n] = (f32x4){0.f, 0.f, 0.f, 0.f};
    bf16x8 At[4][2], B0[2][2], B1[2][2];
    const char* cA = cur.A; const char* cB = cur.B;
    PG8_STAGE(PG8_SB(0, 0), cB, vB[0]); PG8_STAGE(PG8_SB(0, 1), cB, vB[1]); PG8_STAGE(PG8_SA(0, 0), cA, vA[0]); PG8_STAGE(PG8_SA(0, 1), cA, vA[1]);
    if (wr == 1) PG8_BAR;
    PG8_WAIT_V(2); PG8_BAR;
    PG8_STAGE(PG8_SB(1, 0), cB + kstep, vB[0]); PG8_STAGE(PG8_SA(1, 0), cA + kstep, vA[0]); PG8_STAGE(PG8_SB(1, 1), cB + kstep, vB[1]);
    PG8_WAIT_V(6); PG8_BAR;
    for (;;) {
        const bool has_next = S.next(ui + 1, nxt);
        const char* nA = has_next ? nxt.A : cA; const char* nB = has_next ? nxt.B : cB;
        const int nt = cur.nt;
        for (int t = 0; t < nt; t += 2) {
            const bool last = (t == nt - 2);
            const char* a1 = cA + (size_t)(t + 1) * kstep;
            const char* a2 = last ? nA : cA + (size_t)(t + 2) * kstep; const char* b2 = last ? nB : cB + (size_t)(t + 2) * kstep;
            const char* a3 = a2 + kstep; const char* b3 = b2 + kstep;
            PG8_LDB(B0, 0, 0); PG8_LDB(B1, 0, 1); PG8_SCHED; PG8_LDA(At, 0, 0); PG8_STAGE(PG8_SA(1, 1), a1, vA[1]);
            if (last && has_next) mkvoff<GATHER>(nxt, vA, vB);
            PG8_WAIT_V(8); PG8_WAIT_L(0); PG8_BAR; PG8_MMA(0, 0, At, B0); PG8_MMA(0, 1, At, B1); PG8_BAR; PG8_SCHED;
            PG8_LDA(At, 0, 1); PG8_STAGE(PG8_SB(0, 0), b2, vB[0]); PG8_STAGE(PG8_SB(0, 1), b2, vB[1]); PG8_STAGE(PG8_SA(0, 0), a2, vA[0]);
            PG8_WAIT_V(8); PG8_WAIT_L(0); PG8_BAR; PG8_MMA(1, 0, At, B0); PG8_MMA(1, 1, At, B1); PG8_BAR; PG8_SCHED;
            PG8_LDB(B0, 1, 0); PG8_LDB(B1, 1, 1); PG8_SCHED; PG8_LDA(At, 1, 0); PG8_STAGE(PG8_SA(0, 1), a2, vA[1]);
            PG8_WAIT_V(8); PG8_WAIT_L(0); PG8_BAR; PG8_MMA(0, 0, At, B0); PG8_MMA(0, 1, At, B1); PG8_BAR; PG8_SCHED;
            PG8_LDA(At, 1, 1); PG8_STAGE(PG8_SB(1, 0), b3, vB[0]); PG8_STAGE(PG8_SB(1, 1), b3, vB[1]); PG8_STAGE(PG8_SA(1, 0), a3, vA[0]);
            PG8_WAIT_V(8); PG8_WAIT_L(0); PG8_BAR; PG8_MMA(1, 0, At, B0); PG8_MMA(1, 1, At, B1); PG8_BAR; PG8_SCHED;
        }
        if (wr == 0) PG8_BAR;
        E(acc, cur, wr, wc, fr, fq);
        if (!has_next) break;
#pragma unroll
        for (int a = 0; a < 2; ++a)
#pragma unroll
            for (int b = 0; b < 2; ++b)
#pragma unroll
                for (int m = 0; m < 4; ++m)
#pragma unroll
                    for (int n = 0; n < 2; ++n) acc[a][b][m][n] = (f32x4){0.f, 0.f, 0.f, 0.f};
        cur = nxt; cA = nA; cB = nB; ++ui;
        if (wr == 1) PG8_BAR;
    }
    PG8_WAIT_V(0);
    PG8_BAR;
#undef PG8_SA
#undef PG8_SB
#undef PG8_STAGE
#undef PG8_LDA
#undef PG8_LDB
#undef PG8_MMA
#undef PG8_WAIT_V
#undef PG8_WAIT_L
#undef PG8_BAR
#undef PG8_SCHED
}
}
using pg8::GUnit;

namespace att {
constexpr int D = 128, NW = 8, QBLK = 32, KVBLK = 64;
constexpr float SCALE = 0.088388347648318440f;
constexpr float THR = 8.f;
constexpr int LDQ = DM, LDK = DM, LDO = 2 * DM;
constexpr size_t SHM_V = KVBLK * D * 2, SHM_K = KVBLK * D * 2, SHM_ATTN = 2 * SHM_V + 2 * SHM_K + NW * 64 * 4;
#define KSWZ(row, colB) ((row) * 256 + ((colB) ^ (((row) & 7) << 4)))
#define SBAR() __builtin_amdgcn_sched_barrier(0)
__device__ __forceinline__ int crow(int r, int hi) { return (r & 3) + 8 * (r >> 2) + 4 * hi; }
__device__ __forceinline__ unsigned cvtpk(float lo, float hi) { unsigned r; asm volatile("v_cvt_pk_bf16_f32 %0, %1, %2" : "=v"(r) : "v"(lo), "v"(hi)); return r; }
__device__ __forceinline__ void partialSM(f32x16& p0, f32x16& p1, float mnC) {
  constexpr float C = SCALE * 1.4426950408889634f;
  for (int r = 0; r < 16; ++r) p0[r] = fmaf(p0[r], C, mnC); for (int r = 0; r < 16; ++r) p1[r] = fmaf(p1[r], C, mnC);
  for (int r = 0; r < 16; ++r) p0[r] = __builtin_amdgcn_exp2f(p0[r]);
}
__device__ __forceinline__ void finishSM(f32x16& p0, f32x16& p1, float& l_reg, bf16x8& pa0, bf16x8& pa1, bf16x8& pa2, bf16x8& pa3) {
  for (int r = 0; r < 16; ++r) p1[r] = __builtin_amdgcn_exp2f(p1[r]);
  float ps = 0; for (int r = 0; r < 16; ++r) ps += p0[r]; for (int r = 0; r < 16; ++r) ps += p1[r];
  l_reg += ps;
#define PK4(P, BASE, OUT) do { unsigned a0 = cvtpk(P[BASE + 0], P[BASE + 1]), a1 = cvtpk(P[BASE + 2], P[BASE + 3]);   \
    unsigned b0 = cvtpk(P[BASE + 4], P[BASE + 5]), b1 = cvtpk(P[BASE + 6], P[BASE + 7]);                              \
    auto r0 = __builtin_amdgcn_permlane32_swap(a0, b0, false, false); auto r1 = __builtin_amdgcn_permlane32_swap(a1, b1, false, false); \
    u32x4 w = {r0[0], r1[0], r0[1], r1[1]}; OUT = *reinterpret_cast<bf16x8*>(&w); } while (0)
  PK4(p0, 0, pa0); PK4(p0, 8, pa1); PK4(p1, 0, pa2); PK4(p1, 8, pa3);
#undef PK4
}
__device__ __forceinline__ void qkt(f32x16& p0, f32x16& p1, const bf16_t* Ks, const bf16x8* qr, int r32, int hi) {
  p0 = f32x16{}; p1 = f32x16{};
  for (int d0 = 0; d0 < 8; ++d0) { int cb = (d0 * 16 + hi * 8) * 2;
    bf16x8 b0 = *reinterpret_cast<const bf16x8*>((const char*)Ks + KSWZ(r32, cb));
    bf16x8 b1 = *reinterpret_cast<const bf16x8*>((const char*)Ks + KSWZ(32 + r32, cb));
    p0 = __builtin_amdgcn_mfma_f32_32x32x16_bf16(b0, qr[d0], p0, 0, 0, 0);
    p1 = __builtin_amdgcn_mfma_f32_32x32x16_bf16(b1, qr[d0], p1, 0, 0, 0); }
}
__device__ __forceinline__ int v_st(int k, int c) { const int kk = (k & ~0xC) | ((k & 4) << 1) | ((k & 8) >> 1); return ((kk >> 3) * 4 + (c >> 5)) * 512 + ((kk & 7) * 32 + (c & 31)) * 2; }
__device__ __forceinline__ int v_rd_base(int lane) { return ((lane & 3) << 3) | (((lane >> 2) & 3) << 6) | (((lane >> 4) & 1) << 5) | (((lane >> 5) & 1) << 8); }
constexpr int v_rd_off(int d0, int ks, int half) { return d0 * 512 + ks * 4096 + half * 2048; }
template <int OFF> __device__ __forceinline__ s16x4 tr_read(int vb) {
  s16x4 r; asm volatile("ds_read_b64_tr_b16 %0, %1 offset:%2" : "=&v"(r) : "v"(vb), "i"(OFF) : "memory"); return r;
}
template <int D0> __device__ __forceinline__ void pv_one(f32x16& od, int vb, bf16x8 pa0, bf16x8 pa1, bf16x8 pa2, bf16x8 pa3) {
  const s16x4 l0 = tr_read<v_rd_off(D0, 0, 0)>(vb), h0 = tr_read<v_rd_off(D0, 0, 1)>(vb), l1 = tr_read<v_rd_off(D0, 1, 0)>(vb), h1 = tr_read<v_rd_off(D0, 1, 1)>(vb);
  const s16x4 l2 = tr_read<v_rd_off(D0, 2, 0)>(vb), h2 = tr_read<v_rd_off(D0, 2, 1)>(vb), l3 = tr_read<v_rd_off(D0, 3, 0)>(vb), h3 = tr_read<v_rd_off(D0, 3, 1)>(vb);
  asm volatile("s_waitcnt lgkmcnt(0)" ::: "memory"); SBAR();
#define PK(L, H) (bf16x8){L[0], L[1], L[2], L[3], H[0], H[1], H[2], H[3]}
  od = __builtin_amdgcn_mfma_f32_32x32x16_bf16(pa0, PK(l0, h0), od, 0, 0, 0);
  od = __builtin_amdgcn_mfma_f32_32x32x16_bf16(pa1, PK(l1, h1), od, 0, 0, 0);
  od = __builtin_amdgcn_mfma_f32_32x32x16_bf16(pa2, PK(l2, h2), od, 0, 0, 0);
  od = __builtin_amdgcn_mfma_f32_32x32x16_bf16(pa3, PK(l3, h3), od, 0, 0, 0);
#undef PK
}
__device__ __forceinline__ void pv_d0(f32x16* o, int vb, bf16x8 pa0, bf16x8 pa1, bf16x8 pa2, bf16x8 pa3) {
  pv_one<0>(o[0], vb, pa0, pa1, pa2, pa3); pv_one<1>(o[1], vb, pa0, pa1, pa2, pa3); pv_one<2>(o[2], vb, pa0, pa1, pa2, pa3); pv_one<3>(o[3], vb, pa0, pa1, pa2, pa3);
}
__device__ __forceinline__ void attn_dense_body(const bf16_t* Qb, const bf16_t* Kh, const bf16_t* Vh, bf16_t* Ob, int seq, char* lds, float mnC) {
  int tid = threadIdx.x; asm volatile("" : "+v"(tid));
  const int wid = tid >> 6, lane = tid & 63, r32 = lane & 31, hi = lane >> 5;
  bf16_t* V_lds = (bf16_t*)lds; bf16_t* K_lds = (bf16_t*)(lds + 2 * SHM_V);
  float* ws = (float*)(lds + 2 * SHM_V + 2 * SHM_K) + wid * 64; float* li_l = ws;
  float l_reg = 0; f32x16 o[4] = {}; bf16x8 qr[8];
  const bf16_t* Qw = Qb + (long)(wid * QBLK + r32) * LDQ + hi * 8;
#pragma unroll
  for (int d0 = 0; d0 < 8; ++d0) qr[d0] = *reinterpret_cast<const bf16x8*>(Qw + d0 * 16);
  const int sr = tid >> 4, sc = (tid & 15) * 8, vst0 = v_st(sr, sc), vst1 = v_st(32 + sr, sc);
  const int vb0 = (int)(uintptr_t)V_lds + v_rd_base(lane);
  struct { bf16x8 vs0, vs1, ks0, ks1; } sr_[1];
  const unsigned goff = (unsigned)(sr * LDK + sc) * 2u;
#define SLOAD(i, k0) do { const char* vb_ = (const char*)Vh + (size_t)(k0) * (LDK * 2); const char* kb_ = (const char*)Kh + (size_t)(k0) * (LDK * 2); \
    sr_[i].vs0 = *reinterpret_cast<const bf16x8*>(vb_ + goff); sr_[i].vs1 = *reinterpret_cast<const bf16x8*>(vb_ + 32 * LDK * 2 + goff); \
    sr_[i].ks0 = *reinterpret_cast<const bf16x8*>(kb_ + goff); sr_[i].ks1 = *reinterpret_cast<const bf16x8*>(kb_ + 32 * LDK * 2 + goff); } while (0)
#define SWRITE(b, i) do { *(bf16x8*)((char*)V_lds + (b) * SHM_V + vst0) = sr_[i].vs0;          \
    *(bf16x8*)((char*)V_lds + (b) * SHM_V + vst1) = sr_[i].vs1; int kc = sc * 2;               \
    *(bf16x8*)((char*)K_lds + (b) * SHM_K + KSWZ(sr, kc)) = sr_[i].ks0;                       \
    *(bf16x8*)((char*)K_lds + (b) * SHM_K + KSWZ(32 + sr, kc)) = sr_[i].ks1; } while (0)
#define SWAIT() asm volatile("s_waitcnt vmcnt(0)" ::: "memory")
  f32x16 pA0, pA1, pB0, pB1; bf16x8 pa0, pa1, pa2, pa3; const int NT = seq / KVBLK;
  constexpr int SE = 0, SO = 0;
  SLOAD(SE, 0); asm volatile("s_waitcnt vmcnt(0)" ::: "memory"); SWRITE(0, SE); __syncthreads();
  qkt(pA0, pA1, K_lds, qr, r32, hi); partialSM(pA0, pA1, mnC);
  SLOAD(SO, KVBLK);
  SWAIT(); SWRITE(1, SO); __syncthreads();
  for (int j = 1; j + 1 < NT; j += 2) {
    SBAR(); qkt(pB0, pB1, (bf16_t*)((char*)K_lds + SHM_K), qr, r32, hi);
    finishSM(pA0, pA1, l_reg, pa0, pa1, pa2, pa3); SBAR();
    SLOAD(SO, (j + 1) * KVBLK); SBAR();
    pv_d0(o, vb0, pa0, pa1, pa2, pa3); partialSM(pB0, pB1, mnC);
    __syncthreads(); SWAIT(); SWRITE(0, SE);
    __syncthreads();
    SBAR(); qkt(pA0, pA1, K_lds, qr, r32, hi);
    finishSM(pB0, pB1, l_reg, pa0, pa1, pa2, pa3); SBAR();
    SLOAD(SE, (j + 2) * KVBLK); SBAR();
    pv_d0(o, vb0 + (int)SHM_V, pa0, pa1, pa2, pa3); partialSM(pA0, pA1, mnC);
    __syncthreads(); SWAIT(); SWRITE(1, SO);
    __syncthreads();
  }
  SBAR(); qkt(pB0, pB1, (bf16_t*)((char*)K_lds + SHM_K), qr, r32, hi);
  finishSM(pA0, pA1, l_reg, pa0, pa1, pa2, pa3); SBAR();
  pv_d0(o, vb0, pa0, pa1, pa2, pa3); partialSM(pB0, pB1, mnC);
  __syncthreads();
  finishSM(pB0, pB1, l_reg, pa0, pa1, pa2, pa3); SBAR();
  pv_d0(o, vb0 + (int)SHM_V, pa0, pa1, pa2, pa3);
  { auto rr = __builtin_amdgcn_permlane32_swap(__float_as_uint(l_reg), __float_as_uint(l_reg), false, false); l_reg = __uint_as_float(rr[0]) + __uint_as_float(rr[1]); }
  if (hi == 0) li_l[r32] = l_reg; asm volatile("s_waitcnt lgkmcnt(0)" ::: "memory");
  float rli[16];
#pragma unroll
  for (int r = 0; r < 16; ++r) rli[r] = __builtin_amdgcn_rcpf(li_l[crow(r, hi)]);
  bf16_t* Ow = Ob + (long)(wid * QBLK) * LDO;
#pragma unroll
  for (int r = 0; r < 16; ++r) { int orow = crow(r, hi);
    for (int d0 = 0; d0 < 4; ++d0) Ow[(long)orow * LDO + d0 * 32 + r32] = (bf16_t)f2bf(o[d0][r] * rli[r]); }
#undef SLOAD
#undef SWRITE
#undef SWAIT
}
#undef KSWZ
#undef SBAR
}


#define XB_TMO      128
#define XB_XCNT(j)  (256  + 64 * (j))
#define XB_XSUB(j)  (1280 + 64 * (j))
#define XB_XGEN(j)  (2304 + 64 * (j))
#define XB_TOP      3328
#define XB_TOPGEN   3392
#define XCD_BAR_WORDS 3456
#define XB_SPIN_CAP (1u << 18)
__device__ __forceinline__ unsigned xb_ld(unsigned* p)              { return __hip_atomic_load(p, __ATOMIC_RELAXED, __HIP_MEMORY_SCOPE_AGENT); }
__device__ __forceinline__ unsigned xb_add(unsigned* p, unsigned v) { return __hip_atomic_fetch_add(p, v, __ATOMIC_RELAXED, __HIP_MEMORY_SCOPE_AGENT); }
__device__ __forceinline__ unsigned xb_xcc_id() { return (unsigned)__builtin_amdgcn_s_getreg((3 << 11) | 20) & 0xFu; }
#define XB_SPIN(cond, bar) do { unsigned _sp = 0; while (cond) { __builtin_amdgcn_s_sleep(1); \
    if ((++_sp & 255u) == 0u) { if (xb_ld(&(bar)[XB_TMO])) break; if (_sp > XB_SPIN_CAP) { atomicAdd(&(bar)[XB_TMO], 1u); break; } } } } while (0)
__device__ __forceinline__ void xcd_barrier_complete(unsigned* bar, unsigned x, unsigned& nloc, unsigned& nx) {
    const unsigned G = gridDim.x * gridDim.y * gridDim.z;
    unsigned sum, cnt, mine, sp = 0u;
    for (;;) {
        sum = 0u; cnt = 0u; mine = 0u;
#pragma unroll
        for (unsigned j = 0; j < 16; ++j) { const unsigned c = xb_ld(&bar[XB_XCNT(j)]); sum += c; cnt += (c > 0u) ? 1u : 0u; mine = (j == x) ? c : mine; }
        if (sum == G) break;
        __builtin_amdgcn_s_sleep(1);
        if ((++sp & 255u) == 0u) { if (xb_ld(&bar[XB_TMO])) break; if (sp > XB_SPIN_CAP) { atomicAdd(&bar[XB_TMO], 1u); break; } }
    }
    nloc = mine > 0u ? mine : 1u; nx = cnt > 0u ? cnt : 1u;
}
__device__ __forceinline__ void xcd_barrier(unsigned* bar, volatile LAS unsigned* st) {
    asm volatile("s_waitcnt vmcnt(0)" ::: "memory");
    __syncthreads();
    if (threadIdx.x == 0) {
        const unsigned x = xb_xcc_id();
        __builtin_amdgcn_s_waitcnt(0);
        unsigned nloc = st[0], nx = st[1];
        if (nloc == 0u) { xcd_barrier_complete(bar, x, nloc, nx); st[0] = nloc; st[1] = nx; }
        const unsigned old = xb_add(&bar[XB_XSUB(x)], 1u);
        const unsigned gen = old / nloc;
        if (old + 1u == (gen + 1u) * nloc) {
            __builtin_amdgcn_fence(__ATOMIC_RELEASE, "agent");
            asm volatile("s_waitcnt vmcnt(0)" ::: "memory");
            const unsigned og = xb_add(&bar[XB_TOP], 1u);
            const unsigned tg = og / nx;
            if (og + 1u == (tg + 1u) * nx) xb_add(&bar[XB_TOPGEN], 1u);
            else XB_SPIN(xb_ld(&bar[XB_TOPGEN]) == tg, bar);
            __builtin_amdgcn_fence(__ATOMIC_ACQUIRE, "agent");
            xb_add(&bar[XB_XGEN(x)], 1u);
            asm volatile("s_waitcnt vmcnt(0)" ::: "memory");
        } else {
            XB_SPIN(xb_ld(&bar[XB_XGEN(x)]) == gen, bar);
            __builtin_amdgcn_fence(__ATOMIC_ACQUIRE, "agent");
            asm volatile("s_waitcnt vmcnt(0)" ::: "memory");
        }
    }
    __syncthreads();
}

struct Args;
typedef const __attribute__((address_space(4))) Args* KArgsP;
struct Args {
    const float *x, *c, *ctx, *c_ctx, *norm1_w, *norm2_w, *w_mod, *b_mod, *even_w_in, *even_conv_w, *even_w_out, *odd_w_qkv, *odd_q_norm, *odd_k_norm,
                *lq1, *lk1, *lq2, *lk2, *subln_w, *odd_w_out, *moe_w_group, *moe_b_group, *moe_w_expert, *moe_b_expert, *moe_w_gate, *moe_w_up, *moe_w_down;
    float* out; unsigned char* ws; int ph_lo, ph_hi;
};

__device__ __forceinline__ KArgsP kargs() { KArgsP p = (KArgsP)__builtin_amdgcn_kernarg_segment_ptr(); asm volatile("" : "+s"(p)); return p; }

__device__ __forceinline__ void transpose_item(const float* W, int ldw, int K, bf16_t* WT, int dst_row0, int k0, int n0, LAS float* scr, int lane) {
#pragma unroll 8
    for (int i = 0; i < 32; ++i) { const int kk = 2 * i + (lane >> 5); scr[kk * 33 + (lane & 31)] = W[(size_t)(k0 + kk) * ldw + n0 + (lane & 31)]; }
    asm volatile("s_waitcnt lgkmcnt(0)" ::: "memory");
    const int c = lane & 7;
#pragma unroll
    for (int j = 0; j < 4; ++j) { const int n = (lane >> 3) + 8 * j; const LAS float* s = scr + (8 * c) * 33 + n;
        u32x4 o; o.x = pk2(s[0 * 33], s[1 * 33]); o.y = pk2(s[2 * 33], s[3 * 33]); o.z = pk2(s[4 * 33], s[5 * 33]); o.w = pk2(s[6 * 33], s[7 * 33]);
        *(u32x4*)(WT + (size_t)(dst_row0 + n) * K + k0 + 8 * c) = o; }
    asm volatile("s_waitcnt lgkmcnt(0)" ::: "memory");
}
__device__ __forceinline__ void moe_weight_items(const float* w_gate, const float* w_up, const float* w_down, unsigned char* ws, int l, int gw, int ngw, LAS float* scr, int lane) {
    bf16_t* WGU = (bf16_t*)(ws + WS_WGU); bf16_t* WD = (bf16_t*)(ws + WS_WD);
    constexpr int I_G = NEXP * 32 * 16, I_D = NEXP * 8 * 64;
    for (int it = gw; it < 2 * I_G + I_D; it += ngw) {
        if (it < 2 * I_G) { const int up = it >= I_G, r = up ? it - I_G : it, e = r / 512, kb = (r % 512) / 16, nb = r % 16;
            const float* W = (up ? w_up : w_gate) + ((size_t)l * NEXP + e) * DM * EFF;
            const int n0 = nb * 32, row0 = e * 1024 + (n0 >> 7) * 256 + up * 128 + (n0 & 127);
            transpose_item(W, EFF, DM, WGU, row0, kb * 64, n0, scr, lane);
        } else { const int r = it - 2 * I_G, e = r / 512, kb = (r % 512) / 64, nb = r % 64;
            const float* W = w_down + ((size_t)l * NEXP + e) * EFF * DM;
            transpose_item(W, DM, EFF, WD, e * DM + nb * 32, kb * 64, nb * 32, scr, lane); }
    }
}

__device__ __forceinline__ void plain_store(GUnit& u, int ldc) { u.ldc = ldc; u.rs1 = 64 * ldc; u.rs2 = ldc; u.cs = 64; u.nrow = 256; u.bperm = 0; }
struct SchedInProj {
    const char *u0, *win; char *P, *zt2, *ztc; int G, c;
    __device__ __forceinline__ bool next(int i, GUnit& u) const {
        const int L = i * G + c; if (L >= 816 + 544) return false;
        u.lda = DM * 2; u.ldb = DM * 2; u.nt = DM / 64; u.scale = 1.f;
        if (L < 816) { int pm, pn; pg8::tile_of(L, 68, 12, pm, pn);
            u.A = u0 + (size_t)pm * 256 * DM * 2; u.B = win + (size_t)pn * 256 * DM * 2; u.O = P + ((size_t)pm * 256 * 3072 + pn * 256) * 2; plain_store(u, 3072);
        } else { int pm, pn; pg8::tile_of(L - 816, 8, 68, pm, pn);
            u.A = win + (size_t)(3072 + pm * 256) * DM * 2;
            const int g = pm >> 1, part = pm & 1, b = pn / 17, jt = pn % 17;
            if (jt == 0) { u.B = u0 + (size_t)pn * 256 * DM * 2; u.O = ztc + ((size_t)((b * 4 + g) * 256) * 512 + part * 256) * 2; plain_store(u, 512); }
            else { const int tq = jt - 1;
                u.B = u0 + (size_t)(b * TPB + CTX + 4 * tq) * DM * 2;
                u.O = zt2 + (((size_t)((b * 4 + g) * 256) * 64 + 4 * tq) * 128 + part * 64) * 2;
                u.ldc = 8192; u.rs1 = 64 * 8192; u.rs2 = 8192; u.cs = 128; u.nrow = 256; u.bperm = 1; } }
        return true;
    }
};
struct SchedFftA {
    const char *ma, *cmatc, *zt2, *ztc; char *uf, *ycat; int G, c;
    __device__ __forceinline__ bool next(int i, GUnit& u) const {
        const int L = i * G + c; if (L >= 1024 + 16) return false;
        if (L < 1024) { const int w = (L % 8) * 128 + L / 8, bg = w >> 6, chq = w & 63;
            u.A = ma; u.lda = 256; u.B = zt2 + (size_t)((bg * 256 + 4 * chq) * 64) * 256; u.ldb = 256; u.nt = 2;
            u.O = uf + (size_t)(bg * 256 + 4 * chq) * 8192 * 2; u.ldc = 64; u.rs1 = 4096; u.rs2 = 64; u.cs = 8192; u.nrow = 128; u.bperm = 0; u.scale = 1.f;
        } else { const int bg = L - 1024, b = bg >> 2, g = bg & 3;
            u.A = cmatc; u.B = ztc + (size_t)bg * 256 * 1024; u.lda = 1024; u.ldb = 1024; u.nt = 8;
            u.O = ycat + ((size_t)(b * TPB) * DM + 1024 + g * 256) * 2; plain_store(u, DM); u.scale = 1.0f / 256.0f; }
        return true;
    }
};
struct SchedFftB {
    const char *mb, *uf; char* ycat; int G, c;
    __device__ __forceinline__ bool next(int i, GUnit& u) const {
        const int L = i * G + c; if (L >= 256) return false;
        const int w = (L % 8) * 32 + L / 8, bg = w >> 4, kb = w & 15, b = bg >> 2, g = bg & 3;
        u.A = mb + (size_t)kb * 256 * 1024; u.lda = 1024; u.B = uf + ((size_t)bg * 256 * 8192 + kb * 512) * 2; u.ldb = 16384; u.nt = 8;
        u.O = ycat + ((size_t)(b * TPB + CTX + 4 * kb) * DM + 1024 + g * 256) * 2; u.ldc = DM; u.rs1 = DM; u.rs2 = 64 * DM; u.cs = 64; u.nrow = 256; u.bperm = 0; u.scale = 1.0f / 1024.0f;
        return true;
    }
};
struct SchedOut0 {
    const char *ycat, *wout; const float *x, *ctx, *mod; char* h; int G, c;
    __device__ __forceinline__ bool next(int i, GUnit& u) const {
        const int L = i * G + c; if (L >= 68 * 8) return false;
        int pm, pn; pg8::tile_of(L, 68, 8, pm, pn);
        u.A = ycat + (size_t)pm * 256 * DM * 2; u.B = wout + (size_t)pn * 256 * DM * 2; u.lda = DM * 2; u.ldb = DM * 2; u.nt = DM / 64;
        const int b = pm / 17, jt = pm % 17, v = (jt == 0) ? 4 : b;
        u.src = (const char*)((jt == 0 ? ctx + (size_t)b * CTX * DM : x + ((size_t)b * SEQ + (jt - 1) * 256) * DM) + pn * 256);
        u.gate = mod + (size_t)v * MODSZ + 2 * DM + pn * 256;
        u.O = h + ((size_t)pm * 256 * DM + pn * 256) * 4; u.bperm = 0;
        return true;
    }
};
struct SchedOut1 {
    const char *a, *wout; const float* mod; char* h; int G, c;
    __device__ __forceinline__ bool next(int i, GUnit& u) const {
        const int L = i * G + c; if (L >= 64 * 8) return false;
        int lt, pn; pg8::tile_of(L, 64, 8, lt, pn);
        const int b = lt >> 4, ut = b * 17 + 1 + (lt & 15);
        u.A = a + (size_t)ut * 256 * DM * 2; u.B = wout + (size_t)pn * 256 * DM * 2; u.lda = DM * 2; u.ldb = DM * 2; u.nt = DM / 64;
        u.bperm = 0; u.O = h + ((size_t)ut * 256 * DM + pn * 256) * 4; u.src = u.O; u.gate = mod + (size_t)b * MODSZ + 2 * DM + pn * 256;
        return true;
    }
};
struct SchedQKV {
    const char *u1, *wqkv; char *q; int G, c;
    __device__ __forceinline__ bool next(int i, GUnit& u) const {
        const int L = i * G + c; if (L >= 1536 + 64) return false;
        int ut, pn;
        if (L < 1536) { int lt; pg8::tile_of(L, 64, 24, lt, pn); ut = (lt >> 4) * 17 + 1 + (lt & 15); }
        else { const int r = L - 1536; ut = (r & 3) * 17; pn = 8 + (r >> 2); }
        u.A = u1 + (size_t)ut * 256 * DM * 2; u.B = wqkv + (size_t)pn * 256 * DM * 2; u.lda = DM * 2; u.ldb = DM * 2; u.nt = DM / 64; u.scale = 1.f; plain_store(u, DM);
        u.O = q + (size_t)(pn >> 3) * (WS_K - WS_Q) + ((size_t)ut * 256 * DM + (pn & 7) * 256) * 2;
        return true;
    }
};
struct MoeTiles {
    const LAS int* tab;
    __device__ __forceinline__ void init(LAS int* t, const unsigned* cntp) {
        tab = t;
        if (threadIdx.x == 0) { int s = 0;
            for (int e = 0; e < NEXP; ++e) { const int c = (int)cntp[e]; t[e] = c; t[16 + e] = s; s += (c + 255) >> 8; }
            t[32] = s; }
        __syncthreads();
    }
    __device__ __forceinline__ int total() const { return __builtin_amdgcn_readfirstlane(tab[32]); }
    __device__ __forceinline__ void find(int rtg, int& e, int& rt, int& gc) const {
        int ee = 0;
#pragma unroll
        for (int j = 1; j < NEXP; ++j) if (rtg >= tab[16 + j]) ee = j;
        e = __builtin_amdgcn_readfirstlane(ee);
        const int tbe = __builtin_amdgcn_readfirstlane(tab[16 + e]), ce = __builtin_amdgcn_readfirstlane(tab[e]);
        rt = rtg - tbe; gc = ce - rt * 256; if (gc > 256) gc = 256;
    }
};
struct SchedMoe1 {
    MoeTiles T; const char *v, *wgu; char* hid; const int* lst; int G, c;
    __device__ __forceinline__ bool next(int i, GUnit& u) const {
        const int L = i * G + c, nwg = T.total() * 4; if (L >= nwg) return false;
        const int w = pg8::xcd_remap(L, nwg), rtg = w >> 2, pn = w & 3; int e, rt, gc; T.find(rtg, e, rt, gc);
        u.A = v; u.lda = DM * 2; u.glist = lst + (size_t)e * LCAP + rt * 256; u.gcount = gc;
        u.B = wgu + ((size_t)e * 1024 + pn * 256) * DM * 2; u.ldb = DM * 2; u.nt = DM / 64;
        u.O = hid + ((size_t)rtg * 256 * EFF + pn * 128) * 2; u.ldc = EFF; u.bperm = 0;
        return true;
    }
};
struct SchedMoe2 {
    MoeTiles T; const char *hid, *wd; const int* lst; int G, c;
    __device__ __forceinline__ bool next(int i, GUnit& u) const {
        const int L = i * G + c, nwg = T.total() * 8; if (L >= nwg) return false;
        const int w = pg8::xcd_remap(L, nwg), rtg = w >> 3, pn = w & 7; int e, rt, gc; T.find(rtg, e, rt, gc);
        u.A = hid + (size_t)rtg * 256 * EFF * 2; u.lda = EFF * 2; u.B = wd + ((size_t)e * DM + pn * 256) * EFF * 2; u.ldb = EFF * 2; u.nt = EFF / 64;
        u.glist = lst + (size_t)e * LCAP + rt * 256; u.gcount = gc; u.aux = pn; u.bperm = 0;
        return true;
    }
};

__device__ __forceinline__ void row_info(int row, int& b, int& j) { b = row / TPB; j = row - b * TPB; }

__device__ __forceinline__ void norm_mod_store(const f32x4 (&v)[8], float rstd, const float* nw, const float* sc, const float* sh, bf16_t* orow, int lane) {
#pragma unroll
    for (int jj = 0; jj < 8; ++jj) { const int k = 4 * lane + 256 * jj;
        const f32x4 w = *(const f32x4*)(nw + k), s = *(const f32x4*)(sc + k), t = *(const f32x4*)(sh + k);
        const f32x4 y = v[jj] * rstd * w * (1.0f + s) + t;
        u32x2 o; o.x = pk2(y[0], y[1]); o.y = pk2(y[2], y[3]); *(u32x2*)(orow + k) = o; }
}

__device__ __forceinline__ void route_row(const LAS float* yl, const float* wg, const float* bg, const float* we, const float* be, int lane, int& e0, int& e1, float& w0, float& w1) {
    float lg[4] = {0.f, 0.f, 0.f, 0.f}; float le[16];
#pragma unroll
    for (int n = 0; n < 16; ++n) le[n] = 0.f;
#pragma unroll 1
    for (int jj = 0; jj < 8; ++jj) { const f32x4 y4 = *(const LAS f32x4*)(yl + 4 * lane + 256 * jj);
#pragma unroll
        for (int i = 0; i < 4; ++i) { const int k = 4 * lane + 256 * jj + i; const float xv = y4[i];
            const f32x4 g = *(const f32x4*)(wg + (size_t)k * 4);
#pragma unroll
            for (int n = 0; n < 4; ++n) lg[n] = fmaf(xv, g[n], lg[n]);
#pragma unroll
            for (int q = 0; q < 4; ++q) { const f32x4 ev = *(const f32x4*)(we + (size_t)k * 16 + 4 * q);
#pragma unroll
                for (int n = 0; n < 4; ++n) le[4 * q + n] = fmaf(xv, ev[n], le[4 * q + n]); } } }
#pragma unroll
    for (int n = 0; n < 4; ++n) lg[n] = wave_sum(lg[n]) + bg[n];
#pragma unroll
    for (int n = 0; n < 16; ++n) le[n] = wave_sum(le[n]) + be[n];
    int gi = 0; float gm = lg[0];
#pragma unroll
    for (int n = 1; n < 4; ++n) if (lg[n] > gm) { gm = lg[n]; gi = n; }
    float den = 0.f;
#pragma unroll
    for (int n = 0; n < 4; ++n) den += __expf(lg[n] - gm);
    const float gw = 1.0f / den;
    float s[4];
#pragma unroll
    for (int n = 0; n < 4; ++n) { const float m0 = (gi == 0) ? 1.f : 0.f, m1 = (gi == 1) ? 1.f : 0.f, m2 = (gi == 2) ? 1.f : 0.f, m3 = (gi == 3) ? 1.f : 0.f; s[n] = le[n] * m0 + le[4 + n] * m1 + le[8 + n] * m2 + le[12 + n] * m3; }
    int i0 = 0; float v0 = s[0];
#pragma unroll
    for (int n = 1; n < 4; ++n) if (s[n] > v0) { v0 = s[n]; i0 = n; }
    int i1 = -1; float v1 = -3.0e38f;
#pragma unroll
    for (int n = 0; n < 4; ++n) if (n != i0 && s[n] > v1) { v1 = s[n]; i1 = n; }
    const float ex = __expf(v1 - v0), inv = 1.0f / (1.0f + ex);
    e0 = gi * 4 + i0; e1 = gi * 4 + i1; w0 = inv * gw; w1 = ex * inv * gw;
}

#define PHASE_BEGIN KArgsP ka = kargs(); unsigned char* ws = ka->ws; (void)ws; int tid = threadIdx.x; asm volatile("" : "+v"(tid)); const int lane = tid & 63, wave = __builtin_amdgcn_readfirstlane(tid >> 6), gw = blk * NWAVES + wave; (void)lane; (void)gw;
#define ctl ((unsigned*)(ws + WS_CTL))
#define mod ((float*)(ws + WS_MOD))
#define tokw ((float*)(ws + WS_TOKW))
#define list ((int*)(ws + WS_LIST))
#define WIN ((bf16_t*)(ws + WS_WIN))
#define WOUT0 ((bf16_t*)(ws + WS_WOUT0))
#define WQKV ((bf16_t*)(ws + WS_WQKV))
#define WOUT1 ((bf16_t*)(ws + WS_WOUT1))
#define CMAT ((bf16_t*)(ws + WS_CMAT))
#define CMATC ((bf16_t*)(ws + WS_CMATC))
#define H ((float*)(ws + WS_H))
#define U ((bf16_t*)(ws + WS_U))
#define PB ((bf16_t*)(ws + WS_P))
#define YCAT ((bf16_t*)(ws + WS_YCAT))
#define QB ((bf16_t*)(ws + WS_Q))
#define KB ((bf16_t*)(ws + WS_K))
#define VB ((bf16_t*)(ws + WS_V))
#define AB ((bf16_t*)(ws + WS_A))
#define YB ((bf16_t*)(ws + WS_Y))
#define OB ((bf16_t*)(ws + WS_O))
#ifndef PHMASK
#define PHMASK 0x3ffff
#endif
#define PHON(k) (((PHMASK) >> (k)) & 1)
#define IN(k) (lo <= (k) && (k) < hi)
#ifndef XSYNC
#define XSYNC 0
#endif
#define BARW ((unsigned*)(kargs()->ws + WS_CTL) + 4096)
#define BARST ((volatile LAS unsigned*)(lds + RING_BYTES + 512))
#define SYNC(k) do { if (IN(k) && IN((k) + 1)) { \
        if ((k) == 0) { grid.sync(); if (threadIdx.x == 0) (void)xb_add(&BARW[XB_XCNT(xb_xcc_id())], 1u); }     \
        else xcd_barrier(BARW, BARST); \
        if ((k) == 1) for (int xs_ = 0; xs_ < XSYNC; ++xs_) xcd_barrier(BARW, BARST); } } while (0)
#define TS(k) do { if (PROBE && blockIdx.x == 0 && threadIdx.x == 0) { const unsigned long long t_ = __builtin_amdgcn_s_memrealtime(); unsigned long long* tp_ = (unsigned long long*)(kargs()->ws + WS_CTL + 1024); \
        if ((k) == PA0) tp_[0] = t_; if ((k) == PA1) tp_[1] = t_; if ((k) == PB0) tp_[2] = t_; if ((k) == PB1) tp_[3] = t_; } } while (0)
template <int l>
__device__ __forceinline__ void moe_layer(cg::grid_group& grid, LAS unsigned char* lds, int lo, int hi, int G, int blk) {
    const int pb = (l == 0) ? 5 : 14;
#define cnt (ctl + 32 * l)
#define modl (mod + (size_t)l * 5 * MODSZ)
        TS(pb);
        if (PHON(5) && IN(pb)) REPS(5) { PHASE_BEGIN
            LAS int* ri = (LAS int*)lds;
            LAS float* part = (LAS float*)(lds + 4096);
            LAS float* ssq = (LAS float*)(lds + 16384);
            LAS float* rstdL = (LAS float*)(lds + 16896);
            LAS float* red = (LAS float*)(lds + 17408);
            const int ntiles = (l == 0 ? NTOK : NLAT) / 16, t0 = (ntiles * blk) / G, t1 = (ntiles * (blk + 1)) / G;
            const float* wg = ka->moe_w_group + (size_t)l * DM * 4; const float* bgp = ka->moe_b_group + l * 4;
            const float* we = ka->moe_w_expert + (size_t)l * DM * 16; const float* bep = ka->moe_b_expert + l * 16;
            const float* nw = ka->norm2_w + l * DM;
            const float* cbuf = (const float*)(ctl + 8192) + (size_t)l * 5 * 32;
            const int r = lane & 15, q = lane >> 4, K0 = wave * 256;
            float Be[16][4], Bg[16][4]; int curv = -1;
            for (int t = t0; t < t1; ++t) {
                const int row0 = (l == 0) ? t * 16 : ((t * 16) / SEQ) * TPB + CTX + ((t * 16) % SEQ);
                int b, j; row_info(row0, b, j); const int v = (j < CTX) ? 4 : b;
                const float* mv = modl + (size_t)v * MODSZ;
                if (v != curv) { curv = v;
                    gcf wep = (gcf)(we + (size_t)(K0 + 4 * q) * 16 + r); gcf wgp = (gcf)(wg + (size_t)(K0 + 4 * q) * 4 + (r & 3));
                    gcf nwp = (gcf)(nw + K0 + 4 * q); gcf scp = (gcf)(mv + 4 * DM + K0 + 4 * q); const float gmask = (r < 4) ? 1.f : 0.f;
#pragma unroll
                    for (int c = 0; c < 16; ++c) { const f32x4 w4 = *(const __attribute__((address_space(1))) f32x4*)nwp, s4 = *(const __attribute__((address_space(1))) f32x4*)scp;
#pragma unroll
                        for (int s_ = 0; s_ < 4; ++s_) { const float av = w4[s_] * (1.0f + s4[s_]); Be[c][s_] = av * wep[s_ * 16]; Bg[c][s_] = av * gmask * wgp[s_ * 4]; }
                        wep += 256; wgp += 64; nwp += 16; scp += 16; asm volatile("" : "+v"(wep), "+v"(wgp), "+v"(nwp), "+v"(scp) :: "memory"); } }
                const float* hrow = H + (size_t)(row0 + r) * DM + K0 + 4 * q;
                f32x4 ae = {0.f, 0.f, 0.f, 0.f}, ag = {0.f, 0.f, 0.f, 0.f}; float ss = 0.f;
#pragma unroll
                for (int hf = 0; hf < 2; ++hf) { f32x4 Av[8];
#pragma unroll
                    for (int c = 0; c < 8; ++c) Av[c] = *(const f32x4*)(hrow + 16 * (8 * hf + c));
#pragma unroll
                    for (int c = 0; c < 8; ++c)
#pragma unroll
                        for (int s_ = 0; s_ < 4; ++s_) { const float x = Av[c][s_]; ss = fmaf(x, x, ss);
                            ae = __builtin_amdgcn_mfma_f32_16x16x4f32(x, Be[8 * hf + c][s_], ae, 0, 0, 0); ag = __builtin_amdgcn_mfma_f32_16x16x4f32(x, Bg[8 * hf + c][s_], ag, 0, 0, 0); }
                    asm volatile("" ::: "memory"); }
                ss += __shfl_xor(ss, 16); ss += __shfl_xor(ss, 32);
                if (q == 0) ssq[wave * 16 + r] = ss;
#pragma unroll
                for (int g_ = 0; g_ < 4; ++g_) { part[(wave * 16 + 4 * q + g_) * 20 + r] = ae[g_]; if (r < 4) part[(wave * 16 + 4 * q + g_) * 20 + 16 + r] = ag[g_]; }
                __syncthreads();
                if (tid < 320) { float p = 0.f;
#pragma unroll
                    for (int w = 0; w < 8; ++w) p += part[w * 320 + tid];
                    red[tid] = p; }
                __syncthreads();
                if (tid < 16) { float sum = 0.f;
#pragma unroll
                    for (int w = 0; w < 8; ++w) sum += ssq[w * 16 + tid];
                    const float rstd = rsqrtf(sum * (1.0f / DM) + EPS); rstdL[tid] = rstd;
                    float lg[20];
#pragma unroll
                    for (int n = 0; n < 20; ++n) lg[n] = rstd * red[tid * 20 + n] + cbuf[v * 32 + n];
                    int gi = 0; float gm = lg[16];
#pragma unroll
                    for (int n = 1; n < 4; ++n) if (lg[16 + n] > gm) { gm = lg[16 + n]; gi = n; }
                    float den = 0.f;
#pragma unroll
                    for (int n = 0; n < 4; ++n) den += __expf(lg[16 + n] - gm);
                    const float gwt = 1.0f / den; float sv[4];
#pragma unroll
                    for (int n = 0; n < 4; ++n) { const float m0 = (gi == 0) ? 1.f : 0.f, m1 = (gi == 1) ? 1.f : 0.f, m2 = (gi == 2) ? 1.f : 0.f, m3 = (gi == 3) ? 1.f : 0.f; sv[n] = lg[n] * m0 + lg[4 + n] * m1 + lg[8 + n] * m2 + lg[12 + n] * m3; }
                    int i0 = 0; float v0 = sv[0];
#pragma unroll
                    for (int n = 1; n < 4; ++n) if (sv[n] > v0) { v0 = sv[n]; i0 = n; }
                    int i1 = -1; float v1 = -3.0e38f;
#pragma unroll
                    for (int n = 0; n < 4; ++n) if (n != i0 && sv[n] > v1) { v1 = sv[n]; i1 = n; }
                    const float ex = __expf(v1 - v0), inv = 1.0f / (1.0f + ex);
                    const int row = row0 + tid, ix = (t - t0) * 16 + tid;
                    ri[ix * 4 + 0] = gi * 4 + i0; ri[ix * 4 + 1] = gi * 4 + i1; ri[ix * 4 + 2] = row * 2; ri[ix * 4 + 3] = row * 2 + 1;
                    tokw[row * 2] = inv * gwt; tokw[row * 2 + 1] = ex * inv * gwt; }
                __syncthreads();
                { const float rstd = rstdL[r]; gbf up = (gbf)(U + (size_t)(row0 + r) * DM + K0 + 4 * q); gcf hp = (gcf)hrow;
                    gcf nwp = (gcf)(nw + K0 + 4 * q); gcf scp = (gcf)(mv + 4 * DM + K0 + 4 * q); gcf shp = (gcf)(mv + 3 * DM + K0 + 4 * q);
#pragma unroll
                    for (int c = 0; c < 16; ++c) { typedef const __attribute__((address_space(1))) f32x4* g4; const f32x4 w4 = *(g4)nwp, s4 = *(g4)scp, t4 = *(g4)shp;
                        const f32x4 y = *(g4)hp * rstd * w4 * (1.0f + s4) + t4;
                        u32x2 o; o.x = pk2(y[0], y[1]); o.y = pk2(y[2], y[3]); *(__attribute__((address_space(1))) u32x2*)up = o;
                        nwp += 16; scp += 16; shp += 16; hp += 16; up += 16;
                        if ((c & 3) == 3) asm volatile("" : "+v"(nwp), "+v"(scp), "+v"(shp), "+v"(hp), "+v"(up) :: "memory"); } }
            }
            __syncthreads();
            const int nrb = (t1 - t0) * 16;
            if (tid < NEXP) { int n = 0;
                for (int i = 0; i < nrb; ++i) { n += (ri[i * 4] == tid) + (ri[i * 4 + 1] == tid); }
                int* lp = list + (rep_ ? (int)((WS_END - WS_LIST) / 4) : 0); const int base = n ? (int)atomicAdd(cnt + 16 * rep_ + tid, (unsigned)n) : 0; int p = 0;
                for (int i = 0; i < nrb; ++i) { if (ri[i * 4] == tid) lp[(size_t)tid * LCAP + base + p++] = ri[i * 4 + 2]; if (ri[i * 4 + 1] == tid) lp[(size_t)tid * LCAP + base + p++] = ri[i * 4 + 3]; } }
            __syncthreads();
        }
        SYNC(pb);
        TS(pb + 1);
        if (PHON(6) && IN(pb + 1)) REPS(6) { PHASE_BEGIN
            SchedMoe1 S; S.T.init((LAS int*)(lds + RING_BYTES), cnt); S.v = (const char*)U; S.wgu = (const char*)(ws + WS_WGU); S.hid = (char*)(ws + WS_HID); S.lst = list; S.G = G; S.c = blk;
            pg8::gemm_phase<SchedMoe1, pg8::EpiSwiGLU, true>(lds, S, pg8::EpiSwiGLU{});
        }
        SYNC(pb + 1);
        TS(pb + 2);
        if (PHON(7) && IN(pb + 2)) REPS(7) { PHASE_BEGIN
            SchedMoe2 S; S.T.init((LAS int*)(lds + RING_BYTES), cnt); S.hid = (const char*)(ws + WS_HID); S.wd = (const char*)(ws + WS_WD); S.lst = list; S.G = G; S.c = blk;
            pg8::gemm_phase<SchedMoe2, pg8::EpiScatter, false>(lds, S, pg8::EpiScatter{YB, tokw});
        }
        SYNC(pb + 2);
}

__global__ void __launch_bounds__(NTHREADS, 2) fwd_kernel(Args a) {
    extern __shared__ __attribute__((aligned(16))) unsigned char lds_raw[];
    LAS unsigned char* lds = (LAS unsigned char*)lds_raw;
    cg::grid_group grid = cg::this_grid();
    const int G = gridDim.x, blk = blockIdx.x, ngw = G * NWAVES;
    const int lo = a.ph_lo, hi = a.ph_hi;
    if (threadIdx.x < 2) ((LAS unsigned*)(lds + RING_BYTES + 512))[threadIdx.x] = 0u;
    __syncthreads();


    TS(0);
    if (PHON(0) && IN(0)) REPS(0) { PHASE_BEGIN
        if (blk == 0) { if (tid < 64) ctl[tid] = 0u;
            for (int i = tid; i < XCD_BAR_WORDS; i += NTHREADS) (ctl + 4096)[i] = 0u; }
        if (blk < 192) {
            LAS float* sil = (LAS float*)lds; LAS float* red = (LAS float*)(lds + 40960);
            for (int i = tid; i < 5 * DM; i += NTHREADS) { const int v = i / DM, k = i % DM; sil[i] = silu_f(v < 4 ? ka->c[v * DM + k] : ka->c_ctx[k]); }
            __syncthreads();
            const int l = blk / 96, j0 = (blk % 96) * 128;
            const float* wp = ka->w_mod + (size_t)l * DM * MODSZ + j0 + 2 * lane;
            f32x2 acc[5];
#pragma unroll
            for (int v = 0; v < 5; ++v) acc[v] = (f32x2){0.f, 0.f};
#pragma unroll 8
            for (int k = wave * 256; k < wave * 256 + 256; ++k) { const f32x2 w = *(const f32x2*)(wp + (size_t)k * MODSZ);
#pragma unroll
                for (int v = 0; v < 5; ++v) { const float s = sil[v * DM + k]; acc[v].x = fmaf(s, w.x, acc[v].x); acc[v].y = fmaf(s, w.y, acc[v].y); } }
#pragma unroll
            for (int v = 0; v < 5; ++v) { red[(wave * 5 + v) * 128 + 2 * lane] = acc[v].x; red[(wave * 5 + v) * 128 + 2 * lane + 1] = acc[v].y; }
            __syncthreads();
            for (int i = tid; i < 5 * 128; i += NTHREADS) { const int v = i / 128, j = i % 128; float s = ka->b_mod[l * MODSZ + j0 + j];
#pragma unroll
                for (int w = 0; w < 8; ++w) s += red[(w * 5 + v) * 128 + j];
                mod[((size_t)l * 5 + v) * MODSZ + j0 + j] = s; }
            __syncthreads();
        }
        LAS float* tab = (LAS float*)(lds + 135168);
        if (tid < 256) tab[tid] = cospif((float)tid * (1.0f / 128.0f));
        __syncthreads();
        LAS float* scr = (LAS float*)(lds + wave * 16384);
        constexpr int I_IN = 32 * 96, I_O0 = 32 * 64, I_QKV = 32 * 192, I_O1 = 32 * 64;
        for (int it = gw; it < I_IN + I_O0 + I_QKV + I_O1; it += ngw) {
            int r = it;
            if (r < I_IN) { transpose_item(ka->even_w_in, 4096, DM, WIN, (r % 96) * 32, (r / 96) * 64, (r % 96) * 32, scr, lane); continue; } r -= I_IN;
            if (r < I_O0) { transpose_item(ka->even_w_out, DM, DM, WOUT0, (r % 64) * 32, (r / 64) * 64, (r % 64) * 32, scr, lane); continue; } r -= I_O0;
            if (r < I_QKV) { transpose_item(ka->odd_w_qkv, 6144, DM, WQKV, (r % 192) * 32, (r / 192) * 64, (r % 192) * 32, scr, lane); continue; } r -= I_QKV;
            transpose_item(ka->odd_w_out, DM, DM, WOUT1, (r % 64) * 32, (r / 64) * 64, (r % 64) * 32, scr, lane);
        }
        moe_weight_items(ka->moe_w_gate, ka->moe_w_up, ka->moe_w_down, ws, 0, gw, ngw, scr, lane);
        for (int it = gw; it < 8 * 8 * 64; it += ngw) {
            const int gp = it >> 9, m0 = ((it >> 6) & 7) * 32, k0 = (it & 63) * 32, g = gp >> 1, part = gp & 1;
            const int r = lane & 31, hh = lane >> 5;
            f32x16 d = {};
            const float* wrow = ka->even_w_in + (size_t)(k0 + r) * 4096 + 3072 + g * 256 + 8 * hh;
#pragma unroll 4
            for (int j0 = 0; j0 < 256; j0 += 16) {
                const f32x4 b0 = *(const f32x4*)(wrow + j0), b1 = *(const f32x4*)(wrow + j0 + 4);
                u32x4 bw = {pk2(b0[0], b0[1]), pk2(b0[2], b0[3]), pk2(b1[0], b1[1]), pk2(b1[2], b1[3])};
                float av[8];
#pragma unroll
                for (int jj = 0; jj < 8; ++jj) { const int p = ((m0 + r) * (j0 + 8 * hh + jj) - (part ? 64 : 0)) & 255; av[jj] = tab[p]; }
                u32x4 aw = {pk2(av[0], av[1]), pk2(av[2], av[3]), pk2(av[4], av[5]), pk2(av[6], av[7])};
                d = __builtin_amdgcn_mfma_f32_32x32x16_bf16(*reinterpret_cast<bf16x8*>(&aw), *reinterpret_cast<bf16x8*>(&bw), d, 0, 0, 0);
            }
#pragma unroll
            for (int q = 0; q < 16; ++q) { const int row = (q & 3) + 8 * (q >> 2) + 4 * hh;
                WIN[(size_t)(3072 + gp * 256 + m0 + row) * DM + k0 + r] = (bf16_t)f2bf(d[q]); }
        }
        { bf16_t* MA = (bf16_t*)(ws + WS_MA); bf16_t* MB = (bf16_t*)(ws + WS_MB);
          for (int it = gw; it < 256 + 4096 + 256; it += ngw) {
            if (it < 256) { const int r = it & 127, k1 = r >> 1, ri = r & 1;
                for (int col = lane; col < 128; col += 64) { const int part = col >> 6, t1 = col & 63; const float xx = (float)((k1 * t1) & 63) * (1.0f / 32.0f);
                    const float cs = cospif(xx), sn = sinpif(xx); const float val = (ri == 0) ? (part == 0 ? cs : -sn) : (part == 0 ? -sn : -cs);
                    MA[(size_t)it * 128 + col] = (bf16_t)f2bf(val); }
            } else if (it < 256 + 4096) { const int rr = it - 256, kb = rr >> 8, r = rr & 255, k1l = r >> 6, k2 = r & 63, k1 = 4 * kb + k1l;
                const int col0 = lane * 8; float f[8];
#pragma unroll
                for (int i = 0; i < 8; ++i) { const int col = col0 + i, k1l2 = col >> 7, ri = (col >> 6) & 1, t2 = col & 63; const int p = (64 * k2 * t2 + k1 * t2) & 4095; const float xx = (float)p * (1.0f / 2048.0f);
                    f[i] = (k1l2 == k1l) ? (ri ? sinpif(xx) : cospif(xx)) : 0.f; }
                u32x4 o = {pk2(f[0], f[1]), pk2(f[2], f[3]), pk2(f[4], f[5]), pk2(f[6], f[7])};
                *(u32x4*)(MB + (size_t)rr * 512 + col0) = o;
            } else { const int k = it - 256 - 4096; const int col0 = lane * 8, part = col0 >> 8, t0 = col0 & 255; float f[8];
#pragma unroll
                for (int i = 0; i < 8; ++i) { const int p = (k * (t0 + i)) & 255; const float xx = (float)p * (1.0f / 128.0f); f[i] = part ? -sinpif(xx) : cospif(xx); }
                u32x4 o = {pk2(f[0], f[1]), pk2(f[2], f[3]), pk2(f[4], f[5]), pk2(f[6], f[7])};
                *(u32x4*)(CMATC + (size_t)k * 512 + col0) = o; }
          } }
    }
    SYNC(0);

    TS(1);
    if (PHON(1) && IN(1)) REPS(1) { PHASE_BEGIN
        if (gw < 200) { const int l_ = gw / 100, v_ = (gw % 100) / 20, n_ = gw % 20;
            const float* sh = mod + ((size_t)l_ * 5 + v_) * MODSZ + 3 * DM; float acc_ = 0.f;
            for (int k = lane; k < DM; k += 64) acc_ += sh[k] * (n_ < 16 ? ka->moe_w_expert[((size_t)l_ * DM + k) * 16 + n_] : ka->moe_w_group[((size_t)l_ * DM + k) * 4 + (n_ - 16)]);
            acc_ = wave_sum(acc_);
            if (lane == 0) ((float*)(ctl + 8192))[(l_ * 5 + v_) * 32 + n_] = acc_ + (n_ < 16 ? ka->moe_b_expert[l_ * 16 + n_] : ka->moe_b_group[l_ * 4 + n_ - 16]); }
        for (int row = gw; row < NTOK; row += ngw) { int b, j; row_info(row, b, j);
            const float* src = (j < CTX) ? ka->ctx + ((size_t)b * CTX + j) * DM : ka->x + ((size_t)b * SEQ + (j - CTX)) * DM;
            const float* mv = mod + (size_t)(j < CTX ? 4 : b) * MODSZ;
            f32x4 v[8]; float ss = 0.f;
#pragma unroll
            for (int jj = 0; jj < 8; ++jj) { v[jj] = *(const f32x4*)(src + 4 * lane + 256 * jj); ss += v[jj][0] * v[jj][0] + v[jj][1] * v[jj][1] + v[jj][2] * v[jj][2] + v[jj][3] * v[jj][3]; }
            const float rstd = rsqrtf(wave_sum(ss) * (1.0f / DM) + EPS);
            norm_mod_store(v, rstd, ka->norm1_w, mv + DM, mv, U + (size_t)row * DM, lane);
        }
    }
    SYNC(1);

    TS(2);
    if (PHON(2) && IN(2)) REPS(2) { PHASE_BEGIN
        SchedInProj S{(const char*)U, (const char*)WIN, (char*)PB, (char*)(ws + WS_ZTL), (char*)(ws + WS_ZTC), G, blk};
        pg8::gemm_phase<SchedInProj, pg8::EpiStore, false>(lds, S, pg8::EpiStore{});
    }
    SYNC(2);

    TS(3);
    if (PHON(3) && IN(3)) REPS(3) { PHASE_BEGIN
        for (int it = blk * NTHREADS + tid; it < (NTOK / 16) * 128; it += G * NTHREADS) {
            const int chunk = it >> 7, oct = it & 127, r0 = chunk * 16, jm = r0 % TPB, ch0 = oct * 8;
            const bool hasprev = (jm != 0 && jm != CTX), hasnext = (((jm + 16) % TPB) != 0 && (jm + 16) != CTX);
            float w0[8], w1[8], w2[8];
#pragma unroll
            for (int i = 0; i < 8; ++i) { w0[i] = ka->even_conv_w[ch0 + i]; w1[i] = ka->even_conv_w[1024 + ch0 + i]; w2[i] = ka->even_conv_w[2048 + ch0 + i]; }
            float cp[8], cc[8], cn[8];
#define LOADCV(row_, o) do { const u32x4 cg_ = *(const u32x4*)(PB + (size_t)(row_) * 3072 + 1024 + ch0), vi = *(const u32x4*)(PB + (size_t)(row_) * 3072 + 2048 + ch0); \
                o[0] = bflo(cg_.x) * bflo(vi.x); o[1] = bfhi(cg_.x) * bfhi(vi.x); o[2] = bflo(cg_.y) * bflo(vi.y); o[3] = bfhi(cg_.y) * bfhi(vi.y); \
                o[4] = bflo(cg_.z) * bflo(vi.z); o[5] = bfhi(cg_.z) * bfhi(vi.z); o[6] = bflo(cg_.w) * bflo(vi.w); o[7] = bfhi(cg_.w) * bfhi(vi.w); } while (0)
            if (hasprev) LOADCV(r0 - 1, cp); else {
#pragma unroll
                for (int i = 0; i < 8; ++i) cp[i] = 0.f; }
            LOADCV(r0, cc);
            for (int rr = 0; rr < 16; ++rr) { const int row = r0 + rr;
                if (rr < 15 || hasnext) LOADCV(row + 1, cn); else {
#pragma unroll
                    for (int i = 0; i < 8; ++i) cn[i] = 0.f; }
                const u32x4 bg = *(const u32x4*)(PB + (size_t)row * 3072 + ch0);
                float bb[8] = {bflo(bg.x), bfhi(bg.x), bflo(bg.y), bfhi(bg.y), bflo(bg.z), bfhi(bg.z), bflo(bg.w), bfhi(bg.w)}; float y[8];
#pragma unroll
                for (int i = 0; i < 8; ++i) y[i] = bb[i] * (w0[i] * cp[i] + w1[i] * cc[i] + w2[i] * cn[i]);
                u32x4 o = {pk2(y[0], y[1]), pk2(y[2], y[3]), pk2(y[4], y[5]), pk2(y[6], y[7])};
                *(u32x4*)(YCAT + (size_t)row * DM + ch0) = o;
#pragma unroll
                for (int i = 0; i < 8; ++i) { cp[i] = cc[i]; cc[i] = cn[i]; } }
        }
        { SchedFftA S{(const char*)(ws + WS_MA), (const char*)CMATC, (const char*)(ws + WS_ZTL), (const char*)(ws + WS_ZTC), (char*)(ws + WS_UF), (char*)YCAT, G, blk};
          pg8::gemm_phase<SchedFftA, pg8::EpiStore, false>(lds, S, pg8::EpiStore{}); }
        xcd_barrier(BARW, BARST);
        { SchedFftB S{(const char*)(ws + WS_MB), (const char*)(ws + WS_UF), (char*)YCAT, G, blk};
          pg8::gemm_phase<SchedFftB, pg8::EpiStore, false>(lds, S, pg8::EpiStore{}); }
    }
    SYNC(3);

    TS(4);
    if (PHON(4) && IN(4)) REPS(4) { PHASE_BEGIN
        SchedOut0 S{(const char*)YCAT, (const char*)WOUT0, ka->x, ka->ctx, mod, (char*)H, G, blk};
        pg8::gemm_phase<SchedOut0, pg8::EpiResid, false>(lds, S, pg8::EpiResid{});
    }
    SYNC(4);

    moe_layer<0>(grid, lds, lo, hi, G, blk);
    { constexpr int l = 0; (void)l;
            TS(8);
    if (PHON(8) && IN(8)) { PHASE_BEGIN
                const float* mod1 = mod + (size_t)5 * MODSZ;
                for (int row = gw; row < NTOK; row += ngw) { int b, j; row_info(row, b, j); const int vr = (j < CTX) ? 4 : b;
                    const float* g2 = modl + (size_t)vr * MODSZ + 5 * DM; const float* mv1 = mod1 + (size_t)vr * MODSZ;
                    float* hrow = H + (size_t)row * DM; const bf16_t* y0 = YB + (size_t)(row * 2) * DM; const bf16_t* y1 = y0 + DM;
                    f32x4 v[8]; float ss = 0.f;
#pragma unroll
                    for (int jj = 0; jj < 8; ++jj) { const int k = 4 * lane + 256 * jj; const f32x4 hv = *(const f32x4*)(hrow + k), g = *(const f32x4*)(g2 + k);
                        const u32x2 a0 = *(const u32x2*)(y0 + k), a1 = *(const u32x2*)(y1 + k);
                        f32x4 ys = {bflo(a0.x) + bflo(a1.x), bfhi(a0.x) + bfhi(a1.x), bflo(a0.y) + bflo(a1.y), bfhi(a0.y) + bfhi(a1.y)};
                        v[jj] = hv + g * ys; *(f32x4*)(hrow + k) = v[jj];
                        ss += v[jj][0] * v[jj][0] + v[jj][1] * v[jj][1] + v[jj][2] * v[jj][2] + v[jj][3] * v[jj][3]; }
                    const float rstd = rsqrtf(wave_sum(ss) * (1.0f / DM) + EPS);
                    norm_mod_store(v, rstd, ka->norm1_w + DM, mv1 + DM, mv1, U + (size_t)row * DM, lane);
                }
                moe_weight_items(ka->moe_w_gate, ka->moe_w_up, ka->moe_w_down, ws, 1, gw, ngw, (LAS float*)(lds + wave * 16384), lane);
            }
            SYNC(8);
            TS(9);
    if (PHON(9) && IN(9)) REPS(9) { PHASE_BEGIN
                SchedQKV S{(const char*)U, (const char*)WQKV, (char*)QB, G, blk};
                pg8::gemm_phase<SchedQKV, pg8::EpiStore, false>(lds, S, pg8::EpiStore{});
            }
            SYNC(9);
            TS(10);
    if (PHON(10) && IN(10)) { PHASE_BEGIN
                LAS float* rt = (LAS float*)lds;
                for (int i = tid; i < 64 * 32; i += NTHREADS) { const int pos = i >> 5, f = i & 31; const float inv = exp2f(-(float)f * 0.4152410118609203f); const float ang = (float)pos * inv;
                    float tr = ang * 0.15915494309189535f; tr -= floorf(tr); rt[2 * i] = __builtin_amdgcn_cosf(tr); rt[2 * i + 1] = __builtin_amdgcn_sinf(tr); }
                __syncthreads();
                const int hc = lane >> 2, q8 = (lane & 3) * 8;
                for (int it = gw; it < NLAT + NTOK; it += ngw) {
                    const bool isq = it < NLAT; int row;
                    if (isq) row = (it / SEQ) * TPB + CTX + (it % SEQ); else row = it - NLAT;
                    int b, j; row_info(row, b, j); const bool rope = (j >= CTX); const int t = j - CTX, prow = t >> 6, pcol = t & 63;
                    bf16_t* p = (isq ? QB : KB) + (size_t)row * DM + hc * 128; const float* nwp = isq ? ka->odd_q_norm : ka->odd_k_norm;
                    u32x4 raw[4]; float xv[4][8];
                    float ss = 0.f;
#pragma unroll
                    for (int s = 0; s < 4; ++s) { raw[s] = *(const u32x4*)(p + s * 32 + q8);
                        xv[s][0] = bflo(raw[s].x); xv[s][1] = bfhi(raw[s].x); xv[s][2] = bflo(raw[s].y); xv[s][3] = bfhi(raw[s].y); xv[s][4] = bflo(raw[s].z); xv[s][5] = bfhi(raw[s].z); xv[s][6] = bflo(raw[s].w); xv[s][7] = bfhi(raw[s].w);
#pragma unroll
                        for (int i = 0; i < 8; ++i) ss += xv[s][i] * xv[s][i]; }
                    ss += __shfl_xor(ss, 1); ss += __shfl_xor(ss, 2);
                    const float rstd = rsqrtf(ss * (1.0f / 128.0f) + EPS);
#pragma unroll
                    for (int s = 0; s < 4; ++s)
#pragma unroll
                        for (int i = 0; i < 8; ++i) xv[s][i] = xv[s][i] * rstd * nwp[s * 32 + q8 + i];
                    if (rope) {
#pragma unroll
                        for (int ax = 0; ax < 2; ++ax) { const int pos = ax ? pcol : prow;
#pragma unroll
                            for (int i = 0; i < 8; ++i) { const float cs = rt[2 * (pos * 32 + q8 + i)], sn = rt[2 * (pos * 32 + q8 + i) + 1];
                                const float x1 = xv[2 * ax][i], x2 = xv[2 * ax + 1][i]; xv[2 * ax][i] = x1 * cs - x2 * sn; xv[2 * ax + 1][i] = x2 * cs + x1 * sn; } }
                    }
#pragma unroll
                    for (int s = 0; s < 4; ++s) { u32x4 o = {pk2(xv[s][0], xv[s][1]), pk2(xv[s][2], xv[s][3]), pk2(xv[s][4], xv[s][5]), pk2(xv[s][6], xv[s][7])}; *(u32x4*)(p + s * 32 + q8) = o; }
                }
                __syncthreads();
            }
            SYNC(10);
            TS(11);
    if (PHON(11) && IN(11)) REPS(11) { PHASE_BEGIN
                const int vcu = (blk % 8) * (G / 8) + blk / 8;
                float mq = fmaxf(fabsf(ka->odd_q_norm[lane]), fabsf(ka->odd_q_norm[lane + 64])), mk = fmaxf(fabsf(ka->odd_k_norm[lane]), fabsf(ka->odd_k_norm[lane + 64]));
#pragma unroll
                for (int o_ = 1; o_ < 64; o_ <<= 1) { mq = fmaxf(mq, __shfl_xor(mq, o_)); mk = fmaxf(mk, __shfl_xor(mk, o_)); }
                const float mnC = -(128.0f * att::SCALE * mq * mk) * 1.4426950408889634f;
                for (int U0 = vcu; U0 < 2048; U0 += G) {
                    const int combo = U0 >> 4, qb = U0 & 15, vh = combo & 1, cp_ = (combo >> 1) & 1, hh = (combo >> 2) & 7, b = combo >> 5;
                    const bf16_t* Qp = QB + (size_t)(b * TPB + CTX + qb * 256) * DM + hh * 256 + cp_ * 128;
                    const bf16_t* Kp = KB + (size_t)(b * TPB) * DM + hh * 256 + cp_ * 128;
                    const bf16_t* Vp = VB + (size_t)(b * TPB) * DM + hh * 256 + vh * 128;
                    bf16_t* Op = OB + (size_t)(b * SEQ + qb * 256) * (2 * DM) + cp_ * DM + hh * 256 + vh * 128;
                    att::attn_dense_body(Qp, Kp, Vp, Op, TPB, (char*)lds_raw, mnC);
                    __syncthreads();
                }
            }
            SYNC(11);
            TS(12);
    if (PHON(12) && IN(12)) REPS(12) { PHASE_BEGIN
                float d1 = ka->lq1[lane] * ka->lk1[lane] + ka->lq1[lane + 64] * ka->lk1[lane + 64], d2 = ka->lq2[lane] * ka->lk2[lane] + ka->lq2[lane + 64] * ka->lk2[lane + 64];
                d1 = wave_sum(d1); d2 = wave_sum(d2);
                const float lam_init = 0.8f - 0.6f * expf(-0.3f * 1.0f);
                const float lam = expf(d1) - expf(d2) + lam_init;
                const int hh = lane >> 3, e0 = (lane & 7) * 32;
                for (int li = gw; li < NLAT; li += ngw) {
                    const bf16_t* o1 = OB + (size_t)li * (2 * DM) + hh * 256 + e0; const bf16_t* o2 = o1 + DM;
                    float ov[32]; float ss = 0.f;
#pragma unroll
                    for (int s = 0; s < 4; ++s) { const u32x4 p1 = *(const u32x4*)(o1 + 8 * s), p2 = *(const u32x4*)(o2 + 8 * s);
                        ov[8 * s + 0] = bflo(p1.x) - lam * bflo(p2.x); ov[8 * s + 1] = bfhi(p1.x) - lam * bfhi(p2.x); ov[8 * s + 2] = bflo(p1.y) - lam * bflo(p2.y); ov[8 * s + 3] = bfhi(p1.y) - lam * bfhi(p2.y);
                        ov[8 * s + 4] = bflo(p1.z) - lam * bflo(p2.z); ov[8 * s + 5] = bfhi(p1.z) - lam * bfhi(p2.z); ov[8 * s + 6] = bflo(p1.w) - lam * bflo(p2.w); ov[8 * s + 7] = bfhi(p1.w) - lam * bfhi(p2.w); }
#pragma unroll
                    for (int i = 0; i < 32; ++i) ss += ov[i] * ov[i];
                    ss += __shfl_xor(ss, 1); ss += __shfl_xor(ss, 2); ss += __shfl_xor(ss, 4);
                    const float rs = rsqrtf(ss * (1.0f / 256.0f) + EPS) * (1.0f - lam_init);
                    const int row = (li / SEQ) * TPB + CTX + (li % SEQ);
                    bf16_t* ap = AB + (size_t)row * DM + hh * 256 + e0;
#pragma unroll
                    for (int s = 0; s < 4; ++s) { float y[8];
#pragma unroll
                        for (int i = 0; i < 8; ++i) y[i] = ov[8 * s + i] * rs * ka->subln_w[e0 + 8 * s + i];
                        u32x4 o = {pk2(y[0], y[1]), pk2(y[2], y[3]), pk2(y[4], y[5]), pk2(y[6], y[7])}; *(u32x4*)(ap + 8 * s) = o; }
                }
            }
            SYNC(12);
            TS(13);
    if (PHON(13) && IN(13)) { PHASE_BEGIN
                SchedOut1 S{(const char*)AB, (const char*)WOUT1, mod + (size_t)5 * MODSZ, (char*)H, G, blk};
                pg8::gemm_phase<SchedOut1, pg8::EpiResid, false>(lds, S, pg8::EpiResid{});
            }
            SYNC(13);
    }
    moe_layer<1>(grid, lds, lo, hi, G, blk);
    { constexpr int l = 1; (void)l;
            TS(17);
    if (PHON(17) && IN(17)) REPS(17) { PHASE_BEGIN
                for (int li = gw; li < NLAT; li += ngw) { const int b = li / SEQ, row = b * TPB + CTX + (li % SEQ);
                    const float* g2 = modl + (size_t)b * MODSZ + 5 * DM; const float* hrow = H + (size_t)row * DM; const bf16_t* y0 = YB + (size_t)(row * 2) * DM; const bf16_t* y1 = y0 + DM;
                    float* orow = ka->out + (size_t)li * DM;
#pragma unroll
                    for (int jj = 0; jj < 8; ++jj) { const int k = 4 * lane + 256 * jj; const f32x4 hv = *(const f32x4*)(hrow + k), g = *(const f32x4*)(g2 + k);
                        const u32x2 a0 = *(const u32x2*)(y0 + k), a1 = *(const u32x2*)(y1 + k);
                        f32x4 ys = {bflo(a0.x) + bflo(a1.x), bfhi(a0.x) + bfhi(a1.x), bflo(a0.y) + bflo(a1.y), bfhi(a0.y) + bfhi(a1.y)};
                        f32x4 res = hv + g * ys;
#if PROBE
                        { const unsigned long long* tp_ = (const unsigned long long*)(ws + WS_CTL + 1024); const float c2 = (float)(tp_[3] - tp_[2]) * 1e-4f, w1 = (float)(tp_[1] - tp_[0]) * 1e-2f;
                          res = (f32x4){c2, c2, c2, c2}; if (li == 0 && k == 0) res[0] = w1; }
#endif
                        *(f32x4*)(orow + k) = res; }
                }
            }
    }
    TS(18);
#undef IN
#undef SYNC
#undef cnt
#undef modl
#undef ctl
#undef mod
#undef tokw
#undef list
#undef WIN
#undef WOUT0
#undef WQKV
#undef WOUT1
#undef CMAT
#undef CMATC
#undef H
#undef U
#undef PB
#undef YCAT
#undef QB
#undef KB
#undef VB
#undef AB
#undef YB
#undef OB
}

#ifndef N_LAUNCH_MODE
#define N_LAUNCH_MODE 1
#endif
extern "C" void kernel_launch(void* const* d_in, const int* in_sizes, int n_in, void* d_out, int out_size, void* d_ws, size_t ws_size, hipStream_t stream) {
    static int grid = 0;
    if (grid == 0) {
        if (n_in != 27 || out_size != NLAT * DM || ws_size < WS_END) { fprintf(stderr, "kernel_launch: unexpected shapes: n_in %d out %d ws %zu (need %zu)\n", n_in, out_size, ws_size, (size_t)WS_END); grid = -1; return; }
        int dev = 0, cus = 0, per_cu = 0;
        hipGetDevice(&dev); hipDeviceGetAttribute(&cus, hipDeviceAttributeMultiprocessorCount, dev);
        if (hipFuncSetAttribute((const void*)fwd_kernel, hipFuncAttributeMaxDynamicSharedMemorySize, LDS_BYTES) != hipSuccess) { fprintf(stderr, "kernel_launch: hipFuncSetAttribute failed\n"); grid = -1; return; }
        if (hipOccupancyMaxActiveBlocksPerMultiprocessor(&per_cu, (const void*)fwd_kernel, NTHREADS, LDS_BYTES) != hipSuccess || per_cu < 1) { fprintf(stderr, "kernel_launch: occupancy query says %d\n", per_cu); per_cu = 1; }
        (void)hipGetLastError();
        grid = cus;
        if (grid != 256) fprintf(stderr, "kernel_launch: note: %d CUs\n", grid);
    }
    if (grid < 0) return;
    Args a{};
    const float** ap = (const float**)&a;
    for (int i = 0; i < 27; ++i) ap[i] = (const float*)d_in[i];
    a.out = (float*)d_out; a.ws = (unsigned char*)d_ws;
#if N_LAUNCH_MODE == 1
    a.ph_lo = 0; a.ph_hi = 18;
    void* args[] = {&a};
    hipError_t e = hipLaunchCooperativeKernel((const void*)fwd_kernel, dim3(grid), dim3(NTHREADS), args, LDS_BYTES, stream);
    if (e != hipSuccess) fprintf(stderr, "cooperative launch failed: %s (grid %d)\n", hipGetErrorString(e), grid);
#else
    for (int p = 0; p < 18; ++p) { a.ph_lo = p; a.ph_hi = p + 1; void* args[] = {&a};
        hipError_t e = hipLaunchCooperativeKernel((const void*)fwd_kernel, dim3(grid), dim3(NTHREADS), args, LDS_BYTES, stream);
        if (e != hipSuccess) { fprintf(stderr, "launch %d failed: %s\n", p, hipGetErrorString(e)); break; } }
#endif
}
```

```cpp
#include <hip/hip_runtime.h>
#include <hip/hip_cooperative_groups.h>
#include <cstdio>
#include <cstdint>
namespace cg = cooperative_groups;
#ifndef PROBE
#define PROBE 0
#endif
#ifndef REPMASK
#define REPMASK 0x0
#endif
#define REPS(k) for (int rep_ = 0; rep_ <= ((REPMASK >> (k)) & 1); ++rep_)
#ifndef PA0
#define PA0 0
#define PA1 18
#define PB0 0
#define PB1 18
#endif

#define LAS __attribute__((address_space(3)))
typedef unsigned short bf16_t;
typedef short bf16x8 __attribute__((ext_vector_type(8)));
typedef short s16x4 __attribute__((ext_vector_type(4)));
typedef float f32x2 __attribute__((ext_vector_type(2)));
typedef float f32x4 __attribute__((ext_vector_type(4)));
typedef float f32x8 __attribute__((ext_vector_type(8)));
typedef float f32x16 __attribute__((ext_vector_type(16)));
typedef unsigned u32x2 __attribute__((ext_vector_type(2)));
typedef unsigned u32x4 __attribute__((ext_vector_type(4)));

constexpr int DM = 2048, NB = 4, SEQ = 4096, CTX = 256, TPB = SEQ + CTX  ;
constexpr int NTOK = NB * TPB  , NLAT = NB * SEQ  ;
constexpr int NEXP = 16, EFF = 512, LCAP = 2 * NTOK  ;
constexpr float EPS = 1e-6f;
constexpr int NWAVES = 8, NTHREADS = 512;
constexpr int LDS_BYTES = 155648;
constexpr int RING_BYTES = 131072;

constexpr size_t MiB = 1u << 20;
constexpr size_t WS_CTL = 0, WS_MOD = 1 * MiB, WS_TOKW = 2 * MiB, WS_LIST = 3 * MiB;
constexpr size_t WS_WIN = 6 * MiB, WS_WOUT0 = 26 * MiB, WS_WQKV = 34 * MiB, WS_WOUT1 = 58 * MiB, WS_WGU = 66 * MiB, WS_WD = 130 * MiB;
constexpr size_t WS_CMAT = 162 * MiB, WS_CMATC = 226 * MiB, WS_HID = 162 * MiB  ;
constexpr size_t WS_H = 227 * MiB, WS_U = 363 * MiB;
constexpr size_t WS_P = 431 * MiB, WS_ZTL = 533 * MiB, WS_ZTC = 597 * MiB, WS_YCAT = 601 * MiB;
constexpr size_t WS_Q = 431 * MiB, WS_K = 499 * MiB, WS_V = 567 * MiB, WS_A = 431 * MiB;
static_assert(WS_V - WS_K == WS_K - WS_Q, "QKV spacing");
constexpr size_t WS_Y = 669 * MiB, WS_O = 669 * MiB, WS_MB = 805 * MiB, WS_END = 809 * MiB;
constexpr size_t WS_UF = 162 * MiB  , WS_MA = 226 * MiB + 512 * 1024;
constexpr int MODSZ = 6 * DM;

typedef const __attribute__((address_space(1))) float* gcf;
typedef __attribute__((address_space(1))) bf16_t* gbf;
__device__ __forceinline__ unsigned f2bf(float f) { unsigned u = __builtin_bit_cast(unsigned, f); return (u + 0x7fffu + ((u >> 16) & 1u)) >> 16; }
__device__ __forceinline__ unsigned pk2(float lo, float hi) { return f2bf(lo) | (f2bf(hi) << 16); }
__device__ __forceinline__ float bflo(unsigned w) { return __uint_as_float(w << 16); }
__device__ __forceinline__ float bfhi(unsigned w) { return __uint_as_float(w & 0xffff0000u); }
__device__ __forceinline__ unsigned cvt_pk_bf16(float lo, float hi) { unsigned r; asm volatile("v_cvt_pk_bf16_f32 %0, %1, %2" : "=v"(r) : "v"(lo), "v"(hi)); return r; }
__device__ __forceinline__ float wave_sum(float v) {
#pragma unroll
    for (int o = 1; o < 64; o <<= 1) v += __shfl_xor(v, o);
    return v;
}
__device__ __forceinline__ float silu_f(float x) { return x * __builtin_amdgcn_rcpf(1.0f + __expf(-x)); }

namespace pg8 {
constexpr int BM = 256, BK = 64, HALF = 128, HTB = HALF * BK * 2, STAGE_BYTES = 8 * HTB, NXCD = 8, WGM = 8;
__host__ __device__ __forceinline__ int lds_byte(int r, int c) { const int st = (r >> 4) * 2 + (c >> 5), rr = r & 15, cc = c & 31, ob = rr * 64 + cc * 2; return st * 1024 + (ob ^ (((ob >> 9) & 1) << 5)); }
__host__ __device__ __forceinline__ void stage_rc(int b, int& R, int& C) { const int st = b / 1024, sb = b % 1024, swz = sb ^ (((sb >> 9) & 1) << 5); R = (st >> 1) * 16 + swz / 64; C = (st & 1) * 32 + (swz % 64) / 2; }
__host__ __device__ __forceinline__ int perm32(int rho) { const int n = rho >> 4, i = rho & 15; return 8 * (i >> 2) + 4 * n + (i & 3); }

struct GUnit {
    const char* A; const char* B; unsigned lda, ldb; int nt;
    char* O; int ldc; float scale;
    int rs1, rs2, cs, nrow, bperm;
    const char* src; const float* gate;
    const int* glist; int gcount;
    int aux;
};
__device__ __forceinline__ void tile_of(int L, int nM, int nN, int& pm, int& pn) {
    const int nwg = nM * nN; int wgid = L;
    { const int q = nwg / NXCD, r = nwg % NXCD, xcd = wgid % NXCD, off = wgid / NXCD; wgid = (xcd < r ? xcd * (q + 1) : r * (q + 1) + (xcd - r) * q) + off; }
    const int nig = WGM * nN, gid = wgid / nig, fm = gid * WGM, gsz = (nM - fm) < WGM ? (nM - fm) : WGM;
    pm = fm + ((wgid % nig) % gsz); pn = (wgid % nig) / gsz;
}
__device__ __forceinline__ int xcd_remap(int L, int nwg) {
    const int q = nwg / NXCD, r = nwg % NXCD, xcd = L % NXCD, off = L / NXCD; return (xcd < r ? xcd * (q + 1) : r * (q + 1) + (xcd - r) * q) + off;
}

struct EpiStore {
    __device__ __forceinline__ void operator()(const f32x4 (&acc)[2][2][4][2], const GUnit& u, int wr, int wc, int fr, int fq) const {
        const float sc = u.scale;
#pragma unroll
        for (int ai = 0; ai < 2; ++ai) { if (ai * HALF >= u.nrow) break;
#pragma unroll
            for (int m = 0; m < 4; ++m) { bf16_t* rowp = (bf16_t*)u.O + (size_t)(2 * ai + wr) * u.rs1 + (size_t)(m * 16 + fr) * u.rs2 + (wc >> 1) * u.cs + (wc & 1) * 32 + 8 * fq;
#pragma unroll
                for (int bj = 0; bj < 2; ++bj) { const f32x4 v0 = acc[ai][bj][m][0] * sc, v1 = acc[ai][bj][m][1] * sc;
                    u32x4 w; w.x = cvt_pk_bf16(v0[0], v0[1]); w.y = cvt_pk_bf16(v0[2], v0[3]); w.z = cvt_pk_bf16(v1[0], v1[1]); w.w = cvt_pk_bf16(v1[2], v1[3]);
                    *(u32x4*)(rowp + (size_t)bj * 2 * u.cs) = w; } } }
    }
};
struct EpiSwiGLU {
    __device__ __forceinline__ void operator()(const f32x4 (&acc)[2][2][4][2], const GUnit& u, int wr, int wc, int fr, int fq) const {
#pragma unroll
        for (int ai = 0; ai < 2; ++ai)
#pragma unroll
            for (int m = 0; m < 4; ++m) { bf16_t* rowp = (bf16_t*)u.O + (size_t)(ai * HALF + wr * 64 + m * 16 + fr) * u.ldc + wc * 32 + 8 * fq;
                float h[8];
#pragma unroll
                for (int n = 0; n < 2; ++n)
#pragma unroll
                    for (int i = 0; i < 4; ++i) h[4 * n + i] = silu_f(acc[ai][0][m][n][i]) * acc[ai][1][m][n][i];
                u32x4 w; w.x = cvt_pk_bf16(h[0], h[1]); w.y = cvt_pk_bf16(h[2], h[3]); w.z = cvt_pk_bf16(h[4], h[5]); w.w = cvt_pk_bf16(h[6], h[7]);
                *(u32x4*)rowp = w; }
    }
};
struct EpiScatter {
    bf16_t* Y; const float* tokw;
    __device__ __forceinline__ void operator()(const f32x4 (&acc)[2][2][4][2], const GUnit& u, int wr, int wc, int fr, int fq) const {
#pragma unroll
        for (int ai = 0; ai < 2; ++ai)
#pragma unroll
            for (int m = 0; m < 4; ++m) { const int r = ai * HALF + wr * 64 + m * 16 + fr;
                if (r < u.gcount) { const int a = u.glist[r]; const float sc = tokw[a];
                    bf16_t* rowp = Y + (size_t)a * DM + u.aux * 256 + wc * 32 + 8 * fq;
#pragma unroll
                    for (int bj = 0; bj < 2; ++bj) { const f32x4 v0 = acc[ai][bj][m][0] * sc, v1 = acc[ai][bj][m][1] * sc;
                        u32x4 w; w.x = cvt_pk_bf16(v0[0], v0[1]); w.y = cvt_pk_bf16(v0[2], v0[3]); w.z = cvt_pk_bf16(v1[0], v1[1]); w.w = cvt_pk_bf16(v1[2], v1[3]);
                        *(u32x4*)(rowp + bj * HALF) = w; } } }
    }
};
struct EpiResid {
    __device__ __forceinline__ void operator()(const f32x4 (&acc)[2][2][4][2], const GUnit& u, int wr, int wc, int fr, int fq) const {
        f32x4 g[2][2];
#pragma unroll
        for (int bj = 0; bj < 2; ++bj)
#pragma unroll
            for (int n = 0; n < 2; ++n) g[bj][n] = *(const f32x4*)(u.gate + bj * HALF + wc * 32 + 8 * fq + 4 * n);
#pragma unroll
        for (int ai = 0; ai < 2; ++ai)
#pragma unroll
            for (int m = 0; m < 4; ++m) { const size_t off = (size_t)(ai * HALF + wr * 64 + m * 16 + fr) * DM + wc * 32 + 8 * fq;
#pragma unroll
                for (int bj = 0; bj < 2; ++bj)
#pragma unroll
                    for (int n = 0; n < 2; ++n) { const f32x4 s = *(const f32x4*)((const float*)u.src + off + bj * HALF + 4 * n);
                        *(f32x4*)((float*)u.O + off + bj * HALF + 4 * n) = s + g[bj][n] * acc[ai][bj][m][n]; } }
    }
};

template <bool GATHER>
__device__ __forceinline__ void mkvoff(const GUnit& u, unsigned (&vA)[2][2], unsigned (&vB)[2][2]) {
    int tid = threadIdx.x; asm volatile("" : "+v"(tid));
    int R0, C0, R1, C1; stage_rc(tid * 16, R0, C0); stage_rc(tid * 16 + 8192, R1, C1);
    const int Rb0 = (R0 & ~31) + perm32(R0 & 31), Rb1 = (R1 & ~31) + perm32(R1 & 31);
#pragma unroll
    for (int h = 0; h < 2; ++h) {
        if constexpr (GATHER) {
            const int r0 = h * HALF + R0, r1 = h * HALF + R1;
            const int t0 = (r0 < u.gcount) ? (u.glist[r0] >> 1) : 0, t1 = (r1 < u.gcount) ? (u.glist[r1] >> 1) : 0;
            vA[h][0] = (unsigned)t0 * u.lda + (unsigned)C0 * 2u; vA[h][1] = (unsigned)t1 * u.lda + (unsigned)C1 * 2u;
        } else {
            vA[h][0] = (unsigned)(h * HALF + R0) * u.lda + (unsigned)C0 * 2u; vA[h][1] = (unsigned)(h * HALF + R1) * u.lda + (unsigned)C1 * 2u;
        }
        int n0 = h * HALF + Rb0, n1 = h * HALF + Rb1; if (u.bperm) { n0 = 64 * (n0 & 63) + (n0 >> 6); n1 = 64 * (n1 & 63) + (n1 >> 6); }
        vB[h][0] = (unsigned)n0 * u.ldb + (unsigned)C0 * 2u; vB[h][1] = (unsigned)n1 * u.ldb + (unsigned)C1 * 2u;
    }
}

template <class Sched, class Epi, bool GATHER>
__device__ __forceinline__ void gemm_phase(LAS unsigned char* lds, const Sched& S, const Epi& E) {
    int tid = threadIdx.x; asm volatile("" : "+v"(tid));
    const int wid = __builtin_amdgcn_readfirstlane(tid >> 6), lane = tid & 63, wr = wid >> 2, wc = wid & 3, fr = lane & 15, fq = lane >> 4;
    const size_t kstep = (size_t)(BK * 2);
    const unsigned ldsw = (unsigned)wid * 1024u;
    const int aoff = lds_byte(wr * 64 + fr, fq * 8), boff = lds_byte(wc * 32 + fr, fq * 8);
#define PG8_SA(b, h) (((b) * 2 + (h)) * HTB)
#define PG8_SB(b, h) ((4 + (b) * 2 + (h)) * HTB)
#define PG8_STAGE(bufoff, gbase, voff) do { _Pragma("unroll") for (int _i = 0; _i < 2; ++_i) \
        __builtin_amdgcn_global_load_lds((const unsigned*)((const char*)(gbase) + (voff)[_i]), (LAS unsigned*)(lds + (bufoff) + ldsw + _i * 8192), 16, 0, 0); } while (0)
#define PG8_LDA(dst, b, h) do { _Pragma("unroll") for (int m = 0; m < 4; ++m) _Pragma("unroll") for (int k = 0; k < 2; ++k) dst[m][k] = *(const LAS bf16x8*)(lds + PG8_SA(b, h) + aoff + m * 2048 + k * 1024); } while (0)
#define PG8_LDB(dst, b, h) do { _Pragma("unroll") for (int n = 0; n < 2; ++n) _Pragma("unroll") for (int k = 0; k < 2; ++k) dst[n][k] = *(const LAS bf16x8*)(lds + PG8_SB(b, h) + boff + n * 2048 + k * 1024); } while (0)
#define PG8_MMA(ai, bj, At, Bt) do { __builtin_amdgcn_s_setprio(1); _Pragma("unroll") for (int m = 0; m < 4; ++m) _Pragma("unroll") for (int n = 0; n < 2; ++n) _Pragma("unroll") for (int k = 0; k < 2; ++k) \
        acc[ai][bj][m][n] = __builtin_amdgcn_mfma_f32_16x16x32_bf16(Bt[n][k], At[m][k], acc[ai][bj][m][n], 0, 0, 0); __builtin_amdgcn_s_setprio(0); } while (0)
#define PG8_WAIT_V(n) asm volatile("s_waitcnt vmcnt(" #n ")" ::: "memory")
#define PG8_WAIT_L(n) asm volatile("s_waitcnt lgkmcnt(" #n ")" ::: "memory")
#define PG8_BAR __builtin_amdgcn_s_barrier()
#define PG8_SCHED __builtin_amdgcn_sched_barrier(0)
    GUnit cur, nxt; int ui = 0;
    if (!S.next(0, cur)) return;
    unsigned vA[2][2], vB[2][2];
    mkvoff<GATHER>(cur, vA, vB);
    f32x4 acc[2][2][4][2];
#pragma unroll
    for (int a = 0; a < 2; ++a)
#pragma unroll
        for (int b = 0; b < 2; ++b)
#pragma unroll
            for (int m = 0; m < 4; ++m)
#pragma unroll
                for (int n = 0; n < 2; ++n) acc[a][b][m][n] = (f32x4){0.f, 0.f, 0.f, 0.f};
    bf16x8 At[4][2], B0[2][2], B1[2][2];
    const char* cA = cur.A; const char* cB = cur.B;
    PG8_STAGE(PG8_SB(0, 0), cB, vB[0]); PG8_STAGE(PG8_SB(0, 1), cB, vB[1]); PG8_STAGE(PG8_SA(0, 0), cA, vA[0]); PG8_STAGE(PG8_SA(0, 1), cA, vA[1]);
    if (wr == 1) PG8_BAR;
    PG8_WAIT_V(2); PG8_BAR;
    PG8_STAGE(PG8_SB(1, 0), cB + kstep, vB[0]); PG8_STAGE(PG8_SA(1, 0), cA + kstep, vA[0]); PG8_STAGE(PG8_SB(1, 1), cB + kstep, vB[1]);
    PG8_WAIT_V(6); PG8_BAR;
    for (;;) {
        const bool has_next = S.next(ui + 1, nxt);
        const char* nA = has_next ? nxt.A : cA; const char* nB = has_next ? nxt.B : cB;
        const int nt = cur.nt;
        for (int t = 0; t < nt; t += 2) {
            const bool last = (t == nt - 2);
            const char* a1 = cA + (size_t)(t + 1) * kstep;
            const char* a2 = last ? nA : cA + (size_t)(t + 2) * kstep; const char* b2 = last ? nB : cB + (size_t)(t + 2) * kstep;
            const char* a3 = a2 + kstep; const char* b3 = b2 + kstep;
            PG8_LDB(B0, 0, 0); PG8_LDB(B1, 0, 1); PG8_SCHED; PG8_LDA(At, 0, 0); PG8_STAGE(PG8_SA(1, 1), a1, vA[1]);
            if (last && has_next) mkvoff<GATHER>(nxt, vA, vB);
            PG8_WAIT_V(8); PG8_WAIT_L(0); PG8_BAR; PG8_MMA(0, 0, At, B0); PG8_MMA(0, 1, At, B1); PG8_BAR; PG8_SCHED;
            PG8_LDA(At, 0, 1); PG8_STAGE(PG8_SB(0, 0), b2, vB[0]); PG8_STAGE(PG8_SB(0, 1), b2, vB[1]); PG8_STAGE(PG8_SA(0, 0), a2, vA[0]);
            PG8_WAIT_V(8); PG8_WAIT_L(0); PG8_BAR; PG8_MMA(1, 0, At, B0); PG8_MMA(1, 1, At, B1); PG8_BAR; PG8_SCHED;
            PG8_LDB(B0, 1, 0); PG8_LDB(B1, 1, 1); PG8_SCHED; PG8_LDA(At, 1, 0); PG8_STAGE(PG8_SA(0, 1), a2, vA[1]);
            PG8_WAIT_V(8); PG8_WAIT_L(0); PG8_BAR; PG8_MMA(0, 0, At, B0); PG8_MMA(0, 1, At, B1); PG8_BAR; PG8_SCHED;
            PG8_LDA(At, 1, 1); PG8_STAGE(PG8_SB(1, 0), b3, vB[0]); PG8_STAGE(PG8_SB(1, 1), b3, vB[1]); PG8_STAGE(PG8_SA(1, 0), a3, vA[0]);
            PG8_WAIT_V(8); PG8_WAIT_L(0); PG8_BAR; PG8_MMA(1, 0, At, B0); PG8_MMA(1, 1, At, B1); PG8_BAR; PG8_SCHED;
        }
        if (wr == 0) PG8_BAR;
        E(acc, cur, wr, wc, fr, fq);
        if (!has_next) break;
#pragma unroll
        for (int a = 0; a < 2; ++a)
#pragma unroll
            for (int b = 0; b < 2; ++b)
#pragma unroll
                for (int m = 0; m < 4; ++m)
#pragma unroll
                    for (int n = 0; n < 2; ++n) acc[a][b][m][n] = (f32x4){0.f, 0.f, 0.f, 0.f};
        cur = nxt; cA = nA; cB = nB; ++ui;
        if (wr == 1) PG8_BAR;
    }
    PG8_WAIT_V(0);
    PG8_BAR;
#undef PG8_SA
#undef PG8_SB
#undef PG8_STAGE
#undef PG8_LDA
#undef PG8_LDB
#undef PG8_MMA
#undef PG8_WAIT_V
#undef PG8_WAIT_L
#undef PG8_BAR
#undef PG8_SCHED
}
}
using pg8::GUnit;

namespace att {
constexpr int D = 128, NW = 8, QBLK = 32, KVBLK = 64;
constexpr float SCALE = 0.088388347648318440f;
constexpr float THR = 8.f;
constexpr int LDQ = DM, LDK = DM, LDO = 2 * DM;
constexpr size_t SHM_V = KVBLK * D * 2, SHM_K = KVBLK * D * 2, SHM_ATTN = 2 * SHM_V + 2 * SHM_K + NW * 64 * 4;
#define KSWZ(row, colB) ((row) * 256 + ((colB) ^ (((row) & 7) << 4)))
#define SBAR() __builtin_amdgcn_sched_barrier(0)
__device__ __forceinline__ int crow(int r, int hi) { return (r & 3) + 8 * (r >> 2) + 4 * hi; }
__device__ __forceinline__ unsigned cvtpk(float lo, float hi) { unsigned r; asm volatile("v_cvt_pk_bf16_f32 %0, %1, %2" : "=v"(r) : "v"(lo), "v"(hi)); return r; }
__device__ __forceinline__ void partialSM(f32x16& p0, f32x16& p1, float mnC) {
  constexpr float C = SCALE * 1.4426950408889634f;
  for (int r = 0; r < 16; ++r) p0[r] = fmaf(p0[r], C, mnC); for (int r = 0; r < 16; ++r) p1[r] = fmaf(p1[r], C, mnC);
  for (int r = 0; r < 16; ++r) p0[r] = __builtin_amdgcn_exp2f(p0[r]);
}
__device__ __forceinline__ void finishSM(f32x16& p0, f32x16& p1, float& l_reg, bf16x8& pa0, bf16x8& pa1, bf16x8& pa2, bf16x8& pa3) {
  for (int r = 0; r < 16; ++r) p1[r] = __builtin_amdgcn_exp2f(p1[r]);
  float ps = 0; for (int r = 0; r < 16; ++r) ps += p0[r]; for (int r = 0; r < 16; ++r) ps += p1[r];
  l_reg += ps;
#define PK4(P, BASE, OUT) do { unsigned a0 = cvtpk(P[BASE + 0], P[BASE + 1]), a1 = cvtpk(P[BASE + 2], P[BASE + 3]);   \
    unsigned b0 = cvtpk(P[BASE + 4], P[BASE + 5]), b1 = cvtpk(P[BASE + 6], P[BASE + 7]);                              \
    auto r0 = __builtin_amdgcn_permlane32_swap(a0, b0, false, false); auto r1 = __builtin_amdgcn_permlane32_swap(a1, b1, false, false); \
    u32x4 w = {r0[0], r1[0], r0[1], r1[1]}; OUT = *reinterpret_cast<bf16x8*>(&w); } while (0)
  PK4(p0, 0, pa0); PK4(p0, 8, pa1); PK4(p1, 0, pa2); PK4(p1, 8, pa3);
#undef PK4
}
__device__ __forceinline__ void qkt(f32x16& p0, f32x16& p1, const bf16_t* Ks, const bf16x8* qr, int r32, int hi) {
  p0 = f32x16{}; p1 = f32x16{};
  for (int d0 = 0; d0 < 8; ++d0) { int cb = (d0 * 16 + hi * 8) * 2;
    bf16x8 b0 = *reinterpret_cast<const bf16x8*>((const char*)Ks + KSWZ(r32, cb));
    bf16x8 b1 = *reinterpret_cast<const bf16x8*>((const char*)Ks + KSWZ(32 + r32, cb));
    p0 = __builtin_amdgcn_mfma_f32_32x32x16_bf16(b0, qr[d0], p0, 0, 0, 0);
    p1 = __builtin_amdgcn_mfma_f32_32x32x16_bf16(b1, qr[d0], p1, 0, 0, 0); }
}
__device__ __forceinline__ int v_st(int k, int c) { const int kk = (k & ~0xC) | ((k & 4) << 1) | ((k & 8) >> 1); return ((kk >> 3) * 4 + (c >> 5)) * 512 + ((kk & 7) * 32 + (c & 31)) * 2; }
__device__ __forceinline__ int v_rd_base(int lane) { return ((lane & 3) << 3) | (((lane >> 2) & 3) << 6) | (((lane >> 4) & 1) << 5) | (((lane >> 5) & 1) << 8); }
constexpr int v_rd_off(int d0, int ks, int half) { return d0 * 512 + ks * 4096 + half * 2048; }
template <int OFF> __device__ __forceinline__ s16x4 tr_read(int vb) {
  s16x4 r; asm volatile("ds_read_b64_tr_b16 %0, %1 offset:%2" : "=&v"(r) : "v"(vb), "i"(OFF) : "memory"); return r;
}
template <int D0> __device__ __forceinline__ void pv_one(f32x16& od, int vb, bf16x8 pa0, bf16x8 pa1, bf16x8 pa2, bf16x8 pa3) {
  const s16x4 l0 = tr_read<v_rd_off(D0, 0, 0)>(vb), h0 = tr_read<v_rd_off(D0, 0, 1)>(vb), l1 = tr_read<v_rd_off(D0, 1, 0)>(vb), h1 = tr_read<v_rd_off(D0, 1, 1)>(vb);
  const s16x4 l2 = tr_read<v_rd_off(D0, 2, 0)>(vb), h2 = tr_read<v_rd_off(D0, 2, 1)>(vb), l3 = tr_read<v_rd_off(D0, 3, 0)>(vb), h3 = tr_read<v_rd_off(D0, 3, 1)>(vb);
  asm volatile("s_waitcnt lgkmcnt(0)" ::: "memory"); SBAR();
#define PK(L, H) (bf16x8){L[0], L[1], L[2], L[3], H[0], H[1], H[2], H[3]}
  od = __builtin_amdgcn_mfma_f32_32x32x16_bf16(pa0, PK(l0, h0), od, 0, 0, 0);
  od = __builtin_amdgcn_mfma_f32_32x32x16_bf16(pa1, PK(l1, h1), od, 0, 0, 0);
  od = __builtin_amdgcn_mfma_f32_32x32x16_bf16(pa2, PK(l2, h2), od, 0, 0, 0);
  od = __builtin_amdgcn_mfma_f32_32x32x16_bf16(pa3, PK(l3, h3), od, 0, 0, 0);
#undef PK
}
__device__ __forceinline__ void pv_d0(f32x16* o, int vb, bf16x8 pa0, bf16x8 pa1, bf16x8 pa2, bf16x8 pa3) {
  pv_one<0>(o[0], vb, pa0, pa1, pa2, pa3); pv_one<1>(o[1], vb, pa0, pa1, pa2, pa3); pv_one<2>(o[2], vb, pa0, pa1, pa2, pa3); pv_one<3>(o[3], vb, pa0, pa1, pa2, pa3);
}
__device__ __forceinline__ void attn_dense_body(const bf16_t* Qb, const bf16_t* Kh, const bf16_t* Vh, bf16_t* Ob, int seq, char* lds, float mnC) {
  int tid = threadIdx.x; asm volatile("" : "+v"(tid));
  const int wid = tid >> 6, lane = tid & 63, r32 = lane & 31, hi = lane >> 5;
  bf16_t* V_lds = (bf16_t*)lds; bf16_t* K_lds = (bf16_t*)(lds + 2 * SHM_V);
  float* ws = (float*)(lds + 2 * SHM_V + 2 * SHM_K) + wid * 64; float* li_l = ws;
  float l_reg = 0; f32x16 o[4] = {}; bf16x8 qr[8];
  const bf16_t* Qw = Qb + (long)(wid * QBLK + r32) * LDQ + hi * 8;
#pragma unroll
  for (int d0 = 0; d0 < 8; ++d0) qr[d0] = *reinterpret_cast<const bf16x8*>(Qw + d0 * 16);
  const int sr = tid >> 4, sc = (tid & 15) * 8, vst0 = v_st(sr, sc), vst1 = v_st(32 + sr, sc);
  const int vb0 = (int)(uintptr_t)V_lds + v_rd_base(lane);
  struct { bf16x8 vs0, vs1, ks0, ks1; } sr_[1];
  const unsigned goff = (unsigned)(sr * LDK + sc) * 2u;
#define SLOAD(i, k0) do { const char* vb_ = (const char*)Vh + (size_t)(k0) * (LDK * 2); const char* kb_ = (const char*)Kh + (size_t)(k0) * (LDK * 2); \
    sr_[i].vs0 = *reinterpret_cast<const bf16x8*>(vb_ + goff); sr_[i].vs1 = *reinterpret_cast<const bf16x8*>(vb_ + 32 * LDK * 2 + goff); \
    sr_[i].ks0 = *reinterpret_cast<const bf16x8*>(kb_ + goff); sr_[i].ks1 = *reinterpret_cast<const bf16x8*>(kb_ + 32 * LDK * 2 + goff); } while (0)
#define SWRITE(b, i) do { *(bf16x8*)((char*)V_lds + (b) * SHM_V + vst0) = sr_[i].vs0;          \
    *(bf16x8*)((char*)V_lds + (b) * SHM_V + vst1) = sr_[i].vs1; int kc = sc * 2;               \
    *(bf16x8*)((char*)K_lds + (b) * SHM_K + KSWZ(sr, kc)) = sr_[i].ks0;                       \
    *(bf16x8*)((char*)K_lds + (b) * SHM_K + KSWZ(32 + sr, kc)) = sr_[i].ks1; } while (0)
#define SWAIT() asm volatile("s_waitcnt vmcnt(0)" ::: "memory")
  f32x16 pA0, pA1, pB0, pB1; bf16x8 pa0, pa1, pa2, pa3; const int NT = seq / KVBLK;
  constexpr int SE = 0, SO = 0;
  SLOAD(SE, 0); asm volatile("s_waitcnt vmcnt(0)" ::: "memory"); SWRITE(0, SE); __syncthreads();
  qkt(pA0, pA1, K_lds, qr, r32, hi); partialSM(pA0, pA1, mnC);
  SLOAD(SO, KVBLK);
  SWAIT(); SWRITE(1, SO); __syncthreads();
  for (int j = 1; j + 1 < NT; j += 2) {
    SBAR(); qkt(pB0, pB1, (bf16_t*)((char*)K_lds + SHM_K), qr, r32, hi);
    finishSM(pA0, pA1, l_reg, pa0, pa1, pa2, pa3); SBAR();
    SLOAD(SO, (j + 1) * KVBLK); SBAR();
    pv_d0(o, vb0, pa0, pa1, pa2, pa3); partialSM(pB0, pB1, mnC);
    __syncthreads(); SWAIT(); SWRITE(0, SE);
    __syncthreads();
    SBAR(); qkt(pA0, pA1, K_lds, qr, r32, hi);
    finishSM(pB0, pB1, l_reg, pa0, pa1, pa2, pa3); SBAR();
    SLOAD(SE, (j + 2) * KVBLK); SBAR();
    pv_d0(o, vb0 + (int)SHM_V, pa0, pa1, pa2, pa3); partialSM(pA0, pA1, mnC);
    __syncthreads(); SWAIT(); SWRITE(1, SO);
    __syncthreads();
  }
  SBAR(); qkt(pB0, pB1, (bf16_t*)((char*)K_lds + SHM_K), qr, r32, hi);
  finishSM(pA0, pA1, l_reg, pa0, pa1, pa2, pa3); SBAR();
  pv_d0(o, vb0, pa0, pa1, pa2, pa3); partialSM(pB0, pB1, mnC);
  __syncthreads();
  finishSM(pB0, pB1, l_reg, pa0, pa1, pa2, pa3); SBAR();
  pv_d0(o, vb0 + (int)SHM_V, pa0, pa1, pa2, pa3);
  { auto rr = __builtin_amdgcn_permlane32_swap(__float_as_uint(l_reg), __float_as_uint(l_reg), false, false); l_reg = __uint_as_float(rr[0]) + __uint_as_float(rr[1]); }
  if (hi == 0) li_l[r32] = l_reg; asm volatile("s_waitcnt lgkmcnt(0)" ::: "memory");
  float rli[16];
#pragma unroll
  for (int r = 0; r < 16; ++r) rli[r] = __builtin_amdgcn_rcpf(li_l[crow(r, hi)]);
  bf16_t* Ow = Ob + (long)(wid * QBLK) * LDO;
#pragma unroll
  for (int r = 0; r < 16; ++r) { int orow = crow(r, hi);
    for (int d0 = 0; d0 < 4; ++d0) Ow[(long)orow * LDO + d0 * 32 + r32] = (bf16_t)f2bf(o[d0][r] * rli[r]); }
#undef SLOAD
#undef SWRITE
#undef SWAIT
}

constexpr size_t P_V = 0, P_K = 65536, P_X = 98304, P_LI = 131072 + 1024;
__device__ __forceinline__ void attn_pair_body(const bf16_t* Qb, const bf16_t* Kh, const bf16_t* Vh, bf16_t* Ob, int seq, char* lds, float mnC) {
  int tid = threadIdx.x; asm volatile("" : "+v"(tid));
  const int wid = tid >> 6, lane = tid & 63, r32 = lane & 31, hi = lane >> 5, pr = wid & 3, m = wid >> 2;
  char* V_lds = lds + P_V; char* K_lds = lds + P_K; char* X_lds = lds + P_X; float* li_all = (float*)(lds + P_LI);
  float l_reg = 0; f32x16 o[4] = {}; bf16x8 qr[8];
  const bf16_t* Qw = Qb + (long)(pr * QBLK + r32) * LDQ + hi * 8;
#pragma unroll
  for (int d0 = 0; d0 < 8; ++d0) qr[d0] = *reinterpret_cast<const bf16x8*>(Qw + d0 * 16);
  const int sr = tid >> 4, sc = (tid & 15) * 8, vst0 = v_st(sr, sc), vst1 = v_st(32 + sr, sc);
  const int vbm = (int)(uintptr_t)V_lds + m * 16384 + v_rd_base(lane);
  const unsigned goff = (unsigned)(sr * LDK + sc) * 2u;
  const int xw = (int)(pr * 4096 + (2 * m) * 1024 + lane * 16), xr = (int)(pr * 4096 + lane * 16);
  bf16x8 sk0, sk1, sv00, sv01, sv10, sv11;
#define PLOAD(k0) do { const char* vb_ = (const char*)Vh + (size_t)(k0) * (LDK * 2); const char* kb_ = (const char*)Kh + (size_t)(k0) * (LDK * 2); \
    sk0 = *reinterpret_cast<const bf16x8*>(kb_ + goff); sk1 = *reinterpret_cast<const bf16x8*>(kb_ + 32 * LDK * 2 + goff); \
    sv00 = *reinterpret_cast<const bf16x8*>(vb_ + goff); sv01 = *reinterpret_cast<const bf16x8*>(vb_ + goff + 256); \
    sv10 = *reinterpret_cast<const bf16x8*>(vb_ + 32 * LDK * 2 + goff); sv11 = *reinterpret_cast<const bf16x8*>(vb_ + 32 * LDK * 2 + goff + 256); } while (0)
#define PWRITE(b) do { char* vd_ = V_lds + (b) * 32768; char* kd_ = K_lds + (b) * 16384; int kc = sc * 2; \
    *(bf16x8*)(vd_ + vst0) = sv00; *(bf16x8*)(vd_ + 16384 + vst0) = sv01; *(bf16x8*)(vd_ + vst1) = sv10; *(bf16x8*)(vd_ + 16384 + vst1) = sv11; \
    *(bf16x8*)(kd_ + KSWZ(sr, kc)) = sk0; *(bf16x8*)(kd_ + KSWZ(32 + sr, kc)) = sk1; } while (0)
#define PSCORE(b) do { f32x16 p = f32x16{}; const char* kb_ = K_lds + (b) * 16384; \
    _Pragma("unroll") for (int d0 = 0; d0 < 8; ++d0) { const int cb = (d0 * 16 + hi * 8) * 2; \
      const bf16x8 kf = *reinterpret_cast<const bf16x8*>(kb_ + KSWZ(32 * m + r32, cb)); p = __builtin_amdgcn_mfma_f32_32x32x16_bf16(kf, qr[d0], p, 0, 0, 0); } \
    constexpr float C_ = SCALE * 1.4426950408889634f; \
    _Pragma("unroll") for (int r = 0; r < 16; ++r) p[r] = __builtin_amdgcn_exp2f(fmaf(p[r], C_, mnC)); \
    float ps = 0.f; _Pragma("unroll") for (int r = 0; r < 16; ++r) ps += p[r]; l_reg += ps; \
    bf16x8 f0, f1; \
    { unsigned a0 = cvtpk(p[0], p[1]), a1 = cvtpk(p[2], p[3]), b0 = cvtpk(p[4], p[5]), b1 = cvtpk(p[6], p[7]); \
      auto r0 = __builtin_amdgcn_permlane32_swap(a0, b0, false, false); auto r1 = __builtin_amdgcn_permlane32_swap(a1, b1, false, false); u32x4 w = {r0[0], r1[0], r0[1], r1[1]}; f0 = *reinterpret_cast<bf16x8*>(&w); } \
    { unsigned a0 = cvtpk(p[8], p[9]), a1 = cvtpk(p[10], p[11]), b0 = cvtpk(p[12], p[13]), b1 = cvtpk(p[14], p[15]); \
      auto r0 = __builtin_amdgcn_permlane32_swap(a0, b0, false, false); auto r1 = __builtin_amdgcn_permlane32_swap(a1, b1, false, false); u32x4 w = {r0[0], r1[0], r0[1], r1[1]}; f1 = *reinterpret_cast<bf16x8*>(&w); } \
    *(bf16x8*)(X_lds + (b) * 16384 + xw) = f0; *(bf16x8*)(X_lds + (b) * 16384 + xw + 1024) = f1; } while (0)
#define PPV(b) do { const char* xb_ = X_lds + (b) * 16384 + xr; \
    const bf16x8 pa0 = *reinterpret_cast<const bf16x8*>(xb_), pa1 = *reinterpret_cast<const bf16x8*>(xb_ + 1024), pa2 = *reinterpret_cast<const bf16x8*>(xb_ + 2048), pa3 = *reinterpret_cast<const bf16x8*>(xb_ + 3072); \
    pv_d0(o, vbm + (b) * 32768, pa0, pa1, pa2, pa3); } while (0)
  const int NT = seq / KVBLK;
  PLOAD(0); asm volatile("s_waitcnt vmcnt(0)" ::: "memory"); PWRITE(0); __syncthreads();
  PSCORE(0);
  PLOAD(KVBLK); asm volatile("s_waitcnt vmcnt(0)" ::: "memory"); PWRITE(1); __syncthreads();
  for (int j = 1; j + 1 < NT; j += 2) {
    SBAR(); PLOAD((j + 1) * KVBLK); SBAR();
    PSCORE(1); SBAR(); PPV(0);
    __syncthreads(); asm volatile("s_waitcnt vmcnt(0)" ::: "memory"); PWRITE(0); __syncthreads();
    SBAR(); PLOAD((j + 2) * KVBLK); SBAR();
    PSCORE(0); SBAR(); PPV(1);
    __syncthreads(); asm volatile("s_waitcnt vmcnt(0)" ::: "memory"); PWRITE(1); __syncthreads();
  }
  PSCORE(1); SBAR(); PPV(0);
  __syncthreads();
  PPV(1);
  { auto rr = __builtin_amdgcn_permlane32_swap(__float_as_uint(l_reg), __float_as_uint(l_reg), false, false); l_reg = __uint_as_float(rr[0]) + __uint_as_float(rr[1]); }
  if (hi == 0) li_all[wid * 32 + r32] = l_reg;
  __syncthreads();
  float rli[16];
#pragma unroll
  for (int r = 0; r < 16; ++r) { const int q_ = crow(r, hi); rli[r] = __builtin_amdgcn_rcpf(li_all[wid * 32 + q_] + li_all[(wid ^ 4) * 32 + q_]); }
  bf16_t* Ow = Ob + (long)(pr * QBLK) * LDO + m * 128;
#pragma unroll
  for (int r = 0; r < 16; ++r) { int orow = crow(r, hi);
    for (int d0 = 0; d0 < 4; ++d0) Ow[(long)orow * LDO + d0 * 32 + r32] = (bf16_t)f2bf(o[d0][r] * rli[r]); }
  __syncthreads();
#undef PLOAD
#undef PWRITE
#undef PSCORE
#undef PPV
}
#undef KSWZ
#undef SBAR
}


#define XB_TMO      128
#define XB_XCNT(j)  (256  + 64 * (j))
#define XB_XSUB(j)  (1280 + 64 * (j))
#define XB_XGEN(j)  (2304 + 64 * (j))
#define XB_TOP      3328
#define XB_TOPGEN   3392
#define XCD_BAR_WORDS 3456
#define XB_SPIN_CAP (1u << 18)
__device__ __forceinline__ unsigned xb_ld(unsigned* p)              { return __hip_atomic_load(p, __ATOMIC_RELAXED, __HIP_MEMORY_SCOPE_AGENT); }
__device__ __forceinline__ unsigned xb_add(unsigned* p, unsigned v) { return __hip_atomic_fetch_add(p, v, __ATOMIC_RELAXED, __HIP_MEMORY_SCOPE_AGENT); }
__device__ __forceinline__ unsigned xb_xcc_id() { return (unsigned)__builtin_amdgcn_s_getreg((3 << 11) | 20) & 0xFu; }
#define XB_SPIN(cond, bar) do { unsigned _sp = 0; while (cond) { __builtin_amdgcn_s_sleep(1); \
    if ((++_sp & 255u) == 0u) { if (xb_ld(&(bar)[XB_TMO])) break; if (_sp > XB_SPIN_CAP) { atomicAdd(&(bar)[XB_TMO], 1u); break; } } } } while (0)
__device__ __forceinline__ void xcd_barrier_complete(unsigned* bar, unsigned x, unsigned& nloc, unsigned& nx) {
    const unsigned G = gridDim.x * gridDim.y * gridDim.z;
    unsigned sum, cnt, mine, sp = 0u;
    for (;;) {
        sum = 0u; cnt = 0u; mine = 0u;
#pragma unroll
        for (unsigned j = 0; j < 16; ++j) { const unsigned c = xb_ld(&bar[XB_XCNT(j)]); sum += c; cnt += (c > 0u) ? 1u : 0u; mine = (j == x) ? c : mine; }
        if (sum == G) break;
        __builtin_amdgcn_s_sleep(1);
        if ((++sp & 255u) == 0u) { if (xb_ld(&bar[XB_TMO])) break; if (sp > XB_SPIN_CAP) { atomicAdd(&bar[XB_TMO], 1u); break; } }
    }
    nloc = mine > 0u ? mine : 1u; nx = cnt > 0u ? cnt : 1u;
}
__device__ __forceinline__ void xcd_barrier(unsigned* bar, volatile LAS unsigned* st) {
    asm volatile("s_waitcnt vmcnt(0)" ::: "memory");
    __syncthreads();
    if (threadIdx.x == 0) {
        const unsigned x = xb_xcc_id();
        __builtin_amdgcn_s_waitcnt(0);
        unsigned nloc = st[0], nx = st[1];
        if (nloc == 0u) { xcd_barrier_complete(bar, x, nloc, nx); st[0] = nloc; st[1] = nx; }
        const unsigned old = xb_add(&bar[XB_XSUB(x)], 1u);
        const unsigned gen = old / nloc;
        if (old + 1u == (gen + 1u) * nloc) {
            __builtin_amdgcn_fence(__ATOMIC_RELEASE, "agent");
            asm volatile("s_waitcnt vmcnt(0)" ::: "memory");
            const unsigned og = xb_add(&bar[XB_TOP], 1u);
            const unsigned tg = og / nx;
            if (og + 1u == (tg + 1u) * nx) xb_add(&bar[XB_TOPGEN], 1u);
            else XB_SPIN(xb_ld(&bar[XB_TOPGEN]) == tg, bar);
            __builtin_amdgcn_fence(__ATOMIC_ACQUIRE, "agent");
            xb_add(&bar[XB_XGEN(x)], 1u);
            asm volatile("s_waitcnt vmcnt(0)" ::: "memory");
        } else {
            XB_SPIN(xb_ld(&bar[XB_XGEN(x)]) == gen, bar);
            __builtin_amdgcn_fence(__ATOMIC_ACQUIRE, "agent");
            asm volatile("s_waitcnt vmcnt(0)" ::: "memory");
        }
    }
    __syncthreads();
}

struct Args;
typedef const __attribute__((address_space(4))) Args* KArgsP;
struct Args {
    const float *x, *c, *ctx, *c_ctx, *norm1_w, *norm2_w, *w_mod, *b_mod, *even_w_in, *even_conv_w, *even_w_out, *odd_w_qkv, *odd_q_norm, *odd_k_norm,
                *lq1, *lk1, *lq2, *lk2, *subln_w, *odd_w_out, *moe_w_group, *moe_b_group, *moe_w_expert, *moe_b_expert, *moe_w_gate, *moe_w_up, *moe_w_down;
    float* out; unsigned char* ws; int ph_lo, ph_hi;
};

__device__ __forceinline__ KArgsP kargs() { KArgsP p = (KArgsP)__builtin_amdgcn_kernarg_segment_ptr(); asm volatile("" : "+s"(p)); return p; }

__device__ __forceinline__ void transpose_item(const float* W, int ldw, int K, bf16_t* WT, int dst_row0, int k0, int n0, LAS float* scr, int lane) {
#pragma unroll 8
    for (int i = 0; i < 32; ++i) { const int kk = 2 * i + (lane >> 5); scr[kk * 33 + (lane & 31)] = W[(size_t)(k0 + kk) * ldw + n0 + (lane & 31)]; }
    asm volatile("s_waitcnt lgkmcnt(0)" ::: "memory");
    const int c = lane & 7;
#pragma unroll
    for (int j = 0; j < 4; ++j) { const int n = (lane >> 3) + 8 * j; const LAS float* s = scr + (8 * c) * 33 + n;
        u32x4 o; o.x = pk2(s[0 * 33], s[1 * 33]); o.y = pk2(s[2 * 33], s[3 * 33]); o.z = pk2(s[4 * 33], s[5 * 33]); o.w = pk2(s[6 * 33], s[7 * 33]);
        *(u32x4*)(WT + (size_t)(dst_row0 + n) * K + k0 + 8 * c) = o; }
    asm volatile("s_waitcnt lgkmcnt(0)" ::: "memory");
}
__device__ __forceinline__ void moe_weight_items(const float* w_gate, const float* w_up, const float* w_down, unsigned char* ws, int l, int gw, int ngw, LAS float* scr, int lane) {
    bf16_t* WGU = (bf16_t*)(ws + WS_WGU); bf16_t* WD = (bf16_t*)(ws + WS_WD);
    constexpr int I_G = NEXP * 32 * 16, I_D = NEXP * 8 * 64;
    for (int it = gw; it < 2 * I_G + I_D; it += ngw) {
        if (it < 2 * I_G) { const int up = it >= I_G, r = up ? it - I_G : it, e = r / 512, kb = (r % 512) / 16, nb = r % 16;
            const float* W = (up ? w_up : w_gate) + ((size_t)l * NEXP + e) * DM * EFF;
            const int n0 = nb * 32, row0 = e * 1024 + (n0 >> 7) * 256 + up * 128 + (n0 & 127);
            transpose_item(W, EFF, DM, WGU, row0, kb * 64, n0, scr, lane);
        } else { const int r = it - 2 * I_G, e = r / 512, kb = (r % 512) / 64, nb = r % 64;
            const float* W = w_down + ((size_t)l * NEXP + e) * EFF * DM;
            transpose_item(W, DM, EFF, WD, e * DM + nb * 32, kb * 64, nb * 32, scr, lane); }
    }
}

__device__ __forceinline__ void plain_store(GUnit& u, int ldc) { u.ldc = ldc; u.rs1 = 64 * ldc; u.rs2 = ldc; u.cs = 64; u.nrow = 256; u.bperm = 0; }
struct SchedInProj {
    const char *u0, *win; char *P, *zt2, *ztc; int G, c;
    __device__ __forceinline__ bool next(int i, GUnit& u) const {
        const int L = i * G + c; if (L >= 816 + 544) return false;
        u.lda = DM * 2; u.ldb = DM * 2; u.nt = DM / 64; u.scale = 1.f;
        if (L < 816) { int pm, pn; pg8::tile_of(L, 68, 12, pm, pn);
            u.A = u0 + (size_t)pm * 256 * DM * 2; u.B = win + (size_t)pn * 256 * DM * 2; u.O = P + ((size_t)pm * 256 * 3072 + pn * 256) * 2; plain_store(u, 3072);
        } else { int pm, pn; pg8::tile_of(L - 816, 8, 68, pm, pn);
            u.A = win + (size_t)(3072 + pm * 256) * DM * 2;
            const int g = pm >> 1, part = pm & 1, b = pn / 17, jt = pn % 17;
            if (jt == 0) { u.B = u0 + (size_t)pn * 256 * DM * 2; u.O = ztc + ((size_t)((b * 4 + g) * 256) * 512 + part * 256) * 2; plain_store(u, 512); }
            else { const int tq = jt - 1;
                u.B = u0 + (size_t)(b * TPB + CTX + 4 * tq) * DM * 2;
                u.O = zt2 + (((size_t)((b * 4 + g) * 256) * 64 + 4 * tq) * 128 + part * 64) * 2;
                u.ldc = 8192; u.rs1 = 64 * 8192; u.rs2 = 8192; u.cs = 128; u.nrow = 256; u.bperm = 1; } }
        return true;
    }
};
struct SchedFftA {
    const char *ma, *cmatc, *zt2, *ztc; char *uf, *ycat; int G, c;
    __device__ __forceinline__ bool next(int i, GUnit& u) const {
        const int L = i * G + c; if (L >= 1024 + 16) return false;
        if (L < 1024) { const int w = (L % 8) * 128 + L / 8, bg = w >> 6, chq = w & 63;
            u.A = ma; u.lda = 256; u.B = zt2 + (size_t)((bg * 256 + 4 * chq) * 64) * 256; u.ldb = 256; u.nt = 2;
            u.O = uf + (size_t)(bg * 256 + 4 * chq) * 8192 * 2; u.ldc = 64; u.rs1 = 4096; u.rs2 = 64; u.cs = 8192; u.nrow = 128; u.bperm = 0; u.scale = 1.f;
        } else { const int bg = L - 1024, b = bg >> 2, g = bg & 3;
            u.A = cmatc; u.B = ztc + (size_t)bg * 256 * 1024; u.lda = 1024; u.ldb = 1024; u.nt = 8;
            u.O = ycat + ((size_t)(b * TPB) * DM + 1024 + g * 256) * 2; plain_store(u, DM); u.scale = 1.0f / 256.0f; }
        return true;
    }
};
struct SchedFftB {
    const char *mb, *uf; char* ycat; int G, c;
    __device__ __forceinline__ bool next(int i, GUnit& u) const {
        const int L = i * G + c; if (L >= 256) return false;
        const int w = (L % 8) * 32 + L / 8, bg = w >> 4, kb = w & 15, b = bg >> 2, g = bg & 3;
        u.A = mb + (size_t)kb * 256 * 1024; u.lda = 1024; u.B = uf + ((size_t)bg * 256 * 8192 + kb * 512) * 2; u.ldb = 16384; u.nt = 8;
        u.O = ycat + ((size_t)(b * TPB + CTX + 4 * kb) * DM + 1024 + g * 256) * 2; u.ldc = DM; u.rs1 = DM; u.rs2 = 64 * DM; u.cs = 64; u.nrow = 256; u.bperm = 0; u.scale = 1.0f / 1024.0f;
        return true;
    }
};
struct SchedOut0 {
    const char *ycat, *wout; const float *x, *ctx, *mod; char* h; int G, c;
    __device__ __forceinline__ bool next(int i, GUnit& u) const {
        const int L = i * G + c; if (L >= 68 * 8) return false;
        int pm, pn; pg8::tile_of(L, 68, 8, pm, pn);
        u.A = ycat + (size_t)pm * 256 * DM * 2; u.B = wout + (size_t)pn * 256 * DM * 2; u.lda = DM * 2; u.ldb = DM * 2; u.nt = DM / 64;
        const int b = pm / 17, jt = pm % 17, v = (jt == 0) ? 4 : b;
        u.src = (const char*)((jt == 0 ? ctx + (size_t)b * CTX * DM : x + ((size_t)b * SEQ + (jt - 1) * 256) * DM) + pn * 256);
        u.gate = mod + (size_t)v * MODSZ + 2 * DM + pn * 256;
        u.O = h + ((size_t)pm * 256 * DM + pn * 256) * 4; u.bperm = 0;
        return true;
    }
};
struct SchedOut1 {
    const char *a, *wout; const float* mod; char* h; int G, c;
    __device__ __forceinline__ bool next(int i, GUnit& u) const {
        const int L = i * G + c; if (L >= 64 * 8) return false;
        int lt, pn; pg8::tile_of(L, 64, 8, lt, pn);
        const int b = lt >> 4, ut = b * 17 + 1 + (lt & 15);
        u.A = a + (size_t)ut * 256 * DM * 2; u.B = wout + (size_t)pn * 256 * DM * 2; u.lda = DM * 2; u.ldb = DM * 2; u.nt = DM / 64;
        u.bperm = 0; u.O = h + ((size_t)ut * 256 * DM + pn * 256) * 4; u.src = u.O; u.gate = mod + (size_t)b * MODSZ + 2 * DM + pn * 256;
        return true;
    }
};
struct SchedQKV {
    const char *u1, *wqkv; char *q; int G, c;
    __device__ __forceinline__ bool next(int i, GUnit& u) const {
        const int L = i * G + c; if (L >= 1536 + 64) return false;
        int ut, pn;
        if (L < 1536) { int lt; pg8::tile_of(L, 64, 24, lt, pn); ut = (lt >> 4) * 17 + 1 + (lt & 15); }
        else { const int r = L - 1536; ut = (r & 3) * 17; pn = 8 + (r >> 2); }
        u.A = u1 + (size_t)ut * 256 * DM * 2; u.B = wqkv + (size_t)pn * 256 * DM * 2; u.lda = DM * 2; u.ldb = DM * 2; u.nt = DM / 64; u.scale = 1.f; plain_store(u, DM);
        u.O = q + (size_t)(pn >> 3) * (WS_K - WS_Q) + ((size_t)ut * 256 * DM + (pn & 7) * 256) * 2;
        return true;
    }
};
struct MoeTiles {
    const LAS int* tab;
    __device__ __forceinline__ void init(LAS int* t, const unsigned* cntp) {
        tab = t;
        if (threadIdx.x == 0) { int s = 0;
            for (int e = 0; e < NEXP; ++e) { const int c = (int)cntp[e]; t[e] = c; t[16 + e] = s; s += (c + 255) >> 8; }
            t[32] = s; }
        __syncthreads();
    }
    __device__ __forceinline__ int total() const { return __builtin_amdgcn_readfirstlane(tab[32]); }
    __device__ __forceinline__ void find(int rtg, int& e, int& rt, int& gc) const {
        int ee = 0;
#pragma unroll
        for (int j = 1; j < NEXP; ++j) if (rtg >= tab[16 + j]) ee = j;
        e = __builtin_amdgcn_readfirstlane(ee);
        const int tbe = __builtin_amdgcn_readfirstlane(tab[16 + e]), ce = __builtin_amdgcn_readfirstlane(tab[e]);
        rt = rtg - tbe; gc = ce - rt * 256; if (gc > 256) gc = 256;
    }
};
struct SchedMoe1 {
    MoeTiles T; const char *v, *wgu; char* hid; const int* lst; int G, c;
    __device__ __forceinline__ bool next(int i, GUnit& u) const {
        const int L = i * G + c, nwg = T.total() * 4; if (L >= nwg) return false;
        const int w = pg8::xcd_remap(L, nwg), rtg = w >> 2, pn = w & 3; int e, rt, gc; T.find(rtg, e, rt, gc);
        u.A = v; u.lda = DM * 2; u.glist = lst + (size_t)e * LCAP + rt * 256; u.gcount = gc;
        u.B = wgu + ((size_t)e * 1024 + pn * 256) * DM * 2; u.ldb = DM * 2; u.nt = DM / 64;
        u.O = hid + ((size_t)rtg * 256 * EFF + pn * 128) * 2; u.ldc = EFF; u.bperm = 0;
        return true;
    }
};
struct SchedMoe2 {
    MoeTiles T; const char *hid, *wd; const int* lst; int G, c;
    __device__ __forceinline__ bool next(int i, GUnit& u) const {
        const int L = i * G + c, nwg = T.total() * 8; if (L >= nwg) return false;
        const int w = pg8::xcd_remap(L, nwg), rtg = w >> 3, pn = w & 7; int e, rt, gc; T.find(rtg, e, rt, gc);
        u.A = hid + (size_t)rtg * 256 * EFF * 2; u.lda = EFF * 2; u.B = wd + ((size_t)e * DM + pn * 256) * EFF * 2; u.ldb = EFF * 2; u.nt = EFF / 64;
        u.glist = lst + (size_t)e * LCAP + rt * 256; u.gcount = gc; u.aux = pn; u.bperm = 0;
        return true;
    }
};

__device__ __forceinline__ void row_info(int row, int& b, int& j) { b = row / TPB; j = row - b * TPB; }

__device__ __forceinline__ void norm_mod_store(const f32x4 (&v)[8], float rstd, const float* nw, const float* sc, const float* sh, bf16_t* orow, int lane) {
#pragma unroll
    for (int jj = 0; jj < 8; ++jj) { const int k = 4 * lane + 256 * jj;
        const f32x4 w = *(const f32x4*)(nw + k), s = *(const f32x4*)(sc + k), t = *(const f32x4*)(sh + k);
        const f32x4 y = v[jj] * rstd * w * (1.0f + s) + t;
        u32x2 o; o.x = pk2(y[0], y[1]); o.y = pk2(y[2], y[3]); *(u32x2*)(orow + k) = o; }
}

__device__ __forceinline__ void route_row(const LAS float* yl, const float* wg, const float* bg, const float* we, const float* be, int lane, int& e0, int& e1, float& w0, float& w1) {
    float lg[4] = {0.f, 0.f, 0.f, 0.f}; float le[16];
#pragma unroll
    for (int n = 0; n < 16; ++n) le[n] = 0.f;
#pragma unroll 1
    for (int jj = 0; jj < 8; ++jj) { const f32x4 y4 = *(const LAS f32x4*)(yl + 4 * lane + 256 * jj);
#pragma unroll
        for (int i = 0; i < 4; ++i) { const int k = 4 * lane + 256 * jj + i; const float xv = y4[i];
            const f32x4 g = *(const f32x4*)(wg + (size_t)k * 4);
#pragma unroll
            for (int n = 0; n < 4; ++n) lg[n] = fmaf(xv, g[n], lg[n]);
#pragma unroll
            for (int q = 0; q < 4; ++q) { const f32x4 ev = *(const f32x4*)(we + (size_t)k * 16 + 4 * q);
#pragma unroll
                for (int n = 0; n < 4; ++n) le[4 * q + n] = fmaf(xv, ev[n], le[4 * q + n]); } } }
#pragma unroll
    for (int n = 0; n < 4; ++n) lg[n] = wave_sum(lg[n]) + bg[n];
#pragma unroll
    for (int n = 0; n < 16; ++n) le[n] = wave_sum(le[n]) + be[n];
    int gi = 0; float gm = lg[0];
#pragma unroll
    for (int n = 1; n < 4; ++n) if (lg[n] > gm) { gm = lg[n]; gi = n; }
    float den = 0.f;
#pragma unroll
    for (int n = 0; n < 4; ++n) den += __expf(lg[n] - gm);
    const float gw = 1.0f / den;
    float s[4];
#pragma unroll
    for (int n = 0; n < 4; ++n) { const float m0 = (gi == 0) ? 1.f : 0.f, m1 = (gi == 1) ? 1.f : 0.f, m2 = (gi == 2) ? 1.f : 0.f, m3 = (gi == 3) ? 1.f : 0.f; s[n] = le[n] * m0 + le[4 + n] * m1 + le[8 + n] * m2 + le[12 + n] * m3; }
    int i0 = 0; float v0 = s[0];
#pragma unroll
    for (int n = 1; n < 4; ++n) if (s[n] > v0) { v0 = s[n]; i0 = n; }
    int i1 = -1; float v1 = -3.0e38f;
#pragma unroll
    for (int n = 0; n < 4; ++n) if (n != i0 && s[n] > v1) { v1 = s[n]; i1 = n; }
    const float ex = __expf(v1 - v0), inv = 1.0f / (1.0f + ex);
    e0 = gi * 4 + i0; e1 = gi * 4 + i1; w0 = inv * gw; w1 = ex * inv * gw;
}

#define PHASE_BEGIN KArgsP ka = kargs(); unsigned char* ws = ka->ws; (void)ws; int tid = threadIdx.x; asm volatile("" : "+v"(tid)); const int lane = tid & 63, wave = __builtin_amdgcn_readfirstlane(tid >> 6), gw = blk * NWAVES + wave; (void)lane; (void)gw;
#define ctl ((unsigned*)(ws + WS_CTL))
#define mod ((float*)(ws + WS_MOD))
#define tokw ((float*)(ws + WS_TOKW))
#define list ((int*)(ws + WS_LIST))
#define WIN ((bf16_t*)(ws + WS_WIN))
#define WOUT0 ((bf16_t*)(ws + WS_WOUT0))
#define WQKV ((bf16_t*)(ws + WS_WQKV))
#define WOUT1 ((bf16_t*)(ws + WS_WOUT1))
#define CMAT ((bf16_t*)(ws + WS_CMAT))
#define CMATC ((bf16_t*)(ws + WS_CMATC))
#define H ((float*)(ws + WS_H))
#define U ((bf16_t*)(ws + WS_U))
#define PB ((bf16_t*)(ws + WS_P))
#define YCAT ((bf16_t*)(ws + WS_YCAT))
#define QB ((bf16_t*)(ws + WS_Q))
#define KB ((bf16_t*)(ws + WS_K))
#define VB ((bf16_t*)(ws + WS_V))
#define AB ((bf16_t*)(ws + WS_A))
#define YB ((bf16_t*)(ws + WS_Y))
#define OB ((bf16_t*)(ws + WS_O))
#ifndef PHMASK
#define PHMASK 0x3ffff
#endif
#define PHON(k) (((PHMASK) >> (k)) & 1)
#define IN(k) (lo <= (k) && (k) < hi)
#ifndef XSYNC
#define XSYNC 0
#endif
#define BARW ((unsigned*)(kargs()->ws + WS_CTL) + 4096)
#define BARST ((volatile LAS unsigned*)(lds + RING_BYTES + 512))
#define SYNC(k) do { if (IN(k) && IN((k) + 1)) { \
        if ((k) == 0) { grid.sync(); if (threadIdx.x == 0) (void)xb_add(&BARW[XB_XCNT(xb_xcc_id())], 1u); }     \
        else xcd_barrier(BARW, BARST); \
        if ((k) == 1) for (int xs_ = 0; xs_ < XSYNC; ++xs_) xcd_barrier(BARW, BARST); } } while (0)
#define TS(k) do { if (PROBE && blockIdx.x == 0 && threadIdx.x == 0) { const unsigned long long t_ = __builtin_amdgcn_s_memrealtime(); unsigned long long* tp_ = (unsigned long long*)(kargs()->ws + WS_CTL + 1024); \
        if ((k) == PA0) tp_[0] = t_; if ((k) == PA1) tp_[1] = t_; if ((k) == PB0) tp_[2] = t_; if ((k) == PB1) tp_[3] = t_; } } while (0)
template <int l>
__device__ __forceinline__ void moe_layer(cg::grid_group& grid, LAS unsigned char* lds, int lo, int hi, int G, int blk) {
    const int pb = (l == 0) ? 5 : 14;
#define cnt (ctl + 32 * l)
#define modl (mod + (size_t)l * 5 * MODSZ)
        TS(pb);
        if (PHON(5) && IN(pb)) REPS(5) { PHASE_BEGIN
            LAS int* ri = (LAS int*)lds;
            LAS float* part = (LAS float*)(lds + 4096);
            LAS float* ssq = (LAS float*)(lds + 16384);
            LAS float* rstdL = (LAS float*)(lds + 16896);
            LAS float* red = (LAS float*)(lds + 17408);
            const int ntiles = (l == 0 ? NTOK : NLAT) / 16, t0 = (ntiles * blk) / G, t1 = (ntiles * (blk + 1)) / G;
            const float* wg = ka->moe_w_group + (size_t)l * DM * 4; const float* bgp = ka->moe_b_group + l * 4;
            const float* we = ka->moe_w_expert + (size_t)l * DM * 16; const float* bep = ka->moe_b_expert + l * 16;
            const float* nw = ka->norm2_w + l * DM;
            const float* cbuf = (const float*)(ctl + 8192) + (size_t)l * 5 * 32;
            const int r = lane & 15, q = lane >> 4, K0 = wave * 256;
            float Be[16][4], Bg[16][4]; int curv = -1;
            for (int t = t0; t < t1; ++t) {
                const int row0 = (l == 0) ? t * 16 : ((t * 16) / SEQ) * TPB + CTX + ((t * 16) % SEQ);
                int b, j; row_info(row0, b, j); const int v = (j < CTX) ? 4 : b;
                const float* mv = modl + (size_t)v * MODSZ;
                if (v != curv) { curv = v;
                    gcf wep = (gcf)(we + (size_t)(K0 + 4 * q) * 16 + r); gcf wgp = (gcf)(wg + (size_t)(K0 + 4 * q) * 4 + (r & 3));
                    gcf nwp = (gcf)(nw + K0 + 4 * q); gcf scp = (gcf)(mv + 4 * DM + K0 + 4 * q); const float gmask = (r < 4) ? 1.f : 0.f;
#pragma unroll
                    for (int c = 0; c < 16; ++c) { const f32x4 w4 = *(const __attribute__((address_space(1))) f32x4*)nwp, s4 = *(const __attribute__((address_space(1))) f32x4*)scp;
#pragma unroll
                        for (int s_ = 0; s_ < 4; ++s_) { const float av = w4[s_] * (1.0f + s4[s_]); Be[c][s_] = av * wep[s_ * 16]; Bg[c][s_] = av * gmask * wgp[s_ * 4]; }
                        wep += 256; wgp += 64; nwp += 16; scp += 16; asm volatile("" : "+v"(wep), "+v"(wgp), "+v"(nwp), "+v"(scp) :: "memory"); } }
                const float* hrow = H + (size_t)(row0 + r) * DM + K0 + 4 * q;
                f32x4 ae = {0.f, 0.f, 0.f, 0.f}, ag = {0.f, 0.f, 0.f, 0.f}; float ss = 0.f;
#pragma unroll
                for (int hf = 0; hf < 2; ++hf) { f32x4 Av[8];
#pragma unroll
                    for (int c = 0; c < 8; ++c) Av[c] = *(const f32x4*)(hrow + 16 * (8 * hf + c));
#pragma unroll
                    for (int c = 0; c < 8; ++c)
#pragma unroll
                        for (int s_ = 0; s_ < 4; ++s_) { const float x = Av[c][s_]; ss = fmaf(x, x, ss);
                            ae = __builtin_amdgcn_mfma_f32_16x16x4f32(x, Be[8 * hf + c][s_], ae, 0, 0, 0); ag = __builtin_amdgcn_mfma_f32_16x16x4f32(x, Bg[8 * hf + c][s_], ag, 0, 0, 0); }
                    asm volatile("" ::: "memory"); }
                ss += __shfl_xor(ss, 16); ss += __shfl_xor(ss, 32);
                if (q == 0) ssq[wave * 16 + r] = ss;
#pragma unroll
                for (int g_ = 0; g_ < 4; ++g_) { part[(wave * 16 + 4 * q + g_) * 20 + r] = ae[g_]; if (r < 4) part[(wave * 16 + 4 * q + g_) * 20 + 16 + r] = ag[g_]; }
                __syncthreads();
                if (tid < 320) { float p = 0.f;
#pragma unroll
                    for (int w = 0; w < 8; ++w) p += part[w * 320 + tid];
                    red[tid] = p; }
                __syncthreads();
                if (tid < 16) { float sum = 0.f;
#pragma unroll
                    for (int w = 0; w < 8; ++w) sum += ssq[w * 16 + tid];
                    const float rstd = rsqrtf(sum * (1.0f / DM) + EPS); rstdL[tid] = rstd;
                    float lg[20];
#pragma unroll
                    for (int n = 0; n < 20; ++n) lg[n] = rstd * red[tid * 20 + n] + cbuf[v * 32 + n];
                    int gi = 0; float gm = lg[16];
#pragma unroll
                    for (int n = 1; n < 4; ++n) if (lg[16 + n] > gm) { gm = lg[16 + n]; gi = n; }
                    float den = 0.f;
#pragma unroll
                    for (int n = 0; n < 4; ++n) den += __expf(lg[16 + n] - gm);
                    const float gwt = 1.0f / den; float sv[4];
#pragma unroll
                    for (int n = 0; n < 4; ++n) { const float m0 = (gi == 0) ? 1.f : 0.f, m1 = (gi == 1) ? 1.f : 0.f, m2 = (gi == 2) ? 1.f : 0.f, m3 = (gi == 3) ? 1.f : 0.f; sv[n] = lg[n] * m0 + lg[4 + n] * m1 + lg[8 + n] * m2 + lg[12 + n] * m3; }
                    int i0 = 0; float v0 = sv[0];
#pragma unroll
                    for (int n = 1; n < 4; ++n) if (sv[n] > v0) { v0 = sv[n]; i0 = n; }
                    int i1 = -1; float v1 = -3.0e38f;
#pragma unroll
                    for (int n = 0; n < 4; ++n) if (n != i0 && sv[n] > v1) { v1 = sv[n]; i1 = n; }
                    const float ex = __expf(v1 - v0), inv = 1.0f / (1.0f + ex);
                    const int row = row0 + tid, ix = (t - t0) * 16 + tid;
                    ri[ix * 4 + 0] = gi * 4 + i0; ri[ix * 4 + 1] = gi * 4 + i1; ri[ix * 4 + 2] = row * 2; ri[ix * 4 + 3] = row * 2 + 1;
                    tokw[row * 2] = inv * gwt; tokw[row * 2 + 1] = ex * inv * gwt; }
                __syncthreads();
                { const float rstd = rstdL[r]; gbf up = (gbf)(U + (size_t)(row0 + r) * DM + K0 + 4 * q); gcf hp = (gcf)hrow;
                    gcf nwp = (gcf)(nw + K0 + 4 * q); gcf scp = (gcf)(mv + 4 * DM + K0 + 4 * q); gcf shp = (gcf)(mv + 3 * DM + K0 + 4 * q);
#pragma unroll
                    for (int c = 0; c < 16; ++c) { typedef const __attribute__((address_space(1))) f32x4* g4; const f32x4 w4 = *(g4)nwp, s4 = *(g4)scp, t4 = *(g4)shp;
                        const f32x4 y = *(g4)hp * rstd * w4 * (1.0f + s4) + t4;
                        u32x2 o; o.x = pk2(y[0], y[1]); o.y = pk2(y[2], y[3]); *(__attribute__((address_space(1))) u32x2*)up = o;
                        nwp += 16; scp += 16; shp += 16; hp += 16; up += 16;
                        if ((c & 3) == 3) asm volatile("" : "+v"(nwp), "+v"(scp), "+v"(shp), "+v"(hp), "+v"(up) :: "memory"); } }
            }
            __syncthreads();
            const int nrb = (t1 - t0) * 16;
            if (tid < NEXP) { int n = 0;
                for (int i = 0; i < nrb; ++i) { n += (ri[i * 4] == tid) + (ri[i * 4 + 1] == tid); }
                int* lp = list + (rep_ ? (int)((WS_END - WS_LIST) / 4) : 0); const int base = n ? (int)atomicAdd(cnt + 16 * rep_ + tid, (unsigned)n) : 0; int p = 0;
                for (int i = 0; i < nrb; ++i) { if (ri[i * 4] == tid) lp[(size_t)tid * LCAP + base + p++] = ri[i * 4 + 2]; if (ri[i * 4 + 1] == tid) lp[(size_t)tid * LCAP + base + p++] = ri[i * 4 + 3]; } }
            __syncthreads();
        }
        SYNC(pb);
        TS(pb + 1);
        if (PHON(6) && IN(pb + 1)) REPS(6) { PHASE_BEGIN
            SchedMoe1 S; S.T.init((LAS int*)(lds + RING_BYTES), cnt); S.v = (const char*)U; S.wgu = (const char*)(ws + WS_WGU); S.hid = (char*)(ws + WS_HID); S.lst = list; S.G = G; S.c = blk;
            pg8::gemm_phase<SchedMoe1, pg8::EpiSwiGLU, true>(lds, S, pg8::EpiSwiGLU{});
        }
        SYNC(pb + 1);
        TS(pb + 2);
        if (PHON(7) && IN(pb + 2)) REPS(7) { PHASE_BEGIN
            SchedMoe2 S; S.T.init((LAS int*)(lds + RING_BYTES), cnt); S.hid = (const char*)(ws + WS_HID); S.wd = (const char*)(ws + WS_WD); S.lst = list; S.G = G; S.c = blk;
            pg8::gemm_phase<SchedMoe2, pg8::EpiScatter, false>(lds, S, pg8::EpiScatter{YB, tokw});
        }
        SYNC(pb + 2);
}

__global__ void __launch_bounds__(NTHREADS, 2) fwd_kernel(Args a) {
    extern __shared__ __attribute__((aligned(16))) unsigned char lds_raw[];
    LAS unsigned char* lds = (LAS unsigned char*)lds_raw;
    cg::grid_group grid = cg::this_grid();
    const int G = gridDim.x, blk = blockIdx.x, ngw = G * NWAVES;
    const int lo = a.ph_lo, hi = a.ph_hi;
    if (threadIdx.x < 2) ((LAS unsigned*)(lds + RING_BYTES + 512))[threadIdx.x] = 0u;
    __syncthreads();


    TS(0);
    if (PHON(0) && IN(0)) REPS(0) { PHASE_BEGIN
        if (blk == 0) { if (tid < 64) ctl[tid] = 0u;
            for (int i = tid; i < XCD_BAR_WORDS; i += NTHREADS) (ctl + 4096)[i] = 0u; }
        if (blk < 192) {
            LAS float* sil = (LAS float*)lds; LAS float* red = (LAS float*)(lds + 40960);
            for (int i = tid; i < 5 * DM; i += NTHREADS) { const int v = i / DM, k = i % DM; sil[i] = silu_f(v < 4 ? ka->c[v * DM + k] : ka->c_ctx[k]); }
            __syncthreads();
            const int l = blk / 96, j0 = (blk % 96) * 128;
            const float* wp = ka->w_mod + (size_t)l * DM * MODSZ + j0 + 2 * lane;
            f32x2 acc[5];
#pragma unroll
            for (int v = 0; v < 5; ++v) acc[v] = (f32x2){0.f, 0.f};
#pragma unroll 8
            for (int k = wave * 256; k < wave * 256 + 256; ++k) { const f32x2 w = *(const f32x2*)(wp + (size_t)k * MODSZ);
#pragma unroll
                for (int v = 0; v < 5; ++v) { const float s = sil[v * DM + k]; acc[v].x = fmaf(s, w.x, acc[v].x); acc[v].y = fmaf(s, w.y, acc[v].y); } }
#pragma unroll
            for (int v = 0; v < 5; ++v) { red[(wave * 5 + v) * 128 + 2 * lane] = acc[v].x; red[(wave * 5 + v) * 128 + 2 * lane + 1] = acc[v].y; }
            __syncthreads();
            for (int i = tid; i < 5 * 128; i += NTHREADS) { const int v = i / 128, j = i % 128; float s = ka->b_mod[l * MODSZ + j0 + j];
#pragma unroll
                for (int w = 0; w < 8; ++w) s += red[(w * 5 + v) * 128 + j];
                mod[((size_t)l * 5 + v) * MODSZ + j0 + j] = s; }
            __syncthreads();
        }
        LAS float* tab = (LAS float*)(lds + 135168);
        if (tid < 256) tab[tid] = cospif((float)tid * (1.0f / 128.0f));
        __syncthreads();
        LAS float* scr = (LAS float*)(lds + wave * 16384);
        constexpr int I_IN = 32 * 96, I_O0 = 32 * 64, I_QKV = 32 * 192, I_O1 = 32 * 64;
        for (int it = gw; it < I_IN + I_O0 + I_QKV + I_O1; it += ngw) {
            int r = it;
            if (r < I_IN) { transpose_item(ka->even_w_in, 4096, DM, WIN, (r % 96) * 32, (r / 96) * 64, (r % 96) * 32, scr, lane); continue; } r -= I_IN;
            if (r < I_O0) { transpose_item(ka->even_w_out, DM, DM, WOUT0, (r % 64) * 32, (r / 64) * 64, (r % 64) * 32, scr, lane); continue; } r -= I_O0;
            if (r < I_QKV) { transpose_item(ka->odd_w_qkv, 6144, DM, WQKV, (r % 192) * 32, (r / 192) * 64, (r % 192) * 32, scr, lane); continue; } r -= I_QKV;
            transpose_item(ka->odd_w_out, DM, DM, WOUT1, (r % 64) * 32, (r / 64) * 64, (r % 64) * 32, scr, lane);
        }
        moe_weight_items(ka->moe_w_gate, ka->moe_w_up, ka->moe_w_down, ws, 0, gw, ngw, scr, lane);
        for (int it = gw; it < 8 * 8 * 64; it += ngw) {
            const int gp = it >> 9, m0 = ((it >> 6) & 7) * 32, k0 = (it & 63) * 32, g = gp >> 1, part = gp & 1;
            const int r = lane & 31, hh = lane >> 5;
            f32x16 d = {};
            const float* wrow = ka->even_w_in + (size_t)(k0 + r) * 4096 + 3072 + g * 256 + 8 * hh;
#pragma unroll 4
            for (int j0 = 0; j0 < 256; j0 += 16) {
                const f32x4 b0 = *(const f32x4*)(wrow + j0), b1 = *(const f32x4*)(wrow + j0 + 4);
                u32x4 bw = {pk2(b0[0], b0[1]), pk2(b0[2], b0[3]), pk2(b1[0], b1[1]), pk2(b1[2], b1[3])};
                float av[8];
#pragma unroll
                for (int jj = 0; jj < 8; ++jj) { const int p = ((m0 + r) * (j0 + 8 * hh + jj) - (part ? 64 : 0)) & 255; av[jj] = tab[p]; }
                u32x4 aw = {pk2(av[0], av[1]), pk2(av[2], av[3]), pk2(av[4], av[5]), pk2(av[6], av[7])};
                d = __builtin_amdgcn_mfma_f32_32x32x16_bf16(*reinterpret_cast<bf16x8*>(&aw), *reinterpret_cast<bf16x8*>(&bw), d, 0, 0, 0);
            }
#pragma unroll
            for (int q = 0; q < 16; ++q) { const int row = (q & 3) + 8 * (q >> 2) + 4 * hh;
                WIN[(size_t)(3072 + gp * 256 + m0 + row) * DM + k0 + r] = (bf16_t)f2bf(d[q]); }
        }
        { bf16_t* MA = (bf16_t*)(ws + WS_MA); bf16_t* MB = (bf16_t*)(ws + WS_MB);
          for (int it = gw; it < 256 + 4096 + 256; it += ngw) {
            if (it < 256) { const int r = it & 127, k1 = r >> 1, ri = r & 1;
                for (int col = lane; col < 128; col += 64) { const int part = col >> 6, t1 = col & 63; const float xx = (float)((k1 * t1) & 63) * (1.0f / 32.0f);
                    const float cs = cospif(xx), sn = sinpif(xx); const float val = (ri == 0) ? (part == 0 ? cs : -sn) : (part == 0 ? -sn : -cs);
                    MA[(size_t)it * 128 + col] = (bf16_t)f2bf(val); }
            } else if (it < 256 + 4096) { const int rr = it - 256, kb = rr >> 8, r = rr & 255, k1l = r >> 6, k2 = r & 63, k1 = 4 * kb + k1l;
                const int col0 = lane * 8; float f[8];
#pragma unroll
                for (int i = 0; i < 8; ++i) { const int col = col0 + i, k1l2 = col >> 7, ri = (col >> 6) & 1, t2 = col & 63; const int p = (64 * k2 * t2 + k1 * t2) & 4095; const float xx = (float)p * (1.0f / 2048.0f);
                    f[i] = (k1l2 == k1l) ? (ri ? sinpif(xx) : cospif(xx)) : 0.f; }
                u32x4 o = {pk2(f[0], f[1]), pk2(f[2], f[3]), pk2(f[4], f[5]), pk2(f[6], f[7])};
                *(u32x4*)(MB + (size_t)rr * 512 + col0) = o;
            } else { const int k = it - 256 - 4096; const int col0 = lane * 8, part = col0 >> 8, t0 = col0 & 255; float f[8];
#pragma unroll
                for (int i = 0; i < 8; ++i) { const int p = (k * (t0 + i)) & 255; const float xx = (float)p * (1.0f / 128.0f); f[i] = part ? -sinpif(xx) : cospif(xx); }
                u32x4 o = {pk2(f[0], f[1]), pk2(f[2], f[3]), pk2(f[4], f[5]), pk2(f[6], f[7])};
                *(u32x4*)(CMATC + (size_t)k * 512 + col0) = o; }
          } }
    }
    SYNC(0);

    TS(1);
    if (PHON(1) && IN(1)) REPS(1) { PHASE_BEGIN
        if (gw < 200) { const int l_ = gw / 100, v_ = (gw % 100) / 20, n_ = gw % 20;
            const float* sh = mod + ((size_t)l_ * 5 + v_) * MODSZ + 3 * DM; float acc_ = 0.f;
            for (int k = lane; k < DM; k += 64) acc_ += sh[k] * (n_ < 16 ? ka->moe_w_expert[((size_t)l_ * DM + k) * 16 + n_] : ka->moe_w_group[((size_t)l_ * DM + k) * 4 + (n_ - 16)]);
            acc_ = wave_sum(acc_);
            if (lane == 0) ((float*)(ctl + 8192))[(l_ * 5 + v_) * 32 + n_] = acc_ + (n_ < 16 ? ka->moe_b_expert[l_ * 16 + n_] : ka->moe_b_group[l_ * 4 + n_ - 16]); }
        { const int np = NTOK / 2, p0 = (int)(((long)np * gw) / ngw), p1 = (int)(((long)np * (gw + 1)) / ngw);
#define P1_SRC(p_) ({ int b_, j_; row_info(2 * (p_), b_, j_); (j_ < CTX) ? ka->ctx + ((size_t)b_ * CTX + j_) * DM : ka->x + ((size_t)b_ * SEQ + (j_ - CTX)) * DM; })
          f32x4 va[8], vb[8], na[8], nb[8];
          if (p0 < p1) { const float* src = P1_SRC(p0);
#pragma unroll
            for (int jj = 0; jj < 8; ++jj) { va[jj] = *(const f32x4*)(src + 4 * lane + 256 * jj); vb[jj] = *(const f32x4*)(src + DM + 4 * lane + 256 * jj); } }
          for (int p = p0; p < p1; ++p) { const int row = 2 * p; int b, j; row_info(row, b, j);
            const float* mv = mod + (size_t)(j < CTX ? 4 : b) * MODSZ;
            if (p + 1 < p1) { const float* src = P1_SRC(p + 1);
#pragma unroll
                for (int jj = 0; jj < 8; ++jj) { na[jj] = *(const f32x4*)(src + 4 * lane + 256 * jj); nb[jj] = *(const f32x4*)(src + DM + 4 * lane + 256 * jj); } }
            float sa = 0.f, sb = 0.f;
#pragma unroll
            for (int jj = 0; jj < 8; ++jj) { sa += va[jj][0] * va[jj][0] + va[jj][1] * va[jj][1] + va[jj][2] * va[jj][2] + va[jj][3] * va[jj][3]; sb += vb[jj][0] * vb[jj][0] + vb[jj][1] * vb[jj][1] + vb[jj][2] * vb[jj][2] + vb[jj][3] * vb[jj][3]; }
#pragma unroll
            for (int o_ = 1; o_ < 64; o_ <<= 1) { sa += __shfl_xor(sa, o_); sb += __shfl_xor(sb, o_); }
            const float ra = rsqrtf(sa * (1.0f / DM) + EPS), rb = rsqrtf(sb * (1.0f / DM) + EPS);
            bf16_t* oa = U + (size_t)row * DM; bf16_t* ob = oa + DM;
#pragma unroll
            for (int jj = 0; jj < 8; ++jj) { const int k = 4 * lane + 256 * jj;
                const f32x4 w = *(const f32x4*)(ka->norm1_w + k), sc = *(const f32x4*)(mv + DM + k), t = *(const f32x4*)(mv + k); const f32x4 aw = w * (1.0f + sc);
                const f32x4 ya = va[jj] * ra * aw + t, yb = vb[jj] * rb * aw + t;
                u32x2 o; o.x = pk2(ya[0], ya[1]); o.y = pk2(ya[2], ya[3]); *(u32x2*)(oa + k) = o; o.x = pk2(yb[0], yb[1]); o.y = pk2(yb[2], yb[3]); *(u32x2*)(ob + k) = o; }
#pragma unroll
            for (int jj = 0; jj < 8; ++jj) { va[jj] = na[jj]; vb[jj] = nb[jj]; }
          }
#undef P1_SRC
        }
    }
    SYNC(1);

    TS(2);
    if (PHON(2) && IN(2)) REPS(2) { PHASE_BEGIN
        SchedInProj S{(const char*)U, (const char*)WIN, (char*)PB, (char*)(ws + WS_ZTL), (char*)(ws + WS_ZTC), G, blk};
        pg8::gemm_phase<SchedInProj, pg8::EpiStore, false>(lds, S, pg8::EpiStore{});
    }
    SYNC(2);

    TS(3);
    if (PHON(3) && IN(3)) REPS(3) { PHASE_BEGIN
        for (int it = blk * NTHREADS + tid; it < (NTOK / 16) * 128; it += G * NTHREADS) {
            const int chunk = it >> 7, oct = it & 127, r0 = chunk * 16, jm = r0 % TPB, ch0 = oct * 8;
            const bool hasprev = (jm != 0 && jm != CTX), hasnext = (((jm + 16) % TPB) != 0 && (jm + 16) != CTX);
            float w0[8], w1[8], w2[8];
#pragma unroll
            for (int i = 0; i < 8; ++i) { w0[i] = ka->even_conv_w[ch0 + i]; w1[i] = ka->even_conv_w[1024 + ch0 + i]; w2[i] = ka->even_conv_w[2048 + ch0 + i]; }
            float cp[8], cc[8], cn[8];
#define LOADCV(row_, o) do { const u32x4 cg_ = *(const u32x4*)(PB + (size_t)(row_) * 3072 + 1024 + ch0), vi = *(const u32x4*)(PB + (size_t)(row_) * 3072 + 2048 + ch0); \
                o[0] = bflo(cg_.x) * bflo(vi.x); o[1] = bfhi(cg_.x) * bfhi(vi.x); o[2] = bflo(cg_.y) * bflo(vi.y); o[3] = bfhi(cg_.y) * bfhi(vi.y); \
                o[4] = bflo(cg_.z) * bflo(vi.z); o[5] = bfhi(cg_.z) * bfhi(vi.z); o[6] = bflo(cg_.w) * bflo(vi.w); o[7] = bfhi(cg_.w) * bfhi(vi.w); } while (0)
            if (hasprev) LOADCV(r0 - 1, cp); else {
#pragma unroll
                for (int i = 0; i < 8; ++i) cp[i] = 0.f; }
            LOADCV(r0, cc);
            for (int rr = 0; rr < 16; ++rr) { const int row = r0 + rr;
                if (rr < 15 || hasnext) LOADCV(row + 1, cn); else {
#pragma unroll
                    for (int i = 0; i < 8; ++i) cn[i] = 0.f; }
                const u32x4 bg = *(const u32x4*)(PB + (size_t)row * 3072 + ch0);
                float bb[8] = {bflo(bg.x), bfhi(bg.x), bflo(bg.y), bfhi(bg.y), bflo(bg.z), bfhi(bg.z), bflo(bg.w), bfhi(bg.w)}; float y[8];
#pragma unroll
                for (int i = 0; i < 8; ++i) y[i] = bb[i] * (w0[i] * cp[i] + w1[i] * cc[i] + w2[i] * cn[i]);
                u32x4 o = {pk2(y[0], y[1]), pk2(y[2], y[3]), pk2(y[4], y[5]), pk2(y[6], y[7])};
                *(u32x4*)(YCAT + (size_t)row * DM + ch0) = o;
#pragma unroll
                for (int i = 0; i < 8; ++i) { cp[i] = cc[i]; cc[i] = cn[i]; } }
        }
        { SchedFftA S{(const char*)(ws + WS_MA), (const char*)CMATC, (const char*)(ws + WS_ZTL), (const char*)(ws + WS_ZTC), (char*)(ws + WS_UF), (char*)YCAT, G, blk};
          pg8::gemm_phase<SchedFftA, pg8::EpiStore, false>(lds, S, pg8::EpiStore{}); }
        xcd_barrier(BARW, BARST);
        { SchedFftB S{(const char*)(ws + WS_MB), (const char*)(ws + WS_UF), (char*)YCAT, G, blk};
          pg8::gemm_phase<SchedFftB, pg8::EpiStore, false>(lds, S, pg8::EpiStore{}); }
    }
    SYNC(3);

    TS(4);
    if (PHON(4) && IN(4)) REPS(4) { PHASE_BEGIN
        SchedOut0 S{(const char*)YCAT, (const char*)WOUT0, ka->x, ka->ctx, mod, (char*)H, G, blk};
        pg8::gemm_phase<SchedOut0, pg8::EpiResid, false>(lds, S, pg8::EpiResid{});
    }
    SYNC(4);

    moe_layer<0>(grid, lds, lo, hi, G, blk);
    { constexpr int l = 0; (void)l;
            TS(8);
    if (PHON(8) && IN(8)) { PHASE_BEGIN
                const float* mod1 = mod + (size_t)5 * MODSZ;
                for (int row = gw; row < NTOK; row += ngw) { int b, j; row_info(row, b, j); const int vr = (j < CTX) ? 4 : b;
                    const float* g2 = modl + (size_t)vr * MODSZ + 5 * DM; const float* mv1 = mod1 + (size_t)vr * MODSZ;
                    float* hrow = H + (size_t)row * DM; const bf16_t* y0 = YB + (size_t)(row * 2) * DM; const bf16_t* y1 = y0 + DM;
                    f32x4 v[8]; float ss = 0.f;
#pragma unroll
                    for (int jj = 0; jj < 8; ++jj) { const int k = 4 * lane + 256 * jj; const f32x4 hv = *(const f32x4*)(hrow + k), g = *(const f32x4*)(g2 + k);
                        const u32x2 a0 = *(const u32x2*)(y0 + k), a1 = *(const u32x2*)(y1 + k);
                        f32x4 ys = {bflo(a0.x) + bflo(a1.x), bfhi(a0.x) + bfhi(a1.x), bflo(a0.y) + bflo(a1.y), bfhi(a0.y) + bfhi(a1.y)};
                        v[jj] = hv + g * ys; *(f32x4*)(hrow + k) = v[jj];
                        ss += v[jj][0] * v[jj][0] + v[jj][1] * v[jj][1] + v[jj][2] * v[jj][2] + v[jj][3] * v[jj][3]; }
                    const float rstd = rsqrtf(wave_sum(ss) * (1.0f / DM) + EPS);
                    norm_mod_store(v, rstd, ka->norm1_w + DM, mv1 + DM, mv1, U + (size_t)row * DM, lane);
                }
                moe_weight_items(ka->moe_w_gate, ka->moe_w_up, ka->moe_w_down, ws, 1, gw, ngw, (LAS float*)(lds + wave * 16384), lane);
            }
            SYNC(8);
            TS(9);
    if (PHON(9) && IN(9)) REPS(9) { PHASE_BEGIN
                SchedQKV S{(const char*)U, (const char*)WQKV, (char*)QB, G, blk};
                pg8::gemm_phase<SchedQKV, pg8::EpiStore, false>(lds, S, pg8::EpiStore{});
            }
            SYNC(9);
            TS(10);
    if (PHON(10) && IN(10)) { PHASE_BEGIN
                LAS float* rt = (LAS float*)lds;
                for (int i = tid; i < 64 * 32; i += NTHREADS) { const int pos = i >> 5, f = i & 31; const float inv = exp2f(-(float)f * 0.4152410118609203f); const float ang = (float)pos * inv;
                    float tr = ang * 0.15915494309189535f; tr -= floorf(tr); rt[2 * i] = __builtin_amdgcn_cosf(tr); rt[2 * i + 1] = __builtin_amdgcn_sinf(tr); }
                __syncthreads();
                const int hc = lane >> 2, q8 = (lane & 3) * 8;
                for (int it = gw; it < NLAT + NTOK; it += ngw) {
                    const bool isq = it < NLAT; int row;
                    if (isq) row = (it / SEQ) * TPB + CTX + (it % SEQ); else row = it - NLAT;
                    int b, j; row_info(row, b, j); const bool rope = (j >= CTX); const int t = j - CTX, prow = t >> 6, pcol = t & 63;
                    bf16_t* p = (isq ? QB : KB) + (size_t)row * DM + hc * 128; const float* nwp = isq ? ka->odd_q_norm : ka->odd_k_norm;
                    u32x4 raw[4]; float xv[4][8];
                    float ss = 0.f;
#pragma unroll
                    for (int s = 0; s < 4; ++s) { raw[s] = *(const u32x4*)(p + s * 32 + q8);
                        xv[s][0] = bflo(raw[s].x); xv[s][1] = bfhi(raw[s].x); xv[s][2] = bflo(raw[s].y); xv[s][3] = bfhi(raw[s].y); xv[s][4] = bflo(raw[s].z); xv[s][5] = bfhi(raw[s].z); xv[s][6] = bflo(raw[s].w); xv[s][7] = bfhi(raw[s].w);
#pragma unroll
                        for (int i = 0; i < 8; ++i) ss += xv[s][i] * xv[s][i]; }
                    ss += __shfl_xor(ss, 1); ss += __shfl_xor(ss, 2);
                    const float rstd = rsqrtf(ss * (1.0f / 128.0f) + EPS);
#pragma unroll
                    for (int s = 0; s < 4; ++s)
#pragma unroll
                        for (int i = 0; i < 8; ++i) xv[s][i] = xv[s][i] * rstd * nwp[s * 32 + q8 + i];
                    if (rope) {
#pragma unroll
                        for (int ax = 0; ax < 2; ++ax) { const int pos = ax ? pcol : prow;
#pragma unroll
                            for (int i = 0; i < 8; ++i) { const float cs = rt[2 * (pos * 32 + q8 + i)], sn = rt[2 * (pos * 32 + q8 + i) + 1];
                                const float x1 = xv[2 * ax][i], x2 = xv[2 * ax + 1][i]; xv[2 * ax][i] = x1 * cs - x2 * sn; xv[2 * ax + 1][i] = x2 * cs + x1 * sn; } }
                    }
#pragma unroll
                    for (int s = 0; s < 4; ++s) { u32x4 o = {pk2(xv[s][0], xv[s][1]), pk2(xv[s][2], xv[s][3]), pk2(xv[s][4], xv[s][5]), pk2(xv[s][6], xv[s][7])}; *(u32x4*)(p + s * 32 + q8) = o; }
                }
                __syncthreads();
            }
            SYNC(10);
            TS(11);
    if (PHON(11) && IN(11)) REPS(11) { PHASE_BEGIN
                const int vcu = (blk % 8) * (G / 8) + blk / 8;
                float mq = fmaxf(fabsf(ka->odd_q_norm[lane]), fabsf(ka->odd_q_norm[lane + 64])), mk = fmaxf(fabsf(ka->odd_k_norm[lane]), fabsf(ka->odd_k_norm[lane + 64]));
#pragma unroll
                for (int o_ = 1; o_ < 64; o_ <<= 1) { mq = fmaxf(mq, __shfl_xor(mq, o_)); mk = fmaxf(mk, __shfl_xor(mk, o_)); }
                const float mnC = -(128.0f * att::SCALE * mq * mk) * 1.4426950408889634f;
                for (int U0 = vcu; U0 < 2048; U0 += G) {
                    const int combo = U0 >> 5, qb = U0 & 31, cp_ = combo & 1, hh = (combo >> 1) & 7, b = combo >> 4;
                    const bf16_t* Qp = QB + (size_t)(b * TPB + CTX + qb * 128) * DM + hh * 256 + cp_ * 128;
                    const bf16_t* Kp = KB + (size_t)(b * TPB) * DM + hh * 256 + cp_ * 128;
                    const bf16_t* Vp = VB + (size_t)(b * TPB) * DM + hh * 256;
                    bf16_t* Op = OB + (size_t)(b * SEQ + qb * 128) * (2 * DM) + cp_ * DM + hh * 256;
                    att::attn_pair_body(Qp, Kp, Vp, Op, TPB, (char*)lds_raw, mnC);
                }
            }
            SYNC(11);
            TS(12);
    if (PHON(12) && IN(12)) REPS(12) { PHASE_BEGIN
                float d1 = ka->lq1[lane] * ka->lk1[lane] + ka->lq1[lane + 64] * ka->lk1[lane + 64], d2 = ka->lq2[lane] * ka->lk2[lane] + ka->lq2[lane + 64] * ka->lk2[lane + 64];
                d1 = wave_sum(d1); d2 = wave_sum(d2);
                const float lam_init = 0.8f - 0.6f * expf(-0.3f * 1.0f);
                const float lam = expf(d1) - expf(d2) + lam_init;
                const int hh = lane >> 3, e0 = (lane & 7) * 32;
                for (int li = gw; li < NLAT; li += ngw) {
                    const bf16_t* o1 = OB + (size_t)li * (2 * DM) + hh * 256 + e0; const bf16_t* o2 = o1 + DM;
                    float ov[32]; float ss = 0.f;
#pragma unroll
                    for (int s = 0; s < 4; ++s) { const u32x4 p1 = *(const u32x4*)(o1 + 8 * s), p2 = *(const u32x4*)(o2 + 8 * s);
                        ov[8 * s + 0] = bflo(p1.x) - lam * bflo(p2.x); ov[8 * s + 1] = bfhi(p1.x) - lam * bfhi(p2.x); ov[8 * s + 2] = bflo(p1.y) - lam * bflo(p2.y); ov[8 * s + 3] = bfhi(p1.y) - lam * bfhi(p2.y);
                        ov[8 * s + 4] = bflo(p1.z) - lam * bflo(p2.z); ov[8 * s + 5] = bfhi(p1.z) - lam * bfhi(p2.z); ov[8 * s + 6] = bflo(p1.w) - lam * bflo(p2.w); ov[8 * s + 7] = bfhi(p1.w) - lam * bfhi(p2.w); }
#pragma unroll
                    for (int i = 0; i < 32; ++i) ss += ov[i] * ov[i];
                    ss += __shfl_xor(ss, 1); ss += __shfl_xor(ss, 2); ss += __shfl_xor(ss, 4);
                    const float rs = rsqrtf(ss * (1.0f / 256.0f) + EPS) * (1.0f - lam_init);
                    const int row = (li / SEQ) * TPB + CTX + (li % SEQ);
                    bf16_t* ap = AB + (size_t)row * DM + hh * 256 + e0;
#pragma unroll
                    for (int s = 0; s < 4; ++s) { float y[8];
#pragma unroll
                        for (int i = 0; i < 8; ++i) y[i] = ov[8 * s + i] * rs * ka->subln_w[e0 + 8 * s + i];
                        u32x4 o = {pk2(y[0], y[1]), pk2(y[2], y[3]), pk2(y[4], y[5]), pk2(y[6], y[7])}; *(u32x4*)(ap + 8 * s) = o; }
                }
            }
            SYNC(12);
            TS(13);
    if (PHON(13) && IN(13)) { PHASE_BEGIN
                SchedOut1 S{(const char*)AB, (const char*)WOUT1, mod + (size_t)5 * MODSZ, (char*)H, G, blk};
                pg8::gemm_phase<SchedOut1, pg8::EpiResid, false>(lds, S, pg8::EpiResid{});
            }
            SYNC(13);
    }
    moe_layer<1>(grid, lds, lo, hi, G, blk);
    { constexpr int l = 1; (void)l;
            TS(17);
    if (PHON(17) && IN(17)) REPS(17) { PHASE_BEGIN
                for (int li = gw; li < NLAT; li += ngw) { const int b = li / SEQ, row = b * TPB + CTX + (li % SEQ);
                    const float* g2 = modl + (size_t)b * MODSZ + 5 * DM; const float* hrow = H + (size_t)row * DM; const bf16_t* y0 = YB + (size_t)(row * 2) * DM; const bf16_t* y1 = y0 + DM;
                    float* orow = ka->out + (size_t)li * DM;
#pragma unroll
                    for (int jj = 0; jj < 8; ++jj) { const int k = 4 * lane + 256 * jj; const f32x4 hv = *(const f32x4*)(hrow + k), g = *(const f32x4*)(g2 + k);
                        const u32x2 a0 = *(const u32x2*)(y0 + k), a1 = *(const u32x2*)(y1 + k);
                        f32x4 ys = {bflo(a0.x) + bflo(a1.x), bfhi(a0.x) + bfhi(a1.x), bflo(a0.y) + bflo(a1.y), bfhi(a0.y) + bfhi(a1.y)};
                        f32x4 res = hv + g * ys;
#if PROBE
                        { const unsigned long long* tp_ = (const unsigned long long*)(ws + WS_CTL + 1024); const float c2 = (float)(tp_[3] - tp_[2]) * 1e-4f, w1 = (float)(tp_[1] - tp_[0]) * 1e-2f;
                          res = (f32x4){c2, c2, c2, c2}; if (li == 0 && k == 0) res[0] = w1; }
#endif
                        *(f32x4*)(orow + k) = res; }
                }
            }
    }
    TS(18);
#undef IN
#undef SYNC
#undef cnt
#undef modl
#undef ctl
#undef mod
#undef tokw
#undef list
#undef WIN
#undef WOUT0
#undef WQKV
#undef WOUT1
#undef CMAT
#undef CMATC
#undef H
#undef U
#undef PB
#undef YCAT
#undef QB
#undef KB
#undef VB
#undef AB
#undef YB
#undef OB
}

#ifndef N_LAUNCH_MODE
#define N_LAUNCH_MODE 1
#endif
extern "C" void kernel_launch(void* const* d_in, const int* in_sizes, int n_in, void* d_out, int out_size, void* d_ws, size_t ws_size, hipStream_t stream) {
    static int grid = 0;
    if (grid == 0) {
        if (n_in != 27 || out_size != NLAT * DM || ws_size < WS_END) { fprintf(stderr, "kernel_launch: unexpected shapes: n_in %d out %d ws %zu (need %zu)\n", n_in, out_size, ws_size, (size_t)WS_END); grid = -1; return; }
        int dev = 0, cus = 0, per_cu = 0;
        hipGetDevice(&dev); hipDeviceGetAttribute(&cus, hipDeviceAttributeMultiprocessorCount, dev);
        if (hipFuncSetAttribute((const void*)fwd_kernel, hipFuncAttributeMaxDynamicSharedMemorySize, LDS_BYTES) != hipSuccess) { fprintf(stderr, "kernel_launch: hipFuncSetAttribute failed\n"); grid = -1; return; }
        if (hipOccupancyMaxActiveBlocksPerMultiprocessor(&per_cu, (const void*)fwd_kernel, NTHREADS, LDS_BYTES) != hipSuccess || per_cu < 1) { fprintf(stderr, "kernel_launch: occupancy query says %d\n", per_cu); per_cu = 1; }
        (void)hipGetLastError();
        grid = cus;
        if (grid != 256) fprintf(stderr, "kernel_launch: note: %d CUs\n", grid);
    }
    if (grid < 0) return;
    Args a{};
    const float** ap = (const float**)&a;
    for (int i = 0; i < 27; ++i) ap[i] = (const float*)d_in[i];
    a.out = (float*)d_out; a.ws = (unsigned char*)d_ws;
#if N_LAUNCH_MODE == 1
    a.ph_lo = 0; a.ph_hi = 18;
    void* args[] = {&a};
    hipError_t e = hipLaunchCooperativeKernel((const void*)fwd_kernel, dim3(grid), dim3(NTHREADS), args, LDS_BYTES, stream);
    if (e != hipSuccess) fprintf(stderr, "cooperative launch failed: %s (grid %d)\n", hipGetErrorString(e), grid);
#else
    for (int p = 0; p < 18; ++p) { a.ph_lo = p; a.ph_hi = p + 1; void* args[] = {&a};
        hipError_t e = hipLaunchCooperativeKernel((const void*)fwd_kernel, dim3(grid), dim3(NTHREADS), args, LDS_BYTES, stream);
        if (e != hipSuccess) { fprintf(stderr, "launch %d failed: %s\n", p, hipGetErrorString(e)); break; } }
#endif
}
```

```cpp
#include <hip/hip_runtime.h>
#include <hip/hip_cooperative_groups.h>
#include <cstdio>
#include <cstdint>
namespace cg = cooperative_groups;
#ifndef PROBE
#define PROBE 0
#endif
#ifndef REPMASK
#define REPMASK 0x0
#endif
#define REPS(k) for (int rep_ = 0; rep_ <= ((REPMASK >> (k)) & 1); ++rep_)
#ifndef PA0
#define PA0 0
#define PA1 18
#define PB0 0
#define PB1 18
#endif

#define LAS __attribute__((address_space(3)))
typedef unsigned short bf16_t;
typedef short bf16x8 __attribute__((ext_vector_type(8)));
typedef short s16x4 __attribute__((ext_vector_type(4)));
typedef float f32x2 __attribute__((ext_vector_type(2)));
typedef float f32x4 __attribute__((ext_vector_type(4)));
typedef float f32x8 __attribute__((ext_vector_type(8)));
typedef float f32x16 __attribute__((ext_vector_type(16)));
typedef unsigned u32x2 __attribute__((ext_vector_type(2)));
typedef unsigned u32x4 __attribute__((ext_vector_type(4)));

constexpr int DM = 2048, NB = 4, SEQ = 4096, CTX = 256, TPB = SEQ + CTX  ;
constexpr int NTOK = NB * TPB  , NLAT = NB * SEQ  ;
constexpr int NEXP = 16, EFF = 512, LCAP = 2 * NTOK  ;
constexpr float EPS = 1e-6f;
constexpr int NWAVES = 8, NTHREADS = 512;
constexpr int LDS_BYTES = 155648;
constexpr int RING_BYTES = 131072;

constexpr size_t MiB = 1u << 20;
constexpr size_t WS_CTL = 0, WS_MOD = 1 * MiB, WS_TOKW = 2 * MiB, WS_LIST = 3 * MiB;
constexpr size_t WS_WIN = 6 * MiB, WS_WOUT0 = 26 * MiB, WS_WQKV = 34 * MiB, WS_WOUT1 = 58 * MiB, WS_WGU = 66 * MiB, WS_WD = 130 * MiB;
constexpr size_t WS_CMAT = 162 * MiB, WS_CMATC = 226 * MiB, WS_HID = 162 * MiB  ;
constexpr size_t WS_H = 227 * MiB, WS_U = 363 * MiB;
constexpr size_t WS_P = 431 * MiB, WS_ZTL = 533 * MiB, WS_ZTC = 597 * MiB, WS_YCAT = 601 * MiB;
constexpr size_t WS_Q = 431 * MiB, WS_K = 499 * MiB, WS_V = 567 * MiB, WS_A = 431 * MiB;
static_assert(WS_V - WS_K == WS_K - WS_Q, "QKV spacing");
constexpr size_t WS_Y = 669 * MiB, WS_O = 669 * MiB, WS_MB = 805 * MiB, WS_END = 809 * MiB;
constexpr size_t WS_UF = 162 * MiB  , WS_MA = 226 * MiB + 512 * 1024;
constexpr int MODSZ = 6 * DM;

typedef const __attribute__((address_space(1))) float* gcf;
typedef __attribute__((address_space(1))) bf16_t* gbf;
__device__ __forceinline__ unsigned f2bf(float f) { unsigned u = __builtin_bit_cast(unsigned, f); return (u + 0x7fffu + ((u >> 16) & 1u)) >> 16; }
__device__ __forceinline__ unsigned pk2(float lo, float hi) { return f2bf(lo) | (f2bf(hi) << 16); }
__device__ __forceinline__ float bflo(unsigned w) { return __uint_as_float(w << 16); }
__device__ __forceinline__ float bfhi(unsigned w) { return __uint_as_float(w & 0xffff0000u); }
__device__ __forceinline__ f32x4 bf4(u32x2 w) { return (f32x4){bflo(w.x), bfhi(w.x), bflo(w.y), bfhi(w.y)}; }
__device__ __forceinline__ unsigned cvt_pk_bf16(float lo, float hi) { unsigned r; asm volatile("v_cvt_pk_bf16_f32 %0, %1, %2" : "=v"(r) : "v"(lo), "v"(hi)); return r; }
__device__ __forceinline__ float wave_sum(float v) {
#pragma unroll
    for (int o = 1; o < 64; o <<= 1) v += __shfl_xor(v, o);
    return v;
}
__device__ __forceinline__ float silu_f(float x) { return x * __builtin_amdgcn_rcpf(1.0f + __expf(-x)); }

namespace pg8 {
constexpr int BM = 256, BK = 64, HALF = 128, HTB = HALF * BK * 2, STAGE_BYTES = 8 * HTB, NXCD = 8, WGM = 8;
__host__ __device__ __forceinline__ int lds_byte(int r, int c) { const int st = (r >> 4) * 2 + (c >> 5), rr = r & 15, cc = c & 31, ob = rr * 64 + cc * 2; return st * 1024 + (ob ^ (((ob >> 9) & 1) << 5)); }
__host__ __device__ __forceinline__ void stage_rc(int b, int& R, int& C) { const int st = b / 1024, sb = b % 1024, swz = sb ^ (((sb >> 9) & 1) << 5); R = (st >> 1) * 16 + swz / 64; C = (st & 1) * 32 + (swz % 64) / 2; }
__host__ __device__ __forceinline__ int perm32(int rho) { const int n = rho >> 4, i = rho & 15; return 8 * (i >> 2) + 4 * n + (i & 3); }

struct GUnit {
    const char* A; const char* B; unsigned lda, ldb; int nt;
    char* O; int ldc; float scale;
    int rs1, rs2, cs, nrow, bperm;
    const char* src; const float* gate;
    const int* glist; int gcount;
    int aux;
};
__device__ __forceinline__ void tile_of(int L, int nM, int nN, int& pm, int& pn) {
    const int nwg = nM * nN; int wgid = L;
    { const int q = nwg / NXCD, r = nwg % NXCD, xcd = wgid % NXCD, off = wgid / NXCD; wgid = (xcd < r ? xcd * (q + 1) : r * (q + 1) + (xcd - r) * q) + off; }
    const int nig = WGM * nN, gid = wgid / nig, fm = gid * WGM, gsz = (nM - fm) < WGM ? (nM - fm) : WGM;
    pm = fm + ((wgid % nig) % gsz); pn = (wgid % nig) / gsz;
}
__device__ __forceinline__ int xcd_remap(int L, int nwg) {
    const int q = nwg / NXCD, r = nwg % NXCD, xcd = L % NXCD, off = L / NXCD; return (xcd < r ? xcd * (q + 1) : r * (q + 1) + (xcd - r) * q) + off;
}

struct EpiStore {
    __device__ __forceinline__ void operator()(const f32x4 (&acc)[2][2][4][2], const GUnit& u, int wr, int wc, int fr, int fq) const {
        const float sc = u.scale;
#pragma unroll
        for (int ai = 0; ai < 2; ++ai) { if (ai * HALF >= u.nrow) break;
#pragma unroll
            for (int m = 0; m < 4; ++m) { bf16_t* rowp = (bf16_t*)u.O + (size_t)(2 * ai + wr) * u.rs1 + (size_t)(m * 16 + fr) * u.rs2 + (wc >> 1) * u.cs + (wc & 1) * 32 + 8 * fq;
#pragma unroll
                for (int bj = 0; bj < 2; ++bj) { const f32x4 v0 = acc[ai][bj][m][0] * sc, v1 = acc[ai][bj][m][1] * sc;
                    u32x4 w; w.x = cvt_pk_bf16(v0[0], v0[1]); w.y = cvt_pk_bf16(v0[2], v0[3]); w.z = cvt_pk_bf16(v1[0], v1[1]); w.w = cvt_pk_bf16(v1[2], v1[3]);
                    *(u32x4*)(rowp + (size_t)bj * 2 * u.cs) = w; } } }
    }
};
struct EpiSwiGLU {
    __device__ __forceinline__ void operator()(const f32x4 (&acc)[2][2][4][2], const GUnit& u, int wr, int wc, int fr, int fq) const {
#pragma unroll
        for (int ai = 0; ai < 2; ++ai)
#pragma unroll
            for (int m = 0; m < 4; ++m) { bf16_t* rowp = (bf16_t*)u.O + (size_t)(ai * HALF + wr * 64 + m * 16 + fr) * u.ldc + wc * 32 + 8 * fq;
                float h[8];
#pragma unroll
                for (int n = 0; n < 2; ++n)
#pragma unroll
                    for (int i = 0; i < 4; ++i) h[4 * n + i] = silu_f(acc[ai][0][m][n][i]) * acc[ai][1][m][n][i];
                u32x4 w; w.x = cvt_pk_bf16(h[0], h[1]); w.y = cvt_pk_bf16(h[2], h[3]); w.z = cvt_pk_bf16(h[4], h[5]); w.w = cvt_pk_bf16(h[6], h[7]);
                *(u32x4*)rowp = w; }
    }
};
struct EpiScatter {
    bf16_t* Y; const float* tokw;
    __device__ __forceinline__ void operator()(const f32x4 (&acc)[2][2][4][2], const GUnit& u, int wr, int wc, int fr, int fq) const {
#pragma unroll
        for (int ai = 0; ai < 2; ++ai)
#pragma unroll
            for (int m = 0; m < 4; ++m) { const int r = ai * HALF + wr * 64 + m * 16 + fr;
                if (r < u.gcount) { const int a = u.glist[r]; const float sc = tokw[a];
                    bf16_t* rowp = Y + (size_t)a * DM + u.aux * 256 + wc * 32 + 8 * fq;
#pragma unroll
                    for (int bj = 0; bj < 2; ++bj) { const f32x4 v0 = acc[ai][bj][m][0] * sc, v1 = acc[ai][bj][m][1] * sc;
                        u32x4 w; w.x = cvt_pk_bf16(v0[0], v0[1]); w.y = cvt_pk_bf16(v0[2], v0[3]); w.z = cvt_pk_bf16(v1[0], v1[1]); w.w = cvt_pk_bf16(v1[2], v1[3]);
                        *(u32x4*)(rowp + bj * HALF) = w; } } }
    }
};
template <bool SRC_BF16>
struct EpiResid {
    __device__ __forceinline__ void operator()(const f32x4 (&acc)[2][2][4][2], const GUnit& u, int wr, int wc, int fr, int fq) const {
        f32x4 g[2][2];
#pragma unroll
        for (int bj = 0; bj < 2; ++bj)
#pragma unroll
            for (int n = 0; n < 2; ++n) g[bj][n] = *(const f32x4*)(u.gate + bj * HALF + wc * 32 + 8 * fq + 4 * n);
#pragma unroll
        for (int ai = 0; ai < 2; ++ai)
#pragma unroll
            for (int m = 0; m < 4; ++m) { const size_t off = (size_t)(ai * HALF + wr * 64 + m * 16 + fr) * DM + wc * 32 + 8 * fq;
#pragma unroll
                for (int bj = 0; bj < 2; ++bj) { f32x4 s0, s1;
                    if constexpr (SRC_BF16) { const u32x4 w = *(const u32x4*)((const bf16_t*)u.src + off + bj * HALF); s0 = bf4((u32x2){w.x, w.y}); s1 = bf4((u32x2){w.z, w.w}); }
                    else { s0 = *(const f32x4*)((const float*)u.src + off + bj * HALF); s1 = *(const f32x4*)((const float*)u.src + off + bj * HALF + 4); }
                    const f32x4 v0 = s0 + g[bj][0] * acc[ai][bj][m][0], v1 = s1 + g[bj][1] * acc[ai][bj][m][1];
                    u32x4 o; o.x = cvt_pk_bf16(v0[0], v0[1]); o.y = cvt_pk_bf16(v0[2], v0[3]); o.z = cvt_pk_bf16(v1[0], v1[1]); o.w = cvt_pk_bf16(v1[2], v1[3]);
                    *(u32x4*)((bf16_t*)u.O + off + bj * HALF) = o; } }
    }
};

template <bool GATHER>
__device__ __forceinline__ void mkvoff(const GUnit& u, unsigned (&vA)[2][2], unsigned (&vB)[2][2]) {
    int tid = threadIdx.x; asm volatile("" : "+v"(tid));
    int R0, C0, R1, C1; stage_rc(tid * 16, R0, C0); stage_rc(tid * 16 + 8192, R1, C1);
    const int Rb0 = (R0 & ~31) + perm32(R0 & 31), Rb1 = (R1 & ~31) + perm32(R1 & 31);
#pragma unroll
    for (int h = 0; h < 2; ++h) {
        if constexpr (GATHER) {
            const int r0 = h * HALF + R0, r1 = h * HALF + R1;
            const int t0 = (r0 < u.gcount) ? (u.glist[r0] >> 1) : 0, t1 = (r1 < u.gcount) ? (u.glist[r1] >> 1) : 0;
            vA[h][0] = (unsigned)t0 * u.lda + (unsigned)C0 * 2u; vA[h][1] = (unsigned)t1 * u.lda + (unsigned)C1 * 2u;
        } else {
            vA[h][0] = (unsigned)(h * HALF + R0) * u.lda + (unsigned)C0 * 2u; vA[h][1] = (unsigned)(h * HALF + R1) * u.lda + (unsigned)C1 * 2u;
        }
        int n0 = h * HALF + Rb0, n1 = h * HALF + Rb1; if (u.bperm) { n0 = 64 * (n0 & 63) + (n0 >> 6); n1 = 64 * (n1 & 63) + (n1 >> 6); }
        vB[h][0] = (unsigned)n0 * u.ldb + (unsigned)C0 * 2u; vB[h][1] = (unsigned)n1 * u.ldb + (unsigned)C1 * 2u;
    }
}

template <class Sched, class Epi, bool GATHER>
__device__ __forceinline__ void gemm_phase(LAS unsigned char* lds, const Sched& S, const Epi& E) {
    int tid = threadIdx.x; asm volatile("" : "+v"(tid));
    const int wid = __builtin_amdgcn_readfirstlane(tid >> 6), lane = tid & 63, wr = wid >> 2, wc = wid & 3, fr = lane & 15, fq = lane >> 4;
    const size_t kstep = (size_t)(BK * 2);
    const unsigned ldsw = (unsigned)wid * 1024u;
    const int aoff = lds_byte(wr * 64 + fr, fq * 8), boff = lds_byte(wc * 32 + fr, fq * 8);
#define PG8_SA(b, h) (((b) * 2 + (h)) * HTB)
#define PG8_SB(b, h) ((4 + (b) * 2 + (h)) * HTB)
#define PG8_STAGE(bufoff, gbase, voff) do { _Pragma("unroll") for (int _i = 0; _i < 2; ++_i) \
        __builtin_amdgcn_global_load_lds((const unsigned*)((const char*)(gbase) + (voff)[_i]), (LAS unsigned*)(lds + (bufoff) + ldsw + _i * 8192), 16, 0, 0); } while (0)
#define PG8_LDA(dst, b, h) do { _Pragma("unroll") for (int m = 0; m < 4; ++m) _Pragma("unroll") for (int k = 0; k < 2; ++k) dst[m][k] = *(const LAS bf16x8*)(lds + PG8_SA(b, h) + aoff + m * 2048 + k * 1024); } while (0)
#define PG8_LDB(dst, b, h) do { _Pragma("unroll") for (int n = 0; n < 2; ++n) _Pragma("unroll") for (int k = 0; k < 2; ++k) dst[n][k] = *(const LAS bf16x8*)(lds + PG8_SB(b, h) + boff + n * 2048 + k * 1024); } while (0)
#define PG8_MMA(ai, bj, At, Bt) do { __builtin_amdgcn_s_setprio(1); _Pragma("unroll") for (int m = 0; m < 4; ++m) _Pragma("unroll") for (int n = 0; n < 2; ++n) _Pragma("unroll") for (int k = 0; k < 2; ++k) \
        acc[ai][bj][m][n] = __builtin_amdgcn_mfma_f32_16x16x32_bf16(Bt[n][k], At[m][k], acc[ai][bj][m][n], 0, 0, 0); __builtin_amdgcn_s_setprio(0); } while (0)
#define PG8_WAIT_V(n) asm volatile("s_waitcnt vmcnt(" #n ")" ::: "memory")
#define PG8_WAIT_L(n) asm volatile("s_waitcnt lgkmcnt(" #n ")" ::: "memory")
#define PG8_BAR __builtin_amdgcn_s_barrier()
#define PG8_SCHED __builtin_amdgcn_sched_barrier(0)
    GUnit cur, nxt; int ui = 0;
    if (!S.next(0, cur)) return;
    unsigned vA[2][2], vB[2][2];
    mkvoff<GATHER>(cur, vA, vB);
    f32x4 acc[2][2][4][2];
#pragma unroll
    for (int a = 0; a < 2; ++a)
#pragma unroll
        for (int b = 0; b < 2; ++b)
#pragma unroll
            for (int m = 0; m < 4; ++m)
#pragma unroll
                for (int n = 0; n < 2; ++n) acc[a][b][m][n] = (f32x4){0.f, 0.f, 0.f, 0.f};
    bf16x8 At[4][2], B0[2][2], B1[2][2];
    const char* cA = cur.A; const char* cB = cur.B;
    PG8_STAGE(PG8_SB(0, 0), cB, vB[0]); PG8_STAGE(PG8_SB(0, 1), cB, vB[1]); PG8_STAGE(PG8_SA(0, 0), cA, vA[0]); PG8_STAGE(PG8_SA(0, 1), cA, vA[1]);
    if (wr == 1) PG8_BAR;
    PG8_WAIT_V(2); PG8_BAR;
    PG8_STAGE(PG8_SB(1, 0), cB + kstep, vB[0]); PG8_STAGE(PG8_SA(1, 0), cA + kstep, vA[0]); PG8_STAGE(PG8_SB(1, 1), cB + kstep, vB[1]);
    PG8_WAIT_V(6); PG8_BAR;
    for (;;) {
        const bool has_next = S.next(ui + 1, nxt);
        const char* nA = has_next ? nxt.A : cA; const char* nB = has_next ? nxt.B : cB;
        const int nt = cur.nt;
        for (int t = 0; t < nt; t += 2) {
            const bool last = (t == nt - 2);
            const char* a1 = cA + (size_t)(t + 1) * kstep;
            const char* a2 = last ? nA : cA + (size_t)(t + 2) * kstep; const char* b2 = last ? nB : cB + (size_t)(t + 2) * kstep;
            const char* a3 = a2 + kstep; const char* b3 = b2 + kstep;
            PG8_LDB(B0, 0, 0); PG8_LDB(B1, 0, 1); PG8_SCHED; PG8_LDA(At, 0, 0); PG8_STAGE(PG8_SA(1, 1), a1, vA[1]);
            if (last && has_next) mkvoff<GATHER>(nxt, vA, vB);
            PG8_WAIT_V(8); PG8_WAIT_L(0); PG8_BAR; PG8_MMA(0, 0, At, B0); PG8_MMA(0, 1, At, B1); PG8_BAR; PG8_SCHED;
            PG8_LDA(At, 0, 1); PG8_STAGE(PG8_SB(0, 0), b2, vB[0]); PG8_STAGE(PG8_SB(0, 1), b2, vB[1]); PG8_STAGE(PG8_SA(0, 0), a2, vA[0]);
            PG8_WAIT_V(8); PG8_WAIT_L(0); PG8_BAR; PG8_MMA(1, 0, At, B0); PG8_MMA(1, 1, At, B1); PG8_BAR; PG8_SCHED;
            PG8_LDB(B0, 1, 0); PG8_LDB(B1, 1, 1); PG8_SCHED; PG8_LDA(At, 1, 0); PG8_STAGE(PG8_SA(0, 1), a2, vA[1]);
            PG8_WAIT_V(8); PG8_WAIT_L(0); PG8_BAR; PG8_MMA(0, 0, At, B0); PG8_MMA(0, 1, At, B1); PG8_BAR; PG8_SCHED;
            PG8_LDA(At, 1, 1); PG8_STAGE(PG8_SB(1, 0), b3, vB[0]); PG8_STAGE(PG8_SB(1, 1), b3, vB[1]); PG8_STAGE(PG8_SA(1, 0), a3, vA[0]);
            PG8_WAIT_V(8); PG8_WAIT_L(0); PG8_BAR; PG8_MMA(1, 0, At, B0); PG8_MMA(1, 1, At, B1); PG8_BAR; PG8_SCHED;
        }
        if (wr == 0) PG8_BAR;
        E(acc, cur, wr, wc, fr, fq);
        if (!has_next) break;
#pragma unroll
        for (int a = 0; a < 2; ++a)
#pragma unroll
            for (int b = 0; b < 2; ++b)
#pragma unroll
                for (int m = 0; m < 4; ++m)
#pragma unroll
                    for (int n = 0; n < 2; ++n) acc[a][b][m][n] = (f32x4){0.f, 0.f, 0.f, 0.f};
        cur = nxt; cA = nA; cB = nB; ++ui;
        if (wr == 1) PG8_BAR;
    }
    PG8_WAIT_V(0);
    PG8_BAR;
#undef PG8_SA
#undef PG8_SB
#undef PG8_STAGE
#undef PG8_LDA
#undef PG8_LDB
#undef PG8_MMA
#undef PG8_WAIT_V
#undef PG8_WAIT_L
#undef PG8_BAR
#undef PG8_SCHED
}
}
using pg8::GUnit;

namespace att {
constexpr int D = 128, NW = 8, QBLK = 32, KVBLK = 64;
constexpr float SCALE = 0.088388347648318440f;
constexpr float THR = 8.f;
constexpr int LDQ = DM, LDK = DM, LDO = 2 * DM;
constexpr size_t SHM_V = KVBLK * D * 2, SHM_K = KVBLK * D * 2, SHM_ATTN = 2 * SHM_V + 2 * SHM_K + NW * 64 * 4;
#define KSWZ(row, colB) ((row) * 256 + ((colB) ^ (((row) & 7) << 4)))
#define SBAR() __builtin_amdgcn_sched_barrier(0)
__device__ __forceinline__ int crow(int r, int hi) { return (r & 3) + 8 * (r >> 2) + 4 * hi; }
__device__ __forceinline__ unsigned cvtpk(float lo, float hi) { unsigned r; asm volatile("v_cvt_pk_bf16_f32 %0, %1, %2" : "=v"(r) : "v"(lo), "v"(hi)); return r; }
__device__ __forceinline__ void partialSM(f32x16& p0, f32x16& p1, float mnC) {
  constexpr float C = SCALE * 1.4426950408889634f;
  for (int r = 0; r < 16; ++r) p0[r] = fmaf(p0[r], C, mnC); for (int r = 0; r < 16; ++r) p1[r] = fmaf(p1[r], C, mnC);
  for (int r = 0; r < 16; ++r) p0[r] = __builtin_amdgcn_exp2f(p0[r]);
}
__device__ __forceinline__ void finishSM(f32x16& p0, f32x16& p1, float& l_reg, bf16x8& pa0, bf16x8& pa1, bf16x8& pa2, bf16x8& pa3) {
  for (int r = 0; r < 16; ++r) p1[r] = __builtin_amdgcn_exp2f(p1[r]);
  float ps = 0; for (int r = 0; r < 16; ++r) ps += p0[r]; for (int r = 0; r < 16; ++r) ps += p1[r];
  l_reg += ps;
#define PK4(P, BASE, OUT) do { unsigned a0 = cvtpk(P[BASE + 0], P[BASE + 1]), a1 = cvtpk(P[BASE + 2], P[BASE + 3]);   \
    unsigned b0 = cvtpk(P[BASE + 4], P[BASE + 5]), b1 = cvtpk(P[BASE + 6], P[BASE + 7]);                              \
    auto r0 = __builtin_amdgcn_permlane32_swap(a0, b0, false, false); auto r1 = __builtin_amdgcn_permlane32_swap(a1, b1, false, false); \
    u32x4 w = {r0[0], r1[0], r0[1], r1[1]}; OUT = *reinterpret_cast<bf16x8*>(&w); } while (0)
  PK4(p0, 0, pa0); PK4(p0, 8, pa1); PK4(p1, 0, pa2); PK4(p1, 8, pa3);
#undef PK4
}
__device__ __forceinline__ void qkt(f32x16& p0, f32x16& p1, const bf16_t* Ks, const bf16x8* qr, int r32, int hi) {
  p0 = f32x16{}; p1 = f32x16{};
  for (int d0 = 0; d0 < 8; ++d0) { int cb = (d0 * 16 + hi * 8) * 2;
    bf16x8 b0 = *reinterpret_cast<const bf16x8*>((const char*)Ks + KSWZ(r32, cb));
    bf16x8 b1 = *reinterpret_cast<const bf16x8*>((const char*)Ks + KSWZ(32 + r32, cb));
    p0 = __builtin_amdgcn_mfma_f32_32x32x16_bf16(b0, qr[d0], p0, 0, 0, 0);
    p1 = __builtin_amdgcn_mfma_f32_32x32x16_bf16(b1, qr[d0], p1, 0, 0, 0); }
}
__device__ __forceinline__ int v_st(int k, int c) { const int kk = (k & ~0xC) | ((k & 4) << 1) | ((k & 8) >> 1); return ((kk >> 3) * 4 + (c >> 5)) * 512 + ((kk & 7) * 32 + (c & 31)) * 2; }
__device__ __forceinline__ int v_rd_base(int lane) { return ((lane & 3) << 3) | (((lane >> 2) & 3) << 6) | (((lane >> 4) & 1) << 5) | (((lane >> 5) & 1) << 8); }
constexpr int v_rd_off(int d0, int ks, int half) { return d0 * 512 + ks * 4096 + half * 2048; }
template <int OFF> __device__ __forceinline__ s16x4 tr_read(int vb) {
  s16x4 r; asm volatile("ds_read_b64_tr_b16 %0, %1 offset:%2" : "=&v"(r) : "v"(vb), "i"(OFF) : "memory"); return r;
}
template <int D0> __device__ __forceinline__ void pv_one(f32x16& od, int vb, bf16x8 pa0, bf16x8 pa1, bf16x8 pa2, bf16x8 pa3) {
  const s16x4 l0 = tr_read<v_rd_off(D0, 0, 0)>(vb), h0 = tr_read<v_rd_off(D0, 0, 1)>(vb), l1 = tr_read<v_rd_off(D0, 1, 0)>(vb), h1 = tr_read<v_rd_off(D0, 1, 1)>(vb);
  const s16x4 l2 = tr_read<v_rd_off(D0, 2, 0)>(vb), h2 = tr_read<v_rd_off(D0, 2, 1)>(vb), l3 = tr_read<v_rd_off(D0, 3, 0)>(vb), h3 = tr_read<v_rd_off(D0, 3, 1)>(vb);
  asm volatile("s_waitcnt lgkmcnt(0)" ::: "memory"); SBAR();
#define PK(L, H) (bf16x8){L[0], L[1], L[2], L[3], H[0], H[1], H[2], H[3]}
  od = __builtin_amdgcn_mfma_f32_32x32x16_bf16(pa0, PK(l0, h0), od, 0, 0, 0);
  od = __builtin_amdgcn_mfma_f32_32x32x16_bf16(pa1, PK(l1, h1), od, 0, 0, 0);
  od = __builtin_amdgcn_mfma_f32_32x32x16_bf16(pa2, PK(l2, h2), od, 0, 0, 0);
  od = __builtin_amdgcn_mfma_f32_32x32x16_bf16(pa3, PK(l3, h3), od, 0, 0, 0);
#undef PK
}
__device__ __forceinline__ void pv_d0(f32x16* o, int vb, bf16x8 pa0, bf16x8 pa1, bf16x8 pa2, bf16x8 pa3) {
  pv_one<0>(o[0], vb, pa0, pa1, pa2, pa3); pv_one<1>(o[1], vb, pa0, pa1, pa2, pa3); pv_one<2>(o[2], vb, pa0, pa1, pa2, pa3); pv_one<3>(o[3], vb, pa0, pa1, pa2, pa3);
}
__device__ __forceinline__ void attn_dense_body(const bf16_t* Qb, const bf16_t* Kh, const bf16_t* Vh, bf16_t* Ob, int seq, char* lds, float mnC) {
  int tid = threadIdx.x; asm volatile("" : "+v"(tid));
  const int wid = tid >> 6, lane = tid & 63, r32 = lane & 31, hi = lane >> 5;
  bf16_t* V_lds = (bf16_t*)lds; bf16_t* K_lds = (bf16_t*)(lds + 2 * SHM_V);
  float* ws = (float*)(lds + 2 * SHM_V + 2 * SHM_K) + wid * 64; float* li_l = ws;
  float l_reg = 0; f32x16 o[4] = {}; bf16x8 qr[8];
  const bf16_t* Qw = Qb + (long)(wid * QBLK + r32) * LDQ + hi * 8;
#pragma unroll
  for (int d0 = 0; d0 < 8; ++d0) qr[d0] = *reinterpret_cast<const bf16x8*>(Qw + d0 * 16);
  const int sr = tid >> 4, sc = (tid & 15) * 8, vst0 = v_st(sr, sc), vst1 = v_st(32 + sr, sc);
  const int vb0 = (int)(uintptr_t)V_lds + v_rd_base(lane);
  struct { bf16x8 vs0, vs1, ks0, ks1; } sr_[1];
  const unsigned goff = (unsigned)(sr * LDK + sc) * 2u;
#define SLOAD(i, k0) do { const char* vb_ = (const char*)Vh + (size_t)(k0) * (LDK * 2); const char* kb_ = (const char*)Kh + (size_t)(k0) * (LDK * 2); \
    sr_[i].vs0 = *reinterpret_cast<const bf16x8*>(vb_ + goff); sr_[i].vs1 = *reinterpret_cast<const bf16x8*>(vb_ + 32 * LDK * 2 + goff); \
    sr_[i].ks0 = *reinterpret_cast<const bf16x8*>(kb_ + goff); sr_[i].ks1 = *reinterpret_cast<const bf16x8*>(kb_ + 32 * LDK * 2 + goff); } while (0)
#define SWRITE(b, i) do { *(bf16x8*)((char*)V_lds + (b) * SHM_V + vst0) = sr_[i].vs0;          \
    *(bf16x8*)((char*)V_lds + (b) * SHM_V + vst1) = sr_[i].vs1; int kc = sc * 2;               \
    *(bf16x8*)((char*)K_lds + (b) * SHM_K + KSWZ(sr, kc)) = sr_[i].ks0;                       \
    *(bf16x8*)((char*)K_lds + (b) * SHM_K + KSWZ(32 + sr, kc)) = sr_[i].ks1; } while (0)
#define SWAIT() asm volatile("s_waitcnt vmcnt(0)" ::: "memory")
  f32x16 pA0, pA1, pB0, pB1; bf16x8 pa0, pa1, pa2, pa3; const int NT = seq / KVBLK;
  constexpr int SE = 0, SO = 0;
  SLOAD(SE, 0); asm volatile("s_waitcnt vmcnt(0)" ::: "memory"); SWRITE(0, SE); __syncthreads();
  qkt(pA0, pA1, K_lds, qr, r32, hi); partialSM(pA0, pA1, mnC);
  SLOAD(SO, KVBLK);
  SWAIT(); SWRITE(1, SO); __syncthreads();
  for (int j = 1; j + 1 < NT; j += 2) {
    SBAR(); qkt(pB0, pB1, (bf16_t*)((char*)K_lds + SHM_K), qr, r32, hi);
    finishSM(pA0, pA1, l_reg, pa0, pa1, pa2, pa3); SBAR();
    SLOAD(SO, (j + 1) * KVBLK); SBAR();
    pv_d0(o, vb0, pa0, pa1, pa2, pa3); partialSM(pB0, pB1, mnC);
    __syncthreads(); SWAIT(); SWRITE(0, SE);
    __syncthreads();
    SBAR(); qkt(pA0, pA1, K_lds, qr, r32, hi);
    finishSM(pB0, pB1, l_reg, pa0, pa1, pa2, pa3); SBAR();
    SLOAD(SE, (j + 2) * KVBLK); SBAR();
    pv_d0(o, vb0 + (int)SHM_V, pa0, pa1, pa2, pa3); partialSM(pA0, pA1, mnC);
    __syncthreads(); SWAIT(); SWRITE(1, SO);
    __syncthreads();
  }
  SBAR(); qkt(pB0, pB1, (bf16_t*)((char*)K_lds + SHM_K), qr, r32, hi);
  finishSM(pA0, pA1, l_reg, pa0, pa1, pa2, pa3); SBAR();
  pv_d0(o, vb0, pa0, pa1, pa2, pa3); partialSM(pB0, pB1, mnC);
  __syncthreads();
  finishSM(pB0, pB1, l_reg, pa0, pa1, pa2, pa3); SBAR();
  pv_d0(o, vb0 + (int)SHM_V, pa0, pa1, pa2, pa3);
  { auto rr = __builtin_amdgcn_permlane32_swap(__float_as_uint(l_reg), __float_as_uint(l_reg), false, false); l_reg = __uint_as_float(rr[0]) + __uint_as_float(rr[1]); }
  if (hi == 0) li_l[r32] = l_reg; asm volatile("s_waitcnt lgkmcnt(0)" ::: "memory");
  float rli[16];
#pragma unroll
  for (int r = 0; r < 16; ++r) rli[r] = __builtin_amdgcn_rcpf(li_l[crow(r, hi)]);
  bf16_t* Ow = Ob + (long)(wid * QBLK) * LDO;
#pragma unroll
  for (int r = 0; r < 16; ++r) { int orow = crow(r, hi);
    for (int d0 = 0; d0 < 4; ++d0) Ow[(long)orow * LDO + d0 * 32 + r32] = (bf16_t)f2bf(o[d0][r] * rli[r]); }
#undef SLOAD
#undef SWRITE
#undef SWAIT
}

constexpr size_t P_V = 0, P_K = 65536, P_X = 98304, P_LI = 131072 + 1024;
__device__ __forceinline__ void attn_pair_body(const bf16_t* Qb, const bf16_t* Kh, const bf16_t* Vh, bf16_t* Ob, int seq, char* lds, float mnC) {
  int tid = threadIdx.x; asm volatile("" : "+v"(tid));
  const int wid = __builtin_amdgcn_readfirstlane(tid >> 6), lane = tid & 63, r32 = lane & 31, hi = lane >> 5, pr = wid & 3, m = wid >> 2;
  char* V_lds = lds + P_V; char* K_lds = lds + P_K; char* X_lds = lds + P_X; float* li_all = (float*)(lds + P_LI);
  float l_reg = 0; f32x16 o[4] = {}; bf16x8 qr[8];
  const bf16_t* Qw = Qb + (long)(pr * QBLK + r32) * LDQ + hi * 8;
#pragma unroll
  for (int d0 = 0; d0 < 8; ++d0) qr[d0] = *reinterpret_cast<const bf16x8*>(Qw + d0 * 16);
  const int sr = tid >> 4, sc = (tid & 15) * 8, vst0 = v_st(sr, sc), vst1 = v_st(32 + sr, sc);
  const int vbm = (int)(uintptr_t)V_lds + m * 16384 + v_rd_base(lane);
  const unsigned goff = (unsigned)(sr * LDK + sc) * 2u;
  const int xw = (int)(pr * 4096 + (2 * m) * 1024 + lane * 16), xr = (int)(pr * 4096 + lane * 16);
  bf16x8 sk0, sk1, sv00, sv01, sv10, sv11;
#define PLOAD(k0) do { const char* vb_ = (const char*)Vh + (size_t)(k0) * (LDK * 2); const char* kb_ = (const char*)Kh + (size_t)(k0) * (LDK * 2); \
    sk0 = *reinterpret_cast<const bf16x8*>(kb_ + goff); sk1 = *reinterpret_cast<const bf16x8*>(kb_ + 32 * LDK * 2 + goff); \
    sv00 = *reinterpret_cast<const bf16x8*>(vb_ + goff); sv01 = *reinterpret_cast<const bf16x8*>(vb_ + goff + 256); \
    sv10 = *reinterpret_cast<const bf16x8*>(vb_ + 32 * LDK * 2 + goff); sv11 = *reinterpret_cast<const bf16x8*>(vb_ + 32 * LDK * 2 + goff + 256); } while (0)
#define PWRITE(b) do { char* vd_ = V_lds + (b) * 32768; char* kd_ = K_lds + (b) * 16384; int kc = sc * 2; \
    *(bf16x8*)(vd_ + vst0) = sv00; *(bf16x8*)(vd_ + 16384 + vst0) = sv01; *(bf16x8*)(vd_ + vst1) = sv10; *(bf16x8*)(vd_ + 16384 + vst1) = sv11; \
    *(bf16x8*)(kd_ + KSWZ(sr, kc)) = sk0; *(bf16x8*)(kd_ + KSWZ(32 + sr, kc)) = sk1; } while (0)
#define PSCORE(b) do { f32x16 p = f32x16{}; const char* kb_ = K_lds + (b) * 16384; \
    _Pragma("unroll") for (int d0 = 0; d0 < 8; ++d0) { const int cb = (d0 * 16 + hi * 8) * 2; \
      const bf16x8 kf = *reinterpret_cast<const bf16x8*>(kb_ + KSWZ(32 * m + r32, cb)); p = __builtin_amdgcn_mfma_f32_32x32x16_bf16(kf, qr[d0], p, 0, 0, 0); } \
    constexpr float C_ = SCALE * 1.4426950408889634f; \
    _Pragma("unroll") for (int r = 0; r < 16; ++r) p[r] = __builtin_amdgcn_exp2f(fmaf(p[r], C_, mnC)); \
    float ps = 0.f; _Pragma("unroll") for (int r = 0; r < 16; ++r) ps += p[r]; l_reg += ps; \
    bf16x8 f0, f1; \
    { unsigned a0 = cvtpk(p[0], p[1]), a1 = cvtpk(p[2], p[3]), b0 = cvtpk(p[4], p[5]), b1 = cvtpk(p[6], p[7]); \
      auto r0 = __builtin_amdgcn_permlane32_swap(a0, b0, false, false); auto r1 = __builtin_amdgcn_permlane32_swap(a1, b1, false, false); u32x4 w = {r0[0], r1[0], r0[1], r1[1]}; f0 = *reinterpret_cast<bf16x8*>(&w); } \
    { unsigned a0 = cvtpk(p[8], p[9]), a1 = cvtpk(p[10], p[11]), b0 = cvtpk(p[12], p[13]), b1 = cvtpk(p[14], p[15]); \
      auto r0 = __builtin_amdgcn_permlane32_swap(a0, b0, false, false); auto r1 = __builtin_amdgcn_permlane32_swap(a1, b1, false, false); u32x4 w = {r0[0], r1[0], r0[1], r1[1]}; f1 = *reinterpret_cast<bf16x8*>(&w); } \
    *(bf16x8*)(X_lds + (b) * 16384 + xw) = f0; *(bf16x8*)(X_lds + (b) * 16384 + xw + 1024) = f1; } while (0)
#define PPV(b) do { const char* xb_ = X_lds + (b) * 16384 + xr; \
    const bf16x8 pa0 = *reinterpret_cast<const bf16x8*>(xb_), pa1 = *reinterpret_cast<const bf16x8*>(xb_ + 1024), pa2 = *reinterpret_cast<const bf16x8*>(xb_ + 2048), pa3 = *reinterpret_cast<const bf16x8*>(xb_ + 3072); \
    pv_d0(o, vbm + (b) * 32768, pa0, pa1, pa2, pa3); } while (0)
  const int NT = seq / KVBLK;
  PLOAD(0); asm volatile("s_waitcnt vmcnt(0)" ::: "memory"); PWRITE(0); __syncthreads();
  PSCORE(0);
  PLOAD(KVBLK); asm volatile("s_waitcnt vmcnt(0)" ::: "memory"); PWRITE(1); __syncthreads();
  for (int j = 1; j + 1 < NT; j += 2) {
    SBAR(); PLOAD((j + 1) * KVBLK); SBAR();
    PSCORE(1); PPV(0);
    __syncthreads(); asm volatile("s_waitcnt vmcnt(0)" ::: "memory"); PWRITE(0); __syncthreads();
    SBAR(); PLOAD((j + 2) * KVBLK); SBAR();
    PSCORE(0); PPV(1);
    __syncthreads(); asm volatile("s_waitcnt vmcnt(0)" ::: "memory"); PWRITE(1); __syncthreads();
  }
  PSCORE(1); SBAR(); PPV(0);
  __syncthreads();
  PPV(1);
  { auto rr = __builtin_amdgcn_permlane32_swap(__float_as_uint(l_reg), __float_as_uint(l_reg), false, false); l_reg = __uint_as_float(rr[0]) + __uint_as_float(rr[1]); }
  if (hi == 0) li_all[wid * 32 + r32] = l_reg;
  __syncthreads();
  float rli[16];
#pragma unroll
  for (int r = 0; r < 16; ++r) { const int q_ = crow(r, hi); rli[r] = __builtin_amdgcn_rcpf(li_all[wid * 32 + q_] + li_all[(wid ^ 4) * 32 + q_]); }
  bf16_t* Ow = Ob + (long)(pr * QBLK) * LDO + m * 128;
#pragma unroll
  for (int r = 0; r < 16; ++r) { int orow = crow(r, hi);
    for (int d0 = 0; d0 < 4; ++d0) Ow[(long)orow * LDO + d0 * 32 + r32] = (bf16_t)f2bf(o[d0][r] * rli[r]); }
  __syncthreads();
#undef PLOAD
#undef PWRITE
#undef PSCORE
#undef PPV
}
#undef KSWZ
#undef SBAR
}


#define XB_TMO      128
#define XB_XCNT(j)  (256  + 64 * (j))
#define XB_XSUB(j)  (1280 + 64 * (j))
#define XB_XGEN(j)  (2304 + 64 * (j))
#define XB_TOP      3328
#define XB_TOPGEN   3392
#define XCD_BAR_WORDS 3456
#define XB_SPIN_CAP (1u << 18)
__device__ __forceinline__ unsigned xb_ld(unsigned* p)              { return __hip_atomic_load(p, __ATOMIC_RELAXED, __HIP_MEMORY_SCOPE_AGENT); }
__device__ __forceinline__ unsigned xb_add(unsigned* p, unsigned v) { return __hip_atomic_fetch_add(p, v, __ATOMIC_RELAXED, __HIP_MEMORY_SCOPE_AGENT); }
__device__ __forceinline__ unsigned xb_xcc_id() { return (unsigned)__builtin_amdgcn_s_getreg((3 << 11) | 20) & 0xFu; }
#define XB_SPIN(cond, bar) do { unsigned _sp = 0; while (cond) { __builtin_amdgcn_s_sleep(1); \
    if ((++_sp & 255u) == 0u) { if (xb_ld(&(bar)[XB_TMO])) break; if (_sp > XB_SPIN_CAP) { atomicAdd(&(bar)[XB_TMO], 1u); break; } } } } while (0)
__device__ __forceinline__ void xcd_barrier_complete(unsigned* bar, unsigned x, unsigned& nloc, unsigned& nx) {
    const unsigned G = gridDim.x * gridDim.y * gridDim.z;
    unsigned sum, cnt, mine, sp = 0u;
    for (;;) {
        sum = 0u; cnt = 0u; mine = 0u;
#pragma unroll
        for (unsigned j = 0; j < 16; ++j) { const unsigned c = xb_ld(&bar[XB_XCNT(j)]); sum += c; cnt += (c > 0u) ? 1u : 0u; mine = (j == x) ? c : mine; }
        if (sum == G) break;
        __builtin_amdgcn_s_sleep(1);
        if ((++sp & 255u) == 0u) { if (xb_ld(&bar[XB_TMO])) break; if (sp > XB_SPIN_CAP) { atomicAdd(&bar[XB_TMO], 1u); break; } }
    }
    nloc = mine > 0u ? mine : 1u; nx = cnt > 0u ? cnt : 1u;
}
__device__ __forceinline__ void xcd_barrier(unsigned* bar, volatile LAS unsigned* st) {
    asm volatile("s_waitcnt vmcnt(0)" ::: "memory");
    __syncthreads();
    if (threadIdx.x == 0) {
        const unsigned x = xb_xcc_id();
        __builtin_amdgcn_s_waitcnt(0);
        unsigned nloc = st[0], nx = st[1];
        if (nloc == 0u) { xcd_barrier_complete(bar, x, nloc, nx); st[0] = nloc; st[1] = nx; }
        const unsigned old = xb_add(&bar[XB_XSUB(x)], 1u);
        const unsigned gen = old / nloc;
        if (old + 1u == (gen + 1u) * nloc) {
            __builtin_amdgcn_fence(__ATOMIC_RELEASE, "agent");
            asm volatile("s_waitcnt vmcnt(0)" ::: "memory");
            const unsigned og = xb_add(&bar[XB_TOP], 1u);
            const unsigned tg = og / nx;
            if (og + 1u == (tg + 1u) * nx) xb_add(&bar[XB_TOPGEN], 1u);
            else XB_SPIN(xb_ld(&bar[XB_TOPGEN]) == tg, bar);
            __builtin_amdgcn_fence(__ATOMIC_ACQUIRE, "agent");
            xb_add(&bar[XB_XGEN(x)], 1u);
            asm volatile("s_waitcnt vmcnt(0)" ::: "memory");
        } else {
            XB_SPIN(xb_ld(&bar[XB_XGEN(x)]) == gen, bar);
            __builtin_amdgcn_fence(__ATOMIC_ACQUIRE, "agent");
            asm volatile("s_waitcnt vmcnt(0)" ::: "memory");
        }
    }
    __syncthreads();
}

struct Args;
typedef const __attribute__((address_space(4))) Args* KArgsP;
struct Args {
    const float *x, *c, *ctx, *c_ctx, *norm1_w, *norm2_w, *w_mod, *b_mod, *even_w_in, *even_conv_w, *even_w_out, *odd_w_qkv, *odd_q_norm, *odd_k_norm,
                *lq1, *lk1, *lq2, *lk2, *subln_w, *odd_w_out, *moe_w_group, *moe_b_group, *moe_w_expert, *moe_b_expert, *moe_w_gate, *moe_w_up, *moe_w_down;
    float* out; unsigned char* ws; int ph_lo, ph_hi;
};

__device__ __forceinline__ KArgsP kargs() { KArgsP p = (KArgsP)__builtin_amdgcn_kernarg_segment_ptr(); asm volatile("" : "+s"(p)); return p; }

__device__ __forceinline__ void transpose_item(const float* W, int ldw, int K, bf16_t* WT, int dst_row0, int k0, int n0, LAS float* scr, int lane) {
#pragma unroll 8
    for (int i = 0; i < 32; ++i) { const int kk = 2 * i + (lane >> 5); scr[kk * 33 + (lane & 31)] = W[(size_t)(k0 + kk) * ldw + n0 + (lane & 31)]; }
    asm volatile("s_waitcnt lgkmcnt(0)" ::: "memory");
    const int c = lane & 7;
#pragma unroll
    for (int j = 0; j < 4; ++j) { const int n = (lane >> 3) + 8 * j; const LAS float* s = scr + (8 * c) * 33 + n;
        u32x4 o; o.x = pk2(s[0 * 33], s[1 * 33]); o.y = pk2(s[2 * 33], s[3 * 33]); o.z = pk2(s[4 * 33], s[5 * 33]); o.w = pk2(s[6 * 33], s[7 * 33]);
        *(u32x4*)(WT + (size_t)(dst_row0 + n) * K + k0 + 8 * c) = o; }
    asm volatile("s_waitcnt lgkmcnt(0)" ::: "memory");
}
__device__ __forceinline__ void moe_weight_items(const float* w_gate, const float* w_up, const float* w_down, unsigned char* ws, int l, int gw, int ngw, LAS float* scr, int lane) {
    bf16_t* WGU = (bf16_t*)(ws + WS_WGU); bf16_t* WD = (bf16_t*)(ws + WS_WD);
    constexpr int I_G = NEXP * 32 * 16, I_D = NEXP * 8 * 64;
    for (int it = gw; it < 2 * I_G + I_D; it += ngw) {
        if (it < 2 * I_G) { const int up = it >= I_G, r = up ? it - I_G : it, e = r / 512, kb = (r % 512) / 16, nb = r % 16;
            const float* W = (up ? w_up : w_gate) + ((size_t)l * NEXP + e) * DM * EFF;
            const int n0 = nb * 32, row0 = e * 1024 + (n0 >> 7) * 256 + up * 128 + (n0 & 127);
            transpose_item(W, EFF, DM, WGU, row0, kb * 64, n0, scr, lane);
        } else { const int r = it - 2 * I_G, e = r / 512, kb = (r % 512) / 64, nb = r % 64;
            const float* W = w_down + ((size_t)l * NEXP + e) * EFF * DM;
            transpose_item(W, DM, EFF, WD, e * DM + nb * 32, kb * 64, nb * 32, scr, lane); }
    }
}

__device__ __forceinline__ void plain_store(GUnit& u, int ldc) { u.ldc = ldc; u.rs1 = 64 * ldc; u.rs2 = ldc; u.cs = 64; u.nrow = 256; u.bperm = 0; }
struct SchedInProj {
    const char *u0, *win; char *P, *zt2, *ztc; int G, c;
    __device__ __forceinline__ bool next(int i, GUnit& u) const {
        const int L = i * G + c; if (L >= 816 + 544) return false;
        u.lda = DM * 2; u.ldb = DM * 2; u.nt = DM / 64; u.scale = 1.f;
        if (L < 816) { int pm, pn; pg8::tile_of(L, 68, 12, pm, pn);
            u.A = u0 + (size_t)pm * 256 * DM * 2; u.B = win + (size_t)pn * 256 * DM * 2; u.O = P + ((size_t)pm * 256 * 3072 + pn * 256) * 2; plain_store(u, 3072);
        } else { int pm, pn; pg8::tile_of(L - 816, 8, 68, pm, pn);
            u.A = win + (size_t)(3072 + pm * 256) * DM * 2;
            const int g = pm >> 1, part = pm & 1, b = pn / 17, jt = pn % 17;
            if (jt == 0) { u.B = u0 + (size_t)pn * 256 * DM * 2; u.O = ztc + ((size_t)((b * 4 + g) * 256) * 512 + part * 256) * 2; plain_store(u, 512); }
            else { const int tq = jt - 1;
                u.B = u0 + (size_t)(b * TPB + CTX + 4 * tq) * DM * 2;
                u.O = zt2 + (((size_t)((b * 4 + g) * 256) * 64 + 4 * tq) * 128 + part * 64) * 2;
                u.ldc = 8192; u.rs1 = 64 * 8192; u.rs2 = 8192; u.cs = 128; u.nrow = 256; u.bperm = 1; } }
        return true;
    }
};
struct SchedFftA {
    const char *ma, *cmatc, *zt2, *ztc; char *uf, *ycat; int G, c;
    __device__ __forceinline__ bool next(int i, GUnit& u) const {
        const int L = i * G + c; if (L >= 1024 + 16) return false;
        if (L < 1024) { const int w = (L % 8) * 128 + L / 8, bg = w >> 6, chq = w & 63;
            u.A = ma; u.lda = 256; u.B = zt2 + (size_t)((bg * 256 + 4 * chq) * 64) * 256; u.ldb = 256; u.nt = 2;
            u.O = uf + (size_t)(bg * 256 + 4 * chq) * 8192 * 2; u.ldc = 64; u.rs1 = 4096; u.rs2 = 64; u.cs = 8192; u.nrow = 128; u.bperm = 0; u.scale = 1.f;
        } else { const int bg = L - 1024, b = bg >> 2, g = bg & 3;
            u.A = cmatc; u.B = ztc + (size_t)bg * 256 * 1024; u.lda = 1024; u.ldb = 1024; u.nt = 8;
            u.O = ycat + ((size_t)(b * TPB) * DM + 1024 + g * 256) * 2; plain_store(u, DM); u.scale = 1.0f / 256.0f; }
        return true;
    }
};
struct SchedFftB {
    const char *mb, *uf; char* ycat; int G, c;
    __device__ __forceinline__ bool next(int i, GUnit& u) const {
        const int L = i * G + c; if (L >= 256) return false;
        const int w = (L % 8) * 32 + L / 8, bg = w >> 4, kb = w & 15, b = bg >> 2, g = bg & 3;
        u.A = mb + (size_t)kb * 256 * 1024; u.lda = 1024; u.B = uf + ((size_t)bg * 256 * 8192 + kb * 512) * 2; u.ldb = 16384; u.nt = 8;
        u.O = ycat + ((size_t)(b * TPB + CTX + 4 * kb) * DM + 1024 + g * 256) * 2; u.ldc = DM; u.rs1 = DM; u.rs2 = 64 * DM; u.cs = 64; u.nrow = 256; u.bperm = 0; u.scale = 1.0f / 1024.0f;
        return true;
    }
};
struct SchedOut0 {
    const char *ycat, *wout; const float *x, *ctx, *mod; char* h; int G, c;
    __device__ __forceinline__ bool next(int i, GUnit& u) const {
        const int L = i * G + c; if (L >= 68 * 8) return false;
        int pm, pn; pg8::tile_of(L, 68, 8, pm, pn);
        u.A = ycat + (size_t)pm * 256 * DM * 2; u.B = wout + (size_t)pn * 256 * DM * 2; u.lda = DM * 2; u.ldb = DM * 2; u.nt = DM / 64;
        const int b = pm / 17, jt = pm % 17, v = (jt == 0) ? 4 : b;
        u.src = (const char*)((jt == 0 ? ctx + (size_t)b * CTX * DM : x + ((size_t)b * SEQ + (jt - 1) * 256) * DM) + pn * 256);
        u.gate = mod + (size_t)v * MODSZ + 2 * DM + pn * 256;
        u.O = h + ((size_t)pm * 256 * DM + pn * 256) * 2; u.bperm = 0;
        return true;
    }
};
struct SchedOut1 {
    const char *a, *wout; const float* mod; char* h; int G, c;
    __device__ __forceinline__ bool next(int i, GUnit& u) const {
        const int L = i * G + c; if (L >= 64 * 8) return false;
        int lt, pn; pg8::tile_of(L, 64, 8, lt, pn);
        const int b = lt >> 4, ut = b * 17 + 1 + (lt & 15);
        u.A = a + (size_t)ut * 256 * DM * 2; u.B = wout + (size_t)pn * 256 * DM * 2; u.lda = DM * 2; u.ldb = DM * 2; u.nt = DM / 64;
        u.bperm = 0; u.O = h + ((size_t)ut * 256 * DM + pn * 256) * 2; u.src = u.O; u.gate = mod + (size_t)b * MODSZ + 2 * DM + pn * 256;
        return true;
    }
};
struct SchedQKV {
    const char *u1, *wqkv; char *q; int G, c;
    __device__ __forceinline__ bool next(int i, GUnit& u) const {
        const int L = i * G + c; if (L >= 1536 + 64) return false;
        int ut, pn;
        if (L < 1536) { int lt; pg8::tile_of(L, 64, 24, lt, pn); ut = (lt >> 4) * 17 + 1 + (lt & 15); }
        else { const int r = L - 1536; ut = (r & 3) * 17; pn = 8 + (r >> 2); }
        u.A = u1 + (size_t)ut * 256 * DM * 2; u.B = wqkv + (size_t)pn * 256 * DM * 2; u.lda = DM * 2; u.ldb = DM * 2; u.nt = DM / 64; u.scale = 1.f; plain_store(u, DM);
        u.O = q + (size_t)(pn >> 3) * (WS_K - WS_Q) + ((size_t)ut * 256 * DM + (pn & 7) * 256) * 2;
        return true;
    }
};
struct MoeTiles {
    const LAS int* tab;
    __device__ __forceinline__ void init(LAS int* t, const unsigned* cntp) {
        tab = t;
        if (threadIdx.x == 0) { int s = 0;
            for (int e = 0; e < NEXP; ++e) { const int c = (int)cntp[e]; t[e] = c; t[16 + e] = s; s += (c + 255) >> 8; }
            t[32] = s; }
        __syncthreads();
    }
    __device__ __forceinline__ int total() const { return __builtin_amdgcn_readfirstlane(tab[32]); }
    __device__ __forceinline__ void find(int rtg, int& e, int& rt, int& gc) const {
        int ee = 0;
#pragma unroll
        for (int j = 1; j < NEXP; ++j) if (rtg >= tab[16 + j]) ee = j;
        e = __builtin_amdgcn_readfirstlane(ee);
        const int tbe = __builtin_amdgcn_readfirstlane(tab[16 + e]), ce = __builtin_amdgcn_readfirstlane(tab[e]);
        rt = rtg - tbe; gc = ce - rt * 256; if (gc > 256) gc = 256;
    }
};
struct SchedMoe1 {
    MoeTiles T; const char *v, *wgu; char* hid; const int* lst; int G, c;
    __device__ __forceinline__ bool next(int i, GUnit& u) const {
        const int L = i * G + c, nwg = T.total() * 4; if (L >= nwg) return false;
        const int w = pg8::xcd_remap(L, nwg), rtg = w >> 2, pn = w & 3; int e, rt, gc; T.find(rtg, e, rt, gc);
        u.A = v; u.lda = DM * 2; u.glist = lst + (size_t)e * LCAP + rt * 256; u.gcount = gc;
        u.B = wgu + ((size_t)e * 1024 + pn * 256) * DM * 2; u.ldb = DM * 2; u.nt = DM / 64;
        u.O = hid + ((size_t)rtg * 256 * EFF + pn * 128) * 2; u.ldc = EFF; u.bperm = 0;
        return true;
    }
};
struct SchedMoe2 {
    MoeTiles T; const char *hid, *wd; const int* lst; int G, c;
    __device__ __forceinline__ bool next(int i, GUnit& u) const {
        const int L = i * G + c, nwg = T.total() * 8; if (L >= nwg) return false;
        const int w = pg8::xcd_remap(L, nwg), rtg = w >> 3, pn = w & 7; int e, rt, gc; T.find(rtg, e, rt, gc);
        u.A = hid + (size_t)rtg * 256 * EFF * 2; u.lda = EFF * 2; u.B = wd + ((size_t)e * DM + pn * 256) * EFF * 2; u.ldb = EFF * 2; u.nt = EFF / 64;
        u.glist = lst + (size_t)e * LCAP + rt * 256; u.gcount = gc; u.aux = pn; u.bperm = 0;
        return true;
    }
};

__device__ __forceinline__ void row_info(int row, int& b, int& j) { b = row / TPB; j = row - b * TPB; }

__device__ __forceinline__ void norm_mod_store(const f32x4 (&v)[8], float rstd, const float* nw, const float* sc, const float* sh, bf16_t* orow, int lane) {
#pragma unroll
    for (int jj = 0; jj < 8; ++jj) { const int k = 4 * lane + 256 * jj;
        const f32x4 w = *(const f32x4*)(nw + k), s = *(const f32x4*)(sc + k), t = *(const f32x4*)(sh + k);
        const f32x4 y = v[jj] * rstd * w * (1.0f + s) + t;
        u32x2 o; o.x = pk2(y[0], y[1]); o.y = pk2(y[2], y[3]); *(u32x2*)(orow + k) = o; }
}

__device__ __forceinline__ void route_row(const LAS float* yl, const float* wg, const float* bg, const float* we, const float* be, int lane, int& e0, int& e1, float& w0, float& w1) {
    float lg[4] = {0.f, 0.f, 0.f, 0.f}; float le[16];
#pragma unroll
    for (int n = 0; n < 16; ++n) le[n] = 0.f;
#pragma unroll 1
    for (int jj = 0; jj < 8; ++jj) { const f32x4 y4 = *(const LAS f32x4*)(yl + 4 * lane + 256 * jj);
#pragma unroll
        for (int i = 0; i < 4; ++i) { const int k = 4 * lane + 256 * jj + i; const float xv = y4[i];
            const f32x4 g = *(const f32x4*)(wg + (size_t)k * 4);
#pragma unroll
            for (int n = 0; n < 4; ++n) lg[n] = fmaf(xv, g[n], lg[n]);
#pragma unroll
            for (int q = 0; q < 4; ++q) { const f32x4 ev = *(const f32x4*)(we + (size_t)k * 16 + 4 * q);
#pragma unroll
                for (int n = 0; n < 4; ++n) le[4 * q + n] = fmaf(xv, ev[n], le[4 * q + n]); } } }
#pragma unroll
    for (int n = 0; n < 4; ++n) lg[n] = wave_sum(lg[n]) + bg[n];
#pragma unroll
    for (int n = 0; n < 16; ++n) le[n] = wave_sum(le[n]) + be[n];
    int gi = 0; float gm = lg[0];
#pragma unroll
    for (int n = 1; n < 4; ++n) if (lg[n] > gm) { gm = lg[n]; gi = n; }
    float den = 0.f;
#pragma unroll
    for (int n = 0; n < 4; ++n) den += __expf(lg[n] - gm);
    const float gw = 1.0f / den;
    float s[4];
#pragma unroll
    for (int n = 0; n < 4; ++n) { const float m0 = (gi == 0) ? 1.f : 0.f, m1 = (gi == 1) ? 1.f : 0.f, m2 = (gi == 2) ? 1.f : 0.f, m3 = (gi == 3) ? 1.f : 0.f; s[n] = le[n] * m0 + le[4 + n] * m1 + le[8 + n] * m2 + le[12 + n] * m3; }
    int i0 = 0; float v0 = s[0];
#pragma unroll
    for (int n = 1; n < 4; ++n) if (s[n] > v0) { v0 = s[n]; i0 = n; }
    int i1 = -1; float v1 = -3.0e38f;
#pragma unroll
    for (int n = 0; n < 4; ++n) if (n != i0 && s[n] > v1) { v1 = s[n]; i1 = n; }
    const float ex = __expf(v1 - v0), inv = 1.0f / (1.0f + ex);
    e0 = gi * 4 + i0; e1 = gi * 4 + i1; w0 = inv * gw; w1 = ex * inv * gw;
}

#define PHASE_BEGIN KArgsP ka = kargs(); unsigned char* ws = ka->ws; (void)ws; int tid = threadIdx.x; asm volatile("" : "+v"(tid)); const int lane = tid & 63, wave = __builtin_amdgcn_readfirstlane(tid >> 6), gw = blk * NWAVES + wave; (void)lane; (void)gw;
#define ctl ((unsigned*)(ws + WS_CTL))
#define mod ((float*)(ws + WS_MOD))
#define tokw ((float*)(ws + WS_TOKW))
#define list ((int*)(ws + WS_LIST))
#define WIN ((bf16_t*)(ws + WS_WIN))
#define WOUT0 ((bf16_t*)(ws + WS_WOUT0))
#define WQKV ((bf16_t*)(ws + WS_WQKV))
#define WOUT1 ((bf16_t*)(ws + WS_WOUT1))
#define CMAT ((bf16_t*)(ws + WS_CMAT))
#define CMATC ((bf16_t*)(ws + WS_CMATC))
#define H ((bf16_t*)(ws + WS_H))
#define U ((bf16_t*)(ws + WS_U))
#define PB ((bf16_t*)(ws + WS_P))
#define YCAT ((bf16_t*)(ws + WS_YCAT))
#define QB ((bf16_t*)(ws + WS_Q))
#define KB ((bf16_t*)(ws + WS_K))
#define VB ((bf16_t*)(ws + WS_V))
#define AB ((bf16_t*)(ws + WS_A))
#define YB ((bf16_t*)(ws + WS_Y))
#define OB ((bf16_t*)(ws + WS_O))
#ifndef PHMASK
#define PHMASK 0x3ffff
#endif
#define PHON(k) (((PHMASK) >> (k)) & 1)
#define IN(k) (lo <= (k) && (k) < hi)
#ifndef XSYNC
#define XSYNC 0
#endif
#define BARW ((unsigned*)(kargs()->ws + WS_CTL) + 4096)
#define BARST ((volatile LAS unsigned*)(lds + RING_BYTES + 512))
#define SYNC(k) do { if (IN(k) && IN((k) + 1)) { \
        if ((k) == 0) { grid.sync(); if (threadIdx.x == 0) (void)xb_add(&BARW[XB_XCNT(xb_xcc_id())], 1u); }     \
        else xcd_barrier(BARW, BARST); \
        if ((k) == 1) for (int xs_ = 0; xs_ < XSYNC; ++xs_) xcd_barrier(BARW, BARST); } } while (0)
#define TS(k) do { if (PROBE && blockIdx.x == 0 && threadIdx.x == 0) { const unsigned long long t_ = __builtin_amdgcn_s_memrealtime(); unsigned long long* tp_ = (unsigned long long*)(kargs()->ws + WS_CTL + 1024); \
        if ((k) == PA0) tp_[0] = t_; if ((k) == PA1) tp_[1] = t_; if ((k) == PB0) tp_[2] = t_; if ((k) == PB1) tp_[3] = t_; } } while (0)
template <int l>
__device__ __forceinline__ void moe_layer(cg::grid_group& grid, LAS unsigned char* lds, int lo, int hi, int G, int blk) {
    const int pb = (l == 0) ? 5 : 14;
#define cnt (ctl + 32 * l)
#define modl (mod + (size_t)l * 5 * MODSZ)
        TS(pb);
        if (PHON(5) && IN(pb)) REPS(5) { PHASE_BEGIN
            LAS int* ri = (LAS int*)lds;
            LAS float* part = (LAS float*)(lds + 4096);
            LAS float* ssq = (LAS float*)(lds + 16384);
            LAS float* rstdL = (LAS float*)(lds + 16896);
            LAS float* red = (LAS float*)(lds + 17408);
            const int ntiles = (l == 0 ? NTOK : NLAT) / 16, t0 = (ntiles * blk) / G, t1 = (ntiles * (blk + 1)) / G;
            const float* wg = ka->moe_w_group + (size_t)l * DM * 4; const float* bgp = ka->moe_b_group + l * 4;
            const float* we = ka->moe_w_expert + (size_t)l * DM * 16; const float* bep = ka->moe_b_expert + l * 16;
            const float* nw = ka->norm2_w + l * DM;
            const float* cbuf = (const float*)(ctl + 8192) + (size_t)l * 5 * 32;
            const int r = lane & 15, q = lane >> 4, K0 = wave * 256;
            float Be[16][4], Bg[16][4]; int curv = -1;
            for (int t = t0; t < t1; ++t) {
                const int row0 = (l == 0) ? t * 16 : ((t * 16) / SEQ) * TPB + CTX + ((t * 16) % SEQ);
                int b, j; row_info(row0, b, j); const int v = (j < CTX) ? 4 : b;
                const float* mv = modl + (size_t)v * MODSZ;
                if (v != curv) { curv = v;
                    gcf wep = (gcf)(we + (size_t)(K0 + 4 * q) * 16 + r); gcf wgp = (gcf)(wg + (size_t)(K0 + 4 * q) * 4 + (r & 3));
                    gcf nwp = (gcf)(nw + K0 + 4 * q); gcf scp = (gcf)(mv + 4 * DM + K0 + 4 * q); const float gmask = (r < 4) ? 1.f : 0.f;
#pragma unroll
                    for (int c = 0; c < 16; ++c) { const f32x4 w4 = *(const __attribute__((address_space(1))) f32x4*)nwp, s4 = *(const __attribute__((address_space(1))) f32x4*)scp;
#pragma unroll
                        for (int s_ = 0; s_ < 4; ++s_) { const float av = w4[s_] * (1.0f + s4[s_]); Be[c][s_] = av * wep[s_ * 16]; Bg[c][s_] = av * gmask * wgp[s_ * 4]; }
                        wep += 256; wgp += 64; nwp += 16; scp += 16; asm volatile("" : "+v"(wep), "+v"(wgp), "+v"(nwp), "+v"(scp) :: "memory"); } }
                const bf16_t* hrow = H + (size_t)(row0 + r) * DM + K0 + 4 * q;
                f32x4 ae = {0.f, 0.f, 0.f, 0.f}, ag = {0.f, 0.f, 0.f, 0.f}; float ss = 0.f;
#pragma unroll
                for (int hf = 0; hf < 2; ++hf) { f32x4 Av[8];
#pragma unroll
                    for (int c = 0; c < 8; ++c) Av[c] = bf4(*(const u32x2*)(hrow + 16 * (8 * hf + c)));
#pragma unroll
                    for (int c = 0; c < 8; ++c)
#pragma unroll
                        for (int s_ = 0; s_ < 4; ++s_) { const float x = Av[c][s_]; ss = fmaf(x, x, ss);
                            ae = __builtin_amdgcn_mfma_f32_16x16x4f32(x, Be[8 * hf + c][s_], ae, 0, 0, 0); ag = __builtin_amdgcn_mfma_f32_16x16x4f32(x, Bg[8 * hf + c][s_], ag, 0, 0, 0); }
                    asm volatile("" ::: "memory"); }
                ss += __shfl_xor(ss, 16); ss += __shfl_xor(ss, 32);
                if (q == 0) ssq[wave * 16 + r] = ss;
#pragma unroll
                for (int g_ = 0; g_ < 4; ++g_) { part[(wave * 16 + 4 * q + g_) * 20 + r] = ae[g_]; if (r < 4) part[(wave * 16 + 4 * q + g_) * 20 + 16 + r] = ag[g_]; }
                __syncthreads();
                if (tid < 320) { float p = 0.f;
#pragma unroll
                    for (int w = 0; w < 8; ++w) p += part[w * 320 + tid];
                    red[tid] = p; }
                __syncthreads();
                if (tid < 16) { float sum = 0.f;
#pragma unroll
                    for (int w = 0; w < 8; ++w) sum += ssq[w * 16 + tid];
                    const float rstd = rsqrtf(sum * (1.0f / DM) + EPS); rstdL[tid] = rstd;
                    float lg[20];
#pragma unroll
                    for (int n = 0; n < 20; ++n) lg[n] = rstd * red[tid * 20 + n] + cbuf[v * 32 + n];
                    int gi = 0; float gm = lg[16];
#pragma unroll
                    for (int n = 1; n < 4; ++n) if (lg[16 + n] > gm) { gm = lg[16 + n]; gi = n; }
                    float den = 0.f;
#pragma unroll
                    for (int n = 0; n < 4; ++n) den += __expf(lg[16 + n] - gm);
                    const float gwt = 1.0f / den; float sv[4];
#pragma unroll
                    for (int n = 0; n < 4; ++n) { const float m0 = (gi == 0) ? 1.f : 0.f, m1 = (gi == 1) ? 1.f : 0.f, m2 = (gi == 2) ? 1.f : 0.f, m3 = (gi == 3) ? 1.f : 0.f; sv[n] = lg[n] * m0 + lg[4 + n] * m1 + lg[8 + n] * m2 + lg[12 + n] * m3; }
                    int i0 = 0; float v0 = sv[0];
#pragma unroll
                    for (int n = 1; n < 4; ++n) if (sv[n] > v0) { v0 = sv[n]; i0 = n; }
                    int i1 = -1; float v1 = -3.0e38f;
#pragma unroll
                    for (int n = 0; n < 4; ++n) if (n != i0 && sv[n] > v1) { v1 = sv[n]; i1 = n; }
                    const float ex = __expf(v1 - v0), inv = 1.0f / (1.0f + ex);
                    const int row = row0 + tid, ix = (t - t0) * 16 + tid;
                    ri[ix * 4 + 0] = gi * 4 + i0; ri[ix * 4 + 1] = gi * 4 + i1; ri[ix * 4 + 2] = row * 2; ri[ix * 4 + 3] = row * 2 + 1;
                    tokw[row * 2] = inv * gwt; tokw[row * 2 + 1] = ex * inv * gwt; }
                __syncthreads();
                { const float rstd = rstdL[r]; gbf up = (gbf)(U + (size_t)(row0 + r) * DM + K0 + 4 * q); typedef const __attribute__((address_space(1))) bf16_t* gcb; gcb hp = (gcb)hrow;
                    gcf nwp = (gcf)(nw + K0 + 4 * q); gcf scp = (gcf)(mv + 4 * DM + K0 + 4 * q); gcf shp = (gcf)(mv + 3 * DM + K0 + 4 * q);
#pragma unroll
                    for (int c = 0; c < 16; ++c) { typedef const __attribute__((address_space(1))) f32x4* g4; const f32x4 w4 = *(g4)nwp, s4 = *(g4)scp, t4 = *(g4)shp;
                        const f32x4 y = bf4(*(const __attribute__((address_space(1))) u32x2*)hp) * rstd * w4 * (1.0f + s4) + t4;
                        u32x2 o; o.x = pk2(y[0], y[1]); o.y = pk2(y[2], y[3]); *(__attribute__((address_space(1))) u32x2*)up = o;
                        nwp += 16; scp += 16; shp += 16; hp += 16; up += 16;
                        if ((c & 3) == 3) asm volatile("" : "+v"(nwp), "+v"(scp), "+v"(shp), "+v"(hp), "+v"(up) :: "memory"); } }
            }
            __syncthreads();
            const int nrb = (t1 - t0) * 16;
            if (tid < NEXP) { int n = 0;
                for (int i = 0; i < nrb; ++i) { n += (ri[i * 4] == tid) + (ri[i * 4 + 1] == tid); }
                int* lp = list + (rep_ ? (int)((WS_END - WS_LIST) / 4) : 0); const int base = n ? (int)atomicAdd(cnt + 16 * rep_ + tid, (unsigned)n) : 0; int p = 0;
                for (int i = 0; i < nrb; ++i) { if (ri[i * 4] == tid) lp[(size_t)tid * LCAP + base + p++] = ri[i * 4 + 2]; if (ri[i * 4 + 1] == tid) lp[(size_t)tid * LCAP + base + p++] = ri[i * 4 + 3]; } }
            __syncthreads();
        }
        SYNC(pb);
        TS(pb + 1);
        if (PHON(6) && IN(pb + 1)) REPS(6) { PHASE_BEGIN
            SchedMoe1 S; S.T.init((LAS int*)(lds + RING_BYTES), cnt); S.v = (const char*)U; S.wgu = (const char*)(ws + WS_WGU); S.hid = (char*)(ws + WS_HID); S.lst = list; S.G = G; S.c = blk;
            pg8::gemm_phase<SchedMoe1, pg8::EpiSwiGLU, true>(lds, S, pg8::EpiSwiGLU{});
        }
        SYNC(pb + 1);
        TS(pb + 2);
        if (PHON(7) && IN(pb + 2)) REPS(7) { PHASE_BEGIN
            SchedMoe2 S; S.T.init((LAS int*)(lds + RING_BYTES), cnt); S.hid = (const char*)(ws + WS_HID); S.wd = (const char*)(ws + WS_WD); S.lst = list; S.G = G; S.c = blk;
            pg8::gemm_phase<SchedMoe2, pg8::EpiScatter, false>(lds, S, pg8::EpiScatter{YB, tokw});
        }
        SYNC(pb + 2);
}

__global__ void __launch_bounds__(NTHREADS, 2) fwd_kernel(Args a) {
    extern __shared__ __attribute__((aligned(16))) unsigned char lds_raw[];
    LAS unsigned char* lds = (LAS unsigned char*)lds_raw;
    cg::grid_group grid = cg::this_grid();
    const int G = gridDim.x, blk = blockIdx.x, ngw = G * NWAVES;
    const int lo = a.ph_lo, hi = a.ph_hi;
    if (threadIdx.x < 2) ((LAS unsigned*)(lds + RING_BYTES + 512))[threadIdx.x] = 0u;
    __syncthreads();


    TS(0);
    if (PHON(0) && IN(0)) REPS(0) { PHASE_BEGIN
        if (blk == 0) { if (tid < 64) ctl[tid] = 0u;
            for (int i = tid; i < XCD_BAR_WORDS; i += NTHREADS) (ctl + 4096)[i] = 0u; }
        if (blk < 192) {
            LAS float* sil = (LAS float*)lds; LAS float* red = (LAS float*)(lds + 40960);
            for (int i = tid; i < 5 * DM; i += NTHREADS) { const int v = i / DM, k = i % DM; sil[i] = silu_f(v < 4 ? ka->c[v * DM + k] : ka->c_ctx[k]); }
            __syncthreads();
            const int l = blk / 96, j0 = (blk % 96) * 128;
            const float* wp = ka->w_mod + (size_t)l * DM * MODSZ + j0 + 2 * lane;
            f32x2 acc[5];
#pragma unroll
            for (int v = 0; v < 5; ++v) acc[v] = (f32x2){0.f, 0.f};
#pragma unroll 8
            for (int k = wave * 256; k < wave * 256 + 256; ++k) { const f32x2 w = *(const f32x2*)(wp + (size_t)k * MODSZ);
#pragma unroll
                for (int v = 0; v < 5; ++v) { const float s = sil[v * DM + k]; acc[v].x = fmaf(s, w.x, acc[v].x); acc[v].y = fmaf(s, w.y, acc[v].y); } }
#pragma unroll
            for (int v = 0; v < 5; ++v) { red[(wave * 5 + v) * 128 + 2 * lane] = acc[v].x; red[(wave * 5 + v) * 128 + 2 * lane + 1] = acc[v].y; }
            __syncthreads();
            for (int i = tid; i < 5 * 128; i += NTHREADS) { const int v = i / 128, j = i % 128; float s = ka->b_mod[l * MODSZ + j0 + j];
#pragma unroll
                for (int w = 0; w < 8; ++w) s += red[(w * 5 + v) * 128 + j];
                mod[((size_t)l * 5 + v) * MODSZ + j0 + j] = s; }
            __syncthreads();
        }
        LAS float* tab = (LAS float*)(lds + 135168);
        if (tid < 256) tab[tid] = cospif((float)tid * (1.0f / 128.0f));
        __syncthreads();
        LAS float* scr = (LAS float*)(lds + wave * 16384);
        constexpr int I_IN = 32 * 96, I_O0 = 32 * 64;
        for (int it = gw; it < I_IN + I_O0; it += ngw) {
            int r = it;
            if (r < I_IN) { transpose_item(ka->even_w_in, 4096, DM, WIN, (r % 96) * 32, (r / 96) * 64, (r % 96) * 32, scr, lane); continue; } r -= I_IN;
            transpose_item(ka->even_w_out, DM, DM, WOUT0, (r % 64) * 32, (r / 64) * 64, (r % 64) * 32, scr, lane);
        }
        for (int it = gw; it < 8 * 8 * 64; it += ngw) {
            const int gp = it >> 9, m0 = ((it >> 6) & 7) * 32, k0 = (it & 63) * 32, g = gp >> 1, part = gp & 1;
            const int r = lane & 31, hh = lane >> 5;
            f32x16 d = {};
            const float* wrow = ka->even_w_in + (size_t)(k0 + r) * 4096 + 3072 + g * 256 + 8 * hh;
#pragma unroll 4
            for (int j0 = 0; j0 < 256; j0 += 16) {
                const f32x4 b0 = *(const f32x4*)(wrow + j0), b1 = *(const f32x4*)(wrow + j0 + 4);
                u32x4 bw = {pk2(b0[0], b0[1]), pk2(b0[2], b0[3]), pk2(b1[0], b1[1]), pk2(b1[2], b1[3])};
                float av[8];
#pragma unroll
                for (int jj = 0; jj < 8; ++jj) { const int p = ((m0 + r) * (j0 + 8 * hh + jj) - (part ? 64 : 0)) & 255; av[jj] = tab[p]; }
                u32x4 aw = {pk2(av[0], av[1]), pk2(av[2], av[3]), pk2(av[4], av[5]), pk2(av[6], av[7])};
                d = __builtin_amdgcn_mfma_f32_32x32x16_bf16(*reinterpret_cast<bf16x8*>(&aw), *reinterpret_cast<bf16x8*>(&bw), d, 0, 0, 0);
            }
#pragma unroll
            for (int q = 0; q < 16; ++q) { const int row = (q & 3) + 8 * (q >> 2) + 4 * hh;
                WIN[(size_t)(3072 + gp * 256 + m0 + row) * DM + k0 + r] = (bf16_t)f2bf(d[q]); }
        }
        { bf16_t* MA = (bf16_t*)(ws + WS_MA); bf16_t* MB = (bf16_t*)(ws + WS_MB);
          for (int it = gw; it < 256 + 4096 + 256; it += ngw) {
            if (it < 256) { const int r = it & 127, k1 = r >> 1, ri = r & 1;
                for (int col = lane; col < 128; col += 64) { const int part = col >> 6, t1 = col & 63; const float xx = (float)((k1 * t1) & 63) * (1.0f / 32.0f);
                    const float cs = cospif(xx), sn = sinpif(xx); const float val = (ri == 0) ? (part == 0 ? cs : -sn) : (part == 0 ? -sn : -cs);
                    MA[(size_t)it * 128 + col] = (bf16_t)f2bf(val); }
            } else if (it < 256 + 4096) { const int rr = it - 256, kb = rr >> 8, r = rr & 255, k1l = r >> 6, k2 = r & 63, k1 = 4 * kb + k1l;
                const int col0 = lane * 8; float f[8];
#pragma unroll
                for (int i = 0; i < 8; ++i) { const int col = col0 + i, k1l2 = col >> 7, ri = (col >> 6) & 1, t2 = col & 63; const int p = (64 * k2 * t2 + k1 * t2) & 4095; const float xx = (float)p * (1.0f / 2048.0f);
                    f[i] = (k1l2 == k1l) ? (ri ? sinpif(xx) : cospif(xx)) : 0.f; }
                u32x4 o = {pk2(f[0], f[1]), pk2(f[2], f[3]), pk2(f[4], f[5]), pk2(f[6], f[7])};
                *(u32x4*)(MB + (size_t)rr * 512 + col0) = o;
            } else { const int k = it - 256 - 4096; const int col0 = lane * 8, part = col0 >> 8, t0 = col0 & 255; float f[8];
#pragma unroll
                for (int i = 0; i < 8; ++i) { const int p = (k * (t0 + i)) & 255; const float xx = (float)p * (1.0f / 128.0f); f[i] = part ? -sinpif(xx) : cospif(xx); }
                u32x4 o = {pk2(f[0], f[1]), pk2(f[2], f[3]), pk2(f[4], f[5]), pk2(f[6], f[7])};
                *(u32x4*)(CMATC + (size_t)k * 512 + col0) = o; }
          } }
    }
    SYNC(0);

    TS(1);
    if (PHON(1) && IN(1)) REPS(1) { PHASE_BEGIN
        if (gw < 200) { const int l_ = gw / 100, v_ = (gw % 100) / 20, n_ = gw % 20;
            const float* sh = mod + ((size_t)l_ * 5 + v_) * MODSZ + 3 * DM; float acc_ = 0.f;
            for (int k = lane; k < DM; k += 64) acc_ += sh[k] * (n_ < 16 ? ka->moe_w_expert[((size_t)l_ * DM + k) * 16 + n_] : ka->moe_w_group[((size_t)l_ * DM + k) * 4 + (n_ - 16)]);
            acc_ = wave_sum(acc_);
            if (lane == 0) ((float*)(ctl + 8192))[(l_ * 5 + v_) * 32 + n_] = acc_ + (n_ < 16 ? ka->moe_b_expert[l_ * 16 + n_] : ka->moe_b_group[l_ * 4 + n_ - 16]); }
        { const int np = NTOK / 2, p0 = (int)(((long)np * gw) / ngw), p1 = (int)(((long)np * (gw + 1)) / ngw);
#define P1_SRC(p_) ({ int b_, j_; row_info(2 * (p_), b_, j_); (j_ < CTX) ? ka->ctx + ((size_t)b_ * CTX + j_) * DM : ka->x + ((size_t)b_ * SEQ + (j_ - CTX)) * DM; })
          f32x4 va[8], vb[8], na[8], nb[8];
          if (p0 < p1) { const float* src = P1_SRC(p0);
#pragma unroll
            for (int jj = 0; jj < 8; ++jj) { va[jj] = *(const f32x4*)(src + 4 * lane + 256 * jj); vb[jj] = *(const f32x4*)(src + DM + 4 * lane + 256 * jj); } }
          for (int p = p0; p < p1; ++p) { const int row = 2 * p; int b, j; row_info(row, b, j);
            const float* mv = mod + (size_t)(j < CTX ? 4 : b) * MODSZ;
            if (p + 1 < p1) { const float* src = P1_SRC(p + 1);
#pragma unroll
                for (int jj = 0; jj < 8; ++jj) { na[jj] = *(const f32x4*)(src + 4 * lane + 256 * jj); nb[jj] = *(const f32x4*)(src + DM + 4 * lane + 256 * jj); } }
            float sa = 0.f, sb = 0.f;
#pragma unroll
            for (int jj = 0; jj < 8; ++jj) { sa += va[jj][0] * va[jj][0] + va[jj][1] * va[jj][1] + va[jj][2] * va[jj][2] + va[jj][3] * va[jj][3]; sb += vb[jj][0] * vb[jj][0] + vb[jj][1] * vb[jj][1] + vb[jj][2] * vb[jj][2] + vb[jj][3] * vb[jj][3]; }
#pragma unroll
            for (int o_ = 1; o_ < 64; o_ <<= 1) { sa += __shfl_xor(sa, o_); sb += __shfl_xor(sb, o_); }
            const float ra = rsqrtf(sa * (1.0f / DM) + EPS), rb = rsqrtf(sb * (1.0f / DM) + EPS);
            bf16_t* oa = U + (size_t)row * DM; bf16_t* ob = oa + DM;
#pragma unroll
            for (int jj = 0; jj < 8; ++jj) { const int k = 4 * lane + 256 * jj;
                const f32x4 w = *(const f32x4*)(ka->norm1_w + k), sc = *(const f32x4*)(mv + DM + k), t = *(const f32x4*)(mv + k); const f32x4 aw = w * (1.0f + sc);
                const f32x4 ya = va[jj] * ra * aw + t, yb = vb[jj] * rb * aw + t;
                u32x2 o; o.x = pk2(ya[0], ya[1]); o.y = pk2(ya[2], ya[3]); *(u32x2*)(oa + k) = o; o.x = pk2(yb[0], yb[1]); o.y = pk2(yb[2], yb[3]); *(u32x2*)(ob + k) = o; }
#pragma unroll
            for (int jj = 0; jj < 8; ++jj) { va[jj] = na[jj]; vb[jj] = nb[jj]; }
          }
#undef P1_SRC
        }
    }
    SYNC(1);

    TS(2);
    if (PHON(2) && IN(2)) REPS(2) { PHASE_BEGIN
        SchedInProj S{(const char*)U, (const char*)WIN, (char*)PB, (char*)(ws + WS_ZTL), (char*)(ws + WS_ZTC), G, blk};
        pg8::gemm_phase<SchedInProj, pg8::EpiStore, false>(lds, S, pg8::EpiStore{});
        if (blk >= (816 + 544) % 256) {
            const int ib = blk - (816 + 544) % 256, nib = G - (816 + 544) % 256;
            moe_weight_items(ka->moe_w_gate, ka->moe_w_up, ka->moe_w_down, ws, 0, ib * NWAVES + wave, nib * NWAVES, (LAS float*)(lds + wave * 16384), lane); }
    }
    SYNC(2);

    TS(3);
    if (PHON(3) && IN(3)) REPS(3) { PHASE_BEGIN
        for (int it = blk * NTHREADS + tid; it < (NTOK / 16) * 128; it += G * NTHREADS) {
            const int chunk = it >> 7, oct = it & 127, r0 = chunk * 16, jm = r0 % TPB, ch0 = oct * 8;
            const bool hasprev = (jm != 0 && jm != CTX), hasnext = (((jm + 16) % TPB) != 0 && (jm + 16) != CTX);
            float w0[8], w1[8], w2[8];
#pragma unroll
            for (int i = 0; i < 8; ++i) { w0[i] = ka->even_conv_w[ch0 + i]; w1[i] = ka->even_conv_w[1024 + ch0 + i]; w2[i] = ka->even_conv_w[2048 + ch0 + i]; }
            float cp[8], cc[8], cn[8];
#define LOADCV(row_, o) do { const u32x4 cg_ = *(const u32x4*)(PB + (size_t)(row_) * 3072 + 1024 + ch0), vi = *(const u32x4*)(PB + (size_t)(row_) * 3072 + 2048 + ch0); \
                o[0] = bflo(cg_.x) * bflo(vi.x); o[1] = bfhi(cg_.x) * bfhi(vi.x); o[2] = bflo(cg_.y) * bflo(vi.y); o[3] = bfhi(cg_.y) * bfhi(vi.y); \
                o[4] = bflo(cg_.z) * bflo(vi.z); o[5] = bfhi(cg_.z) * bfhi(vi.z); o[6] = bflo(cg_.w) * bflo(vi.w); o[7] = bfhi(cg_.w) * bfhi(vi.w); } while (0)
            if (hasprev) LOADCV(r0 - 1, cp); else {
#pragma unroll
                for (int i = 0; i < 8; ++i) cp[i] = 0.f; }
            LOADCV(r0, cc);
            for (int rr = 0; rr < 16; ++rr) { const int row = r0 + rr;
                if (rr < 15 || hasnext) LOADCV(row + 1, cn); else {
#pragma unroll
                    for (int i = 0; i < 8; ++i) cn[i] = 0.f; }
                const u32x4 bg = *(const u32x4*)(PB + (size_t)row * 3072 + ch0);
                float bb[8] = {bflo(bg.x), bfhi(bg.x), bflo(bg.y), bfhi(bg.y), bflo(bg.z), bfhi(bg.z), bflo(bg.w), bfhi(bg.w)}; float y[8];
#pragma unroll
                for (int i = 0; i < 8; ++i) y[i] = bb[i] * (w0[i] * cp[i] + w1[i] * cc[i] + w2[i] * cn[i]);
                u32x4 o = {pk2(y[0], y[1]), pk2(y[2], y[3]), pk2(y[4], y[5]), pk2(y[6], y[7])};
                *(u32x4*)(YCAT + (size_t)row * DM + ch0) = o;
#pragma unroll
                for (int i = 0; i < 8; ++i) { cp[i] = cc[i]; cc[i] = cn[i]; } }
        }
        { SchedFftA S{(const char*)(ws + WS_MA), (const char*)CMATC, (const char*)(ws + WS_ZTL), (const char*)(ws + WS_ZTC), (char*)(ws + WS_UF), (char*)YCAT, G, blk};
          pg8::gemm_phase<SchedFftA, pg8::EpiStore, false>(lds, S, pg8::EpiStore{}); }
        xcd_barrier(BARW, BARST);
        { SchedFftB S{(const char*)(ws + WS_MB), (const char*)(ws + WS_UF), (char*)YCAT, G, blk};
          pg8::gemm_phase<SchedFftB, pg8::EpiStore, false>(lds, S, pg8::EpiStore{}); }
    }
    SYNC(3);

    TS(4);
    if (PHON(4) && IN(4)) REPS(4) { PHASE_BEGIN
        SchedOut0 S{(const char*)YCAT, (const char*)WOUT0, ka->x, ka->ctx, mod, (char*)H, G, blk};
        pg8::gemm_phase<SchedOut0, pg8::EpiResid<false>, false>(lds, S, pg8::EpiResid<false>{});
        if (blk >= (68 * 8) % 256) {
            const int ib = blk - (68 * 8) % 256, nib = G - (68 * 8) % 256; LAS float* scr = (LAS float*)(lds + wave * 16384);
            constexpr int I_QKV = 32 * 192, I_O1 = 32 * 64;
            for (int it = ib * NWAVES + wave; it < I_QKV + I_O1; it += nib * NWAVES) {
                if (it < I_QKV) transpose_item(ka->odd_w_qkv, 6144, DM, WQKV, (it % 192) * 32, (it / 192) * 64, (it % 192) * 32, scr, lane);
                else { const int r = it - I_QKV; transpose_item(ka->odd_w_out, DM, DM, WOUT1, (r % 64) * 32, (r / 64) * 64, (r % 64) * 32, scr, lane); } } }
    }
    SYNC(4);

    moe_layer<0>(grid, lds, lo, hi, G, blk);
    { constexpr int l = 0; (void)l;
            TS(8);
    if (PHON(8) && IN(8)) { PHASE_BEGIN
                const float* mod1 = mod + (size_t)5 * MODSZ;
                for (int row = gw; row < NTOK; row += ngw) { int b, j; row_info(row, b, j); const int vr = (j < CTX) ? 4 : b;
                    const float* g2 = modl + (size_t)vr * MODSZ + 5 * DM; const float* mv1 = mod1 + (size_t)vr * MODSZ;
                    bf16_t* hrow = H + (size_t)row * DM; const bf16_t* y0 = YB + (size_t)(row * 2) * DM; const bf16_t* y1 = y0 + DM;
                    f32x4 v[8]; float ss = 0.f;
#pragma unroll
                    for (int jj = 0; jj < 8; ++jj) { const int k = 4 * lane + 256 * jj; const f32x4 hv = bf4(*(const u32x2*)(hrow + k)), g = *(const f32x4*)(g2 + k);
                        const u32x2 a0 = *(const u32x2*)(y0 + k), a1 = *(const u32x2*)(y1 + k);
                        f32x4 ys = {bflo(a0.x) + bflo(a1.x), bfhi(a0.x) + bfhi(a1.x), bflo(a0.y) + bflo(a1.y), bfhi(a0.y) + bfhi(a1.y)};
                        v[jj] = hv + g * ys; { u32x2 ho; ho.x = pk2(v[jj][0], v[jj][1]); ho.y = pk2(v[jj][2], v[jj][3]); *(u32x2*)(hrow + k) = ho; }
                        ss += v[jj][0] * v[jj][0] + v[jj][1] * v[jj][1] + v[jj][2] * v[jj][2] + v[jj][3] * v[jj][3]; }
                    const float rstd = rsqrtf(wave_sum(ss) * (1.0f / DM) + EPS);
                    norm_mod_store(v, rstd, ka->norm1_w + DM, mv1 + DM, mv1, U + (size_t)row * DM, lane);
                }
            }
            SYNC(8);
            TS(9);
    if (PHON(9) && IN(9)) REPS(9) { PHASE_BEGIN
                SchedQKV S{(const char*)U, (const char*)WQKV, (char*)QB, G, blk};
                pg8::gemm_phase<SchedQKV, pg8::EpiStore, false>(lds, S, pg8::EpiStore{});
                if (blk >= (1536 + 64) % 256) {
                    const int ib = blk - (1536 + 64) % 256, nib = G - (1536 + 64) % 256;
                    moe_weight_items(ka->moe_w_gate, ka->moe_w_up, ka->moe_w_down, ws, 1, ib * NWAVES + wave, nib * NWAVES, (LAS float*)(lds + wave * 16384), lane); }
            }
            SYNC(9);
            TS(10);
    if (PHON(10) && IN(10)) { PHASE_BEGIN
                LAS float* rt = (LAS float*)lds;
                for (int i = tid; i < 64 * 32; i += NTHREADS) { const int pos = i >> 5, f = i & 31; const float inv = exp2f(-(float)f * 0.4152410118609203f); const float ang = (float)pos * inv;
                    float tr = ang * 0.15915494309189535f; tr -= floorf(tr); rt[2 * i] = __builtin_amdgcn_cosf(tr); rt[2 * i + 1] = __builtin_amdgcn_sinf(tr); }
                __syncthreads();
                const int hc = lane >> 2, q8 = (lane & 3) * 8;
                for (int it = gw; it < NLAT + NTOK; it += ngw) {
                    const bool isq = it < NLAT; int row;
                    if (isq) row = (it / SEQ) * TPB + CTX + (it % SEQ); else row = it - NLAT;
                    int b, j; row_info(row, b, j); const bool rope = (j >= CTX); const int t = j - CTX, prow = t >> 6, pcol = t & 63;
                    bf16_t* p = (isq ? QB : KB) + (size_t)row * DM + hc * 128; const float* nwp = isq ? ka->odd_q_norm : ka->odd_k_norm;
                    u32x4 raw[4]; float xv[4][8];
                    float ss = 0.f;
#pragma unroll
                    for (int s = 0; s < 4; ++s) { raw[s] = *(const u32x4*)(p + s * 32 + q8);
                        xv[s][0] = bflo(raw[s].x); xv[s][1] = bfhi(raw[s].x); xv[s][2] = bflo(raw[s].y); xv[s][3] = bfhi(raw[s].y); xv[s][4] = bflo(raw[s].z); xv[s][5] = bfhi(raw[s].z); xv[s][6] = bflo(raw[s].w); xv[s][7] = bfhi(raw[s].w);
#pragma unroll
                        for (int i = 0; i < 8; ++i) ss += xv[s][i] * xv[s][i]; }
                    ss += __shfl_xor(ss, 1); ss += __shfl_xor(ss, 2);
                    const float rstd = rsqrtf(ss * (1.0f / 128.0f) + EPS);
#pragma unroll
                    for (int s = 0; s < 4; ++s)
#pragma unroll
                        for (int i = 0; i < 8; ++i) xv[s][i] = xv[s][i] * rstd * nwp[s * 32 + q8 + i];
                    if (rope) {
#pragma unroll
                        for (int ax = 0; ax < 2; ++ax) { const int pos = ax ? pcol : prow;
#pragma unroll
                            for (int i = 0; i < 8; ++i) { const float cs = rt[2 * (pos * 32 + q8 + i)], sn = rt[2 * (pos * 32 + q8 + i) + 1];
                                const float x1 = xv[2 * ax][i], x2 = xv[2 * ax + 1][i]; xv[2 * ax][i] = x1 * cs - x2 * sn; xv[2 * ax + 1][i] = x2 * cs + x1 * sn; } }
                    }
#pragma unroll
                    for (int s = 0; s < 4; ++s) { u32x4 o = {pk2(xv[s][0], xv[s][1]), pk2(xv[s][2], xv[s][3]), pk2(xv[s][4], xv[s][5]), pk2(xv[s][6], xv[s][7])}; *(u32x4*)(p + s * 32 + q8) = o; }
                }
                __syncthreads();
            }
            SYNC(10);
            TS(11);
    if (PHON(11) && IN(11)) REPS(11) { PHASE_BEGIN
                const int vcu = (blk % 8) * (G / 8) + blk / 8;
                float mq = fmaxf(fabsf(ka->odd_q_norm[lane]), fabsf(ka->odd_q_norm[lane + 64])), mk = fmaxf(fabsf(ka->odd_k_norm[lane]), fabsf(ka->odd_k_norm[lane + 64]));
#pragma unroll
                for (int o_ = 1; o_ < 64; o_ <<= 1) { mq = fmaxf(mq, __shfl_xor(mq, o_)); mk = fmaxf(mk, __shfl_xor(mk, o_)); }
                const float mnC = -(128.0f * att::SCALE * mq * mk) * 1.4426950408889634f;
                for (int U0 = vcu; U0 < 2048; U0 += G) {
                    const int combo = U0 >> 5, qb = U0 & 31, cp_ = combo & 1, hh = (combo >> 1) & 7, b = combo >> 4;
                    const bf16_t* Qp = QB + (size_t)(b * TPB + CTX + qb * 128) * DM + hh * 256 + cp_ * 128;
                    const bf16_t* Kp = KB + (size_t)(b * TPB) * DM + hh * 256 + cp_ * 128;
                    const bf16_t* Vp = VB + (size_t)(b * TPB) * DM + hh * 256;
                    bf16_t* Op = OB + (size_t)(b * SEQ + qb * 128) * (2 * DM) + cp_ * DM + hh * 256;
                    att::attn_pair_body(Qp, Kp, Vp, Op, TPB, (char*)lds_raw, mnC);
                }
            }
            SYNC(11);
            TS(12);
    if (PHON(12) && IN(12)) REPS(12) { PHASE_BEGIN
                float d1 = ka->lq1[lane] * ka->lk1[lane] + ka->lq1[lane + 64] * ka->lk1[lane + 64], d2 = ka->lq2[lane] * ka->lk2[lane] + ka->lq2[lane + 64] * ka->lk2[lane + 64];
                d1 = wave_sum(d1); d2 = wave_sum(d2);
                const float lam_init = 0.8f - 0.6f * expf(-0.3f * 1.0f);
                const float lam = expf(d1) - expf(d2) + lam_init;
                const int hh = lane >> 3, e0 = (lane & 7) * 32;
                for (int li = gw; li < NLAT; li += ngw) {
                    const bf16_t* o1 = OB + (size_t)li * (2 * DM) + hh * 256 + e0; const bf16_t* o2 = o1 + DM;
                    float ov[32]; float ss = 0.f;
#pragma unroll
                    for (int s = 0; s < 4; ++s) { const u32x4 p1 = *(const u32x4*)(o1 + 8 * s), p2 = *(const u32x4*)(o2 + 8 * s);
                        ov[8 * s + 0] = bflo(p1.x) - lam * bflo(p2.x); ov[8 * s + 1] = bfhi(p1.x) - lam * bfhi(p2.x); ov[8 * s + 2] = bflo(p1.y) - lam * bflo(p2.y); ov[8 * s + 3] = bfhi(p1.y) - lam * bfhi(p2.y);
                        ov[8 * s + 4] = bflo(p1.z) - lam * bflo(p2.z); ov[8 * s + 5] = bfhi(p1.z) - lam * bfhi(p2.z); ov[8 * s + 6] = bflo(p1.w) - lam * bflo(p2.w); ov[8 * s + 7] = bfhi(p1.w) - lam * bfhi(p2.w); }
#pragma unroll
                    for (int i = 0; i < 32; ++i) ss += ov[i] * ov[i];
                    ss += __shfl_xor(ss, 1); ss += __shfl_xor(ss, 2); ss += __shfl_xor(ss, 4);
                    const float rs = rsqrtf(ss * (1.0f / 256.0f) + EPS) * (1.0f - lam_init);
                    const int row = (li / SEQ) * TPB + CTX + (li % SEQ);
                    bf16_t* ap = AB + (size_t)row * DM + hh * 256 + e0;
#pragma unroll
                    for (int s = 0; s < 4; ++s) { float y[8];
#pragma unroll
                        for (int i = 0; i < 8; ++i) y[i] = ov[8 * s + i] * rs * ka->subln_w[e0 + 8 * s + i];
                        u32x4 o = {pk2(y[0], y[1]), pk2(y[2], y[3]), pk2(y[4], y[5]), pk2(y[6], y[7])}; *(u32x4*)(ap + 8 * s) = o; }
                }
            }
            SYNC(12);
            TS(13);
    if (PHON(13) && IN(13)) { PHASE_BEGIN
                SchedOut1 S{(const char*)AB, (const char*)WOUT1, mod + (size_t)5 * MODSZ, (char*)H, G, blk};
                pg8::gemm_phase<SchedOut1, pg8::EpiResid<true>, false>(lds, S, pg8::EpiResid<true>{});
            }
            SYNC(13);
    }
    moe_layer<1>(grid, lds, lo, hi, G, blk);
    { constexpr int l = 1; (void)l;
            TS(17);
    if (PHON(17) && IN(17)) REPS(17) { PHASE_BEGIN
                for (int li = gw; li < NLAT; li += ngw) { const int b = li / SEQ, row = b * TPB + CTX + (li % SEQ);
                    const float* g2 = modl + (size_t)b * MODSZ + 5 * DM; const bf16_t* hrow = H + (size_t)row * DM; const bf16_t* y0 = YB + (size_t)(row * 2) * DM; const bf16_t* y1 = y0 + DM;
                    float* orow = ka->out + (size_t)li * DM;
#pragma unroll
                    for (int jj = 0; jj < 8; ++jj) { const int k = 4 * lane + 256 * jj; const f32x4 hv = bf4(*(const u32x2*)(hrow + k)), g = *(const f32x4*)(g2 + k);
                        const u32x2 a0 = *(const u32x2*)(y0 + k), a1 = *(const u32x2*)(y1 + k);
                        f32x4 ys = {bflo(a0.x) + bflo(a1.x), bfhi(a0.x) + bfhi(a1.x), bflo(a0.y) + bflo(a1.y), bfhi(a0.y) + bfhi(a1.y)};
                        f32x4 res = hv + g * ys;
#if PROBE
                        { const unsigned long long* tp_ = (const unsigned long long*)(ws + WS_CTL + 1024); const float c2 = (float)(tp_[3] - tp_[2]) * 1e-4f, w1 = (float)(tp_[1] - tp_[0]) * 1e-2f;
                          res = (f32x4){c2, c2, c2, c2}; if (li == 0 && k == 0) res[0] = w1; }
#endif
                        *(f32x4*)(orow + k) = res; }
                }
            }
    }
    TS(18);
#undef IN
#undef SYNC
#undef cnt
#undef modl
#undef ctl
#undef mod
#undef tokw
#undef list
#undef WIN
#undef WOUT0
#undef WQKV
#undef WOUT1
#undef CMAT
#undef CMATC
#undef H
#undef U
#undef PB
#undef YCAT
#undef QB
#undef KB
#undef VB
#undef AB
#undef YB
#undef OB
}

#ifndef N_LAUNCH_MODE
#define N_LAUNCH_MODE 1
#endif
extern "C" void kernel_launch(void* const* d_in, const int* in_sizes, int n_in, void* d_out, int out_size, void* d_ws, size_t ws_size, hipStream_t stream) {
    static int grid = 0;
    if (grid == 0) {
        if (n_in != 27 || out_size != NLAT * DM || ws_size < WS_END) { fprintf(stderr, "kernel_launch: unexpected shapes: n_in %d out %d ws %zu (need %zu)\n", n_in, out_size, ws_size, (size_t)WS_END); grid = -1; return; }
        int dev = 0, cus = 0, per_cu = 0;
        hipGetDevice(&dev); hipDeviceGetAttribute(&cus, hipDeviceAttributeMultiprocessorCount, dev);
        if (hipFuncSetAttribute((const void*)fwd_kernel, hipFuncAttributeMaxDynamicSharedMemorySize, LDS_BYTES) != hipSuccess) { fprintf(stderr, "kernel_launch: hipFuncSetAttribute failed\n"); grid = -1; return; }
        if (hipOccupancyMaxActiveBlocksPerMultiprocessor(&per_cu, (const void*)fwd_kernel, NTHREADS, LDS_BYTES) != hipSuccess || per_cu < 1) { fprintf(stderr, "kernel_launch: occupancy query says %d\n", per_cu); per_cu = 1; }
        (void)hipGetLastError();
        grid = cus;
        if (grid != 256) fprintf(stderr, "kernel_launch: note: %d CUs\n", grid);
    }
    if (grid < 0) return;
    Args a{};
    const float** ap = (const float**)&a;
    for (int i = 0; i < 27; ++i) ap[i] = (const float*)d_in[i];
    a.out = (float*)d_out; a.ws = (unsigned char*)d_ws;
#if N_LAUNCH_MODE == 1
    a.ph_lo = 0; a.ph_hi = 18;
    void* args[] = {&a};
    hipError_t e = hipLaunchCooperativeKernel((const void*)fwd_kernel, dim3(grid), dim3(NTHREADS), args, LDS_BYTES, stream);
    if (e != hipSuccess) fprintf(stderr, "cooperative launch failed: %s (grid %d)\n", hipGetErrorString(e), grid);
#else
    for (int p = 0; p < 18; ++p) { a.ph_lo = p; a.ph_hi = p + 1; void* args[] = {&a};
        hipError_t e = hipLaunchCooperativeKernel((const void*)fwd_kernel, dim3(grid), dim3(NTHREADS), args, LDS_BYTES, stream);
        if (e != hipSuccess) { fprintf(stderr, "launch %d failed: %s\n", p, hipGetErrorString(e)); break; } }
#endif
}
```

```cpp
#include <hip/hip_runtime.h>
#include <hip/hip_cooperative_groups.h>
#include <cstdio>
#include <cstdint>
namespace cg = cooperative_groups;
#ifndef PROBE
#define PROBE 0
#endif
#ifndef REPMASK
#define REPMASK 0x0
#endif
#define REPS(k) for (int rep_ = 0; rep_ <= ((REPMASK >> (k)) & 1); ++rep_)
#ifndef PA0
#define PA0 0
#define PA1 18
#define PB0 0
#define PB1 18
#endif

#define LAS __attribute__((address_space(3)))
typedef unsigned short bf16_t;
typedef short bf16x8 __attribute__((ext_vector_type(8)));
typedef short s16x4 __attribute__((ext_vector_type(4)));
typedef float f32x2 __attribute__((ext_vector_type(2)));
typedef float f32x4 __attribute__((ext_vector_type(4)));
typedef float f32x8 __attribute__((ext_vector_type(8)));
typedef float f32x16 __attribute__((ext_vector_type(16)));
typedef unsigned u32x2 __attribute__((ext_vector_type(2)));
typedef unsigned u32x4 __attribute__((ext_vector_type(4)));

constexpr int DM = 2048, NB = 4, SEQ = 4096, CTX = 256, TPB = SEQ + CTX  ;
constexpr int NTOK = NB * TPB  , NLAT = NB * SEQ  ;
constexpr int NEXP = 16, EFF = 512, LCAP = 2 * NTOK  ;
constexpr float EPS = 1e-6f;
constexpr int NWAVES = 8, NTHREADS = 512;
constexpr int LDS_BYTES = 155648;
constexpr int RING_BYTES = 131072;

constexpr size_t MiB = 1u << 20;
constexpr size_t WS_CTL = 0, WS_MOD = 1 * MiB, WS_TOKW = 2 * MiB, WS_LIST = 3 * MiB;
constexpr size_t WS_WIN = 6 * MiB, WS_WOUT0 = 26 * MiB, WS_WQKV = 34 * MiB, WS_WOUT1 = 58 * MiB, WS_WGU = 66 * MiB, WS_WD = 130 * MiB;
constexpr size_t WS_CMAT = 162 * MiB, WS_CMATC = 226 * MiB, WS_HID = 162 * MiB  ;
constexpr size_t WS_H = 227 * MiB, WS_U = 363 * MiB;
constexpr size_t WS_P = 431 * MiB, WS_ZTL = 533 * MiB, WS_ZTC = 597 * MiB, WS_YCAT = 601 * MiB;
constexpr size_t WS_Q = 431 * MiB, WS_K = 499 * MiB, WS_V = 567 * MiB, WS_A = 431 * MiB;
static_assert(WS_V - WS_K == WS_K - WS_Q, "QKV spacing");
constexpr size_t WS_Y = 669 * MiB, WS_O = 669 * MiB, WS_MB = 805 * MiB, WS_END = 809 * MiB;
constexpr size_t WS_UF = 162 * MiB  , WS_MA = 226 * MiB + 512 * 1024;
constexpr int MODSZ = 6 * DM;

typedef const __attribute__((address_space(1))) float* gcf;
typedef __attribute__((address_space(1))) bf16_t* gbf;
__device__ __forceinline__ unsigned f2bf(float f) { unsigned u = __builtin_bit_cast(unsigned, f); return (u + 0x7fffu + ((u >> 16) & 1u)) >> 16; }
__device__ __forceinline__ unsigned pk2(float lo, float hi) { return f2bf(lo) | (f2bf(hi) << 16); }
__device__ __forceinline__ float bflo(unsigned w) { return __uint_as_float(w << 16); }
__device__ __forceinline__ float bfhi(unsigned w) { return __uint_as_float(w & 0xffff0000u); }
__device__ __forceinline__ f32x4 bf4(u32x2 w) { return (f32x4){bflo(w.x), bfhi(w.x), bflo(w.y), bfhi(w.y)}; }
__device__ __forceinline__ unsigned cvt_pk_bf16(float lo, float hi) { unsigned r; asm volatile("v_cvt_pk_bf16_f32 %0, %1, %2" : "=v"(r) : "v"(lo), "v"(hi)); return r; }
__device__ __forceinline__ float wave_sum(float v) {
#pragma unroll
    for (int o = 1; o < 64; o <<= 1) v += __shfl_xor(v, o);
    return v;
}
__device__ __forceinline__ float silu_f(float x) { return x * __builtin_amdgcn_rcpf(1.0f + __expf(-x)); }

namespace pg8 {
constexpr int BM = 256, BK = 64, HALF = 128, HTB = HALF * BK * 2, STAGE_BYTES = 8 * HTB, NXCD = 8, WGM = 8;
__host__ __device__ __forceinline__ int lds_byte(int r, int c) { const int st = (r >> 4) * 2 + (c >> 5), rr = r & 15, cc = c & 31, ob = rr * 64 + cc * 2; return st * 1024 + (ob ^ (((ob >> 9) & 1) << 5)); }
__host__ __device__ __forceinline__ void stage_rc(int b, int& R, int& C) { const int st = b / 1024, sb = b % 1024, swz = sb ^ (((sb >> 9) & 1) << 5); R = (st >> 1) * 16 + swz / 64; C = (st & 1) * 32 + (swz % 64) / 2; }
__host__ __device__ __forceinline__ int perm32(int rho) { const int n = rho >> 4, i = rho & 15; return 8 * (i >> 2) + 4 * n + (i & 3); }

struct GUnit {
    const char* A; const char* B; unsigned lda, ldb; int nt;
    char* O; int ldc; float scale;
    int rs1, rs2, cs, nrow, bperm;
    const char* src; const float* gate;
    const int* glist; int gcount;
    int aux;
};
__device__ __forceinline__ void tile_of(int L, int nM, int nN, int& pm, int& pn) {
    const int nwg = nM * nN; int wgid = L;
    { const int q = nwg / NXCD, r = nwg % NXCD, xcd = wgid % NXCD, off = wgid / NXCD; wgid = (xcd < r ? xcd * (q + 1) : r * (q + 1) + (xcd - r) * q) + off; }
    const int nig = WGM * nN, gid = wgid / nig, fm = gid * WGM, gsz = (nM - fm) < WGM ? (nM - fm) : WGM;
    pm = fm + ((wgid % nig) % gsz); pn = (wgid % nig) / gsz;
}
__device__ __forceinline__ int xcd_remap(int L, int nwg) {
    const int q = nwg / NXCD, r = nwg % NXCD, xcd = L % NXCD, off = L / NXCD; return (xcd < r ? xcd * (q + 1) : r * (q + 1) + (xcd - r) * q) + off;
}

struct EpiStore {
    __device__ __forceinline__ void operator()(const f32x4 (&acc)[2][2][4][2], const GUnit& u, int wr, int wc, int fr, int fq) const {
        const float sc = u.scale;
#pragma unroll
        for (int ai = 0; ai < 2; ++ai) { if (ai * HALF >= u.nrow) break;
#pragma unroll
            for (int m = 0; m < 4; ++m) { bf16_t* rowp = (bf16_t*)u.O + (size_t)(2 * ai + wr) * u.rs1 + (size_t)(m * 16 + fr) * u.rs2 + (wc >> 1) * u.cs + (wc & 1) * 32 + 8 * fq;
#pragma unroll
                for (int bj = 0; bj < 2; ++bj) { const f32x4 v0 = acc[ai][bj][m][0] * sc, v1 = acc[ai][bj][m][1] * sc;
                    u32x4 w; w.x = cvt_pk_bf16(v0[0], v0[1]); w.y = cvt_pk_bf16(v0[2], v0[3]); w.z = cvt_pk_bf16(v1[0], v1[1]); w.w = cvt_pk_bf16(v1[2], v1[3]);
                    *(u32x4*)(rowp + (size_t)bj * 2 * u.cs) = w; } } }
    }
};
struct EpiSwiGLU {
    __device__ __forceinline__ void operator()(const f32x4 (&acc)[2][2][4][2], const GUnit& u, int wr, int wc, int fr, int fq) const {
#pragma unroll
        for (int ai = 0; ai < 2; ++ai)
#pragma unroll
            for (int m = 0; m < 4; ++m) { bf16_t* rowp = (bf16_t*)u.O + (size_t)(ai * HALF + wr * 64 + m * 16 + fr) * u.ldc + wc * 32 + 8 * fq;
                float h[8];
#pragma unroll
                for (int n = 0; n < 2; ++n)
#pragma unroll
                    for (int i = 0; i < 4; ++i) h[4 * n + i] = silu_f(acc[ai][0][m][n][i]) * acc[ai][1][m][n][i];
                u32x4 w; w.x = cvt_pk_bf16(h[0], h[1]); w.y = cvt_pk_bf16(h[2], h[3]); w.z = cvt_pk_bf16(h[4], h[5]); w.w = cvt_pk_bf16(h[6], h[7]);
                *(u32x4*)rowp = w; }
    }
};
struct EpiScatter {
    bf16_t* Y; const float* tokw;
    __device__ __forceinline__ void operator()(const f32x4 (&acc)[2][2][4][2], const GUnit& u, int wr, int wc, int fr, int fq) const {
#pragma unroll
        for (int ai = 0; ai < 2; ++ai)
#pragma unroll
            for (int m = 0; m < 4; ++m) { const int r = ai * HALF + wr * 64 + m * 16 + fr;
                if (r < u.gcount) { const int a = u.glist[r]; const float sc = tokw[a];
                    bf16_t* rowp = Y + (size_t)a * DM + u.aux * 256 + wc * 32 + 8 * fq;
#pragma unroll
                    for (int bj = 0; bj < 2; ++bj) { const f32x4 v0 = acc[ai][bj][m][0] * sc, v1 = acc[ai][bj][m][1] * sc;
                        u32x4 w; w.x = cvt_pk_bf16(v0[0], v0[1]); w.y = cvt_pk_bf16(v0[2], v0[3]); w.z = cvt_pk_bf16(v1[0], v1[1]); w.w = cvt_pk_bf16(v1[2], v1[3]);
                        *(u32x4*)(rowp + bj * HALF) = w; } } }
    }
};
template <bool SRC_BF16>
struct EpiResid {
    __device__ __forceinline__ void operator()(const f32x4 (&acc)[2][2][4][2], const GUnit& u, int wr, int wc, int fr, int fq) const {
        f32x4 g[2][2];
#pragma unroll
        for (int bj = 0; bj < 2; ++bj)
#pragma unroll
            for (int n = 0; n < 2; ++n) g[bj][n] = *(const f32x4*)(u.gate + bj * HALF + wc * 32 + 8 * fq + 4 * n);
#pragma unroll
        for (int ai = 0; ai < 2; ++ai)
#pragma unroll
            for (int m = 0; m < 4; ++m) { const size_t off = (size_t)(ai * HALF + wr * 64 + m * 16 + fr) * DM + wc * 32 + 8 * fq;
#pragma unroll
                for (int bj = 0; bj < 2; ++bj) { f32x4 s0, s1;
                    if constexpr (SRC_BF16) { const u32x4 w = *(const u32x4*)((const bf16_t*)u.src + off + bj * HALF); s0 = bf4((u32x2){w.x, w.y}); s1 = bf4((u32x2){w.z, w.w}); }
                    else { s0 = *(const f32x4*)((const float*)u.src + off + bj * HALF); s1 = *(const f32x4*)((const float*)u.src + off + bj * HALF + 4); }
                    const f32x4 v0 = s0 + g[bj][0] * acc[ai][bj][m][0], v1 = s1 + g[bj][1] * acc[ai][bj][m][1];
                    u32x4 o; o.x = cvt_pk_bf16(v0[0], v0[1]); o.y = cvt_pk_bf16(v0[2], v0[3]); o.z = cvt_pk_bf16(v1[0], v1[1]); o.w = cvt_pk_bf16(v1[2], v1[3]);
                    *(u32x4*)((bf16_t*)u.O + off + bj * HALF) = o; } }
    }
};

struct EpiQKV {
    const float *qw, *kw; LAS float* xch;
    __device__ __forceinline__ void operator()(const f32x4 (&acc)[2][2][4][2], const GUnit& u, int wr, int wc, int fr_, int fq_) const {
        if (u.aux == 0) { EpiStore{}(acc, u, wr, wc, fr_, fq_); return; }
        int fr = fr_, fq = fq_; asm volatile("" : "+v"(fr), "+v"(fq));
#pragma unroll
        for (int ai = 0; ai < 2; ++ai)
#pragma unroll
            for (int m = 0; m < 4; ++m)
#pragma unroll
                for (int bj = 0; bj < 2; ++bj) { const f32x4 a = acc[ai][bj][m][0], b = acc[ai][bj][m][1];
                    float s = (a[0] * a[0] + a[1] * a[1]) + (a[2] * a[2] + a[3] * a[3]) + (b[0] * b[0] + b[1] * b[1]) + (b[2] * b[2] + b[3] * b[3]);
                    s += __shfl_xor(s, 16); s += __shfl_xor(s, 32);
                    if (fq == 0) xch[((ai * HALF + wr * 64 + m * 16 + fr) * 2 + bj) * 4 + wc] = s; }
        asm volatile("s_waitcnt lgkmcnt(0)" ::: "memory"); __builtin_amdgcn_s_barrier(); asm volatile("" ::: "memory");
        const int axis = wc >> 1, fb = 4 * (wc & 1) + fq;
        const float* nwp = (u.ldc == 1 ? kw : qw) + axis * 64 + 4 * fb;
        const f32x4 w1 = *(const f32x4*)nwp, w2 = *(const f32x4*)(nwp + 32);
        f32x4 invf;
#pragma unroll
        for (int i = 0; i < 4; ++i) invf[i] = __builtin_amdgcn_exp2f(-(float)(4 * fb + i) * 0.4152410118609203f - 2.6514961294723187f);
        const bool rope = u.gcount >= 0;
#pragma unroll
        for (int ai = 0; ai < 2; ++ai)
#pragma unroll
            for (int m = 0; m < 4; ++m) { const int r = ai * HALF + wr * 64 + m * 16 + fr; const int t = u.gcount + r; const float pos = (float)(axis ? (t & 63) : (t >> 6));
                f32x4 cs, sn;
#pragma unroll
                for (int i = 0; i < 4; ++i) { float tr = pos * invf[i]; tr -= floorf(tr); cs[i] = rope ? __builtin_amdgcn_cosf(tr) : 1.0f; sn[i] = rope ? __builtin_amdgcn_sinf(tr) : 0.0f; }
                unsigned roff = (unsigned)(r * DM + wc * 32 + 8 * fq) * 2u; asm volatile("" : "+v"(roff));
                bf16_t* rowp = (bf16_t*)(u.O + roff);
#pragma unroll
                for (int bj = 0; bj < 2; ++bj) { const f32x4 t4 = *(const LAS f32x4*)(xch + (r * 2 + bj) * 4); const float rs = rsqrtf(((t4[0] + t4[1]) + (t4[2] + t4[3])) * (1.0f / 128.0f) + EPS);
                    const f32x4 x1 = acc[ai][bj][m][0] * rs * w1, x2 = acc[ai][bj][m][1] * rs * w2;
                    const f32x4 y1 = x1 * cs - x2 * sn, y2 = x2 * cs + x1 * sn;
                    u32x4 o; o.x = cvt_pk_bf16(y1[0], y1[1]); o.y = cvt_pk_bf16(y1[2], y1[3]); o.z = cvt_pk_bf16(y2[0], y2[1]); o.w = cvt_pk_bf16(y2[2], y2[3]);
                    *(u32x4*)(rowp + bj * HALF) = o; }
                asm volatile("" ::: "memory"); }
        asm volatile("s_waitcnt lgkmcnt(0)" ::: "memory"); __builtin_amdgcn_s_barrier(); asm volatile("" ::: "memory");
    }
};

template <bool GATHER>
__device__ __forceinline__ void mkvoff(const GUnit& u, unsigned (&vA)[2][2], unsigned (&vB)[2][2]) {
    int tid = threadIdx.x; asm volatile("" : "+v"(tid));
    int R0, C0, R1, C1; stage_rc(tid * 16, R0, C0); stage_rc(tid * 16 + 8192, R1, C1);
    const int Rb0 = (R0 & ~31) + perm32(R0 & 31), Rb1 = (R1 & ~31) + perm32(R1 & 31);
#pragma unroll
    for (int h = 0; h < 2; ++h) {
        if constexpr (GATHER) {
            const int r0 = h * HALF + R0, r1 = h * HALF + R1;
            const int t0 = (r0 < u.gcount) ? (u.glist[r0] >> 1) : 0, t1 = (r1 < u.gcount) ? (u.glist[r1] >> 1) : 0;
            vA[h][0] = (unsigned)t0 * u.lda + (unsigned)C0 * 2u; vA[h][1] = (unsigned)t1 * u.lda + (unsigned)C1 * 2u;
        } else {
            vA[h][0] = (unsigned)(h * HALF + R0) * u.lda + (unsigned)C0 * 2u; vA[h][1] = (unsigned)(h * HALF + R1) * u.lda + (unsigned)C1 * 2u;
        }
        int n0 = h * HALF + Rb0, n1 = h * HALF + Rb1; if (u.bperm) { n0 = 64 * (n0 & 63) + (n0 >> 6); n1 = 64 * (n1 & 63) + (n1 >> 6); }
        vB[h][0] = (unsigned)n0 * u.ldb + (unsigned)C0 * 2u; vB[h][1] = (unsigned)n1 * u.ldb + (unsigned)C1 * 2u;
    }
}

template <class Sched, class Epi, bool GATHER>
__device__ __forceinline__ void gemm_phase(LAS unsigned char* lds, const Sched& S, const Epi& E) {
    int tid = threadIdx.x; asm volatile("" : "+v"(tid));
    const int wid = __builtin_amdgcn_readfirstlane(tid >> 6), lane = tid & 63, wr = wid >> 2, wc = wid & 3, fr = lane & 15, fq = lane >> 4;
    const size_t kstep = (size_t)(BK * 2);
    const unsigned ldsw = (unsigned)wid * 1024u;
    const int aoff = lds_byte(wr * 64 + fr, fq * 8), boff = lds_byte(wc * 32 + fr, fq * 8);
#define PG8_SA(b, h) (((b) * 2 + (h)) * HTB)
#define PG8_SB(b, h) ((4 + (b) * 2 + (h)) * HTB)
#define PG8_STAGE(bufoff, gbase, voff) do { _Pragma("unroll") for (int _i = 0; _i < 2; ++_i) \
        __builtin_amdgcn_global_load_lds((const unsigned*)((const char*)(gbase) + (voff)[_i]), (LAS unsigned*)(lds + (bufoff) + ldsw + _i * 8192), 16, 0, 0); } while (0)
#define PG8_LDA(dst, b, h) do { _Pragma("unroll") for (int m = 0; m < 4; ++m) _Pragma("unroll") for (int k = 0; k < 2; ++k) dst[m][k] = *(const LAS bf16x8*)(lds + PG8_SA(b, h) + aoff + m * 2048 + k * 1024); } while (0)
#define PG8_LDB(dst, b, h) do { _Pragma("unroll") for (int n = 0; n < 2; ++n) _Pragma("unroll") for (int k = 0; k < 2; ++k) dst[n][k] = *(const LAS bf16x8*)(lds + PG8_SB(b, h) + boff + n * 2048 + k * 1024); } while (0)
#define PG8_MMA(ai, bj, At, Bt) do { __builtin_amdgcn_s_setprio(1); _Pragma("unroll") for (int m = 0; m < 4; ++m) _Pragma("unroll") for (int n = 0; n < 2; ++n) _Pragma("unroll") for (int k = 0; k < 2; ++k) \
        acc[ai][bj][m][n] = __builtin_amdgcn_mfma_f32_16x16x32_bf16(Bt[n][k], At[m][k], acc[ai][bj][m][n], 0, 0, 0); __builtin_amdgcn_s_setprio(0); } while (0)
#define PG8_WAIT_V(n) asm volatile("s_waitcnt vmcnt(" #n ")" ::: "memory")
#define PG8_WAIT_L(n) asm volatile("s_waitcnt lgkmcnt(" #n ")" ::: "memory")
#define PG8_BAR __builtin_amdgcn_s_barrier()
#define PG8_SCHED __builtin_amdgcn_sched_barrier(0)
    GUnit cur, nxt; int ui = 0;
    if (!S.next(0, cur)) return;
    unsigned vA[2][2], vB[2][2];
    mkvoff<GATHER>(cur, vA, vB);
    f32x4 acc[2][2][4][2];
#pragma unroll
    for (int a = 0; a < 2; ++a)
#pragma unroll
        for (int b = 0; b < 2; ++b)
#pragma unroll
            for (int m = 0; m < 4; ++m)
#pragma unroll
                for (int n = 0; n < 2; ++n) acc[a][b][m][n] = (f32x4){0.f, 0.f, 0.f, 0.f};
    bf16x8 At[4][2], B0[2][2], B1[2][2];
    const char* cA = cur.A; const char* cB = cur.B;
    PG8_STAGE(PG8_SB(0, 0), cB, vB[0]); PG8_STAGE(PG8_SB(0, 1), cB, vB[1]); PG8_STAGE(PG8_SA(0, 0), cA, vA[0]); PG8_STAGE(PG8_SA(0, 1), cA, vA[1]);
    if (wr == 1) PG8_BAR;
    PG8_WAIT_V(2); PG8_BAR;
    PG8_STAGE(PG8_SB(1, 0), cB + kstep, vB[0]); PG8_STAGE(PG8_SA(1, 0), cA + kstep, vA[0]); PG8_STAGE(PG8_SB(1, 1), cB + kstep, vB[1]);
    PG8_WAIT_V(6); PG8_BAR;
    for (;;) {
        const bool has_next = S.next(ui + 1, nxt);
        const char* nA = has_next ? nxt.A : cA; const char* nB = has_next ? nxt.B : cB;
        const int nt = cur.nt;
        for (int t = 0; t < nt; t += 2) {
            const bool last = (t == nt - 2);
            const char* a1 = cA + (size_t)(t + 1) * kstep;
            const char* a2 = last ? nA : cA + (size_t)(t + 2) * kstep; const char* b2 = last ? nB : cB + (size_t)(t + 2) * kstep;
            const char* a3 = a2 + kstep; const char* b3 = b2 + kstep;
            PG8_LDB(B0, 0, 0); PG8_LDB(B1, 0, 1); PG8_SCHED; PG8_LDA(At, 0, 0); PG8_STAGE(PG8_SA(1, 1), a1, vA[1]);
            if (last && has_next) mkvoff<GATHER>(nxt, vA, vB);
            PG8_WAIT_V(8); PG8_WAIT_L(0); PG8_BAR; PG8_MMA(0, 0, At, B0); PG8_MMA(0, 1, At, B1); PG8_BAR; PG8_SCHED;
            PG8_LDA(At, 0, 1); PG8_STAGE(PG8_SB(0, 0), b2, vB[0]); PG8_STAGE(PG8_SB(0, 1), b2, vB[1]); PG8_STAGE(PG8_SA(0, 0), a2, vA[0]);
            PG8_WAIT_V(8); PG8_WAIT_L(0); PG8_BAR; PG8_MMA(1, 0, At, B0); PG8_MMA(1, 1, At, B1); PG8_BAR; PG8_SCHED;
            PG8_LDB(B0, 1, 0); PG8_LDB(B1, 1, 1); PG8_SCHED; PG8_LDA(At, 1, 0); PG8_STAGE(PG8_SA(0, 1), a2, vA[1]);
            PG8_WAIT_V(8); PG8_WAIT_L(0); PG8_BAR; PG8_MMA(0, 0, At, B0); PG8_MMA(0, 1, At, B1); PG8_BAR; PG8_SCHED;
            PG8_LDA(At, 1, 1); PG8_STAGE(PG8_SB(1, 0), b3, vB[0]); PG8_STAGE(PG8_SB(1, 1), b3, vB[1]); PG8_STAGE(PG8_SA(1, 0), a3, vA[0]);
            PG8_WAIT_V(8); PG8_WAIT_L(0); PG8_BAR; PG8_MMA(1, 0, At, B0); PG8_MMA(1, 1, At, B1); PG8_BAR; PG8_SCHED;
        }
        if (wr == 0) PG8_BAR;
        E(acc, cur, wr, wc, fr, fq);
        if (!has_next) break;
#pragma unroll
        for (int a = 0; a < 2; ++a)
#pragma unroll
            for (int b = 0; b < 2; ++b)
#pragma unroll
                for (int m = 0; m < 4; ++m)
#pragma unroll
                    for (int n = 0; n < 2; ++n) acc[a][b][m][n] = (f32x4){0.f, 0.f, 0.f, 0.f};
        cur = nxt; cA = nA; cB = nB; ++ui;
        if (wr == 1) PG8_BAR;
    }
    PG8_WAIT_V(0);
    PG8_BAR;
#undef PG8_SA
#undef PG8_SB
#undef PG8_STAGE
#undef PG8_LDA
#undef PG8_LDB
#undef PG8_MMA
#undef PG8_WAIT_V
#undef PG8_WAIT_L
#undef PG8_BAR
#undef PG8_SCHED
}
}
using pg8::GUnit;

namespace att {
constexpr int D = 128, NW = 8, QBLK = 32, KVBLK = 64;
constexpr float SCALE = 0.088388347648318440f;
constexpr float THR = 8.f;
constexpr int LDQ = DM, LDK = DM, LDO = 2 * DM;
constexpr size_t SHM_V = KVBLK * D * 2, SHM_K = KVBLK * D * 2, SHM_ATTN = 2 * SHM_V + 2 * SHM_K + NW * 64 * 4;
#define KSWZ(row, colB) ((row) * 256 + ((colB) ^ (((row) & 7) << 4)))
#define SBAR() __builtin_amdgcn_sched_barrier(0)
__device__ __forceinline__ int crow(int r, int hi) { return (r & 3) + 8 * (r >> 2) + 4 * hi; }
__device__ __forceinline__ unsigned cvtpk(float lo, float hi) { unsigned r; asm volatile("v_cvt_pk_bf16_f32 %0, %1, %2" : "=v"(r) : "v"(lo), "v"(hi)); return r; }
__device__ __forceinline__ void partialSM(f32x16& p0, f32x16& p1, float mnC) {
  constexpr float C = SCALE * 1.4426950408889634f;
  for (int r = 0; r < 16; ++r) p0[r] = fmaf(p0[r], C, mnC); for (int r = 0; r < 16; ++r) p1[r] = fmaf(p1[r], C, mnC);
  for (int r = 0; r < 16; ++r) p0[r] = __builtin_amdgcn_exp2f(p0[r]);
}
__device__ __forceinline__ void finishSM(f32x16& p0, f32x16& p1, float& l_reg, bf16x8& pa0, bf16x8& pa1, bf16x8& pa2, bf16x8& pa3) {
  for (int r = 0; r < 16; ++r) p1[r] = __builtin_amdgcn_exp2f(p1[r]);
  float ps = 0; for (int r = 0; r < 16; ++r) ps += p0[r]; for (int r = 0; r < 16; ++r) ps += p1[r];
  l_reg += ps;
#define PK4(P, BASE, OUT) do { unsigned a0 = cvtpk(P[BASE + 0], P[BASE + 1]), a1 = cvtpk(P[BASE + 2], P[BASE + 3]);   \
    unsigned b0 = cvtpk(P[BASE + 4], P[BASE + 5]), b1 = cvtpk(P[BASE + 6], P[BASE + 7]);                              \
    auto r0 = __builtin_amdgcn_permlane32_swap(a0, b0, false, false); auto r1 = __builtin_amdgcn_permlane32_swap(a1, b1, false, false); \
    u32x4 w = {r0[0], r1[0], r0[1], r1[1]}; OUT = *reinterpret_cast<bf16x8*>(&w); } while (0)
  PK4(p0, 0, pa0); PK4(p0, 8, pa1); PK4(p1, 0, pa2); PK4(p1, 8, pa3);
#undef PK4
}
__device__ __forceinline__ void qkt(f32x16& p0, f32x16& p1, const bf16_t* Ks, const bf16x8* qr, int r32, int hi) {
  p0 = f32x16{}; p1 = f32x16{};
  for (int d0 = 0; d0 < 8; ++d0) { int cb = (d0 * 16 + hi * 8) * 2;
    bf16x8 b0 = *reinterpret_cast<const bf16x8*>((const char*)Ks + KSWZ(r32, cb));
    bf16x8 b1 = *reinterpret_cast<const bf16x8*>((const char*)Ks + KSWZ(32 + r32, cb));
    p0 = __builtin_amdgcn_mfma_f32_32x32x16_bf16(b0, qr[d0], p0, 0, 0, 0);
    p1 = __builtin_amdgcn_mfma_f32_32x32x16_bf16(b1, qr[d0], p1, 0, 0, 0); }
}
__device__ __forceinline__ int v_st(int k, int c) { const int kk = (k & ~0xC) | ((k & 4) << 1) | ((k & 8) >> 1); return ((kk >> 3) * 4 + (c >> 5)) * 512 + ((kk & 7) * 32 + (c & 31)) * 2; }
__device__ __forceinline__ int v_rd_base(int lane) { return ((lane & 3) << 3) | (((lane >> 2) & 3) << 6) | (((lane >> 4) & 1) << 5) | (((lane >> 5) & 1) << 8); }
constexpr int v_rd_off(int d0, int ks, int half) { return d0 * 512 + ks * 4096 + half * 2048; }
template <int OFF> __device__ __forceinline__ s16x4 tr_read(int vb) {
  s16x4 r; asm volatile("ds_read_b64_tr_b16 %0, %1 offset:%2" : "=&v"(r) : "v"(vb), "i"(OFF) : "memory"); return r;
}
template <int D0> __device__ __forceinline__ void pv_one(f32x16& od, int vb, bf16x8 pa0, bf16x8 pa1, bf16x8 pa2, bf16x8 pa3) {
  const s16x4 l0 = tr_read<v_rd_off(D0, 0, 0)>(vb), h0 = tr_read<v_rd_off(D0, 0, 1)>(vb), l1 = tr_read<v_rd_off(D0, 1, 0)>(vb), h1 = tr_read<v_rd_off(D0, 1, 1)>(vb);
  const s16x4 l2 = tr_read<v_rd_off(D0, 2, 0)>(vb), h2 = tr_read<v_rd_off(D0, 2, 1)>(vb), l3 = tr_read<v_rd_off(D0, 3, 0)>(vb), h3 = tr_read<v_rd_off(D0, 3, 1)>(vb);
  asm volatile("s_waitcnt lgkmcnt(0)" ::: "memory"); SBAR();
#define PK(L, H) (bf16x8){L[0], L[1], L[2], L[3], H[0], H[1], H[2], H[3]}
  od = __builtin_amdgcn_mfma_f32_32x32x16_bf16(pa0, PK(l0, h0), od, 0, 0, 0);
  od = __builtin_amdgcn_mfma_f32_32x32x16_bf16(pa1, PK(l1, h1), od, 0, 0, 0);
  od = __builtin_amdgcn_mfma_f32_32x32x16_bf16(pa2, PK(l2, h2), od, 0, 0, 0);
  od = __builtin_amdgcn_mfma_f32_32x32x16_bf16(pa3, PK(l3, h3), od, 0, 0, 0);
#undef PK
}
__device__ __forceinline__ void pv_d0(f32x16* o, int vb, bf16x8 pa0, bf16x8 pa1, bf16x8 pa2, bf16x8 pa3) {
  pv_one<0>(o[0], vb, pa0, pa1, pa2, pa3); pv_one<1>(o[1], vb, pa0, pa1, pa2, pa3); pv_one<2>(o[2], vb, pa0, pa1, pa2, pa3); pv_one<3>(o[3], vb, pa0, pa1, pa2, pa3);
}
#define PVP_RD(L, H, D0) do { L[0] = tr_read<v_rd_off(D0, 0, 0)>(vb); H[0] = tr_read<v_rd_off(D0, 0, 1)>(vb); L[1] = tr_read<v_rd_off(D0, 1, 0)>(vb); H[1] = tr_read<v_rd_off(D0, 1, 1)>(vb); \
    L[2] = tr_read<v_rd_off(D0, 2, 0)>(vb); H[2] = tr_read<v_rd_off(D0, 2, 1)>(vb); L[3] = tr_read<v_rd_off(D0, 3, 0)>(vb); H[3] = tr_read<v_rd_off(D0, 3, 1)>(vb); } while (0)
#define PVP_PK(L, H) (bf16x8){L[0], L[1], L[2], L[3], H[0], H[1], H[2], H[3]}
#define PVP_MF(OD, L, H) do { OD = __builtin_amdgcn_mfma_f32_32x32x16_bf16(pa0, PVP_PK(L[0], H[0]), OD, 0, 0, 0); OD = __builtin_amdgcn_mfma_f32_32x32x16_bf16(pa1, PVP_PK(L[1], H[1]), OD, 0, 0, 0); \
    OD = __builtin_amdgcn_mfma_f32_32x32x16_bf16(pa2, PVP_PK(L[2], H[2]), OD, 0, 0, 0); OD = __builtin_amdgcn_mfma_f32_32x32x16_bf16(pa3, PVP_PK(L[3], H[3]), OD, 0, 0, 0); } while (0)
__device__ __forceinline__ void pv_pipe(f32x16* o, int vb, bf16x8 pa0, bf16x8 pa1, bf16x8 pa2, bf16x8 pa3) {
  s16x4 la[4], ha[4], lb[4], hb[4];
  PVP_RD(la, ha, 0); PVP_RD(lb, hb, 1);
  asm volatile("s_waitcnt lgkmcnt(8)" ::: "memory"); SBAR(); PVP_MF(o[0], la, ha); SBAR();
  PVP_RD(la, ha, 2);
  asm volatile("s_waitcnt lgkmcnt(8)" ::: "memory"); SBAR(); PVP_MF(o[1], lb, hb); SBAR();
  PVP_RD(lb, hb, 3);
  asm volatile("s_waitcnt lgkmcnt(8)" ::: "memory"); SBAR(); PVP_MF(o[2], la, ha); SBAR();
  asm volatile("s_waitcnt lgkmcnt(0)" ::: "memory"); SBAR(); PVP_MF(o[3], lb, hb);
}
__device__ __forceinline__ void attn_dense_body(const bf16_t* Qb, const bf16_t* Kh, const bf16_t* Vh, bf16_t* Ob, int seq, char* lds, float mnC) {
  int tid = threadIdx.x; asm volatile("" : "+v"(tid));
  const int wid = tid >> 6, lane = tid & 63, r32 = lane & 31, hi = lane >> 5;
  bf16_t* V_lds = (bf16_t*)lds; bf16_t* K_lds = (bf16_t*)(lds + 2 * SHM_V);
  float* ws = (float*)(lds + 2 * SHM_V + 2 * SHM_K) + wid * 64; float* li_l = ws;
  float l_reg = 0; f32x16 o[4] = {}; bf16x8 qr[8];
  const bf16_t* Qw = Qb + (long)(wid * QBLK + r32) * LDQ + hi * 8;
#pragma unroll
  for (int d0 = 0; d0 < 8; ++d0) qr[d0] = *reinterpret_cast<const bf16x8*>(Qw + d0 * 16);
  const int sr = tid >> 4, sc = (tid & 15) * 8, vst0 = v_st(sr, sc), vst1 = v_st(32 + sr, sc);
  const int vb0 = (int)(uintptr_t)V_lds + v_rd_base(lane);
  struct { bf16x8 vs0, vs1, ks0, ks1; } sr_[1];
  const unsigned goff = (unsigned)(sr * LDK + sc) * 2u;
#define SLOAD(i, k0) do { const char* vb_ = (const char*)Vh + (size_t)(k0) * (LDK * 2); const char* kb_ = (const char*)Kh + (size_t)(k0) * (LDK * 2); \
    sr_[i].vs0 = *reinterpret_cast<const bf16x8*>(vb_ + goff); sr_[i].vs1 = *reinterpret_cast<const bf16x8*>(vb_ + 32 * LDK * 2 + goff); \
    sr_[i].ks0 = *reinterpret_cast<const bf16x8*>(kb_ + goff); sr_[i].ks1 = *reinterpret_cast<const bf16x8*>(kb_ + 32 * LDK * 2 + goff); } while (0)
#define SWRITE(b, i) do { *(bf16x8*)((char*)V_lds + (b) * SHM_V + vst0) = sr_[i].vs0;          \
    *(bf16x8*)((char*)V_lds + (b) * SHM_V + vst1) = sr_[i].vs1; int kc = sc * 2;               \
    *(bf16x8*)((char*)K_lds + (b) * SHM_K + KSWZ(sr, kc)) = sr_[i].ks0;                       \
    *(bf16x8*)((char*)K_lds + (b) * SHM_K + KSWZ(32 + sr, kc)) = sr_[i].ks1; } while (0)
#define SWAIT() asm volatile("s_waitcnt vmcnt(0)" ::: "memory")
  f32x16 pA0, pA1, pB0, pB1; bf16x8 pa0, pa1, pa2, pa3; const int NT = seq / KVBLK;
  constexpr int SE = 0, SO = 0;
  SLOAD(SE, 0); asm volatile("s_waitcnt vmcnt(0)" ::: "memory"); SWRITE(0, SE); __syncthreads();
  qkt(pA0, pA1, K_lds, qr, r32, hi); partialSM(pA0, pA1, mnC);
  SLOAD(SO, KVBLK);
  SWAIT(); SWRITE(1, SO); __syncthreads();
  for (int j = 1; j + 1 < NT; j += 2) {
    SBAR(); qkt(pB0, pB1, (bf16_t*)((char*)K_lds + SHM_K), qr, r32, hi);
    finishSM(pA0, pA1, l_reg, pa0, pa1, pa2, pa3); SBAR();
    SLOAD(SO, (j + 1) * KVBLK); SBAR();
    pv_d0(o, vb0, pa0, pa1, pa2, pa3); partialSM(pB0, pB1, mnC);
    __syncthreads(); SWAIT(); SWRITE(0, SE);
    __syncthreads();
    SBAR(); qkt(pA0, pA1, K_lds, qr, r32, hi);
    finishSM(pB0, pB1, l_reg, pa0, pa1, pa2, pa3); SBAR();
    SLOAD(SE, (j + 2) * KVBLK); SBAR();
    pv_d0(o, vb0 + (int)SHM_V, pa0, pa1, pa2, pa3); partialSM(pA0, pA1, mnC);
    __syncthreads(); SWAIT(); SWRITE(1, SO);
    __syncthreads();
  }
  SBAR(); qkt(pB0, pB1, (bf16_t*)((char*)K_lds + SHM_K), qr, r32, hi);
  finishSM(pA0, pA1, l_reg, pa0, pa1, pa2, pa3); SBAR();
  pv_d0(o, vb0, pa0, pa1, pa2, pa3); partialSM(pB0, pB1, mnC);
  __syncthreads();
  finishSM(pB0, pB1, l_reg, pa0, pa1, pa2, pa3); SBAR();
  pv_d0(o, vb0 + (int)SHM_V, pa0, pa1, pa2, pa3);
  { auto rr = __builtin_amdgcn_permlane32_swap(__float_as_uint(l_reg), __float_as_uint(l_reg), false, false); l_reg = __uint_as_float(rr[0]) + __uint_as_float(rr[1]); }
  if (hi == 0) li_l[r32] = l_reg; asm volatile("s_waitcnt lgkmcnt(0)" ::: "memory");
  float rli[16];
#pragma unroll
  for (int r = 0; r < 16; ++r) rli[r] = __builtin_amdgcn_rcpf(li_l[crow(r, hi)]);
  bf16_t* Ow = Ob + (long)(wid * QBLK) * LDO;
#pragma unroll
  for (int r = 0; r < 16; ++r) { int orow = crow(r, hi);
    for (int d0 = 0; d0 < 4; ++d0) Ow[(long)orow * LDO + d0 * 32 + r32] = (bf16_t)f2bf(o[d0][r] * rli[r]); }
#undef SLOAD
#undef SWRITE
#undef SWAIT
}

constexpr size_t P_V = 0, P_K = 65536, P_X = 98304, P_LI = 131072 + 1024;
__device__ __forceinline__ void attn_pair_body(const bf16_t* Qb, const bf16_t* Kh, const bf16_t* Vh, bf16_t* Ob, int seq, char* lds, float mnC) {
  int tid = threadIdx.x; asm volatile("" : "+v"(tid));
  const int wid = __builtin_amdgcn_readfirstlane(tid >> 6), lane = tid & 63, r32 = lane & 31, hi = lane >> 5, pr = wid & 3, m = wid >> 2;
  char* V_lds = lds + P_V; char* K_lds = lds + P_K; char* X_lds = lds + P_X; float* li_all = (float*)(lds + P_LI);
  float l_reg = 0; f32x16 o[4] = {}; bf16x8 qr[8];
  const bf16_t* Qw = Qb + (long)(pr * QBLK + r32) * LDQ + hi * 8;
#pragma unroll
  for (int d0 = 0; d0 < 8; ++d0) qr[d0] = *reinterpret_cast<const bf16x8*>(Qw + d0 * 16);
  const int sr = tid >> 4, sc = (tid & 15) * 8, vst0 = v_st(sr, sc), vst1 = v_st(32 + sr, sc);
  const int vbm = (int)(uintptr_t)V_lds + m * 16384 + v_rd_base(lane);
  const unsigned goff = (unsigned)(sr * LDK + sc) * 2u;
  const int xw = (int)(pr * 4096 + (2 * m) * 1024 + lane * 16), xr = (int)(pr * 4096 + lane * 16);
  bf16x8 sk0, sk1, sv00, sv01, sv10, sv11;
#define PLOAD(k0) do { const char* vb_ = (const char*)Vh + (size_t)(k0) * (LDK * 2); const char* kb_ = (const char*)Kh + (size_t)(k0) * (LDK * 2); \
    sk0 = *reinterpret_cast<const bf16x8*>(kb_ + goff); sk1 = *reinterpret_cast<const bf16x8*>(kb_ + 32 * LDK * 2 + goff); \
    sv00 = *reinterpret_cast<const bf16x8*>(vb_ + goff); sv01 = *reinterpret_cast<const bf16x8*>(vb_ + goff + 256); \
    sv10 = *reinterpret_cast<const bf16x8*>(vb_ + 32 * LDK * 2 + goff); sv11 = *reinterpret_cast<const bf16x8*>(vb_ + 32 * LDK * 2 + goff + 256); } while (0)
#define PWRITE(b) do { char* vd_ = V_lds + (b) * 32768; char* kd_ = K_lds + (b) * 16384; int kc = sc * 2; \
    *(bf16x8*)(vd_ + vst0) = sv00; *(bf16x8*)(vd_ + 16384 + vst0) = sv01; *(bf16x8*)(vd_ + vst1) = sv10; *(bf16x8*)(vd_ + 16384 + vst1) = sv11; \
    *(bf16x8*)(kd_ + KSWZ(sr, kc)) = sk0; *(bf16x8*)(kd_ + KSWZ(32 + sr, kc)) = sk1; } while (0)
#define PSCORE(b) do { f32x16 p = f32x16{}; const char* kb_ = K_lds + (b) * 16384; \
    _Pragma("unroll") for (int d0 = 0; d0 < 8; ++d0) { const int cb = (d0 * 16 + hi * 8) * 2; \
      const bf16x8 kf = *reinterpret_cast<const bf16x8*>(kb_ + KSWZ(32 * m + r32, cb)); p = __builtin_amdgcn_mfma_f32_32x32x16_bf16(kf, qr[d0], p, 0, 0, 0); } \
    constexpr float C_ = SCALE * 1.4426950408889634f; \
    _Pragma("unroll") for (int r = 0; r < 16; ++r) p[r] = __builtin_amdgcn_exp2f(fmaf(p[r], C_, mnC)); \
    float ps = 0.f; _Pragma("unroll") for (int r = 0; r < 16; ++r) ps += p[r]; l_reg += ps; \
    bf16x8 f0, f1; \
    { unsigned a0 = cvtpk(p[0], p[1]), a1 = cvtpk(p[2], p[3]), b0 = cvtpk(p[4], p[5]), b1 = cvtpk(p[6], p[7]); \
      auto r0 = __builtin_amdgcn_permlane32_swap(a0, b0, false, false); auto r1 = __builtin_amdgcn_permlane32_swap(a1, b1, false, false); u32x4 w = {r0[0], r1[0], r0[1], r1[1]}; f0 = *reinterpret_cast<bf16x8*>(&w); } \
    { unsigned a0 = cvtpk(p[8], p[9]), a1 = cvtpk(p[10], p[11]), b0 = cvtpk(p[12], p[13]), b1 = cvtpk(p[14], p[15]); \
      auto r0 = __builtin_amdgcn_permlane32_swap(a0, b0, false, false); auto r1 = __builtin_amdgcn_permlane32_swap(a1, b1, false, false); u32x4 w = {r0[0], r1[0], r0[1], r1[1]}; f1 = *reinterpret_cast<bf16x8*>(&w); } \
    *(bf16x8*)(X_lds + (b) * 16384 + xw) = f0; *(bf16x8*)(X_lds + (b) * 16384 + xw + 1024) = f1; } while (0)
#define PPV(b) do { const char* xb_ = X_lds + (b) * 16384 + xr; \
    const bf16x8 pa0 = *reinterpret_cast<const bf16x8*>(xb_), pa1 = *reinterpret_cast<const bf16x8*>(xb_ + 1024), pa2 = *reinterpret_cast<const bf16x8*>(xb_ + 2048), pa3 = *reinterpret_cast<const bf16x8*>(xb_ + 3072); \
    asm volatile("s_waitcnt lgkmcnt(0)" ::: "memory"); pv_pipe(o, vbm + (b) * 32768, pa0, pa1, pa2, pa3); } while (0)
  const int NT = seq / KVBLK;
  PLOAD(0); asm volatile("s_waitcnt vmcnt(0)" ::: "memory"); PWRITE(0); __syncthreads();
  PSCORE(0);
  PLOAD(KVBLK); asm volatile("s_waitcnt vmcnt(0)" ::: "memory"); PWRITE(1); __syncthreads();
  for (int j = 1; j + 1 < NT; j += 2) {
    SBAR(); PLOAD((j + 1) * KVBLK); SBAR();
    PSCORE(1); PPV(0);
    __syncthreads(); asm volatile("s_waitcnt vmcnt(0)" ::: "memory"); PWRITE(0); __syncthreads();
    SBAR(); PLOAD((j + 2) * KVBLK); SBAR();
    PSCORE(0); PPV(1);
    __syncthreads(); asm volatile("s_waitcnt vmcnt(0)" ::: "memory"); PWRITE(1); __syncthreads();
  }
  PSCORE(1); SBAR(); PPV(0);
  __syncthreads();
  PPV(1);
  { auto rr = __builtin_amdgcn_permlane32_swap(__float_as_uint(l_reg), __float_as_uint(l_reg), false, false); l_reg = __uint_as_float(rr[0]) + __uint_as_float(rr[1]); }
  if (hi == 0) li_all[wid * 32 + r32] = l_reg;
  __syncthreads();
  float rli[16];
#pragma unroll
  for (int r = 0; r < 16; ++r) { const int q_ = crow(r, hi); rli[r] = __builtin_amdgcn_rcpf(li_all[wid * 32 + q_] + li_all[(wid ^ 4) * 32 + q_]); }
  bf16_t* Ow = Ob + (long)(pr * QBLK) * LDO + m * 128;
#pragma unroll
  for (int r = 0; r < 16; ++r) { int orow = crow(r, hi);
    for (int d0 = 0; d0 < 4; ++d0) Ow[(long)orow * LDO + d0 * 32 + r32] = (bf16_t)f2bf(o[d0][r] * rli[r]); }
  __syncthreads();
#undef PLOAD
#undef PWRITE
#undef PSCORE
#undef PPV
}
#undef KSWZ
#undef SBAR
}


#define XB_TMO      128
#define XB_XCNT(j)  (256  + 64 * (j))
#define XB_XSUB(j)  (1280 + 64 * (j))
#define XB_XGEN(j)  (2304 + 64 * (j))
#define XB_TOP      3328
#define XB_TOPGEN   3392
#define XCD_BAR_WORDS 3456
#define XB_SPIN_CAP (1u << 18)
__device__ __forceinline__ unsigned xb_ld(unsigned* p)              { return __hip_atomic_load(p, __ATOMIC_RELAXED, __HIP_MEMORY_SCOPE_AGENT); }
__device__ __forceinline__ unsigned xb_add(unsigned* p, unsigned v) { return __hip_atomic_fetch_add(p, v, __ATOMIC_RELAXED, __HIP_MEMORY_SCOPE_AGENT); }
__device__ __forceinline__ unsigned xb_xcc_id() { return (unsigned)__builtin_amdgcn_s_getreg((3 << 11) | 20) & 0xFu; }
#define XB_SPIN(cond, bar) do { unsigned _sp = 0; while (cond) { __builtin_amdgcn_s_sleep(1); \
    if ((++_sp & 255u) == 0u) { if (xb_ld(&(bar)[XB_TMO])) break; if (_sp > XB_SPIN_CAP) { atomicAdd(&(bar)[XB_TMO], 1u); break; } } } } while (0)
__device__ __forceinline__ void xcd_barrier_complete(unsigned* bar, unsigned x, unsigned& nloc, unsigned& nx) {
    const unsigned G = gridDim.x * gridDim.y * gridDim.z;
    unsigned sum, cnt, mine, sp = 0u;
    for (;;) {
        sum = 0u; cnt = 0u; mine = 0u;
#pragma unroll
        for (unsigned j = 0; j < 16; ++j) { const unsigned c = xb_ld(&bar[XB_XCNT(j)]); sum += c; cnt += (c > 0u) ? 1u : 0u; mine = (j == x) ? c : mine; }
        if (sum == G) break;
        __builtin_amdgcn_s_sleep(1);
        if ((++sp & 255u) == 0u) { if (xb_ld(&bar[XB_TMO])) break; if (sp > XB_SPIN_CAP) { atomicAdd(&bar[XB_TMO], 1u); break; } }
    }
    nloc = mine > 0u ? mine : 1u; nx = cnt > 0u ? cnt : 1u;
}
__device__ __forceinline__ void xcd_barrier(unsigned* bar, volatile LAS unsigned* st) {
    asm volatile("s_waitcnt vmcnt(0)" ::: "memory");
    __syncthreads();
    if (threadIdx.x == 0) {
        const unsigned x = xb_xcc_id();
        __builtin_amdgcn_s_waitcnt(0);
        unsigned nloc = st[0], nx = st[1];
        if (nloc == 0u) { xcd_barrier_complete(bar, x, nloc, nx); st[0] = nloc; st[1] = nx; }
        const unsigned old = xb_add(&bar[XB_XSUB(x)], 1u);
        const unsigned gen = old / nloc;
        if (old + 1u == (gen + 1u) * nloc) {
            __builtin_amdgcn_fence(__ATOMIC_RELEASE, "agent");
            asm volatile("s_waitcnt vmcnt(0)" ::: "memory");
            const unsigned og = xb_add(&bar[XB_TOP], 1u);
            const unsigned tg = og / nx;
            if (og + 1u == (tg + 1u) * nx) xb_add(&bar[XB_TOPGEN], 1u);
            else XB_SPIN(xb_ld(&bar[XB_TOPGEN]) == tg, bar);
            __builtin_amdgcn_fence(__ATOMIC_ACQUIRE, "agent");
            xb_add(&bar[XB_XGEN(x)], 1u);
            asm volatile("s_waitcnt vmcnt(0)" ::: "memory");
        } else {
            XB_SPIN(xb_ld(&bar[XB_XGEN(x)]) == gen, bar);
            __builtin_amdgcn_fence(__ATOMIC_ACQUIRE, "agent");
            asm volatile("s_waitcnt vmcnt(0)" ::: "memory");
        }
    }
    __syncthreads();
}

struct Args;
typedef const __attribute__((address_space(4))) Args* KArgsP;
struct Args {
    const float *x, *c, *ctx, *c_ctx, *norm1_w, *norm2_w, *w_mod, *b_mod, *even_w_in, *even_conv_w, *even_w_out, *odd_w_qkv, *odd_q_norm, *odd_k_norm,
                *lq1, *lk1, *lq2, *lk2, *subln_w, *odd_w_out, *moe_w_group, *moe_b_group, *moe_w_expert, *moe_b_expert, *moe_w_gate, *moe_w_up, *moe_w_down;
    float* out; unsigned char* ws; int ph_lo, ph_hi;
};

__device__ __forceinline__ KArgsP kargs() { KArgsP p = (KArgsP)__builtin_amdgcn_kernarg_segment_ptr(); asm volatile("" : "+s"(p)); return p; }

__device__ __forceinline__ void transpose_item(const float* W, int ldw, int K, bf16_t* WT, int dst_row0, int k0, int n0, LAS float* scr, int lane, bool rperm = false) {
#pragma unroll 8
    for (int i = 0; i < 32; ++i) { const int kk = 2 * i + (lane >> 5); scr[kk * 33 + (lane & 31)] = W[(size_t)(k0 + kk) * ldw + n0 + (lane & 31)]; }
    asm volatile("s_waitcnt lgkmcnt(0)" ::: "memory");
    const int c = lane & 7;
#pragma unroll
    for (int j = 0; j < 4; ++j) { const int n = (lane >> 3) + 8 * j; const LAS float* s = scr + (8 * c) * 33 + n;
        u32x4 o; o.x = pk2(s[0 * 33], s[1 * 33]); o.y = pk2(s[2 * 33], s[3 * 33]); o.z = pk2(s[4 * 33], s[5 * 33]); o.w = pk2(s[6 * 33], s[7 * 33]);
        const int nd = rperm ? 8 * (n >> 2) + (n & 3) : n;
        *(u32x4*)(WT + (size_t)(dst_row0 + nd) * K + k0 + 8 * c) = o; }
    asm volatile("s_waitcnt lgkmcnt(0)" ::: "memory");
}
__device__ __forceinline__ void moe_weight_items(const float* w_gate, const float* w_up, const float* w_down, unsigned char* ws, int l, int gw, int ngw, LAS float* scr, int lane, int part  ) {
    bf16_t* WGU = (bf16_t*)(ws + WS_WGU); bf16_t* WD = (bf16_t*)(ws + WS_WD);
    constexpr int I_G = NEXP * 32 * 16, I_D = NEXP * 8 * 64;
    for (int it = (part ? 2 * I_G : 0) + gw; it < (part ? 2 * I_G + I_D : 2 * I_G); it += ngw) {
        if (it < 2 * I_G) { const int up = it >= I_G, r = up ? it - I_G : it, e = r / 512, kb = (r % 512) / 16, nb = r % 16;
            const float* W = (up ? w_up : w_gate) + ((size_t)l * NEXP + e) * DM * EFF;
            const int n0 = nb * 32, row0 = e * 1024 + (n0 >> 7) * 256 + up * 128 + (n0 & 127);
            transpose_item(W, EFF, DM, WGU, row0, kb * 64, n0, scr, lane);
        } else { const int r = it - 2 * I_G, e = r / 512, kb = (r % 512) / 64, nb = r % 64;
            const float* W = w_down + ((size_t)l * NEXP + e) * EFF * DM;
            transpose_item(W, DM, EFF, WD, e * DM + nb * 32, kb * 64, nb * 32, scr, lane); }
    }
}

__device__ __forceinline__ void plain_store(GUnit& u, int ldc) { u.ldc = ldc; u.rs1 = 64 * ldc; u.rs2 = ldc; u.cs = 64; u.nrow = 256; u.bperm = 0; }
struct SchedInProj {
    const char *u0, *win; char *P, *zt2, *ztc; int G, c;
    __device__ __forceinline__ bool next(int i, GUnit& u) const {
        const int L = i * G + c; if (L >= 816 + 544) return false;
        u.lda = DM * 2; u.ldb = DM * 2; u.nt = DM / 64; u.scale = 1.f;
        if (L < 816) { int pm, pn; pg8::tile_of(L, 68, 12, pm, pn);
            u.A = u0 + (size_t)pm * 256 * DM * 2; u.B = win + (size_t)pn * 256 * DM * 2; u.O = P + ((size_t)pm * 256 * 3072 + pn * 256) * 2; plain_store(u, 3072);
        } else { int pm, pn; pg8::tile_of(L - 816, 8, 68, pm, pn);
            u.A = win + (size_t)(3072 + pm * 256) * DM * 2;
            const int g = pm >> 1, part = pm & 1, b = pn / 17, jt = pn % 17;
            if (jt == 0) { u.B = u0 + (size_t)pn * 256 * DM * 2; u.O = ztc + ((size_t)((b * 4 + g) * 256) * 512 + part * 256) * 2; plain_store(u, 512); }
            else { const int tq = jt - 1;
                u.B = u0 + (size_t)(b * TPB + CTX + 4 * tq) * DM * 2;
                u.O = zt2 + (((size_t)((b * 4 + g) * 256) * 64 + 4 * tq) * 128 + part * 64) * 2;
                u.ldc = 8192; u.rs1 = 64 * 8192; u.rs2 = 8192; u.cs = 128; u.nrow = 256; u.bperm = 1; } }
        return true;
    }
};
struct SchedFftA {
    const char *ma, *cmatc, *zt2, *ztc; char *uf, *ycat; int G, c;
    __device__ __forceinline__ bool next(int i, GUnit& u) const {
        const int L = i * G + c; if (L >= 1024 + 16) return false;
        if (L < 1024) { const int w = (L % 8) * 128 + L / 8, bg = w >> 6, chq = w & 63;
            u.A = ma; u.lda = 256; u.B = zt2 + (size_t)((bg * 256 + 4 * chq) * 64) * 256; u.ldb = 256; u.nt = 2;
            u.O = uf + (size_t)(bg * 256 + 4 * chq) * 8192 * 2; u.ldc = 64; u.rs1 = 4096; u.rs2 = 64; u.cs = 8192; u.nrow = 128; u.bperm = 0; u.scale = 1.f;
        } else { const int bg = L - 1024, b = bg >> 2, g = bg & 3;
            u.A = cmatc; u.B = ztc + (size_t)bg * 256 * 1024; u.lda = 1024; u.ldb = 1024; u.nt = 8;
            u.O = ycat + ((size_t)(b * TPB) * DM + 1024 + g * 256) * 2; plain_store(u, DM); u.scale = 1.0f / 256.0f; }
        return true;
    }
};
struct SchedFftB {
    const char *mb, *uf; char* ycat; int G, c;
    __device__ __forceinline__ bool next(int i, GUnit& u) const {
        const int L = i * G + c; if (L >= 256) return false;
        const int w = (L % 8) * 32 + L / 8, bg = w >> 4, kb = w & 15, b = bg >> 2, g = bg & 3;
        u.A = mb + (size_t)kb * 256 * 1024; u.lda = 1024; u.B = uf + ((size_t)bg * 256 * 8192 + kb * 512) * 2; u.ldb = 16384; u.nt = 8;
        u.O = ycat + ((size_t)(b * TPB + CTX + 4 * kb) * DM + 1024 + g * 256) * 2; u.ldc = DM; u.rs1 = DM; u.rs2 = 64 * DM; u.cs = 64; u.nrow = 256; u.bperm = 0; u.scale = 1.0f / 1024.0f;
        return true;
    }
};
struct SchedOut0 {
    const char *ycat, *wout; const float *x, *ctx, *mod; char* h; int G, c;
    __device__ __forceinline__ bool next(int i, GUnit& u) const {
        const int L = i * G + c; if (L >= 68 * 8) return false;
        int pm, pn; pg8::tile_of(L, 68, 8, pm, pn);
        u.A = ycat + (size_t)pm * 256 * DM * 2; u.B = wout + (size_t)pn * 256 * DM * 2; u.lda = DM * 2; u.ldb = DM * 2; u.nt = DM / 64;
        const int b = pm / 17, jt = pm % 17, v = (jt == 0) ? 4 : b;
        u.src = (const char*)((jt == 0 ? ctx + (size_t)b * CTX * DM : x + ((size_t)b * SEQ + (jt - 1) * 256) * DM) + pn * 256);
        u.gate = mod + (size_t)v * MODSZ + 2 * DM + pn * 256;
        u.O = h + ((size_t)pm * 256 * DM + pn * 256) * 2; u.bperm = 0;
        return true;
    }
};
struct SchedOut1 {
    const char *a, *wout; const float* mod; char* h; int G, c;
    __device__ __forceinline__ bool next(int i, GUnit& u) const {
        const int L = i * G + c; if (L >= 64 * 8) return false;
        int lt, pn; pg8::tile_of(L, 64, 8, lt, pn);
        const int b = lt >> 4, ut = b * 17 + 1 + (lt & 15);
        u.A = a + (size_t)ut * 256 * DM * 2; u.B = wout + (size_t)pn * 256 * DM * 2; u.lda = DM * 2; u.ldb = DM * 2; u.nt = DM / 64;
        u.bperm = 0; u.O = h + ((size_t)ut * 256 * DM + pn * 256) * 2; u.src = u.O; u.gate = mod + (size_t)b * MODSZ + 2 * DM + pn * 256;
        return true;
    }
};
struct SchedQKV {
    const char *u1, *wqkv; char *q; int G, c;
    __device__ __forceinline__ bool next(int i, GUnit& u) const {
        const int L = i * G + c; if (L >= 1536 + 64) return false;
        int ut, pn;
        if (L < 1536) { int lt; pg8::tile_of(L, 64, 24, lt, pn); ut = (lt >> 4) * 17 + 1 + (lt & 15); u.gcount = (lt & 15) * 256; }
        else { const int r = L - 1536; ut = (r & 3) * 17; pn = 8 + (r >> 2); u.gcount = -1; }
        u.A = u1 + (size_t)ut * 256 * DM * 2; u.B = wqkv + (size_t)pn * 256 * DM * 2; u.lda = DM * 2; u.ldb = DM * 2; u.nt = DM / 64; u.scale = 1.f; plain_store(u, DM);
        u.aux = pn < 16 ? 1 : 0; if (pn < 16) u.ldc = pn >> 3;
        u.O = q + (size_t)(pn >> 3) * (WS_K - WS_Q) + ((size_t)ut * 256 * DM + (pn & 7) * 256) * 2;
        return true;
    }
};
struct MoeTiles {
    const LAS int* tab;
    __device__ __forceinline__ void init(LAS int* t, const unsigned* cntp) {
        tab = t;
        if (threadIdx.x == 0) { int s = 0;
            for (int e = 0; e < NEXP; ++e) { const int c = (int)cntp[e]; t[e] = c; t[16 + e] = s; s += (c + 255) >> 8; }
            t[32] = s; }
        __syncthreads();
    }
    __device__ __forceinline__ int total() const { return __builtin_amdgcn_readfirstlane(tab[32]); }
    __device__ __forceinline__ void find(int rtg, int& e, int& rt, int& gc) const {
        int ee = 0;
#pragma unroll
        for (int j = 1; j < NEXP; ++j) if (rtg >= tab[16 + j]) ee = j;
        e = __builtin_amdgcn_readfirstlane(ee);
        const int tbe = __builtin_amdgcn_readfirstlane(tab[16 + e]), ce = __builtin_amdgcn_readfirstlane(tab[e]);
        rt = rtg - tbe; gc = ce - rt * 256; if (gc > 256) gc = 256;
    }
};
struct SchedMoe1 {
    MoeTiles T; const char *v, *wgu; char* hid; const int* lst; int G, c;
    __device__ __forceinline__ bool next(int i, GUnit& u) const {
        const int L = i * G + c, nwg = T.total() * 4; if (L >= nwg) return false;
        const int w = pg8::xcd_remap(L, nwg), rtg = w >> 2, pn = w & 3; int e, rt, gc; T.find(rtg, e, rt, gc);
        u.A = v; u.lda = DM * 2; u.glist = lst + (size_t)e * LCAP + rt * 256; u.gcount = gc;
        u.B = wgu + ((size_t)e * 1024 + pn * 256) * DM * 2; u.ldb = DM * 2; u.nt = DM / 64;
        u.O = hid + ((size_t)rtg * 256 * EFF + pn * 128) * 2; u.ldc = EFF; u.bperm = 0;
        return true;
    }
};
struct SchedMoe2 {
    MoeTiles T; const char *hid, *wd; const int* lst; int G, c;
    __device__ __forceinline__ bool next(int i, GUnit& u) const {
        const int L = i * G + c, nwg = T.total() * 8; if (L >= nwg) return false;
        const int w = pg8::xcd_remap(L, nwg), rtg = w >> 3, pn = w & 7; int e, rt, gc; T.find(rtg, e, rt, gc);
        u.A = hid + (size_t)rtg * 256 * EFF * 2; u.lda = EFF * 2; u.B = wd + ((size_t)e * DM + pn * 256) * EFF * 2; u.ldb = EFF * 2; u.nt = EFF / 64;
        u.glist = lst + (size_t)e * LCAP + rt * 256; u.gcount = gc; u.aux = pn; u.bperm = 0;
        return true;
    }
};

__device__ __forceinline__ void row_info(int row, int& b, int& j) { b = row / TPB; j = row - b * TPB; }

__device__ __forceinline__ void norm_mod_store(const f32x4 (&v)[8], float rstd, const float* nw, const float* sc, const float* sh, bf16_t* orow, int lane) {
#pragma unroll
    for (int jj = 0; jj < 8; ++jj) { const int k = 4 * lane + 256 * jj;
        const f32x4 w = *(const f32x4*)(nw + k), s = *(const f32x4*)(sc + k), t = *(const f32x4*)(sh + k);
        const f32x4 y = v[jj] * rstd * w * (1.0f + s) + t;
        u32x2 o; o.x = pk2(y[0], y[1]); o.y = pk2(y[2], y[3]); *(u32x2*)(orow + k) = o; }
}

__device__ __forceinline__ void route_row(const LAS float* yl, const float* wg, const float* bg, const float* we, const float* be, int lane, int& e0, int& e1, float& w0, float& w1) {
    float lg[4] = {0.f, 0.f, 0.f, 0.f}; float le[16];
#pragma unroll
    for (int n = 0; n < 16; ++n) le[n] = 0.f;
#pragma unroll 1
    for (int jj = 0; jj < 8; ++jj) { const f32x4 y4 = *(const LAS f32x4*)(yl + 4 * lane + 256 * jj);
#pragma unroll
        for (int i = 0; i < 4; ++i) { const int k = 4 * lane + 256 * jj + i; const float xv = y4[i];
            const f32x4 g = *(const f32x4*)(wg + (size_t)k * 4);
#pragma unroll
            for (int n = 0; n < 4; ++n) lg[n] = fmaf(xv, g[n], lg[n]);
#pragma unroll
            for (int q = 0; q < 4; ++q) { const f32x4 ev = *(const f32x4*)(we + (size_t)k * 16 + 4 * q);
#pragma unroll
                for (int n = 0; n < 4; ++n) le[4 * q + n] = fmaf(xv, ev[n], le[4 * q + n]); } } }
#pragma unroll
    for (int n = 0; n < 4; ++n) lg[n] = wave_sum(lg[n]) + bg[n];
#pragma unroll
    for (int n = 0; n < 16; ++n) le[n] = wave_sum(le[n]) + be[n];
    int gi = 0; float gm = lg[0];
#pragma unroll
    for (int n = 1; n < 4; ++n) if (lg[n] > gm) { gm = lg[n]; gi = n; }
    float den = 0.f;
#pragma unroll
    for (int n = 0; n < 4; ++n) den += __expf(lg[n] - gm);
    const float gw = 1.0f / den;
    float s[4];
#pragma unroll
    for (int n = 0; n < 4; ++n) { const float m0 = (gi == 0) ? 1.f : 0.f, m1 = (gi == 1) ? 1.f : 0.f, m2 = (gi == 2) ? 1.f : 0.f, m3 = (gi == 3) ? 1.f : 0.f; s[n] = le[n] * m0 + le[4 + n] * m1 + le[8 + n] * m2 + le[12 + n] * m3; }
    int i0 = 0; float v0 = s[0];
#pragma unroll
    for (int n = 1; n < 4; ++n) if (s[n] > v0) { v0 = s[n]; i0 = n; }
    int i1 = -1; float v1 = -3.0e38f;
#pragma unroll
    for (int n = 0; n < 4; ++n) if (n != i0 && s[n] > v1) { v1 = s[n]; i1 = n; }
    const float ex = __expf(v1 - v0), inv = 1.0f / (1.0f + ex);
    e0 = gi * 4 + i0; e1 = gi * 4 + i1; w0 = inv * gw; w1 = ex * inv * gw;
}

#define PHASE_BEGIN KArgsP ka = kargs(); unsigned char* ws = ka->ws; (void)ws; int tid = threadIdx.x; asm volatile("" : "+v"(tid)); const int lane = tid & 63, wave = __builtin_amdgcn_readfirstlane(tid >> 6), gw = blk * NWAVES + wave; (void)lane; (void)gw;
#define ctl ((unsigned*)(ws + WS_CTL))
#define mod ((float*)(ws + WS_MOD))
#define tokw ((float*)(ws + WS_TOKW))
#define list ((int*)(ws + WS_LIST))
#define WIN ((bf16_t*)(ws + WS_WIN))
#define WOUT0 ((bf16_t*)(ws + WS_WOUT0))
#define WQKV ((bf16_t*)(ws + WS_WQKV))
#define WOUT1 ((bf16_t*)(ws + WS_WOUT1))
#define CMAT ((bf16_t*)(ws + WS_CMAT))
#define CMATC ((bf16_t*)(ws + WS_CMATC))
#define H ((bf16_t*)(ws + WS_H))
#define U ((bf16_t*)(ws + WS_U))
#define PB ((bf16_t*)(ws + WS_P))
#define YCAT ((bf16_t*)(ws + WS_YCAT))
#define QB ((bf16_t*)(ws + WS_Q))
#define KB ((bf16_t*)(ws + WS_K))
#define VB ((bf16_t*)(ws + WS_V))
#define AB ((bf16_t*)(ws + WS_A))
#define YB ((bf16_t*)(ws + WS_Y))
#define OB ((bf16_t*)(ws + WS_O))
#ifndef PHMASK
#define PHMASK 0x3ffff
#endif
#define PHON(k) (((PHMASK) >> (k)) & 1)
#define IN(k) (lo <= (k) && (k) < hi)
#ifndef XSYNC
#define XSYNC 0
#endif
#define BARW ((unsigned*)(kargs()->ws + WS_CTL) + 4096)
#define BARST ((volatile LAS unsigned*)(lds + RING_BYTES + 512))
#define SYNC(k) do { if (IN(k) && IN((k) + 1)) { \
        if ((k) == 0) { grid.sync(); if (threadIdx.x == 0) (void)xb_add(&BARW[XB_XCNT(xb_xcc_id())], 1u); }     \
        else xcd_barrier(BARW, BARST); \
        if ((k) == 1) for (int xs_ = 0; xs_ < XSYNC; ++xs_) xcd_barrier(BARW, BARST); } } while (0)
#define TS(k) do { if (PROBE && blockIdx.x == 0 && threadIdx.x == 0) { const unsigned long long t_ = __builtin_amdgcn_s_memrealtime(); unsigned long long* tp_ = (unsigned long long*)(kargs()->ws + WS_CTL + 1024); \
        if ((k) == PA0) tp_[0] = t_; if ((k) == PA1) tp_[1] = t_; if ((k) == PB0) tp_[2] = t_; if ((k) == PB1) tp_[3] = t_; } } while (0)
template <int l>
__device__ __forceinline__ void moe_layer(cg::grid_group& grid, LAS unsigned char* lds, int lo, int hi, int G, int blk) {
    const int pb = (l == 0) ? 5 : 14;
#define cnt (ctl + 32 * l)
#define modl (mod + (size_t)l * 5 * MODSZ)
        TS(pb);
        if (PHON(5) && IN(pb)) REPS(5) { PHASE_BEGIN
            LAS int* ri = (LAS int*)lds;
            LAS float* part = (LAS float*)(lds + 4096);
            LAS float* ssq = (LAS float*)(lds + 16384);
            LAS float* rstdL = (LAS float*)(lds + 16896);
            LAS float* red = (LAS float*)(lds + 17408);
            const int ntiles = (l == 0 ? NTOK : NLAT) / 16, t0 = (ntiles * blk) / G, t1 = (ntiles * (blk + 1)) / G;
            const float* wg = ka->moe_w_group + (size_t)l * DM * 4; const float* bgp = ka->moe_b_group + l * 4;
            const float* we = ka->moe_w_expert + (size_t)l * DM * 16; const float* bep = ka->moe_b_expert + l * 16;
            const float* nw = ka->norm2_w + l * DM;
            const float* cbuf = (const float*)(ctl + 8192) + (size_t)l * 5 * 32;
            const int r = lane & 15, q = lane >> 4, K0 = wave * 256;
            float Be[16][4], Bg[16][4]; int curv = -1;
            for (int t = t0; t < t1; ++t) {
                const int row0 = (l == 0) ? t * 16 : ((t * 16) / SEQ) * TPB + CTX + ((t * 16) % SEQ);
                int b, j; row_info(row0, b, j); const int v = (j < CTX) ? 4 : b;
                const float* mv = modl + (size_t)v * MODSZ;
                if (v != curv) { curv = v;
                    gcf wep = (gcf)(we + (size_t)(K0 + 4 * q) * 16 + r); gcf wgp = (gcf)(wg + (size_t)(K0 + 4 * q) * 4 + (r & 3));
                    gcf nwp = (gcf)(nw + K0 + 4 * q); gcf scp = (gcf)(mv + 4 * DM + K0 + 4 * q); const float gmask = (r < 4) ? 1.f : 0.f;
#pragma unroll
                    for (int c = 0; c < 16; ++c) { const f32x4 w4 = *(const __attribute__((address_space(1))) f32x4*)nwp, s4 = *(const __attribute__((address_space(1))) f32x4*)scp;
#pragma unroll
                        for (int s_ = 0; s_ < 4; ++s_) { const float av = w4[s_] * (1.0f + s4[s_]); Be[c][s_] = av * wep[s_ * 16]; Bg[c][s_] = av * gmask * wgp[s_ * 4]; }
                        wep += 256; wgp += 64; nwp += 16; scp += 16; asm volatile("" : "+v"(wep), "+v"(wgp), "+v"(nwp), "+v"(scp) :: "memory"); } }
                const bf16_t* hrow = H + (size_t)(row0 + r) * DM + K0 + 4 * q;
                f32x4 ae = {0.f, 0.f, 0.f, 0.f}, ag = {0.f, 0.f, 0.f, 0.f}; float ss = 0.f;
#pragma unroll
                for (int hf = 0; hf < 2; ++hf) { f32x4 Av[8];
#pragma unroll
                    for (int c = 0; c < 8; ++c) Av[c] = bf4(*(const u32x2*)(hrow + 16 * (8 * hf + c)));
#pragma unroll
                    for (int c = 0; c < 8; ++c)
#pragma unroll
                        for (int s_ = 0; s_ < 4; ++s_) { const float x = Av[c][s_]; ss = fmaf(x, x, ss);
                            ae = __builtin_amdgcn_mfma_f32_16x16x4f32(x, Be[8 * hf + c][s_], ae, 0, 0, 0); ag = __builtin_amdgcn_mfma_f32_16x16x4f32(x, Bg[8 * hf + c][s_], ag, 0, 0, 0); }
                    asm volatile("" ::: "memory"); }
                ss += __shfl_xor(ss, 16); ss += __shfl_xor(ss, 32);
                if (q == 0) ssq[wave * 16 + r] = ss;
#pragma unroll
                for (int g_ = 0; g_ < 4; ++g_) { part[(wave * 16 + 4 * q + g_) * 20 + r] = ae[g_]; if (r < 4) part[(wave * 16 + 4 * q + g_) * 20 + 16 + r] = ag[g_]; }
                __syncthreads();
                if (tid < 320) { float p = 0.f;
#pragma unroll
                    for (int w = 0; w < 8; ++w) p += part[w * 320 + tid];
                    red[tid] = p; }
                __syncthreads();
                if (tid < 16) { float sum = 0.f;
#pragma unroll
                    for (int w = 0; w < 8; ++w) sum += ssq[w * 16 + tid];
                    const float rstd = rsqrtf(sum * (1.0f / DM) + EPS); rstdL[tid] = rstd;
                    float lg[20];
#pragma unroll
                    for (int n = 0; n < 20; ++n) lg[n] = rstd * red[tid * 20 + n] + cbuf[v * 32 + n];
                    int gi = 0; float gm = lg[16];
#pragma unroll
                    for (int n = 1; n < 4; ++n) if (lg[16 + n] > gm) { gm = lg[16 + n]; gi = n; }
                    float den = 0.f;
#pragma unroll
                    for (int n = 0; n < 4; ++n) den += __expf(lg[16 + n] - gm);
                    const float gwt = 1.0f / den; float sv[4];
#pragma unroll
                    for (int n = 0; n < 4; ++n) { const float m0 = (gi == 0) ? 1.f : 0.f, m1 = (gi == 1) ? 1.f : 0.f, m2 = (gi == 2) ? 1.f : 0.f, m3 = (gi == 3) ? 1.f : 0.f; sv[n] = lg[n] * m0 + lg[4 + n] * m1 + lg[8 + n] * m2 + lg[12 + n] * m3; }
                    int i0 = 0; float v0 = sv[0];
#pragma unroll
                    for (int n = 1; n < 4; ++n) if (sv[n] > v0) { v0 = sv[n]; i0 = n; }
                    int i1 = -1; float v1 = -3.0e38f;
#pragma unroll
                    for (int n = 0; n < 4; ++n) if (n != i0 && sv[n] > v1) { v1 = sv[n]; i1 = n; }
                    const float ex = __expf(v1 - v0), inv = 1.0f / (1.0f + ex);
                    const int row = row0 + tid, ix = (t - t0) * 16 + tid;
                    ri[ix * 4 + 0] = gi * 4 + i0; ri[ix * 4 + 1] = gi * 4 + i1; ri[ix * 4 + 2] = row * 2; ri[ix * 4 + 3] = row * 2 + 1;
                    tokw[row * 2] = inv * gwt; tokw[row * 2 + 1] = ex * inv * gwt; }
                __syncthreads();
                { const float rstd = rstdL[r]; gbf up = (gbf)(U + (size_t)(row0 + r) * DM + K0 + 4 * q); typedef const __attribute__((address_space(1))) bf16_t* gcb; gcb hp = (gcb)hrow;
                    gcf nwp = (gcf)(nw + K0 + 4 * q); gcf scp = (gcf)(mv + 4 * DM + K0 + 4 * q); gcf shp = (gcf)(mv + 3 * DM + K0 + 4 * q);
#pragma unroll
                    for (int c = 0; c < 16; ++c) { typedef const __attribute__((address_space(1))) f32x4* g4; const f32x4 w4 = *(g4)nwp, s4 = *(g4)scp, t4 = *(g4)shp;
                        const f32x4 y = bf4(*(const __attribute__((address_space(1))) u32x2*)hp) * rstd * w4 * (1.0f + s4) + t4;
                        u32x2 o; o.x = pk2(y[0], y[1]); o.y = pk2(y[2], y[3]); *(__attribute__((address_space(1))) u32x2*)up = o;
                        nwp += 16; scp += 16; shp += 16; hp += 16; up += 16;
                        if ((c & 3) == 3) asm volatile("" : "+v"(nwp), "+v"(scp), "+v"(shp), "+v"(hp), "+v"(up) :: "memory"); } }
            }
            __syncthreads();
            const int nrb = (t1 - t0) * 16;
            if (tid < NEXP) { int n = 0;
                for (int i = 0; i < nrb; ++i) { n += (ri[i * 4] == tid) + (ri[i * 4 + 1] == tid); }
                int* lp = list + (rep_ ? (int)((WS_END - WS_LIST) / 4) : 0); const int base = n ? (int)atomicAdd(cnt + 16 * rep_ + tid, (unsigned)n) : 0; int p = 0;
                for (int i = 0; i < nrb; ++i) { if (ri[i * 4] == tid) lp[(size_t)tid * LCAP + base + p++] = ri[i * 4 + 2]; if (ri[i * 4 + 1] == tid) lp[(size_t)tid * LCAP + base + p++] = ri[i * 4 + 3]; } }
            __syncthreads();
        }
        SYNC(pb);
        TS(pb + 1);
        if (PHON(6) && IN(pb + 1)) REPS(6) { PHASE_BEGIN
            SchedMoe1 S; S.T.init((LAS int*)(lds + RING_BYTES), cnt); S.v = (const char*)U; S.wgu = (const char*)(ws + WS_WGU); S.hid = (char*)(ws + WS_HID); S.lst = list; S.G = G; S.c = blk;
            pg8::gemm_phase<SchedMoe1, pg8::EpiSwiGLU, true>(lds, S, pg8::EpiSwiGLU{});
        }
        SYNC(pb + 1);
        TS(pb + 2);
        if (PHON(7) && IN(pb + 2)) REPS(7) { PHASE_BEGIN
            SchedMoe2 S; S.T.init((LAS int*)(lds + RING_BYTES), cnt); S.hid = (const char*)(ws + WS_HID); S.wd = (const char*)(ws + WS_WD); S.lst = list; S.G = G; S.c = blk;
            pg8::gemm_phase<SchedMoe2, pg8::EpiScatter, false>(lds, S, pg8::EpiScatter{YB, tokw});
        }
        SYNC(pb + 2);
}

__global__ void __launch_bounds__(NTHREADS, 2) fwd_kernel(Args a) {
    extern __shared__ __attribute__((aligned(16))) unsigned char lds_raw[];
    LAS unsigned char* lds = (LAS unsigned char*)lds_raw;
    cg::grid_group grid = cg::this_grid();
    const int G = gridDim.x, blk = blockIdx.x, ngw = G * NWAVES;
    const int lo = a.ph_lo, hi = a.ph_hi;
    if (threadIdx.x < 2) ((LAS unsigned*)(lds + RING_BYTES + 512))[threadIdx.x] = 0u;
    __syncthreads();


    TS(0);
    if (PHON(0) && IN(0)) REPS(0) { PHASE_BEGIN
        if (blk == 0) { if (tid < 64) ctl[tid] = 0u;
            for (int i = tid; i < XCD_BAR_WORDS; i += NTHREADS) (ctl + 4096)[i] = 0u; }
        if (blk < 192) {
            LAS float* sil = (LAS float*)lds; LAS float* red = (LAS float*)(lds + 40960);
            for (int i = tid; i < 5 * DM; i += NTHREADS) { const int v = i / DM, k = i % DM; sil[i] = silu_f(v < 4 ? ka->c[v * DM + k] : ka->c_ctx[k]); }
            __syncthreads();
            const int l = blk / 96, j0 = (blk % 96) * 128;
            const float* wp = ka->w_mod + (size_t)l * DM * MODSZ + j0 + 2 * lane;
            f32x2 acc[5];
#pragma unroll
            for (int v = 0; v < 5; ++v) acc[v] = (f32x2){0.f, 0.f};
#pragma unroll 16
            for (int k = wave * 256; k < wave * 256 + 256; ++k) { const f32x2 w = *(const f32x2*)(wp + (size_t)k * MODSZ);
#pragma unroll
                for (int v = 0; v < 5; ++v) { const float s = sil[v * DM + k]; acc[v].x = fmaf(s, w.x, acc[v].x); acc[v].y = fmaf(s, w.y, acc[v].y); } }
#pragma unroll
            for (int v = 0; v < 5; ++v) { red[(wave * 5 + v) * 128 + 2 * lane] = acc[v].x; red[(wave * 5 + v) * 128 + 2 * lane + 1] = acc[v].y; }
            __syncthreads();
            for (int i = tid; i < 5 * 128; i += NTHREADS) { const int v = i / 128, j = i % 128; float s = ka->b_mod[l * MODSZ + j0 + j];
#pragma unroll
                for (int w = 0; w < 8; ++w) s += red[(w * 5 + v) * 128 + j];
                mod[((size_t)l * 5 + v) * MODSZ + j0 + j] = s; }
            __syncthreads();
        }
        LAS float* tab = (LAS float*)(lds + 135168);
        if (tid < 256) tab[tid] = cospif((float)tid * (1.0f / 128.0f));
        __syncthreads();
        LAS float* scr = (LAS float*)(lds + wave * 16384);
        constexpr int I_IN = 32 * 96, I_O0 = 32 * 64;
        for (int it = gw; it < I_IN + I_O0; it += ngw) {
            int r = it;
            if (r < I_IN) { transpose_item(ka->even_w_in, 4096, DM, WIN, (r % 96) * 32, (r / 96) * 64, (r % 96) * 32, scr, lane); continue; } r -= I_IN;
            transpose_item(ka->even_w_out, DM, DM, WOUT0, (r % 64) * 32, (r / 64) * 64, (r % 64) * 32, scr, lane);
        }
        for (int it = gw; it < 8 * 8 * 64; it += ngw) {
            const int gp = it >> 9, m0 = ((it >> 6) & 7) * 32, k0 = (it & 63) * 32, g = gp >> 1, part = gp & 1;
            const int r = lane & 31, hh = lane >> 5;
            f32x16 d = {};
            const float* wrow = ka->even_w_in + (size_t)(k0 + r) * 4096 + 3072 + g * 256 + 8 * hh;
#pragma unroll 4
            for (int j0 = 0; j0 < 256; j0 += 16) {
                const f32x4 b0 = *(const f32x4*)(wrow + j0), b1 = *(const f32x4*)(wrow + j0 + 4);
                u32x4 bw = {pk2(b0[0], b0[1]), pk2(b0[2], b0[3]), pk2(b1[0], b1[1]), pk2(b1[2], b1[3])};
                float av[8];
#pragma unroll
                for (int jj = 0; jj < 8; ++jj) { const int p = ((m0 + r) * (j0 + 8 * hh + jj) - (part ? 64 : 0)) & 255; av[jj] = tab[p]; }
                u32x4 aw = {pk2(av[0], av[1]), pk2(av[2], av[3]), pk2(av[4], av[5]), pk2(av[6], av[7])};
                d = __builtin_amdgcn_mfma_f32_32x32x16_bf16(*reinterpret_cast<bf16x8*>(&aw), *reinterpret_cast<bf16x8*>(&bw), d, 0, 0, 0);
            }
#pragma unroll
            for (int q = 0; q < 16; ++q) { const int row = (q & 3) + 8 * (q >> 2) + 4 * hh;
                WIN[(size_t)(3072 + gp * 256 + m0 + row) * DM + k0 + r] = (bf16_t)f2bf(d[q]); }
        }
        { bf16_t* MA = (bf16_t*)(ws + WS_MA); bf16_t* MB = (bf16_t*)(ws + WS_MB);
          for (int it = gw; it < 256 + 4096 + 256; it += ngw) {
            if (it < 256) { const int r = it & 127, k1 = r >> 1, ri = r & 1;
                for (int col = lane; col < 128; col += 64) { const int part = col >> 6, t1 = col & 63; const float xx = (float)((k1 * t1) & 63) * (1.0f / 32.0f);
                    const float cs = cospif(xx), sn = sinpif(xx); const float val = (ri == 0) ? (part == 0 ? cs : -sn) : (part == 0 ? -sn : -cs);
                    MA[(size_t)it * 128 + col] = (bf16_t)f2bf(val); }
            } else if (it < 256 + 4096) { const int rr = it - 256, kb = rr >> 8, r = rr & 255, k1l = r >> 6, k2 = r & 63, k1 = 4 * kb + k1l;
                const int col0 = lane * 8; float f[8];
#pragma unroll
                for (int i = 0; i < 8; ++i) { const int col = col0 + i, k1l2 = col >> 7, ri = (col >> 6) & 1, t2 = col & 63; const int p = (64 * k2 * t2 + k1 * t2) & 4095; const float xx = (float)p * (1.0f / 2048.0f);
                    f[i] = (k1l2 == k1l) ? (ri ? sinpif(xx) : cospif(xx)) : 0.f; }
                u32x4 o = {pk2(f[0], f[1]), pk2(f[2], f[3]), pk2(f[4], f[5]), pk2(f[6], f[7])};
                *(u32x4*)(MB + (size_t)rr * 512 + col0) = o;
            } else { const int k = it - 256 - 4096; const int col0 = lane * 8, part = col0 >> 8, t0 = col0 & 255; float f[8];
#pragma unroll
                for (int i = 0; i < 8; ++i) { const int p = (k * (t0 + i)) & 255; const float xx = (float)p * (1.0f / 128.0f); f[i] = part ? -sinpif(xx) : cospif(xx); }
                u32x4 o = {pk2(f[0], f[1]), pk2(f[2], f[3]), pk2(f[4], f[5]), pk2(f[6], f[7])};
                *(u32x4*)(CMATC + (size_t)k * 512 + col0) = o; }
          } }
    }
    SYNC(0);

    TS(1);
    if (PHON(1) && IN(1)) REPS(1) { PHASE_BEGIN
        if (gw < 200) { const int l_ = gw / 100, v_ = (gw % 100) / 20, n_ = gw % 20;
            const float* sh = mod + ((size_t)l_ * 5 + v_) * MODSZ + 3 * DM; float acc_ = 0.f;
            for (int k = lane; k < DM; k += 64) acc_ += sh[k] * (n_ < 16 ? ka->moe_w_expert[((size_t)l_ * DM + k) * 16 + n_] : ka->moe_w_group[((size_t)l_ * DM + k) * 4 + (n_ - 16)]);
            acc_ = wave_sum(acc_);
            if (lane == 0) ((float*)(ctl + 8192))[(l_ * 5 + v_) * 32 + n_] = acc_ + (n_ < 16 ? ka->moe_b_expert[l_ * 16 + n_] : ka->moe_b_group[l_ * 4 + n_ - 16]); }
        { const int np = NTOK / 2, p0 = (int)(((long)np * gw) / ngw), p1 = (int)(((long)np * (gw + 1)) / ngw);
#define P1_SRC(p_) ({ int b_, j_; row_info(2 * (p_), b_, j_); (j_ < CTX) ? ka->ctx + ((size_t)b_ * CTX + j_) * DM : ka->x + ((size_t)b_ * SEQ + (j_ - CTX)) * DM; })
          f32x4 va[8], vb[8], na[8], nb[8];
          if (p0 < p1) { const float* src = P1_SRC(p0);
#pragma unroll
            for (int jj = 0; jj < 8; ++jj) { va[jj] = *(const f32x4*)(src + 4 * lane + 256 * jj); vb[jj] = *(const f32x4*)(src + DM + 4 * lane + 256 * jj); } }
          for (int p = p0; p < p1; ++p) { const int row = 2 * p; int b, j; row_info(row, b, j);
            const float* mv = mod + (size_t)(j < CTX ? 4 : b) * MODSZ;
            if (p + 1 < p1) { const float* src = P1_SRC(p + 1);
#pragma unroll
                for (int jj = 0; jj < 8; ++jj) { na[jj] = *(const f32x4*)(src + 4 * lane + 256 * jj); nb[jj] = *(const f32x4*)(src + DM + 4 * lane + 256 * jj); } }
            float sa = 0.f, sb = 0.f;
#pragma unroll
            for (int jj = 0; jj < 8; ++jj) { sa += va[jj][0] * va[jj][0] + va[jj][1] * va[jj][1] + va[jj][2] * va[jj][2] + va[jj][3] * va[jj][3]; sb += vb[jj][0] * vb[jj][0] + vb[jj][1] * vb[jj][1] + vb[jj][2] * vb[jj][2] + vb[jj][3] * vb[jj][3]; }
#pragma unroll
            for (int o_ = 1; o_ < 64; o_ <<= 1) { sa += __shfl_xor(sa, o_); sb += __shfl_xor(sb, o_); }
            const float ra = rsqrtf(sa * (1.0f / DM) + EPS), rb = rsqrtf(sb * (1.0f / DM) + EPS);
            bf16_t* oa = U + (size_t)row * DM; bf16_t* ob = oa + DM;
#pragma unroll
            for (int jj = 0; jj < 8; ++jj) { const int k = 4 * lane + 256 * jj;
                const f32x4 w = *(const f32x4*)(ka->norm1_w + k), sc = *(const f32x4*)(mv + DM + k), t = *(const f32x4*)(mv + k); const f32x4 aw = w * (1.0f + sc);
                const f32x4 ya = va[jj] * ra * aw + t, yb = vb[jj] * rb * aw + t;
                u32x2 o; o.x = pk2(ya[0], ya[1]); o.y = pk2(ya[2], ya[3]); *(u32x2*)(oa + k) = o; o.x = pk2(yb[0], yb[1]); o.y = pk2(yb[2], yb[3]); *(u32x2*)(ob + k) = o; }
#pragma unroll
            for (int jj = 0; jj < 8; ++jj) { va[jj] = na[jj]; vb[jj] = nb[jj]; }
          }
#undef P1_SRC
        }
    }
    SYNC(1);

    TS(2);
    if (PHON(2) && IN(2)) REPS(2) { PHASE_BEGIN
        SchedInProj S{(const char*)U, (const char*)WIN, (char*)PB, (char*)(ws + WS_ZTL), (char*)(ws + WS_ZTC), G, blk};
        pg8::gemm_phase<SchedInProj, pg8::EpiStore, false>(lds, S, pg8::EpiStore{});
        if (blk >= (816 + 544) % 256) {
            const int ib = blk - (816 + 544) % 256, nib = G - (816 + 544) % 256;
            moe_weight_items(ka->moe_w_gate, ka->moe_w_up, ka->moe_w_down, ws, 0, ib * NWAVES + wave, nib * NWAVES, (LAS float*)(lds + wave * 16384), lane, 0); }
    }
    SYNC(2);

    TS(3);
    if (PHON(3) && IN(3)) REPS(3) { PHASE_BEGIN
        for (int it = blk * NTHREADS + tid; it < (NTOK / 16) * 128; it += G * NTHREADS) {
            const int chunk = it >> 7, oct = it & 127, r0 = chunk * 16, jm = r0 % TPB, ch0 = oct * 8;
            const bool hasprev = (jm != 0 && jm != CTX), hasnext = (((jm + 16) % TPB) != 0 && (jm + 16) != CTX);
            float w0[8], w1[8], w2[8];
#pragma unroll
            for (int i = 0; i < 8; ++i) { w0[i] = ka->even_conv_w[ch0 + i]; w1[i] = ka->even_conv_w[1024 + ch0 + i]; w2[i] = ka->even_conv_w[2048 + ch0 + i]; }
            float cp[8], cc[8], cn[8];
#define LOADCV(row_, o) do { const u32x4 cg_ = *(const u32x4*)(PB + (size_t)(row_) * 3072 + 1024 + ch0), vi = *(const u32x4*)(PB + (size_t)(row_) * 3072 + 2048 + ch0); \
                o[0] = bflo(cg_.x) * bflo(vi.x); o[1] = bfhi(cg_.x) * bfhi(vi.x); o[2] = bflo(cg_.y) * bflo(vi.y); o[3] = bfhi(cg_.y) * bfhi(vi.y); \
                o[4] = bflo(cg_.z) * bflo(vi.z); o[5] = bfhi(cg_.z) * bfhi(vi.z); o[6] = bflo(cg_.w) * bflo(vi.w); o[7] = bfhi(cg_.w) * bfhi(vi.w); } while (0)
            if (hasprev) LOADCV(r0 - 1, cp); else {
#pragma unroll
                for (int i = 0; i < 8; ++i) cp[i] = 0.f; }
            LOADCV(r0, cc);
            for (int rr = 0; rr < 16; ++rr) { const int row = r0 + rr;
                if (rr < 15 || hasnext) LOADCV(row + 1, cn); else {
#pragma unroll
                    for (int i = 0; i < 8; ++i) cn[i] = 0.f; }
                const u32x4 bg = *(const u32x4*)(PB + (size_t)row * 3072 + ch0);
                float bb[8] = {bflo(bg.x), bfhi(bg.x), bflo(bg.y), bfhi(bg.y), bflo(bg.z), bfhi(bg.z), bflo(bg.w), bfhi(bg.w)}; float y[8];
#pragma unroll
                for (int i = 0; i < 8; ++i) y[i] = bb[i] * (w0[i] * cp[i] + w1[i] * cc[i] + w2[i] * cn[i]);
                u32x4 o = {pk2(y[0], y[1]), pk2(y[2], y[3]), pk2(y[4], y[5]), pk2(y[6], y[7])};
                *(u32x4*)(YCAT + (size_t)row * DM + ch0) = o;
#pragma unroll
                for (int i = 0; i < 8; ++i) { cp[i] = cc[i]; cc[i] = cn[i]; } }
        }
        { SchedFftA S{(const char*)(ws + WS_MA), (const char*)CMATC, (const char*)(ws + WS_ZTL), (const char*)(ws + WS_ZTC), (char*)(ws + WS_UF), (char*)YCAT, G, blk};
          pg8::gemm_phase<SchedFftA, pg8::EpiStore, false>(lds, S, pg8::EpiStore{}); }
        xcd_barrier(BARW, BARST);
        { SchedFftB S{(const char*)(ws + WS_MB), (const char*)(ws + WS_UF), (char*)YCAT, G, blk};
          pg8::gemm_phase<SchedFftB, pg8::EpiStore, false>(lds, S, pg8::EpiStore{}); }
    }
    SYNC(3);

    TS(4);
    if (PHON(4) && IN(4)) REPS(4) { PHASE_BEGIN
        SchedOut0 S{(const char*)YCAT, (const char*)WOUT0, ka->x, ka->ctx, mod, (char*)H, G, blk};
        pg8::gemm_phase<SchedOut0, pg8::EpiResid<false>, false>(lds, S, pg8::EpiResid<false>{});
        if (blk >= (68 * 8) % 256) {
            const int ib = blk - (68 * 8) % 256, nib = G - (68 * 8) % 256; LAS float* scr = (LAS float*)(lds + wave * 16384);
            constexpr int I_QKV = 32 * 192, I_O1 = 32 * 64;
            for (int it = ib * NWAVES + wave; it < I_QKV + I_O1; it += nib * NWAVES) {
                if (it < I_QKV) { const int n0 = (it % 192) * 32; const bool qk = n0 < 4096; const int d0_ = n0 & 127;
                    const int row0 = qk ? (n0 & ~127) + (d0_ >> 6) * 64 + ((d0_ >> 5) & 1) * 4 : n0;
                    transpose_item(ka->odd_w_qkv, 6144, DM, WQKV, row0, (it / 192) * 64, n0, scr, lane, qk); }
                else { const int r = it - I_QKV; transpose_item(ka->odd_w_out, DM, DM, WOUT1, (r % 64) * 32, (r / 64) * 64, (r % 64) * 32, scr, lane); } }
            moe_weight_items(ka->moe_w_gate, ka->moe_w_up, ka->moe_w_down, ws, 0, ib * NWAVES + wave, nib * NWAVES, scr, lane, 1); }
    }
    SYNC(4);

    moe_layer<0>(grid, lds, lo, hi, G, blk);
    { constexpr int l = 0; (void)l;
            TS(8);
    if (PHON(8) && IN(8)) { PHASE_BEGIN
                const float* mod1 = mod + (size_t)5 * MODSZ;
                { const int np = NTOK / 2, p0 = (int)(((long)np * gw) / ngw), p1 = (int)(((long)np * (gw + 1)) / ngw);
                  for (int p = p0; p < p1; ++p) { const int row = 2 * p; int b, j; row_info(row, b, j); const int vr = (j < CTX) ? 4 : b;
                    const float* g2 = modl + (size_t)vr * MODSZ + 5 * DM; const float* mv1 = mod1 + (size_t)vr * MODSZ;
                    bf16_t* hrow = H + (size_t)row * DM; const bf16_t* y0 = YB + (size_t)(row * 2) * DM;
                    u32x2 ha[8], hb[8], ya0[8], ya1[8], yb0[8], yb1[8];
#pragma unroll
                    for (int jj = 0; jj < 8; ++jj) { const int k = 4 * lane + 256 * jj; ha[jj] = *(const u32x2*)(hrow + k); hb[jj] = *(const u32x2*)(hrow + DM + k);
                        ya0[jj] = *(const u32x2*)(y0 + k); ya1[jj] = *(const u32x2*)(y0 + DM + k); yb0[jj] = *(const u32x2*)(y0 + 2 * DM + k); yb1[jj] = *(const u32x2*)(y0 + 3 * DM + k); }
                    f32x4 va[8], vb[8]; float sa = 0.f, sb = 0.f;
#pragma unroll
                    for (int jj = 0; jj < 8; ++jj) { const int k = 4 * lane + 256 * jj; const f32x4 g = *(const f32x4*)(g2 + k);
                        va[jj] = bf4(ha[jj]) + g * (bf4(ya0[jj]) + bf4(ya1[jj])); vb[jj] = bf4(hb[jj]) + g * (bf4(yb0[jj]) + bf4(yb1[jj]));
                        u32x2 ho; ho.x = pk2(va[jj][0], va[jj][1]); ho.y = pk2(va[jj][2], va[jj][3]); *(u32x2*)(hrow + k) = ho;
                        ho.x = pk2(vb[jj][0], vb[jj][1]); ho.y = pk2(vb[jj][2], vb[jj][3]); *(u32x2*)(hrow + DM + k) = ho;
                        sa += va[jj][0] * va[jj][0] + va[jj][1] * va[jj][1] + va[jj][2] * va[jj][2] + va[jj][3] * va[jj][3];
                        sb += vb[jj][0] * vb[jj][0] + vb[jj][1] * vb[jj][1] + vb[jj][2] * vb[jj][2] + vb[jj][3] * vb[jj][3]; }
#pragma unroll
                    for (int o_ = 1; o_ < 64; o_ <<= 1) { sa += __shfl_xor(sa, o_); sb += __shfl_xor(sb, o_); }
                    const float ra = rsqrtf(sa * (1.0f / DM) + EPS), rb = rsqrtf(sb * (1.0f / DM) + EPS);
                    bf16_t* oa = U + (size_t)row * DM; bf16_t* ob = oa + DM; const float* nw1 = ka->norm1_w + DM;
#pragma unroll
                    for (int jj = 0; jj < 8; ++jj) { const int k = 4 * lane + 256 * jj;
                        const f32x4 w = *(const f32x4*)(nw1 + k), sc = *(const f32x4*)(mv1 + DM + k), t = *(const f32x4*)(mv1 + k); const f32x4 aw = w * (1.0f + sc);
                        const f32x4 ya = va[jj] * ra * aw + t, yb = vb[jj] * rb * aw + t;
                        u32x2 o; o.x = pk2(ya[0], ya[1]); o.y = pk2(ya[2], ya[3]); *(u32x2*)(oa + k) = o; o.x = pk2(yb[0], yb[1]); o.y = pk2(yb[2], yb[3]); *(u32x2*)(ob + k) = o; }
                  } }
            }
            SYNC(8);
            TS(9);
    if (PHON(9) && IN(9)) REPS(9) { PHASE_BEGIN
                SchedQKV S{(const char*)U, (const char*)WQKV, (char*)QB, G, blk};
                pg8::gemm_phase<SchedQKV, pg8::EpiQKV, false>(lds, S, pg8::EpiQKV{ka->odd_q_norm, ka->odd_k_norm, (LAS float*)(lds + RING_BYTES + 2048)});
                if (blk >= (1536 + 64) % 256) {
                    const int ib = blk - (1536 + 64) % 256, nib = G - (1536 + 64) % 256;
                    moe_weight_items(ka->moe_w_gate, ka->moe_w_up, ka->moe_w_down, ws, 1, ib * NWAVES + wave, nib * NWAVES, (LAS float*)(lds + wave * 16384), lane, 0); }
            }
            SYNC(9);
            TS(11);
    if (PHON(11) && IN(11)) REPS(11) { PHASE_BEGIN
                const int vcu = (blk % 8) * (G / 8) + blk / 8;
                float mq = fmaxf(fabsf(ka->odd_q_norm[lane]), fabsf(ka->odd_q_norm[lane + 64])), mk = fmaxf(fabsf(ka->odd_k_norm[lane]), fabsf(ka->odd_k_norm[lane + 64]));
#pragma unroll
                for (int o_ = 1; o_ < 64; o_ <<= 1) { mq = fmaxf(mq, __shfl_xor(mq, o_)); mk = fmaxf(mk, __shfl_xor(mk, o_)); }
                const float mnC = -(128.0f * att::SCALE * mq * mk) * 1.4426950408889634f;
                for (int U0 = vcu; U0 < 2048; U0 += G) {
                    const int combo = U0 >> 5, qb = U0 & 31, cp_ = combo & 1, hh = (combo >> 1) & 7, b = combo >> 4;
                    const bf16_t* Qp = QB + (size_t)(b * TPB + CTX + qb * 128) * DM + hh * 256 + cp_ * 128;
                    const bf16_t* Kp = KB + (size_t)(b * TPB) * DM + hh * 256 + cp_ * 128;
                    const bf16_t* Vp = VB + (size_t)(b * TPB) * DM + hh * 256;
                    bf16_t* Op = OB + (size_t)(b * SEQ + qb * 128) * (2 * DM) + cp_ * DM + hh * 256;
                    att::attn_pair_body(Qp, Kp, Vp, Op, TPB, (char*)lds_raw, mnC);
                }
            }
            SYNC(11);
            TS(12);
    if (PHON(12) && IN(12)) REPS(12) { PHASE_BEGIN
                float d1 = ka->lq1[lane] * ka->lk1[lane] + ka->lq1[lane + 64] * ka->lk1[lane + 64], d2 = ka->lq2[lane] * ka->lk2[lane] + ka->lq2[lane + 64] * ka->lk2[lane + 64];
                d1 = wave_sum(d1); d2 = wave_sum(d2);
                const float lam_init = 0.8f - 0.6f * expf(-0.3f * 1.0f);
                const float lam = expf(d1) - expf(d2) + lam_init;
                const int hh = lane >> 3, e0 = (lane & 7) * 32;
                for (int li = gw; li < NLAT; li += ngw) {
                    const bf16_t* o1 = OB + (size_t)li * (2 * DM) + hh * 256 + e0; const bf16_t* o2 = o1 + DM;
                    float ov[32]; float ss = 0.f;
#pragma unroll
                    for (int s = 0; s < 4; ++s) { const u32x4 p1 = *(const u32x4*)(o1 + 8 * s), p2 = *(const u32x4*)(o2 + 8 * s);
                        ov[8 * s + 0] = bflo(p1.x) - lam * bflo(p2.x); ov[8 * s + 1] = bfhi(p1.x) - lam * bfhi(p2.x); ov[8 * s + 2] = bflo(p1.y) - lam * bflo(p2.y); ov[8 * s + 3] = bfhi(p1.y) - lam * bfhi(p2.y);
                        ov[8 * s + 4] = bflo(p1.z) - lam * bflo(p2.z); ov[8 * s + 5] = bfhi(p1.z) - lam * bfhi(p2.z); ov[8 * s + 6] = bflo(p1.w) - lam * bflo(p2.w); ov[8 * s + 7] = bfhi(p1.w) - lam * bfhi(p2.w); }
#pragma unroll
                    for (int i = 0; i < 32; ++i) ss += ov[i] * ov[i];
                    ss += __shfl_xor(ss, 1); ss += __shfl_xor(ss, 2); ss += __shfl_xor(ss, 4);
                    const float rs = rsqrtf(ss * (1.0f / 256.0f) + EPS) * (1.0f - lam_init);
                    const int row = (li / SEQ) * TPB + CTX + (li % SEQ);
                    bf16_t* ap = AB + (size_t)row * DM + hh * 256 + e0;
#pragma unroll
                    for (int s = 0; s < 4; ++s) { float y[8];
#pragma unroll
                        for (int i = 0; i < 8; ++i) y[i] = ov[8 * s + i] * rs * ka->subln_w[e0 + 8 * s + i];
                        u32x4 o = {pk2(y[0], y[1]), pk2(y[2], y[3]), pk2(y[4], y[5]), pk2(y[6], y[7])}; *(u32x4*)(ap + 8 * s) = o; }
                }
                moe_weight_items(ka->moe_w_gate, ka->moe_w_up, ka->moe_w_down, ws, 1, gw, ngw, (LAS float*)(lds + wave * 16384), lane, 1);
            }
            SYNC(12);
            TS(13);
    if (PHON(13) && IN(13)) { PHASE_BEGIN
                SchedOut1 S{(const char*)AB, (const char*)WOUT1, mod + (size_t)5 * MODSZ, (char*)H, G, blk};
                pg8::gemm_phase<SchedOut1, pg8::EpiResid<true>, false>(lds, S, pg8::EpiResid<true>{});
            }
            SYNC(13);
    }
    moe_layer<1>(grid, lds, lo, hi, G, blk);
    { constexpr int l = 1; (void)l;
            TS(17);
    if (PHON(17) && IN(17)) REPS(17) { PHASE_BEGIN
                { const int np = NLAT / 2, p0 = (int)(((long)np * gw) / ngw), p1 = (int)(((long)np * (gw + 1)) / ngw);
                  for (int p = p0; p < p1; ++p) { const int li = 2 * p, b = li / SEQ, row = b * TPB + CTX + (li % SEQ);
                    const float* g2 = modl + (size_t)b * MODSZ + 5 * DM; const bf16_t* hrow = H + (size_t)row * DM; const bf16_t* y0 = YB + (size_t)(row * 2) * DM;
                    float* orow = ka->out + (size_t)li * DM;
                    u32x2 ha[8], hb[8], ya0[8], ya1[8], yb0[8], yb1[8];
#pragma unroll
                    for (int jj = 0; jj < 8; ++jj) { const int k = 4 * lane + 256 * jj; ha[jj] = *(const u32x2*)(hrow + k); hb[jj] = *(const u32x2*)(hrow + DM + k);
                        ya0[jj] = *(const u32x2*)(y0 + k); ya1[jj] = *(const u32x2*)(y0 + DM + k); yb0[jj] = *(const u32x2*)(y0 + 2 * DM + k); yb1[jj] = *(const u32x2*)(y0 + 3 * DM + k); }
#pragma unroll
                    for (int jj = 0; jj < 8; ++jj) { const int k = 4 * lane + 256 * jj; const f32x4 g = *(const f32x4*)(g2 + k);
                        f32x4 ra = bf4(ha[jj]) + g * (bf4(ya0[jj]) + bf4(ya1[jj])), rb = bf4(hb[jj]) + g * (bf4(yb0[jj]) + bf4(yb1[jj]));
#if PROBE
                        { const unsigned long long* tp_ = (const unsigned long long*)(ws + WS_CTL + 1024); const float c2 = (float)(tp_[3] - tp_[2]) * 1e-4f, w1 = (float)(tp_[1] - tp_[0]) * 1e-2f;
                          ra = (f32x4){c2, c2, c2, c2}; rb = ra; if (li == 0 && k == 0) ra[0] = w1; }
#endif
                        *(f32x4*)(orow + k) = ra; *(f32x4*)(orow + DM + k) = rb; }
                  } }
            }
    }
    TS(18);
#undef IN
#undef SYNC
#undef cnt
#undef modl
#undef ctl
#undef mod
#undef tokw
#undef list
#undef WIN
#undef WOUT0
#undef WQKV
#undef WOUT1
#undef CMAT
#undef CMATC
#undef H
#undef U
#undef PB
#undef YCAT
#undef QB
#undef KB
#undef VB
#undef AB
#undef YB
#undef OB
}

#ifndef N_LAUNCH_MODE
#define N_LAUNCH_MODE 1
#endif
extern "C" void kernel_launch(void* const* d_in, const int* in_sizes, int n_in, void* d_out, int out_size, void* d_ws, size_t ws_size, hipStream_t stream) {
    static int grid = 0;
    if (grid == 0) {
        if (n_in != 27 || out_size != NLAT * DM || ws_size < WS_END) { fprintf(stderr, "kernel_launch: unexpected shapes: n_in %d out %d ws %zu (need %zu)\n", n_in, out_size, ws_size, (size_t)WS_END); grid = -1; return; }
        int dev = 0, cus = 0, per_cu = 0;
        hipGetDevice(&dev); hipDeviceGetAttribute(&cus, hipDeviceAttributeMultiprocessorCount, dev);
        if (hipFuncSetAttribute((const void*)fwd_kernel, hipFuncAttributeMaxDynamicSharedMemorySize, LDS_BYTES) != hipSuccess) { fprintf(stderr, "kernel_launch: hipFuncSetAttribute failed\n"); grid = -1; return; }
        if (hipOccupancyMaxActiveBlocksPerMultiprocessor(&per_cu, (const void*)fwd_kernel, NTHREADS, LDS_BYTES) != hipSuccess || per_cu < 1) { fprintf(stderr, "kernel_launch: occupancy query says %d\n", per_cu); per_cu = 1; }
        (void)hipGetLastError();
        grid = cus;
        if (grid != 256) fprintf(stderr, "kernel_launch: note: %d CUs\n", grid);
    }
    if (grid < 0) return;
    Args a{};
    const float** ap = (const float**)&a;
    for (int i = 0; i < 27; ++i) ap[i] = (const float*)d_in[i];
    a.out = (float*)d_out; a.ws = (unsigned char*)d_ws;
#if N_LAUNCH_MODE == 1
    a.ph_lo = 0; a.ph_hi = 18;
    void* args[] = {&a};
    hipError_t e = hipLaunchCooperativeKernel((const void*)fwd_kernel, dim3(grid), dim3(NTHREADS), args, LDS_BYTES, stream);
    if (e != hipSuccess) fprintf(stderr, "cooperative launch failed: %s (grid %d)\n", hipGetErrorString(e), grid);
#else
    for (int p = 0; p < 18; ++p) { a.ph_lo = p; a.ph_hi = p + 1; void* args[] = {&a};
        hipError_t e = hipLaunchCooperativeKernel((const void*)fwd_kernel, dim3(grid), dim3(NTHREADS), args, LDS_BYTES, stream);
        if (e != hipSuccess) { fprintf(stderr, "launch %d failed: %s\n", p, hipGetErrorString(e)); break; } }
#endif
}
```
